# Optimizing an MI355X kernel written in HIP

```python
import math
import numpy as np
import jax
import jax.numpy as jnp
from jax import lax

D_MODEL = 1024
BATCH = 1
SEQ = 16384
DEPTH = 1
DEC_BATCH = 4
DEC_SEQ = 8192
PAST_LEN = 128

HEAD_DIM = 64
N_HEADS_TOTAL = D_MODEL // HEAD_DIM
N_HEADS_M = 4
N_HEADS_A = (N_HEADS_TOTAL - N_HEADS_M) // 2
N_HEADS_B = N_HEADS_TOTAL - N_HEADS_M - N_HEADS_A
WIDTH_A = N_HEADS_A * HEAD_DIM
WIDTH_B = N_HEADS_B * HEAD_DIM
WIDTH_M = N_HEADS_M * HEAD_DIM
MIX_WIDTH = WIDTH_A + WIDTH_B + WIDTH_M
IN_WIDTH = 3 * WIDTH_A + 3 * WIDTH_B + WIDTH_M
DILATED_PATTERNS = ((128, 1), (512, 4), (2048, 16))
GRID_W = 64
NA_ROWS = 8
NA_COLS = 16
N_MEM = 256
D_FF = 4 * D_MODEL
ROPE_THETA = 500000.0
ROPE_DIMS = HEAD_DIM // 4
EPS = 1e-6
NEG_INF = -1e30

kernel_name = "hybrid_dilated_natten_memory_encoder"


def rmsnorm(x, g):
    xf = x.astype(jnp.float32)
    y = xf * lax.rsqrt(jnp.mean(xf * xf, axis=-1, keepdims=True) + EPS)
    return (y * g.astype(jnp.float32)).astype(x.dtype)


def partial_rope(x, pos):
    half = ROPE_DIMS // 2
    inv = ROPE_THETA ** (-(jnp.arange(half, dtype=jnp.float32) * 2.0 / ROPE_DIMS))
    ang = pos[:, None] * inv[None, :]
    cos = jnp.cos(ang)[None, :, None, :]
    sin = jnp.sin(ang)[None, :, None, :]
    xf = x.astype(jnp.float32)
    x1 = xf[..., :half]
    x2 = xf[..., half:ROPE_DIMS]
    rot = jnp.concatenate([x1 * cos - x2 * sin, x2 * cos + x1 * sin, xf[..., ROPE_DIMS:]], axis=-1)
    return rot.astype(x.dtype)


def local_window_attention(q, k, v, half):
    n, L, h, d = q.shape
    bq = half
    nb = -(-L // bq)
    lp = nb * bq
    qp = jnp.pad(q, ((0, 0), (0, lp - L), (0, 0), (0, 0))).reshape(n, nb, bq, h, d)
    pad_kv = ((0, 0), (half, lp - L + half), (0, 0), (0, 0))
    kp = jnp.pad(k, pad_kv).reshape(n, nb + 2, bq, h, d)
    vp = jnp.pad(v, pad_kv).reshape(n, nb + 2, bq, h, d)
    kb = jnp.concatenate([kp[:, :nb], kp[:, 1:nb + 1], kp[:, 2:nb + 2]], axis=2)
    vb = jnp.concatenate([vp[:, :nb], vp[:, 1:nb + 1], vp[:, 2:nb + 2]], axis=2)
    qpos = np.arange(lp).reshape(nb, bq)
    kpos = np.arange(nb)[:, None] * bq + np.arange(3 * bq)[None, :] - half
    dist = kpos[:, None, :] - qpos[:, :, None]
    mask = (np.abs(dist) <= half) & (kpos[:, None, :] >= 0) & (kpos[:, None, :] < L)
    s = jnp.einsum('nbqhd,nbkhd->nhbqk', qp, kb).astype(jnp.float32) * (d ** -0.5)
    s = jnp.where(mask[None, None], s, NEG_INF)
    lse = jax.nn.logsumexp(s, axis=-1)
    p = jnp.exp(s - lse[..., None]).astype(v.dtype)
    o = jnp.einsum('nhbqk,nbkhd->nbqhd', p, vb).reshape(n, lp, h, d)[:, :L]
    lse = lse.transpose(0, 2, 3, 1).reshape(n, lp, h)[:, :L]
    return o, lse


def dilated_attention(q, k, v):
    b, t, h, d = q.shape
    outs = []
    lses = []
    for window, dil in DILATED_PATTERNS:
        half = window // (2 * dil)
        L = t // dil
        def to_res(z):
            return z.reshape(b, L, dil, h, d).transpose(0, 2, 1, 3, 4).reshape(b * dil, L, h, d)
        o, lse = local_window_attention(to_res(q), to_res(k), to_res(v), half)
        outs.append(o.reshape(b, dil, L, h, d).transpose(0, 2, 1, 3, 4).reshape(b, t, h, d))
        lses.append(lse.reshape(b, dil, L, h).transpose(0, 2, 1, 3).reshape(b, t, h))
    w = jax.nn.softmax(jnp.stack(lses, axis=0), axis=0)
    o = jnp.sum(w[..., None] * jnp.stack(outs, axis=0).astype(jnp.float32), axis=0)
    return o.astype(q.dtype)


def neighbourhood_attention(q, k, v, rpb):
    b, t, h, d = q.shape
    rows = t // GRID_W
    kr = min(NA_ROWS, rows)
    row_start = np.clip(np.arange(rows) - kr // 2, 0, rows - kr)
    col_start = np.clip(np.arange(GRID_W) - NA_COLS // 2, 0, GRID_W - NA_COLS)
    col_idx = col_start[:, None] + np.arange(NA_COLS)[None, :]
    dcol = col_idx - np.arange(GRID_W)[:, None] + NA_COLS - 1
    drow = row_start[:, None] + np.arange(kr)[None, :] - np.arange(rows)[:, None] + NA_ROWS - 1
    bias_col = rpb[:, :, dcol]
    qg = q.reshape(b, rows, GRID_W, h, d)
    kg = k.reshape(b, rows, GRID_W, h, d)
    vg = v.reshape(b, rows, GRID_W, h, d)
    scale = d ** -0.5

    def one_row(args):
        q_row, r0, dr = args
        k_rows = lax.dynamic_slice_in_dim(kg, r0, kr, axis=1)
        v_rows = lax.dynamic_slice_in_dim(vg, r0, kr, axis=1)
        k_win = k_rows[:, :, col_idx]
        v_win = v_rows[:, :, col_idx]
        s = jnp.einsum('bchd,bicjhd->bhcij', q_row, k_win).astype(jnp.float32) * scale
        bias = bias_col[:, dr].transpose(0, 2, 1, 3).astype(jnp.float32)
        s = s + bias[None]
        p = jax.nn.softmax(s.reshape(b, h, GRID_W, kr * NA_COLS), axis=-1)
        p = p.reshape(b, h, GRID_W, kr, NA_COLS).astype(v.dtype)
        return jnp.einsum('bhcij,bicjhd->bchd', p, v_win)

    out = lax.map(one_row, (qg.transpose(1, 0, 2, 3, 4),
                            jnp.asarray(row_start, dtype=jnp.int32),
                            jnp.asarray(drow, dtype=jnp.int32)))
    return out.transpose(1, 0, 2, 3, 4).reshape(b, t, h, d)


def memory_attention(q, mem, norm_mem, w_mem_kv, k_norm_m):
    b, m, _ = mem.shape
    kv = (rmsnorm(mem, norm_mem) @ w_mem_kv).reshape(b, m, 2, N_HEADS_M, HEAD_DIM)
    k = rmsnorm(kv[:, :, 0], k_norm_m)
    v = kv[:, :, 1]
    s = jnp.einsum('bthd,bmhd->bhtm', q, k).astype(jnp.float32) * (HEAD_DIM ** -0.5)
    p = jax.nn.softmax(s, axis=-1).astype(v.dtype)
    return jnp.einsum('bhtm,bmhd->bthd', p, v)


def encoder_layer(x, mem, norm_attn, w_in, q_norm_a, k_norm_a, q_norm_b, k_norm_b, rpb_b,
                  norm_mem, w_mem_kv, q_norm_m, k_norm_m, out_norm_a, out_norm_b, out_norm_m,
                  w_out, norm_ffn, w_ff1, w_ff2):
    b, t, _ = x.shape
    h = rmsnorm(x, norm_attn)
    proj = h @ w_in
    splits = np.cumsum([WIDTH_A, WIDTH_A, WIDTH_A, WIDTH_B, WIDTH_B, WIDTH_B])
    qa, ka, va, qb, kb, vb, qm = jnp.split(proj, splits, axis=-1)
    heads = lambda z, n: z.reshape(b, t, n, HEAD_DIM)
    pos = jnp.arange(t, dtype=jnp.float32)
    qa = partial_rope(rmsnorm(heads(qa, N_HEADS_A), q_norm_a), pos)
    ka = partial_rope(rmsnorm(heads(ka, N_HEADS_A), k_norm_a), pos)
    oa = dilated_attention(qa, ka, heads(va, N_HEADS_A))
    qb = rmsnorm(heads(qb, N_HEADS_B), q_norm_b)
    kb = rmsnorm(heads(kb, N_HEADS_B), k_norm_b)
    ob = neighbourhood_attention(qb, kb, heads(vb, N_HEADS_B), rpb_b)
    qm = rmsnorm(heads(qm, N_HEADS_M), q_norm_m)
    om = memory_attention(qm, mem, norm_mem, w_mem_kv, k_norm_m)
    mixed = jnp.concatenate([rmsnorm(oa.reshape(b, t, WIDTH_A), out_norm_a),
                             rmsnorm(ob.reshape(b, t, WIDTH_B), out_norm_b),
                             rmsnorm(om.reshape(b, t, WIDTH_M), out_norm_m)], axis=-1)
    x = x + mixed @ w_out
    hf = rmsnorm(x, norm_ffn)
    x = x + jnp.square(jax.nn.relu(hf @ w_ff1)) @ w_ff2
    return x


def setup_inputs(seed: int = 0) -> dict:
    key = jax.random.key(seed)
    ks = jax.random.split(key, 24)
    f32 = jnp.float32
    nrm = lambda k, shape, scale: jax.random.normal(k, shape, dtype=f32) * scale
    gain = lambda k, n: 1.0 + 0.02 * jax.random.normal(k, (DEPTH, n), dtype=f32)
    return {
        "x_prompt": nrm(ks[0], (BATCH, SEQ, D_MODEL), 1.0),
        "x_sample": nrm(ks[1], (DEC_BATCH, DEC_SEQ, D_MODEL), 1.0),
        "mem_prompt": nrm(ks[2], (BATCH, N_MEM, D_MODEL), 1.0),
        "mem_sample": nrm(ks[3], (DEC_BATCH, N_MEM, D_MODEL), 1.0),
        "norm_attn": gain(ks[4], D_MODEL),
        "w_in": nrm(ks[5], (DEPTH, D_MODEL, IN_WIDTH), D_MODEL ** -0.5),
        "q_norm_a": gain(ks[6], HEAD_DIM),
        "k_norm_a": gain(ks[7], HEAD_DIM),
        "q_norm_b": gain(ks[8], HEAD_DIM),
        "k_norm_b": gain(ks[9], HEAD_DIM),
        "rpb_b": nrm(ks[10], (DEPTH, N_HEADS_B, 2 * NA_ROWS - 1, 2 * NA_COLS - 1), 0.1),
        "norm_mem": gain(ks[11], D_MODEL),
        "w_mem_kv": nrm(ks[12], (DEPTH, D_MODEL, 2 * WIDTH_M), D_MODEL ** -0.5),
        "q_norm_m": gain(ks[13], HEAD_DIM),
        "k_norm_m": gain(ks[14], HEAD_DIM),
        "out_norm_a": gain(ks[15], WIDTH_A),
        "out_norm_b": gain(ks[16], WIDTH_B),
        "out_norm_m": gain(ks[17], WIDTH_M),
        "w_out": nrm(ks[18], (DEPTH, MIX_WIDTH, D_MODEL), MIX_WIDTH ** -0.5),
        "norm_ffn": gain(ks[19], D_MODEL),
        "w_ff1": nrm(ks[20], (DEPTH, D_MODEL, D_FF), D_MODEL ** -0.5),
        "w_ff2": nrm(ks[21], (DEPTH, D_FF, D_MODEL), D_FF ** -0.5),
    }


def reference(x_prompt, x_sample, mem_prompt, mem_sample, norm_attn, w_in, q_norm_a, k_norm_a,
              q_norm_b, k_norm_b, rpb_b, norm_mem, w_mem_kv, q_norm_m, k_norm_m,
              out_norm_a, out_norm_b, out_norm_m, w_out, norm_ffn, w_ff1, w_ff2):
    y_prompt = x_prompt
    y_sample = x_sample
    for i in range(DEPTH):
        layer_args = (norm_attn[i], w_in[i], q_norm_a[i], k_norm_a[i], q_norm_b[i], k_norm_b[i],
                      rpb_b[i], norm_mem[i], w_mem_kv[i], q_norm_m[i], k_norm_m[i],
                      out_norm_a[i], out_norm_b[i], out_norm_m[i], w_out[i], norm_ffn[i],
                      w_ff1[i], w_ff2[i])
        y_prompt = encoder_layer(y_prompt, mem_prompt, *layer_args)
        y_sample = encoder_layer(y_sample, mem_sample, *layer_args)
    return (y_prompt, y_sample)
```

```cpp
#include <hip/hip_runtime.h>
#include <hip/hip_cooperative_groups.h>
#include <cstdio>
#include <cstdint>
namespace cg = cooperative_groups;

constexpr int DM = 1024, TP = 16384, TS = 8192, NBS = 4, MTOK = TP + NBS * TS;
constexpr int NQKV = 2560, NHEADS = 40, FF = 4096, NMEM = 256, NBATCH = 1 + NBS, MMEM = NBATCH * NMEM;
constexpr float RMS_EPS = 1e-6f;
constexpr float LOG2E = 1.4426950408889634f;
constexpr float QSCALE = 0.125f * LOG2E;
namespace pg8 {
#define PG8_LAS __attribute__((address_space(3)))
typedef unsigned short bf16_t;
typedef short bf16x8 __attribute__((ext_vector_type(8)));
typedef float f32x4 __attribute__((ext_vector_type(4)));
typedef unsigned u32x4 __attribute__((ext_vector_type(4)));
constexpr int BM = 256, BK = 64, HALF = 128, HTB = HALF * BK * 2  , STAGE_BYTES = 8 * HTB, NXCD = 8, WGM = 8;

__host__ __device__ __forceinline__ int lds_byte(int r, int c) { const int st = (r >> 4) * 2 + (c >> 5), rr = r & 15, cc = c & 31, ob = rr * 64 + cc * 2; return st * 1024 + (ob ^ (((ob >> 9) & 1) << 5)); }
__host__ __device__ __forceinline__ void stage_rc(int b, int& R, int& C) { const int st = b / 1024, sb = b % 1024, swz = sb ^ (((sb >> 9) & 1) << 5); R = (st >> 1) * 16 + swz / 64; C = (st & 1) * 32 + (swz % 64) / 2; }
__host__ __device__ __forceinline__ int perm32(int rho) { const int n = rho >> 4, i = rho & 15; return 8 * (i >> 2) + 4 * n + (i & 3); }

struct Unit { int pm, pn; };
struct Gemm { const bf16_t* A; const bf16_t* Bt; int M, N, K; };

struct StaticOrder {
    int nM, nN, nwg, G, c;
    __host__ __device__ void init(int M, int N, int G_, int c_) { nM = M / BM; nN = N / BM; nwg = nM * nN; G = G_; c = c_; }
    __host__ __device__ bool next(int i, Unit& u) const {
        const long L = (long)i * G + c; if (L >= nwg) return false;
        int wgid = (int)L; { const int q = nwg / NXCD, r = nwg % NXCD, xcd = wgid % NXCD, off = wgid / NXCD; wgid = (xcd < r ? xcd * (q + 1) : r * (q + 1) + (xcd - r) * q) + off; }
        const int nig = WGM * nN, gid = wgid / nig, fm = gid * WGM, gsz = (nM - fm) < WGM ? (nM - fm) : WGM;
        u.pm = fm + ((wgid % nig) % gsz); u.pn = (wgid % nig) / gsz; return true;
    }
    __device__ __forceinline__ void a_ready(const Unit&) const {}
    __device__ __forceinline__ void done(const Unit&) const {}
};

__device__ __forceinline__ unsigned cvt_pk_bf16(float lo, float hi) { unsigned r; asm volatile("v_cvt_pk_bf16_f32 %0, %1, %2" : "=v"(r) : "v"(lo), "v"(hi)); return r; }
typedef float f32x2 __attribute__((ext_vector_type(2)));
__device__ __forceinline__ float sq4(const f32x4 v) { return (v[0] * v[0] + v[1] * v[1]) + (v[2] * v[2] + v[3] * v[3]); }
__device__ __forceinline__ u32x4 pack8(const f32x4 a, const f32x4 b) { u32x4 w; w.x = cvt_pk_bf16(a[0], a[1]); w.y = cvt_pk_bf16(a[2], a[3]); w.z = cvt_pk_bf16(b[0], b[1]); w.w = cvt_pk_bf16(b[2], b[3]); return w; }

struct EpiQKV {
    static constexpr bool PERM = true, AFTER_DRAIN = false;
    bf16_t* QKV;
    const float *gqa, *gka, *gqb, *gkb, *gqm;
    const float *rc, *rs;
    __device__ __forceinline__ void operator()(const f32x4 (&acc)[2][2][4][2], const Unit& u, int wr, int wc, int fr, int fq) const {
        const int hidx = u.pn * 4 + wc;
        const float* gain = nullptr; bool rope = false; float qs = 1.f;
        if (hidx < 6) { gain = gqa; rope = true; qs = QSCALE; } else if (hidx < 12) { gain = gka; rope = true; } else if (hidx < 18) { } else if (hidx < 24) { gain = gqb; qs = QSCALE; }
        else if (hidx < 30) { gain = gkb; } else if (hidx < 36) { } else { gain = gqm; qs = QSCALE; }
        const bool rl = rope && fq < 2;
        f32x4 g[2][2];
#pragma unroll
        for (int bj = 0; bj < 2; ++bj)
#pragma unroll
            for (int n = 0; n < 2; ++n) { const int d0 = (rl && bj == 0) ? (8 * n + 4 * fq) : (32 * bj + 8 * fq + 4 * n); g[bj][n] = gain ? *(const f32x4*)(gain + d0) : (f32x4){1.f, 1.f, 1.f, 1.f}; }
        bf16_t* base = QKV + (size_t)hidx * MTOK * 64 + 8 * fq;
#pragma unroll
        for (int ai = 0; ai < 2; ++ai)
#pragma unroll
            for (int m = 0; m < 4; ++m) {
                const int row = u.pm * BM + ai * HALF + wr * 64 + m * 16 + fr;
                f32x4 v[2][2];
#pragma unroll
                for (int bj = 0; bj < 2; ++bj)
#pragma unroll
                    for (int n = 0; n < 2; ++n) v[bj][n] = acc[ai][bj][m][n];
                if (gain) {
                    float ss = (sq4(v[0][0]) + sq4(v[0][1])) + (sq4(v[1][0]) + sq4(v[1][1]));
                    ss += __shfl_xor(ss, 16); ss += __shfl_xor(ss, 32);
                    const float r = rsqrtf(ss * (1.f / 64.f) + RMS_EPS) * qs;
#pragma unroll
                    for (int bj = 0; bj < 2; ++bj)
#pragma unroll
                        for (int n = 0; n < 2; ++n) v[bj][n] = v[bj][n] * r * g[bj][n];
                    if (rope) {
                        const int pos = row < TP ? row : ((row - TP) & (TS - 1));
                        const f32x4 c = *(const f32x4*)(rc + pos * 8 + 4 * (fq & 1)), s = *(const f32x4*)(rs + pos * 8 + 4 * (fq & 1));
                        if (fq < 2) { const f32x4 x1 = v[0][0], x2 = v[0][1]; v[0][0] = x1 * c - x2 * s; v[0][1] = x2 * c + x1 * s; }
                    }
                }
                bf16_t* rowp = base + (size_t)row * 64;
                *(u32x4*)(rowp) = pack8(v[0][0], v[0][1]);
                *(u32x4*)(rowp + 32) = pack8(v[1][0], v[1][1]);
            }
    }
};
struct EpiMemKV {
    static constexpr bool PERM = true, AFTER_DRAIN = false;
    bf16_t* MK; bf16_t* MV; const float* gk;
    __device__ __forceinline__ void operator()(const f32x4 (&acc)[2][2][4][2], const Unit& u, int wr, int wc, int fr, int fq) const {
        const int hidx = u.pn * 4 + wc; const bool isk = hidx < 4; const int h = hidx & 3;
        f32x4 g[2][2];
#pragma unroll
        for (int bj = 0; bj < 2; ++bj)
#pragma unroll
            for (int n = 0; n < 2; ++n) g[bj][n] = isk ? *(const f32x4*)(gk + 32 * bj + 8 * fq + 4 * n) : (f32x4){1.f, 1.f, 1.f, 1.f};
        bf16_t* base = (isk ? MK : MV) + 8 * fq;
#pragma unroll
        for (int ai = 0; ai < 2; ++ai)
#pragma unroll
            for (int m = 0; m < 4; ++m) {
                const int row = u.pm * BM + ai * HALF + wr * 64 + m * 16 + fr;
                f32x4 v[2][2];
#pragma unroll
                for (int bj = 0; bj < 2; ++bj)
#pragma unroll
                    for (int n = 0; n < 2; ++n) v[bj][n] = acc[ai][bj][m][n];
                if (isk) {
                    float ss = (sq4(v[0][0]) + sq4(v[0][1])) + (sq4(v[1][0]) + sq4(v[1][1]));
                    ss += __shfl_xor(ss, 16); ss += __shfl_xor(ss, 32);
                    const float r = rsqrtf(ss * (1.f / 64.f) + RMS_EPS);
#pragma unroll
                    for (int bj = 0; bj < 2; ++bj)
#pragma unroll
                        for (int n = 0; n < 2; ++n) v[bj][n] = v[bj][n] * r * g[bj][n];
                }
                bf16_t* rowp = base + ((size_t)((row >> 8) * 4 + h) * NMEM + (row & 255)) * 64;
                *(u32x4*)(rowp) = pack8(v[0][0], v[0][1]);
                *(u32x4*)(rowp + 32) = pack8(v[1][0], v[1][1]);
            }
    }
};
struct EpiX1 {
    static constexpr bool PERM = true, AFTER_DRAIN = false;
    const float* xp; const float* xs; float* out; bf16_t* x1b; float* ssq;
    __device__ __forceinline__ void operator()(const f32x4 (&acc)[2][2][4][2], const Unit& u, int wr, int wc, int fr, int fq) const {
        const int col0 = u.pn * BM + wc * 32 + 8 * fq;
#pragma unroll
        for (int ai = 0; ai < 2; ++ai)
#pragma unroll
            for (int m = 0; m < 4; ++m) {
                const int row = u.pm * BM + ai * HALF + wr * 64 + m * 16 + fr;
                const float* xrow = (row < TP ? xp + (size_t)row * DM : xs + (size_t)(row - TP) * DM) + col0;
                float* orow = out + (size_t)row * DM + col0; bf16_t* brow = x1b + (size_t)row * DM + col0;
                float ss = 0.f;
#pragma unroll
                for (int bj = 0; bj < 2; ++bj) {
                    const f32x4 v0 = acc[ai][bj][m][0] + *(const f32x4*)(xrow + bj * HALF), v1 = acc[ai][bj][m][1] + *(const f32x4*)(xrow + bj * HALF + 4);
                    *(f32x4*)(orow + bj * HALF) = v0; *(f32x4*)(orow + bj * HALF + 4) = v1;
                    *(u32x4*)(brow + bj * HALF) = pack8(v0, v1);
                    ss += sq4(v0) + sq4(v1);
                }
                ss += __shfl_xor(ss, 16); ss += __shfl_xor(ss, 32);
                if (fq == 0) unsafeAtomicAdd(ssq + row, ss);
            }
    }
};
struct EpiH {
    static constexpr bool PERM = true, AFTER_DRAIN = false;
    bf16_t* H; const float* ssq;
    __device__ __forceinline__ void operator()(const f32x4 (&acc)[2][2][4][2], const Unit& u, int wr, int wc, int fr, int fq) const {
        const int col0 = u.pn * BM + wc * 32 + 8 * fq;
#pragma unroll
        for (int ai = 0; ai < 2; ++ai)
#pragma unroll
            for (int m = 0; m < 4; ++m) {
                const int row = u.pm * BM + ai * HALF + wr * 64 + m * 16 + fr;
                const float r = rsqrtf(ssq[row] * (1.f / DM) + RMS_EPS);
                bf16_t* hrow = H + (size_t)row * FF + col0;
#pragma unroll
                for (int bj = 0; bj < 2; ++bj) {
                    f32x4 v0 = acc[ai][bj][m][0] * r, v1 = acc[ai][bj][m][1] * r;
#pragma unroll
                    for (int e = 0; e < 4; ++e) { const float a = fmaxf(v0[e], 0.f), b = fmaxf(v1[e], 0.f); v0[e] = a * a; v1[e] = b * b; }
                    *(u32x4*)(hrow + bj * HALF) = pack8(v0, v1);
                }
            }
    }
};
struct EpiOut {
    static constexpr bool PERM = true, AFTER_DRAIN = false;
    float* out;
    __device__ __forceinline__ void operator()(const f32x4 (&acc)[2][2][4][2], const Unit& u, int wr, int wc, int fr, int fq) const {
        const int col0 = u.pn * BM + wc * 32 + 8 * fq;
#pragma unroll
        for (int ai = 0; ai < 2; ++ai)
#pragma unroll
            for (int m = 0; m < 4; ++m) {
                const int row = u.pm * BM + ai * HALF + wr * 64 + m * 16 + fr;
                float* orow = out + (size_t)row * DM + col0;
#pragma unroll
                for (int bj = 0; bj < 2; ++bj) {
                    const f32x4 v0 = acc[ai][bj][m][0] + *(const f32x4*)(orow + bj * HALF), v1 = acc[ai][bj][m][1] + *(const f32x4*)(orow + bj * HALF + 4);
                    *(f32x4*)(orow + bj * HALF) = v0; *(f32x4*)(orow + bj * HALF + 4) = v1;
                }
            }
    }
};

template <class Epi, class Sched, bool ALIGN_EPI = false, bool SP2 = false>
__device__ __forceinline__ void gemm_phase(PG8_LAS unsigned char* lds, const Gemm g, const Sched& S, const Epi& E) {
    const int tid = threadIdx.x, wid = __builtin_amdgcn_readfirstlane(tid >> 6), lane = tid & 63, wr = wid >> 2, wc = wid & 3, fr = lane & 15, fq = lane >> 4;
    const int K = g.K, nt = K / BK;
    unsigned voffA[2], voffB[2];
#pragma unroll
    for (int i = 0; i < 2; ++i) { int R, C; stage_rc(tid * 16 + i * 8192, R, C); const int Rb = Epi::PERM ? ((R & ~31) + perm32(R & 31)) : R;
        voffA[i] = (unsigned)(R * K + C) * 2u; voffB[i] = (unsigned)(Rb * K + C) * 2u; }
    const size_t kstep = (size_t)(BK * 2);
    const size_t hstep = (size_t)HALF * K * 2;
    const size_t tstep = 2 * hstep;
    const unsigned ldsw = (unsigned)wid * 1024u;
    const int aoff = lds_byte(wr * 64 + fr, fq * 8), boff = lds_byte(wc * 32 + fr, fq * 8);
#define PG8_SA(b, h) (((b) * 2 + (h)) * HTB)
#define PG8_SB(b, h) ((4 + (b) * 2 + (h)) * HTB)
#define PG8_STAGE(bufoff, gbase, voff) do { _Pragma("unroll") for (int _i = 0; _i < 2; ++_i) \
        __builtin_amdgcn_global_load_lds((const unsigned*)((const char*)(gbase) + (voff)[_i]), (PG8_LAS unsigned*)(lds + (bufoff) + ldsw + _i * 8192), 16, 0, 0); } while (0)
#define PG8_LDA(dst, b, h) do { _Pragma("unroll") for (int m = 0; m < 4; ++m) _Pragma("unroll") for (int k = 0; k < 2; ++k) dst[m][k] = *(const PG8_LAS bf16x8*)(lds + PG8_SA(b, h) + aoff + m * 2048 + k * 1024); } while (0)
#define PG8_LDB(dst, b, h) do { _Pragma("unroll") for (int n = 0; n < 2; ++n) _Pragma("unroll") for (int k = 0; k < 2; ++k) dst[n][k] = *(const PG8_LAS bf16x8*)(lds + PG8_SB(b, h) + boff + n * 2048 + k * 1024); } while (0)
#define PG8_MMA(ai, bj, At, Bt) do { __builtin_amdgcn_s_setprio(1); _Pragma("unroll") for (int m = 0; m < 4; ++m) _Pragma("unroll") for (int n = 0; n < 2; ++n) _Pragma("unroll") for (int k = 0; k < 2; ++k) \
        acc[ai][bj][m][n] = __builtin_amdgcn_mfma_f32_16x16x32_bf16(Bt[n][k], At[m][k], acc[ai][bj][m][n], 0, 0, 0); __builtin_amdgcn_s_setprio(0); } while (0)
#define PG8_WAIT_V(n) asm volatile("s_waitcnt vmcnt(" #n ")" ::: "memory")
#define PG8_WAIT_L(n) asm volatile("s_waitcnt lgkmcnt(" #n ")" ::: "memory")
#define PG8_BAR __builtin_amdgcn_s_barrier()
#define PG8_SCHED __builtin_amdgcn_sched_barrier(0)
    Unit cur, nxt; int ui = 0;
    if (!S.next(0, cur)) return;
    f32x4 acc[2][2][4][2];
#pragma unroll
    for (int a = 0; a < 2; ++a)
#pragma unroll
        for (int b = 0; b < 2; ++b)
#pragma unroll
            for (int m = 0; m < 4; ++m)
#pragma unroll
                for (int n = 0; n < 2; ++n) acc[a][b][m][n] = (f32x4){0.f, 0.f, 0.f, 0.f};
    bf16x8 At[4][2], B0[2][2], B1[2][2];
    const char* cA = (const char*)g.A + (size_t)cur.pm * tstep; const char* cB = (const char*)g.Bt + (size_t)cur.pn * tstep;
    S.a_ready(cur);
    if constexpr (SP2) {
        PG8_STAGE(PG8_SB(0, 0), cB, voffB); PG8_STAGE(PG8_SB(0, 1), cB + hstep, voffB); PG8_STAGE(PG8_SA(0, 0), cA, voffA); PG8_STAGE(PG8_SA(0, 1), cA + hstep, voffA);
        if (wr == 1) PG8_BAR;
        PG8_WAIT_V(2); PG8_BAR;
        PG8_STAGE(PG8_SB(1, 0), cB + kstep, voffB); PG8_STAGE(PG8_SA(1, 0), cA + kstep, voffA); PG8_STAGE(PG8_SB(1, 1), cB + hstep + kstep, voffB);
        PG8_WAIT_V(6); PG8_BAR;
    } else {
        PG8_STAGE(PG8_SB(0, 0), cB, voffB); PG8_STAGE(PG8_SA(0, 0), cA, voffA); PG8_STAGE(PG8_SB(0, 1), cB + hstep, voffB); PG8_STAGE(PG8_SA(0, 1), cA + hstep, voffA);
        if (wr == 1) PG8_BAR;
        PG8_WAIT_V(4); PG8_BAR;
        PG8_STAGE(PG8_SB(1, 0), cB + kstep, voffB); PG8_STAGE(PG8_SA(1, 0), cA + kstep, voffA); PG8_STAGE(PG8_SB(1, 1), cB + hstep + kstep, voffB);
        PG8_WAIT_V(6); PG8_BAR;
    }
    for (;;) {
        const bool has_next = S.next(ui + 1, nxt);
        const char* nA = has_next ? (const char*)g.A + (size_t)nxt.pm * tstep : cA; const char* nB = has_next ? (const char*)g.Bt + (size_t)nxt.pn * tstep : cB;
        for (int t = 0; t < nt; t += 2) {
            const bool last = (t == nt - 2);
            const char* a1 = cA + (size_t)(t + 1) * kstep;
            const char* a2 = last ? nA : cA + (size_t)(t + 2) * kstep; const char* b2 = last ? nB : cB + (size_t)(t + 2) * kstep;
            const char* a3 = a2 + kstep; const char* b3 = b2 + kstep;
            if (last && has_next) S.a_ready(nxt);
            if constexpr (SP2) {
            PG8_LDB(B0, 0, 0); PG8_LDB(B1, 0, 1); PG8_SCHED; PG8_LDA(At, 0, 0); PG8_STAGE(PG8_SA(1, 1), a1 + hstep, voffA);
            PG8_WAIT_V(8); PG8_WAIT_L(0); PG8_BAR; PG8_MMA(0, 0, At, B0); PG8_MMA(0, 1, At, B1); PG8_BAR; PG8_SCHED;
            PG8_LDA(At, 0, 1); PG8_STAGE(PG8_SB(0, 0), b2, voffB); PG8_STAGE(PG8_SB(0, 1), b2 + hstep, voffB); PG8_STAGE(PG8_SA(0, 0), a2, voffA);
            PG8_WAIT_V(8); PG8_WAIT_L(0); PG8_BAR; PG8_MMA(1, 0, At, B0); PG8_MMA(1, 1, At, B1); PG8_BAR; PG8_SCHED;
            PG8_LDB(B0, 1, 0); PG8_LDB(B1, 1, 1); PG8_SCHED; PG8_LDA(At, 1, 0); PG8_STAGE(PG8_SA(0, 1), a2 + hstep, voffA);
            PG8_WAIT_V(8); PG8_WAIT_L(0); PG8_BAR; PG8_MMA(0, 0, At, B0); PG8_MMA(0, 1, At, B1); PG8_BAR; PG8_SCHED;
            PG8_LDA(At, 1, 1); PG8_STAGE(PG8_SB(1, 0), b3, voffB); PG8_STAGE(PG8_SB(1, 1), b3 + hstep, voffB); PG8_STAGE(PG8_SA(1, 0), a3, voffA);
            PG8_WAIT_V(8); PG8_WAIT_L(0); PG8_BAR; PG8_MMA(1, 0, At, B0); PG8_MMA(1, 1, At, B1); PG8_BAR; PG8_SCHED;
            } else {
            PG8_LDB(B0, 0, 0); PG8_SCHED; PG8_LDA(At, 0, 0); PG8_STAGE(PG8_SA(1, 1), a1 + hstep, voffA);
            PG8_WAIT_L(8); PG8_BAR; PG8_WAIT_L(0); PG8_MMA(0, 0, At, B0); PG8_BAR; PG8_SCHED;
            PG8_LDB(B1, 0, 1); PG8_STAGE(PG8_SB(0, 0), b2, voffB);
            PG8_BAR; PG8_WAIT_L(0); PG8_MMA(0, 1, At, B1); PG8_BAR;
            PG8_LDA(At, 0, 1); PG8_STAGE(PG8_SA(0, 0), a2, voffA);
            PG8_BAR; PG8_WAIT_L(0); PG8_MMA(1, 0, At, B0); PG8_BAR; PG8_SCHED;
            PG8_STAGE(PG8_SB(0, 1), b2 + hstep, voffB);
            PG8_WAIT_V(6); PG8_BAR; PG8_MMA(1, 1, At, B1); PG8_BAR;
            PG8_LDB(B0, 1, 0); PG8_SCHED; PG8_LDA(At, 1, 0); PG8_STAGE(PG8_SA(0, 1), a2 + hstep, voffA);
            PG8_WAIT_L(8); PG8_BAR; PG8_WAIT_L(0); PG8_MMA(0, 0, At, B0); PG8_BAR; PG8_SCHED;
            PG8_LDB(B1, 1, 1); PG8_STAGE(PG8_SB(1, 0), b3, voffB);
            PG8_BAR; PG8_WAIT_L(0); PG8_MMA(0, 1, At, B1); PG8_BAR;
            PG8_LDA(At, 1, 1); PG8_STAGE(PG8_SA(1, 0), a3, voffA);
            PG8_BAR; PG8_WAIT_L(0); PG8_MMA(1, 0, At, B0); PG8_BAR; PG8_SCHED;
            PG8_STAGE(PG8_SB(1, 1), b3 + hstep, voffB);
            PG8_WAIT_V(6); PG8_BAR; PG8_MMA(1, 1, At, B1); PG8_BAR;
            }
        }
        if constexpr (ALIGN_EPI) { if (wr == 0) PG8_BAR; }
        if constexpr (!Epi::AFTER_DRAIN) { E(acc, cur, wr, wc, fr, fq); S.done(cur); }
        if (!has_next) break;
#pragma unroll
        for (int a = 0; a < 2; ++a)
#pragma unroll
            for (int b = 0; b < 2; ++b)
#pragma unroll
                for (int m = 0; m < 4; ++m)
#pragma unroll
                    for (int n = 0; n < 2; ++n) acc[a][b][m][n] = (f32x4){0.f, 0.f, 0.f, 0.f};
        cur = nxt; cA = nA; cB = nB; ++ui;
        if constexpr (ALIGN_EPI) { if (wr == 1) PG8_BAR; }
    }
    PG8_WAIT_V(0);
    if constexpr (!ALIGN_EPI) { if (wr == 0) PG8_BAR; }
    PG8_BAR;
    if constexpr (Epi::AFTER_DRAIN) { E.fused(acc, cur, wr, wc, fr, fq, lds, wid, lane); S.done(cur); }
#undef PG8_SA
#undef PG8_SB
#undef PG8_STAGE
#undef PG8_LDA
#undef PG8_LDB
#undef PG8_MMA
#undef PG8_WAIT_V
#undef PG8_WAIT_L
#undef PG8_BAR
#undef PG8_SCHED
}
}

constexpr int NWAVES = 8;
#ifndef MK_N_LAUNCHES
#define MK_N_LAUNCHES 1
#endif
constexpr int NPH = 7;
constexpr int N_LAUNCHES = MK_N_LAUNCHES;

constexpr size_t MiB = 1u << 20;
constexpr size_t WS_CTL = 0, WS_SSQF = 1 * MiB, CTL_ZERO_BYTES = 2 * MiB;
constexpr size_t WS_ROPE = 2 * MiB;
constexpr size_t WS_WIN = 3 * MiB, WS_WMEM = 8 * MiB, WS_WOUT = 9 * MiB, WS_W1 = 11 * MiB, WS_W2 = 19 * MiB;
constexpr size_t WS_XNMEM = 27 * MiB, WS_MK = 30 * MiB, WS_MV = 31 * MiB;
constexpr size_t WS_X1B = 32 * MiB;
constexpr size_t WS_XN = 128 * MiB, WS_O = 128 * MiB;
constexpr size_t WS_QKV = 224 * MiB;
constexpr size_t WS_H = 128 * MiB;
constexpr size_t WS_END = 512 * MiB;
static_assert(WS_QKV + (size_t)NHEADS * MTOK * 64 * 2 <= WS_END && WS_H + (size_t)MTOK * FF * 2 <= WS_END && WS_X1B + (size_t)MTOK * DM * 2 <= WS_XN && WS_XN + (size_t)MTOK * DM * 2 <= WS_QKV, "d_ws map");

constexpr int RING_BYTES = 131072;
constexpr int LDS_BYTES = 147456;

#define LAS __attribute__((address_space(3)))
typedef unsigned short bf16;
typedef unsigned v4u __attribute__((ext_vector_type(4)));
typedef float f32x4 __attribute__((ext_vector_type(4)));
#define LDS_WAIT() asm volatile("s_waitcnt lgkmcnt(0)" ::: "memory")
__device__ __forceinline__ unsigned f2bf(float f) { unsigned u = __builtin_bit_cast(unsigned, f); return (u + 0x7fffu + ((u >> 16) & 1u)) >> 16; }
__device__ __forceinline__ unsigned pk2(float lo, float hi) { return f2bf(lo) | (f2bf(hi) << 16); }
__device__ __forceinline__ float bflo(unsigned w) { return __uint_as_float(w << 16); }
__device__ __forceinline__ float bfhi(unsigned w) { return __uint_as_float(w & 0xffff0000u); }
__device__ __forceinline__ float wave_sum(float v) {
#pragma unroll
    for (int o = 1; o < 64; o <<= 1) v += __shfl_xor(v, o);
    return v;
}

struct Frame {
    LAS unsigned char* lds;
    int tid, lane, wave, vcu, G;
    const float* in[22]; float* out; unsigned char* ws;
};

template <class CM, class KS>
__device__ __forceinline__ void p0_transpose_item(const float* W, int K, int N, bf16* WT, LAS float* scr, int item, int lane, CM cm, KS ks) {
    const int nblk = N / 32, kb = item / nblk, nb = item % nblk, k0 = 64 * kb, n0 = 32 * nb;
    const int sc = cm(n0 + (lane & 31));
#pragma unroll 8
    for (int i = 0; i < 32; ++i) { const int kk = 2 * i + (lane >> 5); scr[kk * 33 + (lane & 31)] = W[(size_t)(k0 + kk) * N + sc] * ks(k0 + kk); }
    LDS_WAIT(); asm volatile("" ::: "memory");
    const int c = lane & 7;
#pragma unroll
    for (int j = 0; j < 4; ++j) { const int n = (lane >> 3) + 8 * j; const LAS float* s = scr + (8 * c) * 33 + n;
        v4u o; o.x = pk2(s[0 * 33], s[1 * 33]); o.y = pk2(s[2 * 33], s[3 * 33]); o.z = pk2(s[4 * 33], s[5 * 33]); o.w = pk2(s[6 * 33], s[7 * 33]);
        *(v4u*)(WT + (size_t)(n0 + n) * K + k0 + 8 * c) = o; }
    LDS_WAIT(); asm volatile("" ::: "memory");
}
struct CMapHead { int nrope;
    __device__ __forceinline__ int operator()(int c) const { const int pn = c >> 8, bj = (c >> 7) & 1, hh = (c >> 5) & 3, p5 = c & 31, hidx = 4 * pn + hh; int p = 32 * bj + p5;
        if (hidx < nrope && p < 16) p = (p & 3) + 8 * ((p >> 2) & 1) + 4 * (p >> 3); return 64 * hidx + p; } };
struct CMapId { __device__ __forceinline__ int operator()(int c) const { return c; } };
struct KSOne { __device__ __forceinline__ float operator()(int) const { return 1.f; } };
struct KSVec { const float* g; __device__ __forceinline__ float operator()(int k) const { return g[k]; } };
struct KSOut { const float *a, *b, *m; __device__ __forceinline__ float operator()(int k) const { return k < 384 ? a[k] : (k < 768 ? b[k - 384] : m[k - 768]); } };

__device__ __forceinline__ void rms_row_to_bf16(const float* xrow, const float* g, bf16* orow, int lane) {
    const f32x4* xr = (const f32x4*)xrow + lane; const f32x4* gr = (const f32x4*)g + lane;
    f32x4 v[4]; float s = 0.f;
#pragma unroll
    for (int j = 0; j < 4; ++j) { v[j] = xr[64 * j]; s += (v[j].x * v[j].x + v[j].y * v[j].y) + (v[j].z * v[j].z + v[j].w * v[j].w); }
    const float rstd = rsqrtf(wave_sum(s) * (1.f / DM) + RMS_EPS);
    unsigned long long* o8 = (unsigned long long*)orow + lane;
#pragma unroll
    for (int j = 0; j < 4; ++j) { const f32x4 gg = gr[64 * j]; o8[64 * j] = (unsigned long long)pk2(v[j].x * rstd * gg.x, v[j].y * rstd * gg.y) | ((unsigned long long)pk2(v[j].z * rstd * gg.z, v[j].w * rstd * gg.w) << 32); }
}
__device__ __forceinline__ void p0_prologue(Frame& F) {
    LAS float* scr = (LAS float*)(F.lds + F.wave * 16384);
    const int gw = F.vcu * NWAVES + F.wave, NGW = F.G * NWAVES;
    unsigned char* ws = F.ws;
    constexpr int I_IN = (DM / 64) * (NQKV / 32), I_MEM = (DM / 64) * (512 / 32), I_OUT = (DM / 64) * (DM / 32), I_1 = (DM / 64) * (FF / 32), I_2 = (FF / 64) * (DM / 32);
    constexpr int NITEMS = I_IN + I_MEM + I_OUT + I_1 + I_2;
    for (int it = gw; it < NITEMS; it += NGW) {
        int r = it;
        if (r < I_IN) { p0_transpose_item(F.in[5], DM, NQKV, (bf16*)(ws + WS_WIN), scr, r, F.lane, CMapHead{12}, KSOne{}); continue; } r -= I_IN;
        if (r < I_MEM) { p0_transpose_item(F.in[12], DM, 512, (bf16*)(ws + WS_WMEM), scr, r, F.lane, CMapHead{0}, KSOne{}); continue; } r -= I_MEM;
        if (r < I_OUT) { p0_transpose_item(F.in[18], DM, DM, (bf16*)(ws + WS_WOUT), scr, r, F.lane, CMapId{}, KSOut{F.in[15], F.in[16], F.in[17]}); continue; } r -= I_OUT;
        if (r < I_1) { p0_transpose_item(F.in[20], DM, FF, (bf16*)(ws + WS_W1), scr, r, F.lane, CMapId{}, KSVec{F.in[19]}); continue; } r -= I_1;
        p0_transpose_item(F.in[21], FF, DM, (bf16*)(ws + WS_W2), scr, r, F.lane, CMapId{}, KSOne{});
    }
    for (int m = gw; m < MTOK + MMEM; m += NGW) {
        if (m < MTOK) { const float* xrow = m < TP ? F.in[0] + (size_t)m * DM : F.in[1] + (size_t)(m - TP) * DM; rms_row_to_bf16(xrow, F.in[4], (bf16*)(ws + WS_XN) + (size_t)m * DM, F.lane); }
        else { const int r = m - MTOK; const float* xrow = r < NMEM ? F.in[2] + (size_t)r * DM : F.in[3] + (size_t)(r - NMEM) * DM; rms_row_to_bf16(xrow, F.in[11], (bf16*)(ws + WS_XNMEM) + (size_t)r * DM, F.lane); }
    }
    float* rc = (float*)(ws + WS_ROPE); float* rs = rc + TP * 8;
    for (int i = (F.vcu * NWAVES * 64) + F.tid; i < TP * 8; i += F.G * NWAVES * 64) {
        const int pos = i >> 3, fi = i & 7;
        const float inv = exp2f(-(float)fi * 0.125f * 18.931568569324174f);
        const float ang = (float)pos * inv;
        const double rev = (double)ang * 0.15915494309189535; const float fr = (float)(rev - __builtin_rint(rev));
        rc[i] = __builtin_amdgcn_cosf(fr); rs[i] = __builtin_amdgcn_sinf(fr);
    }
}

template <int NR, class KF>
__device__ __forceinline__ void attn_item(const bf16* qrow, const bf16* Kb, const bf16* Vb, const KF& kf, bf16* orow, int lane) {
    float q[64];
#pragma unroll
    for (int c = 0; c < 8; ++c) { const v4u w = *(const v4u*)(qrow + 8 * c);
#pragma unroll
        for (int e = 0; e < 4; ++e) { q[8 * c + 2 * e] = bflo(w[e]); q[8 * c + 2 * e + 1] = bfhi(w[e]); } }
    float p[NR]; float lsum = 0.f;
#pragma unroll
    for (int r = 0; r < NR; ++r) {
        long ridx; float bias; const bool ok = kf(64 * r + lane, ridx, bias);
        const bf16* krow = Kb + ridx * 64; float s = 0.f;
#pragma unroll
        for (int c = 0; c < 8; ++c) { const v4u w = *(const v4u*)(krow + 8 * c);
#pragma unroll
            for (int e = 0; e < 4; ++e) s += q[8 * c + 2 * e] * bflo(w[e]) + q[8 * c + 2 * e + 1] * bfhi(w[e]); }
        p[r] = ok ? exp2f(s + bias) : 0.f; lsum += p[r];
    }
    lsum = wave_sum(lsum);
    float o = 0.f;
#pragma unroll
    for (int r = 0; r < NR; ++r) {
#pragma unroll 8
        for (int l = 0; l < 64; ++l) {
            long ridx; float bias; (void)kf(64 * r + l, ridx, bias);
            const float pj = __int_as_float(__builtin_amdgcn_readlane(__float_as_int(p[r]), l));
            o += pj * __uint_as_float((unsigned)Vb[ridx * 64 + lane] << 16);
        }
    }
    orow[lane] = (bf16)f2bf(o / lsum);
}
struct KeyA { long sb; int pos, T;
    __device__ __forceinline__ bool operator()(int j, long& ridx, float& bias) const { const int pat = j >= 258 ? 2 : (j >= 129 ? 1 : 0), idx = j - 129 * pat, dil = 1 << (2 * pat), kp = pos + (idx - 64) * dil;
        const bool ok = j < 387 && kp >= 0 && kp < T; ridx = sb + (ok ? kp : pos); bias = 0.f; return ok; } };
struct KeyB { long sb; int r, c, rs, cs; const float* rpb;
    __device__ __forceinline__ bool operator()(int j, long& ridx, float& bias) const { const int kr = (j >> 4) & 7, kc = j & 15; ridx = sb + (rs + kr) * 64 + cs + kc;
        bias = rpb[(rs + kr - r + 7) * 31 + (cs + kc - c + 15)] * LOG2E; return true; } };
struct KeyM { long b0;
    __device__ __forceinline__ bool operator()(int j, long& ridx, float& bias) const { ridx = b0 + (j & 255); bias = 0.f; return true; } };

__device__ __forceinline__ void attn_simple_phase(Frame& F) {
    const int gw = F.vcu * NWAVES + F.wave, NGW = F.G * NWAVES;
    const bf16* QKV = (const bf16*)(F.ws + WS_QKV); bf16* O = (bf16*)(F.ws + WS_O);
    const bf16* MK = (const bf16*)(F.ws + WS_MK); const bf16* MV = (const bf16*)(F.ws + WS_MV);
    for (int it = gw; it < MTOK * 16; it += NGW) {
        const int hh = it / MTOK, row = it - hh * MTOK;
        const int sbat = row < TP ? 0 : 1 + ((row - TP) >> 13);
        const long sb = row < TP ? 0 : TP + (long)(sbat - 1) * TS; const int T = row < TP ? TP : TS, pos = (int)(row - sb);
        if (hh < 6) {
            const int h = hh;
            attn_item<7>(QKV + ((size_t)(0 + h) * MTOK + row) * 64, QKV + (size_t)(6 + h) * MTOK * 64, QKV + (size_t)(12 + h) * MTOK * 64, KeyA{sb, pos, T}, O + (size_t)row * DM + h * 64, F.lane);
        } else if (hh < 12) {
            const int h = hh - 6, rows = T / 64, r = pos >> 6, c = pos & 63;
            int rs = r - 4; rs = rs < 0 ? 0 : (rs > rows - 8 ? rows - 8 : rs); int cs = c - 8; cs = cs < 0 ? 0 : (cs > 48 ? 48 : cs);
            attn_item<2>(QKV + ((size_t)(18 + h) * MTOK + row) * 64, QKV + (size_t)(24 + h) * MTOK * 64, QKV + (size_t)(30 + h) * MTOK * 64, KeyB{sb, r, c, rs, cs, F.in[10] + h * 15 * 31}, O + (size_t)row * DM + 384 + h * 64, F.lane);
        } else {
            const int h = hh - 12;
            attn_item<4>(QKV + ((size_t)(36 + h) * MTOK + row) * 64, MK, MV, KeyM{(long)(sbat * 4 + h) * NMEM}, O + (size_t)row * DM + 768 + h * 64, F.lane);
        }
    }
}
__device__ __forceinline__ void onorm_phase(Frame& F) {
    const int gw = F.vcu * NWAVES + F.wave, NGW = F.G * NWAVES;
    bf16* O = (bf16*)(F.ws + WS_O);
    for (int m = gw; m < MTOK; m += NGW) {
        v4u* p = (v4u*)(O + (size_t)m * DM) + 2 * F.lane; v4u w0 = p[0], w1 = p[1];
        float v[16];
#pragma unroll
        for (int e = 0; e < 4; ++e) { v[2 * e] = bflo(w0[e]); v[2 * e + 1] = bfhi(w0[e]); v[8 + 2 * e] = bflo(w1[e]); v[8 + 2 * e + 1] = bfhi(w1[e]); }
        float ss = 0.f;
#pragma unroll
        for (int e = 0; e < 16; ++e) ss += v[e] * v[e];
        const int grp = F.lane < 24 ? 0 : (F.lane < 48 ? 1 : 2);
        const float sa = wave_sum(grp == 0 ? ss : 0.f), sb = wave_sum(grp == 1 ? ss : 0.f), sm = wave_sum(grp == 2 ? ss : 0.f);
        const float r = grp == 0 ? rsqrtf(sa * (1.f / 384.f) + RMS_EPS) : (grp == 1 ? rsqrtf(sb * (1.f / 384.f) + RMS_EPS) : rsqrtf(sm * (1.f / 256.f) + RMS_EPS));
#pragma unroll
        for (int e = 0; e < 4; ++e) { w0[e] = pk2(v[2 * e] * r, v[2 * e + 1] * r); w1[e] = pk2(v[8 + 2 * e] * r, v[8 + 2 * e + 1] * r); }
        p[0] = w0; p[1] = w1;
    }
}

struct Args { const float* in[22]; float* out; unsigned char* ws; int ph_lo, ph_hi; };
__global__ void __launch_bounds__(NWAVES * 64, 2) skel_fwd(Args args) {
    extern __shared__ __attribute__((aligned(16))) unsigned char lds[];
    cg::grid_group grid = cg::this_grid();
    Frame F;
    F.lds = (LAS unsigned char*)lds;
    F.tid = threadIdx.x; F.lane = F.tid & 63; F.wave = __builtin_amdgcn_readfirstlane(F.tid >> 6);
    F.G = gridDim.x; { const int bx = blockIdx.x; F.vcu = (F.G % 8 == 0) ? (bx % 8) * (F.G / 8) + bx / 8 : bx; }
#pragma unroll
    for (int i = 0; i < 22; ++i) F.in[i] = args.in[i];
    F.out = args.out; F.ws = args.ws;
    unsigned char* ws = args.ws;
    const int lo = args.ph_lo, hi = args.ph_hi;
#define IN(k) (lo <= (k) && (k) < hi)
#define BOTH(k) (IN(k) && IN((k) + 1))
#define GRID_BAR() grid.sync()

    if (IN(0)) { p0_prologue(F); if (BOTH(0)) GRID_BAR(); }

    if (IN(1)) {
        {
            pg8::Gemm g{(const pg8::bf16_t*)(ws + WS_XN), (const pg8::bf16_t*)(ws + WS_WIN), MTOK, NQKV, DM}; pg8::StaticOrder S; S.init(MTOK, NQKV, F.G, (int)blockIdx.x);
            pg8::EpiQKV E{(pg8::bf16_t*)(ws + WS_QKV), F.in[6], F.in[7], F.in[8], F.in[9], F.in[13], (const float*)(ws + WS_ROPE), (const float*)(ws + WS_ROPE) + TP * 8};
            pg8::gemm_phase<pg8::EpiQKV, pg8::StaticOrder, true, true>(F.lds, g, S, E);
        }
        {
            pg8::Gemm g{(const pg8::bf16_t*)(ws + WS_XNMEM), (const pg8::bf16_t*)(ws + WS_WMEM), MMEM, 512, DM}; pg8::StaticOrder S; S.init(MMEM, 512, F.G, F.G - 1 - (int)blockIdx.x);
            pg8::EpiMemKV E{(pg8::bf16_t*)(ws + WS_MK), (pg8::bf16_t*)(ws + WS_MV), F.in[14]};
            pg8::gemm_phase<pg8::EpiMemKV, pg8::StaticOrder, true, true>(F.lds, g, S, E);
        }
        if (BOTH(1)) GRID_BAR();
    }

    if (IN(2)) { attn_simple_phase(F); if (BOTH(2)) GRID_BAR(); }

    if (IN(3)) { onorm_phase(F); if (BOTH(3)) GRID_BAR(); }

    if (IN(4)) {
        pg8::Gemm g{(const pg8::bf16_t*)(ws + WS_O), (const pg8::bf16_t*)(ws + WS_WOUT), MTOK, DM, DM}; pg8::StaticOrder S; S.init(MTOK, DM, F.G, (int)blockIdx.x);
        pg8::EpiX1 E{F.in[0], F.in[1], F.out, (pg8::bf16_t*)(ws + WS_X1B), (float*)(ws + WS_SSQF)};
        pg8::gemm_phase<pg8::EpiX1, pg8::StaticOrder, true, true>(F.lds, g, S, E);
        if (BOTH(4)) GRID_BAR();
    }

    if (IN(5)) {
        pg8::Gemm g{(const pg8::bf16_t*)(ws + WS_X1B), (const pg8::bf16_t*)(ws + WS_W1), MTOK, FF, DM}; pg8::StaticOrder S; S.init(MTOK, FF, F.G, (int)blockIdx.x);
        pg8::EpiH E{(pg8::bf16_t*)(ws + WS_H), (const float*)(ws + WS_SSQF)};
        pg8::gemm_phase<pg8::EpiH, pg8::StaticOrder, true, true>(F.lds, g, S, E);
        if (BOTH(5)) GRID_BAR();
    }

    if (IN(6)) {
        pg8::Gemm g{(const pg8::bf16_t*)(ws + WS_H), (const pg8::bf16_t*)(ws + WS_W2), MTOK, DM, FF}; pg8::StaticOrder S; S.init(MTOK, DM, F.G, (int)blockIdx.x);
        pg8::EpiOut E{F.out};
        pg8::gemm_phase<pg8::EpiOut, pg8::StaticOrder, true, true>(F.lds, g, S, E);
    }
#undef IN
#undef BOTH
}

extern "C" void kernel_launch(void* const* d_in, const int* in_sizes, int n_in, void* d_out, int out_size, void* d_ws, size_t ws_size, hipStream_t stream) {
    static int grid = 0;
    if (grid == 0) {
        if (n_in != 22 || in_sizes[0] != TP * DM || in_sizes[1] != NBS * TS * DM || out_size != MTOK * DM || ws_size < WS_END) {
            fprintf(stderr, "kernel_launch: unexpected shapes / workspace (n_in %d, in0 %d, out %d, ws %zu); nothing launched\n", n_in, n_in > 0 ? in_sizes[0] : -1, out_size, ws_size); grid = -1; return; }
        int dev = 0, cus = 0, per_cu = 0;
        if (hipGetDevice(&dev) != hipSuccess || hipDeviceGetAttribute(&cus, hipDeviceAttributeMultiprocessorCount, dev) != hipSuccess) { grid = -1; return; }
        if (hipFuncSetAttribute((const void*)skel_fwd, hipFuncAttributeMaxDynamicSharedMemorySize, LDS_BYTES) != hipSuccess) { fprintf(stderr, "kernel_launch: hipFuncSetAttribute failed\n"); grid = -1; return; }
        if (hipOccupancyMaxActiveBlocksPerMultiprocessor(&per_cu, (const void*)skel_fwd, NWAVES * 64, LDS_BYTES) != hipSuccess || per_cu < 1) { fprintf(stderr, "kernel_launch: occupancy query says %d\n", per_cu); (void)hipGetLastError(); grid = -1; return; }
        grid = cus * per_cu;
    }
    if (grid < 0) return;
    if (hipMemsetAsync((char*)d_ws + WS_CTL, 0, CTL_ZERO_BYTES, stream) != hipSuccess) return;
    Args a{};
    for (int i = 0; i < 22; ++i) a.in[i] = (const float*)d_in[i];
    a.out = (float*)d_out; a.ws = (unsigned char*)d_ws;
    if (N_LAUNCHES == 1) {
        a.ph_lo = 0; a.ph_hi = NPH;
        void* kargs[] = {&a};
        hipError_t e = hipLaunchCooperativeKernel((const void*)skel_fwd, dim3(grid), dim3(NWAVES * 64), kargs, LDS_BYTES, stream);
        if (e != hipSuccess) fprintf(stderr, "kernel_launch: cooperative launch failed: %s (grid %d)\n", hipGetErrorString(e), grid);
    } else {
        for (int li = 0; li < NPH; ++li) { a.ph_lo = li; a.ph_hi = li + 1; hipLaunchKernelGGL(skel_fwd, dim3(grid), dim3(NWAVES * 64), LDS_BYTES, stream, a); }
    }
}
```

```cpp
#include <hip/hip_runtime.h>
#include <hip/hip_cooperative_groups.h>
#include <cstdio>
#include <cstdint>
namespace cg = cooperative_groups;

constexpr int DM = 1024, TP = 16384, TS = 8192, NBS = 4, MTOK = TP + NBS * TS;
constexpr int NQKV = 2560, NHEADS = 40, FF = 4096, NMEM = 256, NBATCH = 1 + NBS, MMEM = NBATCH * NMEM;
constexpr float RMS_EPS = 1e-6f;
constexpr float LOG2E = 1.4426950408889634f;
constexpr float QSCALE = 0.125f * LOG2E;
#ifndef ATT_A_MFMA
#define ATT_A_MFMA 1
#endif
#ifndef ATT_B_MFMA
#define ATT_B_MFMA 1
#endif
#ifndef ATT_M_MFMA
#define ATT_M_MFMA 1
#endif
namespace pg8 {
#define PG8_LAS __attribute__((address_space(3)))
typedef unsigned short bf16_t;
typedef short bf16x8 __attribute__((ext_vector_type(8)));
typedef float f32x4 __attribute__((ext_vector_type(4)));
typedef unsigned u32x4 __attribute__((ext_vector_type(4)));
constexpr int BM = 256, BK = 64, HALF = 128, HTB = HALF * BK * 2  , STAGE_BYTES = 8 * HTB, NXCD = 8, WGM = 8;

__host__ __device__ __forceinline__ int lds_byte(int r, int c) { const int st = (r >> 4) * 2 + (c >> 5), rr = r & 15, cc = c & 31, ob = rr * 64 + cc * 2; return st * 1024 + (ob ^ (((ob >> 9) & 1) << 5)); }
__host__ __device__ __forceinline__ void stage_rc(int b, int& R, int& C) { const int st = b / 1024, sb = b % 1024, swz = sb ^ (((sb >> 9) & 1) << 5); R = (st >> 1) * 16 + swz / 64; C = (st & 1) * 32 + (swz % 64) / 2; }
__host__ __device__ __forceinline__ int perm32(int rho) { const int n = rho >> 4, i = rho & 15; return 8 * (i >> 2) + 4 * n + (i & 3); }

struct Unit { int pm, pn; };
struct Gemm { const bf16_t* A; const bf16_t* Bt; int M, N, K; };

struct StaticOrder {
    int nM, nN, nwg, G, c;
    __host__ __device__ void init(int M, int N, int G_, int c_) { nM = M / BM; nN = N / BM; nwg = nM * nN; G = G_; c = c_; }
    __host__ __device__ bool next(int i, Unit& u) const {
        const long L = (long)i * G + c; if (L >= nwg) return false;
        int wgid = (int)L; { const int q = nwg / NXCD, r = nwg % NXCD, xcd = wgid % NXCD, off = wgid / NXCD; wgid = (xcd < r ? xcd * (q + 1) : r * (q + 1) + (xcd - r) * q) + off; }
        const int nig = WGM * nN, gid = wgid / nig, fm = gid * WGM, gsz = (nM - fm) < WGM ? (nM - fm) : WGM;
        u.pm = fm + ((wgid % nig) % gsz); u.pn = (wgid % nig) / gsz; return true;
    }
    __device__ __forceinline__ void a_ready(const Unit&) const {}
    __device__ __forceinline__ void done(const Unit&) const {}
};

__device__ __forceinline__ unsigned cvt_pk_bf16(float lo, float hi) { unsigned r; asm volatile("v_cvt_pk_bf16_f32 %0, %1, %2" : "=v"(r) : "v"(lo), "v"(hi)); return r; }
typedef float f32x2 __attribute__((ext_vector_type(2)));
__device__ __forceinline__ float sq4(const f32x4 v) { return (v[0] * v[0] + v[1] * v[1]) + (v[2] * v[2] + v[3] * v[3]); }
__device__ __forceinline__ u32x4 pack8(const f32x4 a, const f32x4 b) { u32x4 w; w.x = cvt_pk_bf16(a[0], a[1]); w.y = cvt_pk_bf16(a[2], a[3]); w.z = cvt_pk_bf16(b[0], b[1]); w.w = cvt_pk_bf16(b[2], b[3]); return w; }

struct EpiQKV {
    static constexpr bool PERM = true, AFTER_DRAIN = false;
    bf16_t* QKV;
    const float *gqa, *gka, *gqb, *gkb, *gqm;
    const float *rc, *rs;
    __device__ __forceinline__ void operator()(const f32x4 (&acc)[2][2][4][2], const Unit& u, int wr, int wc, int fr, int fq) const {
        const int hidx = u.pn * 4 + wc;
        const float* gain = nullptr; bool rope = false; float qs = 1.f;
        if (hidx < 6) { gain = gqa; rope = true; qs = QSCALE; } else if (hidx < 12) { gain = gka; rope = true; } else if (hidx < 18) { } else if (hidx < 24) { gain = gqb; qs = QSCALE; }
        else if (hidx < 30) { gain = gkb; } else if (hidx < 36) { } else { gain = gqm; qs = QSCALE; }
        const bool rl = rope && fq < 2;
        f32x4 g[2][2];
#pragma unroll
        for (int bj = 0; bj < 2; ++bj)
#pragma unroll
            for (int n = 0; n < 2; ++n) { const int d0 = (rl && bj == 0) ? (8 * n + 4 * fq) : (32 * bj + 8 * fq + 4 * n); g[bj][n] = gain ? *(const f32x4*)(gain + d0) : (f32x4){1.f, 1.f, 1.f, 1.f}; }
        bf16_t* base = QKV + (size_t)hidx * MTOK * 64 + 8 * fq;
#pragma unroll
        for (int ai = 0; ai < 2; ++ai)
#pragma unroll
            for (int m = 0; m < 4; ++m) {
                const int row = u.pm * BM + ai * HALF + wr * 64 + m * 16 + fr;
                f32x4 v[2][2];
#pragma unroll
                for (int bj = 0; bj < 2; ++bj)
#pragma unroll
                    for (int n = 0; n < 2; ++n) v[bj][n] = acc[ai][bj][m][n];
                if (gain) {
                    float ss = (sq4(v[0][0]) + sq4(v[0][1])) + (sq4(v[1][0]) + sq4(v[1][1]));
                    ss += __shfl_xor(ss, 16); ss += __shfl_xor(ss, 32);
                    const float r = rsqrtf(ss * (1.f / 64.f) + RMS_EPS) * qs;
#pragma unroll
                    for (int bj = 0; bj < 2; ++bj)
#pragma unroll
                        for (int n = 0; n < 2; ++n) v[bj][n] = v[bj][n] * r * g[bj][n];
                    if (rope) {
                        const int pos = row < TP ? row : ((row - TP) & (TS - 1));
                        const f32x4 c = *(const f32x4*)(rc + pos * 8 + 4 * (fq & 1)), s = *(const f32x4*)(rs + pos * 8 + 4 * (fq & 1));
                        if (fq < 2) { const f32x4 x1 = v[0][0], x2 = v[0][1]; v[0][0] = x1 * c - x2 * s; v[0][1] = x2 * c + x1 * s; }
                    }
                }
                bf16_t* rowp = base + (size_t)row * 64;
                *(u32x4*)(rowp) = pack8(v[0][0], v[0][1]);
                *(u32x4*)(rowp + 32) = pack8(v[1][0], v[1][1]);
            }
    }
};
struct EpiMemKV {
    static constexpr bool PERM = true, AFTER_DRAIN = false;
    bf16_t* MK; bf16_t* MV; const float* gk;
    __device__ __forceinline__ void operator()(const f32x4 (&acc)[2][2][4][2], const Unit& u, int wr, int wc, int fr, int fq) const {
        const int hidx = u.pn * 4 + wc; const bool isk = hidx < 4; const int h = hidx & 3;
        f32x4 g[2][2];
#pragma unroll
        for (int bj = 0; bj < 2; ++bj)
#pragma unroll
            for (int n = 0; n < 2; ++n) g[bj][n] = isk ? *(const f32x4*)(gk + 32 * bj + 8 * fq + 4 * n) : (f32x4){1.f, 1.f, 1.f, 1.f};
        bf16_t* base = (isk ? MK : MV) + 8 * fq;
#pragma unroll
        for (int ai = 0; ai < 2; ++ai)
#pragma unroll
            for (int m = 0; m < 4; ++m) {
                const int row = u.pm * BM + ai * HALF + wr * 64 + m * 16 + fr;
                f32x4 v[2][2];
#pragma unroll
                for (int bj = 0; bj < 2; ++bj)
#pragma unroll
                    for (int n = 0; n < 2; ++n) v[bj][n] = acc[ai][bj][m][n];
                if (isk) {
                    float ss = (sq4(v[0][0]) + sq4(v[0][1])) + (sq4(v[1][0]) + sq4(v[1][1]));
                    ss += __shfl_xor(ss, 16); ss += __shfl_xor(ss, 32);
                    const float r = rsqrtf(ss * (1.f / 64.f) + RMS_EPS);
#pragma unroll
                    for (int bj = 0; bj < 2; ++bj)
#pragma unroll
                        for (int n = 0; n < 2; ++n) v[bj][n] = v[bj][n] * r * g[bj][n];
                }
                bf16_t* rowp = base + ((size_t)((row >> 8) * 4 + h) * NMEM + (row & 255)) * 64;
                *(u32x4*)(rowp) = pack8(v[0][0], v[0][1]);
                *(u32x4*)(rowp + 32) = pack8(v[1][0], v[1][1]);
            }
    }
};
struct EpiX1 {
    static constexpr bool PERM = true, AFTER_DRAIN = false;
    const float* xp; const float* xs; float* out; bf16_t* x1b; float* ssq;
    __device__ __forceinline__ void operator()(const f32x4 (&acc)[2][2][4][2], const Unit& u, int wr, int wc, int fr, int fq) const {
        const int col0 = u.pn * BM + wc * 32 + 8 * fq;
#pragma unroll
        for (int ai = 0; ai < 2; ++ai)
#pragma unroll
            for (int m = 0; m < 4; ++m) {
                const int row = u.pm * BM + ai * HALF + wr * 64 + m * 16 + fr;
                const float* xrow = (row < TP ? xp + (size_t)row * DM : xs + (size_t)(row - TP) * DM) + col0;
                float* orow = out + (size_t)row * DM + col0; bf16_t* brow = x1b + (size_t)row * DM + col0;
                float ss = 0.f;
#pragma unroll
                for (int bj = 0; bj < 2; ++bj) {
                    const f32x4 v0 = acc[ai][bj][m][0] + *(const f32x4*)(xrow + bj * HALF), v1 = acc[ai][bj][m][1] + *(const f32x4*)(xrow + bj * HALF + 4);
                    *(f32x4*)(orow + bj * HALF) = v0; *(f32x4*)(orow + bj * HALF + 4) = v1;
                    *(u32x4*)(brow + bj * HALF) = pack8(v0, v1);
                    ss += sq4(v0) + sq4(v1);
                }
                ss += __shfl_xor(ss, 16); ss += __shfl_xor(ss, 32);
                if (fq == 0) unsafeAtomicAdd(ssq + row, ss);
            }
    }
};
struct EpiH {
    static constexpr bool PERM = true, AFTER_DRAIN = false;
    bf16_t* H; const float* ssq;
    __device__ __forceinline__ void operator()(const f32x4 (&acc)[2][2][4][2], const Unit& u, int wr, int wc, int fr, int fq) const {
        const int col0 = u.pn * BM + wc * 32 + 8 * fq;
#pragma unroll
        for (int ai = 0; ai < 2; ++ai)
#pragma unroll
            for (int m = 0; m < 4; ++m) {
                const int row = u.pm * BM + ai * HALF + wr * 64 + m * 16 + fr;
                const float r = rsqrtf(ssq[row] * (1.f / DM) + RMS_EPS);
                bf16_t* hrow = H + (size_t)row * FF + col0;
#pragma unroll
                for (int bj = 0; bj < 2; ++bj) {
                    f32x4 v0 = acc[ai][bj][m][0] * r, v1 = acc[ai][bj][m][1] * r;
#pragma unroll
                    for (int e = 0; e < 4; ++e) { const float a = fmaxf(v0[e], 0.f), b = fmaxf(v1[e], 0.f); v0[e] = a * a; v1[e] = b * b; }
                    *(u32x4*)(hrow + bj * HALF) = pack8(v0, v1);
                }
            }
    }
};
struct EpiOut {
    static constexpr bool PERM = true, AFTER_DRAIN = false;
    float* out;
    __device__ __forceinline__ void operator()(const f32x4 (&acc)[2][2][4][2], const Unit& u, int wr, int wc, int fr, int fq) const {
        const int col0 = u.pn * BM + wc * 32 + 8 * fq;
#pragma unroll
        for (int ai = 0; ai < 2; ++ai)
#pragma unroll
            for (int m = 0; m < 4; ++m) {
                const int row = u.pm * BM + ai * HALF + wr * 64 + m * 16 + fr;
                float* orow = out + (size_t)row * DM + col0;
#pragma unroll
                for (int bj = 0; bj < 2; ++bj) {
                    const f32x4 v0 = acc[ai][bj][m][0] + *(const f32x4*)(orow + bj * HALF), v1 = acc[ai][bj][m][1] + *(const f32x4*)(orow + bj * HALF + 4);
                    *(f32x4*)(orow + bj * HALF) = v0; *(f32x4*)(orow + bj * HALF + 4) = v1;
                }
            }
    }
};

template <class Epi, class Sched, bool ALIGN_EPI = false, bool SP2 = false>
__device__ __forceinline__ void gemm_phase(PG8_LAS unsigned char* lds, const Gemm g, const Sched& S, const Epi& E) {
    const int tid = threadIdx.x, wid = __builtin_amdgcn_readfirstlane(tid >> 6), lane = tid & 63, wr = wid >> 2, wc = wid & 3, fr = lane & 15, fq = lane >> 4;
    const int K = g.K, nt = K / BK;
    unsigned voffA[2], voffB[2];
#pragma unroll
    for (int i = 0; i < 2; ++i) { int R, C; stage_rc(tid * 16 + i * 8192, R, C); const int Rb = Epi::PERM ? ((R & ~31) + perm32(R & 31)) : R;
        voffA[i] = (unsigned)(R * K + C) * 2u; voffB[i] = (unsigned)(Rb * K + C) * 2u; }
    const size_t kstep = (size_t)(BK * 2);
    const size_t hstep = (size_t)HALF * K * 2;
    const size_t tstep = 2 * hstep;
    const unsigned ldsw = (unsigned)wid * 1024u;
    const int aoff = lds_byte(wr * 64 + fr, fq * 8), boff = lds_byte(wc * 32 + fr, fq * 8);
#define PG8_SA(b, h) (((b) * 2 + (h)) * HTB)
#define PG8_SB(b, h) ((4 + (b) * 2 + (h)) * HTB)
#define PG8_STAGE(bufoff, gbase, voff) do { _Pragma("unroll") for (int _i = 0; _i < 2; ++_i) \
        __builtin_amdgcn_global_load_lds((const unsigned*)((const char*)(gbase) + (voff)[_i]), (PG8_LAS unsigned*)(lds + (bufoff) + ldsw + _i * 8192), 16, 0, 0); } while (0)
#define PG8_LDA(dst, b, h) do { _Pragma("unroll") for (int m = 0; m < 4; ++m) _Pragma("unroll") for (int k = 0; k < 2; ++k) dst[m][k] = *(const PG8_LAS bf16x8*)(lds + PG8_SA(b, h) + aoff + m * 2048 + k * 1024); } while (0)
#define PG8_LDB(dst, b, h) do { _Pragma("unroll") for (int n = 0; n < 2; ++n) _Pragma("unroll") for (int k = 0; k < 2; ++k) dst[n][k] = *(const PG8_LAS bf16x8*)(lds + PG8_SB(b, h) + boff + n * 2048 + k * 1024); } while (0)
#define PG8_MMA(ai, bj, At, Bt) do { __builtin_amdgcn_s_setprio(1); _Pragma("unroll") for (int m = 0; m < 4; ++m) _Pragma("unroll") for (int n = 0; n < 2; ++n) _Pragma("unroll") for (int k = 0; k < 2; ++k) \
        acc[ai][bj][m][n] = __builtin_amdgcn_mfma_f32_16x16x32_bf16(Bt[n][k], At[m][k], acc[ai][bj][m][n], 0, 0, 0); __builtin_amdgcn_s_setprio(0); } while (0)
#define PG8_WAIT_V(n) asm volatile("s_waitcnt vmcnt(" #n ")" ::: "memory")
#define PG8_WAIT_L(n) asm volatile("s_waitcnt lgkmcnt(" #n ")" ::: "memory")
#define PG8_BAR __builtin_amdgcn_s_barrier()
#define PG8_SCHED __builtin_amdgcn_sched_barrier(0)
    Unit cur, nxt; int ui = 0;
    if (!S.next(0, cur)) return;
    f32x4 acc[2][2][4][2];
#pragma unroll
    for (int a = 0; a < 2; ++a)
#pragma unroll
        for (int b = 0; b < 2; ++b)
#pragma unroll
            for (int m = 0; m < 4; ++m)
#pragma unroll
                for (int n = 0; n < 2; ++n) acc[a][b][m][n] = (f32x4){0.f, 0.f, 0.f, 0.f};
    bf16x8 At[4][2], B0[2][2], B1[2][2];
    const char* cA = (const char*)g.A + (size_t)cur.pm * tstep; const char* cB = (const char*)g.Bt + (size_t)cur.pn * tstep;
    S.a_ready(cur);
    if constexpr (SP2) {
        PG8_STAGE(PG8_SB(0, 0), cB, voffB); PG8_STAGE(PG8_SB(0, 1), cB + hstep, voffB); PG8_STAGE(PG8_SA(0, 0), cA, voffA); PG8_STAGE(PG8_SA(0, 1), cA + hstep, voffA);
        if (wr == 1) PG8_BAR;
        PG8_WAIT_V(2); PG8_BAR;
        PG8_STAGE(PG8_SB(1, 0), cB + kstep, voffB); PG8_STAGE(PG8_SA(1, 0), cA + kstep, voffA); PG8_STAGE(PG8_SB(1, 1), cB + hstep + kstep, voffB);
        PG8_WAIT_V(6); PG8_BAR;
    } else {
        PG8_STAGE(PG8_SB(0, 0), cB, voffB); PG8_STAGE(PG8_SA(0, 0), cA, voffA); PG8_STAGE(PG8_SB(0, 1), cB + hstep, voffB); PG8_STAGE(PG8_SA(0, 1), cA + hstep, voffA);
        if (wr == 1) PG8_BAR;
        PG8_WAIT_V(4); PG8_BAR;
        PG8_STAGE(PG8_SB(1, 0), cB + kstep, voffB); PG8_STAGE(PG8_SA(1, 0), cA + kstep, voffA); PG8_STAGE(PG8_SB(1, 1), cB + hstep + kstep, voffB);
        PG8_WAIT_V(6); PG8_BAR;
    }
    for (;;) {
        const bool has_next = S.next(ui + 1, nxt);
        const char* nA = has_next ? (const char*)g.A + (size_t)nxt.pm * tstep : cA; const char* nB = has_next ? (const char*)g.Bt + (size_t)nxt.pn * tstep : cB;
        for (int t = 0; t < nt; t += 2) {
            const bool last = (t == nt - 2);
            const char* a1 = cA + (size_t)(t + 1) * kstep;
            const char* a2 = last ? nA : cA + (size_t)(t + 2) * kstep; const char* b2 = last ? nB : cB + (size_t)(t + 2) * kstep;
            const char* a3 = a2 + kstep; const char* b3 = b2 + kstep;
            if (last && has_next) S.a_ready(nxt);
            if constexpr (SP2) {
            PG8_LDB(B0, 0, 0); PG8_LDB(B1, 0, 1); PG8_SCHED; PG8_LDA(At, 0, 0); PG8_STAGE(PG8_SA(1, 1), a1 + hstep, voffA);
            PG8_WAIT_V(8); PG8_WAIT_L(0); PG8_BAR; PG8_MMA(0, 0, At, B0); PG8_MMA(0, 1, At, B1); PG8_BAR; PG8_SCHED;
            PG8_LDA(At, 0, 1); PG8_STAGE(PG8_SB(0, 0), b2, voffB); PG8_STAGE(PG8_SB(0, 1), b2 + hstep, voffB); PG8_STAGE(PG8_SA(0, 0), a2, voffA);
            PG8_WAIT_V(8); PG8_WAIT_L(0); PG8_BAR; PG8_MMA(1, 0, At, B0); PG8_MMA(1, 1, At, B1); PG8_BAR; PG8_SCHED;
            PG8_LDB(B0, 1, 0); PG8_LDB(B1, 1, 1); PG8_SCHED; PG8_LDA(At, 1, 0); PG8_STAGE(PG8_SA(0, 1), a2 + hstep, voffA);
            PG8_WAIT_V(8); PG8_WAIT_L(0); PG8_BAR; PG8_MMA(0, 0, At, B0); PG8_MMA(0, 1, At, B1); PG8_BAR; PG8_SCHED;
            PG8_LDA(At, 1, 1); PG8_STAGE(PG8_SB(1, 0), b3, voffB); PG8_STAGE(PG8_SB(1, 1), b3 + hstep, voffB); PG8_STAGE(PG8_SA(1, 0), a3, voffA);
            PG8_WAIT_V(8); PG8_WAIT_L(0); PG8_BAR; PG8_MMA(1, 0, At, B0); PG8_MMA(1, 1, At, B1); PG8_BAR; PG8_SCHED;
            } else {
            PG8_LDB(B0, 0, 0); PG8_SCHED; PG8_LDA(At, 0, 0); PG8_STAGE(PG8_SA(1, 1), a1 + hstep, voffA);
            PG8_WAIT_L(8); PG8_BAR; PG8_WAIT_L(0); PG8_MMA(0, 0, At, B0); PG8_BAR; PG8_SCHED;
            PG8_LDB(B1, 0, 1); PG8_STAGE(PG8_SB(0, 0), b2, voffB);
            PG8_BAR; PG8_WAIT_L(0); PG8_MMA(0, 1, At, B1); PG8_BAR;
            PG8_LDA(At, 0, 1); PG8_STAGE(PG8_SA(0, 0), a2, voffA);
            PG8_BAR; PG8_WAIT_L(0); PG8_MMA(1, 0, At, B0); PG8_BAR; PG8_SCHED;
            PG8_STAGE(PG8_SB(0, 1), b2 + hstep, voffB);
            PG8_WAIT_V(6); PG8_BAR; PG8_MMA(1, 1, At, B1); PG8_BAR;
            PG8_LDB(B0, 1, 0); PG8_SCHED; PG8_LDA(At, 1, 0); PG8_STAGE(PG8_SA(0, 1), a2 + hstep, voffA);
            PG8_WAIT_L(8); PG8_BAR; PG8_WAIT_L(0); PG8_MMA(0, 0, At, B0); PG8_BAR; PG8_SCHED;
            PG8_LDB(B1, 1, 1); PG8_STAGE(PG8_SB(1, 0), b3, voffB);
            PG8_BAR; PG8_WAIT_L(0); PG8_MMA(0, 1, At, B1); PG8_BAR;
            PG8_LDA(At, 1, 1); PG8_STAGE(PG8_SA(1, 0), a3, voffA);
            PG8_BAR; PG8_WAIT_L(0); PG8_MMA(1, 0, At, B0); PG8_BAR; PG8_SCHED;
            PG8_STAGE(PG8_SB(1, 1), b3 + hstep, voffB);
            PG8_WAIT_V(6); PG8_BAR; PG8_MMA(1, 1, At, B1); PG8_BAR;
            }
        }
        if constexpr (ALIGN_EPI) { if (wr == 0) PG8_BAR; }
        if constexpr (!Epi::AFTER_DRAIN) { E(acc, cur, wr, wc, fr, fq); S.done(cur); }
        if (!has_next) break;
#pragma unroll
        for (int a = 0; a < 2; ++a)
#pragma unroll
            for (int b = 0; b < 2; ++b)
#pragma unroll
                for (int m = 0; m < 4; ++m)
#pragma unroll
                    for (int n = 0; n < 2; ++n) acc[a][b][m][n] = (f32x4){0.f, 0.f, 0.f, 0.f};
        cur = nxt; cA = nA; cB = nB; ++ui;
        if constexpr (ALIGN_EPI) { if (wr == 1) PG8_BAR; }
    }
    PG8_WAIT_V(0);
    if constexpr (!ALIGN_EPI) { if (wr == 0) PG8_BAR; }
    PG8_BAR;
    if constexpr (Epi::AFTER_DRAIN) { E.fused(acc, cur, wr, wc, fr, fq, lds, wid, lane); S.done(cur); }
#undef PG8_SA
#undef PG8_SB
#undef PG8_STAGE
#undef PG8_LDA
#undef PG8_LDB
#undef PG8_MMA
#undef PG8_WAIT_V
#undef PG8_WAIT_L
#undef PG8_BAR
#undef PG8_SCHED
}
}

constexpr int NWAVES = 8;
#ifndef MK_N_LAUNCHES
#define MK_N_LAUNCHES 1
#endif
constexpr int NPH = 7;
constexpr int N_LAUNCHES = MK_N_LAUNCHES;

constexpr size_t MiB = 1u << 20;
constexpr size_t WS_CTL = 0, WS_SSQF = 1 * MiB, CTL_ZERO_BYTES = 2 * MiB;
constexpr size_t WS_ROPE = 2 * MiB;
constexpr size_t WS_WIN = 3 * MiB, WS_WMEM = 8 * MiB, WS_WOUT = 9 * MiB, WS_W1 = 11 * MiB, WS_W2 = 19 * MiB;
constexpr size_t WS_XNMEM = 27 * MiB, WS_MK = 30 * MiB, WS_MV = 31 * MiB;
constexpr size_t WS_X1B = 32 * MiB;
constexpr size_t WS_XN = 128 * MiB, WS_O = 128 * MiB;
constexpr size_t WS_QKV = 224 * MiB;
constexpr size_t WS_H = 128 * MiB;
constexpr size_t WS_END = 512 * MiB;
static_assert(WS_QKV + (size_t)NHEADS * MTOK * 64 * 2 <= WS_END && WS_H + (size_t)MTOK * FF * 2 <= WS_END && WS_X1B + (size_t)MTOK * DM * 2 <= WS_XN && WS_XN + (size_t)MTOK * DM * 2 <= WS_QKV, "d_ws map");

constexpr int RING_BYTES = 131072;
constexpr int LDS_BYTES = 147456;

#define LAS __attribute__((address_space(3)))
typedef unsigned short bf16;
typedef unsigned v4u __attribute__((ext_vector_type(4)));
typedef float f32x4 __attribute__((ext_vector_type(4)));
#define LDS_WAIT() asm volatile("s_waitcnt lgkmcnt(0)" ::: "memory")
__device__ __forceinline__ unsigned f2bf(float f) { unsigned u = __builtin_bit_cast(unsigned, f); return (u + 0x7fffu + ((u >> 16) & 1u)) >> 16; }
__device__ __forceinline__ unsigned pk2(float lo, float hi) { return f2bf(lo) | (f2bf(hi) << 16); }
__device__ __forceinline__ float bflo(unsigned w) { return __uint_as_float(w << 16); }
__device__ __forceinline__ float bfhi(unsigned w) { return __uint_as_float(w & 0xffff0000u); }
__device__ __forceinline__ float wave_sum(float v) {
#pragma unroll
    for (int o = 1; o < 64; o <<= 1) v += __shfl_xor(v, o);
    return v;
}

struct Frame {
    LAS unsigned char* lds;
    int tid, lane, wave, vcu, G;
    float* out; unsigned char* ws;
};
struct Args { const float* in[22]; float* out; unsigned char* ws; int ph_lo, ph_hi; };


namespace att {
typedef short bf16x8 __attribute__((ext_vector_type(8)));
typedef short s16x4 __attribute__((ext_vector_type(4)));
typedef short v4i16_t __attribute__((ext_vector_type(4)));
typedef float f32x16 __attribute__((ext_vector_type(16)));
typedef float f32x4 __attribute__((ext_vector_type(4)));
typedef unsigned u32x4 __attribute__((ext_vector_type(4)));
typedef float f32x2_t __attribute__((ext_vector_type(2))); typedef __bf16 bf16x2_t __attribute__((ext_vector_type(2)));
typedef __attribute__((address_space(3))) unsigned char* lptr;
__device__ __forceinline__ unsigned cvtpk(float lo, float hi) { f32x2_t v = {lo, hi}; bf16x2_t b = __builtin_convertvector(v, bf16x2_t); return __builtin_bit_cast(unsigned, b); }
__device__ __forceinline__ s16x4 vtr(lptr p) { return __builtin_bit_cast(s16x4, __builtin_amdgcn_ds_read_tr16_b64_v4i16((__attribute__((address_space(3))) v4i16_t*)p)); }
__device__ __forceinline__ int creg(int r) { return (r & 3) + 8 * (r >> 2); }
constexpr float NEG = -INFINITY;

template <class Spec> __device__ __forceinline__ void load_tile(const Spec& S, int t, bf16x8 (&kn)[4], u32x4 (&vn)[4], int lane) {
    const int r32 = lane & 31, hi = lane >> 5;
    const bf16* kp = S.krow(t, r32) + 8 * hi;
#pragma unroll
    for (int d0 = 0; d0 < 4; ++d0) kn[d0] = *(const bf16x8*)(kp + 16 * d0);
    const bf16* v0 = S.vrow(t, lane >> 2) + 8 * (lane & 3);
    const bf16* v1 = S.vrow(t, 16 + (lane >> 2)) + 8 * (lane & 3);
    vn[0] = *(const u32x4*)(v0); vn[1] = *(const u32x4*)(v1); vn[2] = *(const u32x4*)(v0 + 32); vn[3] = *(const u32x4*)(v1 + 32);
}
template <class Spec> __device__ __forceinline__ void run_tiles(const Spec& S, const bf16x8 (&qr)[4], f32x16 (&o)[2], float& lsum, lptr vbuf, int lane) {
    const int hi = lane >> 5;
    const int NT = S.ntiles();
    const int loff = ((lane >> 4) & 1) * 32 + (lane & 3) * 8 + (4 * hi + ((lane & 15) >> 2)) * 64;
    bf16x8 kn[4]; u32x4 vn[4];
    load_tile(S, 0, kn, vn, lane);
    for (int t = 0; t < NT; ++t) {
        bf16x8 kf[4];
#pragma unroll
        for (int d0 = 0; d0 < 4; ++d0) kf[d0] = kn[d0];
        lptr vb = vbuf + (t & 1) * 4096;
#pragma unroll
        for (int j = 0; j < 4; ++j) *(__attribute__((address_space(3))) u32x4*)(vb + j * 1024 + lane * 16) = vn[j];
        if (t + 1 < NT) load_tile(S, t + 1, kn, vn, lane);
        f32x16 p = {};
#pragma unroll
        for (int d0 = 0; d0 < 4; ++d0) p = __builtin_amdgcn_mfma_f32_32x32x16_bf16(kf[d0], qr[d0], p, 0, 0, 0);
        S.mask(t, p, lane);
        float sacc = 0.f;
#pragma unroll
        for (int r = 0; r < 16; ++r) { p[r] = __builtin_amdgcn_exp2f(p[r]); sacc += p[r]; }
        lsum += sacc;
        u32x4 pw0, pw1;
        pw0[0] = cvtpk(p[0], p[1]); pw0[1] = cvtpk(p[2], p[3]); pw0[2] = cvtpk(p[4], p[5]); pw0[3] = cvtpk(p[6], p[7]);
        pw1[0] = cvtpk(p[8], p[9]); pw1[1] = cvtpk(p[10], p[11]); pw1[2] = cvtpk(p[12], p[13]); pw1[3] = cvtpk(p[14], p[15]);
#pragma unroll
        for (int dh = 0; dh < 2; ++dh) {
            const s16x4 l0 = vtr(vb + dh * 2048 + loff), h0 = vtr(vb + dh * 2048 + 512 + loff), l1 = vtr(vb + dh * 2048 + 1024 + loff), h1 = vtr(vb + dh * 2048 + 1536 + loff);
            const bf16x8 f0 = {l0[0], l0[1], l0[2], l0[3], h0[0], h0[1], h0[2], h0[3]}, f1 = {l1[0], l1[1], l1[2], l1[3], h1[0], h1[1], h1[2], h1[3]};
            o[dh] = __builtin_amdgcn_mfma_f32_32x32x16_bf16(__builtin_bit_cast(bf16x8, pw0), f0, o[dh], 0, 0, 0);
            o[dh] = __builtin_amdgcn_mfma_f32_32x32x16_bf16(__builtin_bit_cast(bf16x8, pw1), f1, o[dh], 0, 0, 0);
        }
    }
}
__device__ __forceinline__ void load_q(bf16x8 (&qr)[4], const bf16* qrow, int lane) {
    const int hi = lane >> 5;
#pragma unroll
    for (int d0 = 0; d0 < 4; ++d0) qr[d0] = *(const bf16x8*)(qrow + 16 * d0 + 8 * hi);
}
template <class RowFn> __device__ __forceinline__ void store_out(const f32x16 (&o)[2], float lsum, lptr wbuf, const RowFn& orow, int lane) {
    const int r32 = lane & 31, hi = lane >> 5;
    lsum += __shfl_xor(lsum, 32);
    __attribute__((address_space(3))) float* ls = (__attribute__((address_space(3))) float*)(wbuf + 4096);
    if (hi == 0) ls[r32] = lsum;
    __attribute__((address_space(3))) unsigned short* stg = (__attribute__((address_space(3))) unsigned short*)wbuf;
    float rl[16];
#pragma unroll
    for (int g = 0; g < 4; ++g) { const f32x4 lv = *(__attribute__((address_space(3))) f32x4*)(ls + 8 * g + 4 * hi);
#pragma unroll
        for (int j = 0; j < 4; ++j) rl[4 * g + j] = 1.0f / lv[j]; }
#pragma unroll
    for (int r = 0; r < 16; ++r) { const int q = creg(r) + 4 * hi;
#pragma unroll
        for (int dh = 0; dh < 2; ++dh) stg[q * 64 + dh * 32 + r32] = (unsigned short)f2bf(o[dh][r] * rl[r]); }
#pragma unroll
    for (int i = 0; i < 4; ++i) { const int row = i * 8 + (lane >> 3), ch = lane & 7; const u32x4 v = *(__attribute__((address_space(3))) u32x4*)(stg + row * 64 + ch * 8); *(u32x4*)(orow(row) + ch * 8) = v; }
}

struct SpecM { const bf16* K; const bf16* V;
    __device__ __forceinline__ int ntiles() const { return 8; }
    __device__ __forceinline__ const bf16* krow(int t, int i) const { return K + (32 * t + i) * 64; }
    __device__ __forceinline__ const bf16* vrow(int t, int i) const { return V + (32 * t + i) * 64; }
    __device__ __forceinline__ void mask(int, f32x16&, int) const {}
};
struct SpecB { const bf16* K; const bf16* V;
    int nt, rk0, w0;
    int rlo, dr0;
    int cb;
    const __attribute__((address_space(3))) float* tb;
    __device__ __forceinline__ int ntiles() const { return nt; }
    __device__ __forceinline__ const bf16* krow(int t, int i) const { return K + ((rk0 + t) * 64 + w0 + i) * 64; }
    __device__ __forceinline__ const bf16* vrow(int t, int i) const { return V + ((rk0 + t) * 64 + w0 + i) * 64; }
    __device__ __forceinline__ void mask(int t, f32x16& p, int lane) const {
        const int hi = lane >> 5, rk = rk0 + t; const bool rok = (unsigned)(rk - rlo) < 8u;
        int dr = rk + dr0; dr = dr < 0 ? 0 : (dr > 14 ? 14 : dr);
        const __attribute__((address_space(3))) float* tp = tb + dr * 64 + 4 * hi; const int cbh = rok ? cb + 4 * hi : -4096;
#pragma unroll
        for (int r = 0; r < 16; ++r) { const bool ok = (unsigned)(cbh + creg(r)) < 16u; p[r] = ok ? p[r] + tp[creg(r)] : NEG; }
    }
};
struct SpecA { const bf16* K; const bf16* V;
    int kp0, dil, T;
    __device__ __forceinline__ int ntiles() const { return 5; }
    __device__ __forceinline__ int kpos(int t, int i) const { int p = kp0 + (32 * t + i) * dil; return p < 0 ? 0 : (p >= T ? T - 1 : p); }
    __device__ __forceinline__ const bf16* krow(int t, int i) const { return K + kpos(t, i) * 64; }
    __device__ __forceinline__ const bf16* vrow(int t, int i) const { return V + kpos(t, i) * 64; }
    __device__ __forceinline__ void mask(int t, f32x16& p, int lane) const {
        const int r32 = lane & 31, hi = lane >> 5;
        const int lo = kp0 + 32 * t * dil, hip = lo + 31 * dil;
        if (t == 0 || t == 4) {
            const int base = 32 * t - r32 + 4 * hi;
#pragma unroll
            for (int r = 0; r < 16; ++r) { if ((unsigned)(base + creg(r)) > 128u) p[r] = NEG; } }
        if (lo < 0 || hip >= T) {
            const int kb = lo + 4 * hi * dil;
#pragma unroll
            for (int r = 0; r < 16; ++r) { const int kp = kb + creg(r) * dil; if ((unsigned)kp >= (unsigned)T) p[r] = NEG; } }
    }
};
struct SpecA16 { const bf16* K; const bf16* V;
    int kp0, T;
    __device__ __forceinline__ int ntiles() const { return 9; }
    __device__ __forceinline__ int kpos(int t, int i) const { int p = kp0 + (16 * t + (i & 15)) * 16 + (i >> 4); return p < 0 ? 0 : (p >= T ? T - 1 : p); }
    __device__ __forceinline__ const bf16* krow(int t, int i) const { return K + kpos(t, i) * 64; }
    __device__ __forceinline__ const bf16* vrow(int t, int i) const { return V + kpos(t, i) * 64; }
    __device__ __forceinline__ void mask(int t, f32x16& p, int lane) const {
        const int r32 = lane & 31, hi = lane >> 5, cq = r32 >> 4, iq = r32 & 15;
        const int lo = kp0 + 256 * t, hip = lo + 15 * 16 + 1;
        const int b0 = cq == 0 ? 16 * t - iq + 4 * hi : -4096, b1 = cq == 1 ? 16 * t - iq + 4 * hi : -4096;
#pragma unroll
        for (int r = 0; r < 16; ++r) { if ((unsigned)((r < 8 ? b0 : b1) + (creg(r) & 15)) > 128u) p[r] = NEG; }
        if (lo < 0 || hip >= T) {
            const int kb = lo + 4 * hi * 16;
#pragma unroll
            for (int r = 0; r < 16; ++r) { const int kp = kb + (creg(r) & 15) * 16 + (r >> 3); if ((unsigned)kp >= (unsigned)T) p[r] = NEG; } }
    }
};
}
template <class CM, class KS>
__device__ __forceinline__ void p0_transpose_item(const float* W, int K, int N, bf16* WT, LAS float* scr, int item, int lane, CM cm, KS ks) {
    const int nblk = N / 32, kb = item / nblk, nb = item % nblk, k0 = 64 * kb, n0 = 32 * nb;
    const int sc = cm(n0 + (lane & 31));
#pragma unroll 8
    for (int i = 0; i < 32; ++i) { const int kk = 2 * i + (lane >> 5); scr[kk * 33 + (lane & 31)] = W[(size_t)(k0 + kk) * N + sc] * ks(k0 + kk); }
    LDS_WAIT(); asm volatile("" ::: "memory");
    const int c = lane & 7;
#pragma unroll
    for (int j = 0; j < 4; ++j) { const int n = (lane >> 3) + 8 * j; const LAS float* s = scr + (8 * c) * 33 + n;
        v4u o; o.x = pk2(s[0 * 33], s[1 * 33]); o.y = pk2(s[2 * 33], s[3 * 33]); o.z = pk2(s[4 * 33], s[5 * 33]); o.w = pk2(s[6 * 33], s[7 * 33]);
        *(v4u*)(WT + (size_t)(n0 + n) * K + k0 + 8 * c) = o; }
    LDS_WAIT(); asm volatile("" ::: "memory");
}
struct CMapHead { int nrope;
    __device__ __forceinline__ int operator()(int c) const { const int pn = c >> 8, bj = (c >> 7) & 1, hh = (c >> 5) & 3, p5 = c & 31, hidx = 4 * pn + hh; int p = 32 * bj + p5;
        if (hidx < nrope && p < 16) p = (p & 3) + 8 * ((p >> 2) & 1) + 4 * (p >> 3); return 64 * hidx + p; } };
struct CMapId { __device__ __forceinline__ int operator()(int c) const { return c; } };
struct KSOne { __device__ __forceinline__ float operator()(int) const { return 1.f; } };
struct KSVec { const float* g; __device__ __forceinline__ float operator()(int k) const { return g[k]; } };
struct KSOut { const float *a, *b, *m; __device__ __forceinline__ float operator()(int k) const { return k < 384 ? a[k] : (k < 768 ? b[k - 384] : m[k - 768]); } };

__device__ __forceinline__ void rms_row_to_bf16(const float* xrow, const float* g, bf16* orow, int lane) {
    const f32x4* xr = (const f32x4*)xrow + lane; const f32x4* gr = (const f32x4*)g + lane;
    f32x4 v[4]; float s = 0.f;
#pragma unroll
    for (int j = 0; j < 4; ++j) { v[j] = xr[64 * j]; s += (v[j].x * v[j].x + v[j].y * v[j].y) + (v[j].z * v[j].z + v[j].w * v[j].w); }
    const float rstd = rsqrtf(wave_sum(s) * (1.f / DM) + RMS_EPS);
    unsigned long long* o8 = (unsigned long long*)orow + lane;
#pragma unroll
    for (int j = 0; j < 4; ++j) { const f32x4 gg = gr[64 * j]; o8[64 * j] = (unsigned long long)pk2(v[j].x * rstd * gg.x, v[j].y * rstd * gg.y) | ((unsigned long long)pk2(v[j].z * rstd * gg.z, v[j].w * rstd * gg.w) << 32); }
}
__device__ __forceinline__ void p0_prologue(Frame& F, const Args& A) {
    LAS float* scr = (LAS float*)(F.lds + F.wave * 16384);
    const int gw = F.vcu * NWAVES + F.wave, NGW = F.G * NWAVES;
    unsigned char* ws = F.ws;
    constexpr int I_IN = (DM / 64) * (NQKV / 32), I_MEM = (DM / 64) * (512 / 32), I_OUT = (DM / 64) * (DM / 32), I_1 = (DM / 64) * (FF / 32), I_2 = (FF / 64) * (DM / 32);
    constexpr int NITEMS = I_IN + I_MEM + I_OUT + I_1 + I_2;
    for (int it = gw; it < NITEMS; it += NGW) {
        int r = it;
        if (r < I_IN) { p0_transpose_item(A.in[5], DM, NQKV, (bf16*)(ws + WS_WIN), scr, r, F.lane, CMapHead{12}, KSOne{}); continue; } r -= I_IN;
        if (r < I_MEM) { p0_transpose_item(A.in[12], DM, 512, (bf16*)(ws + WS_WMEM), scr, r, F.lane, CMapHead{0}, KSOne{}); continue; } r -= I_MEM;
        if (r < I_OUT) { p0_transpose_item(A.in[18], DM, DM, (bf16*)(ws + WS_WOUT), scr, r, F.lane, CMapId{}, KSOut{A.in[15], A.in[16], A.in[17]}); continue; } r -= I_OUT;
        if (r < I_1) { p0_transpose_item(A.in[20], DM, FF, (bf16*)(ws + WS_W1), scr, r, F.lane, CMapId{}, KSVec{A.in[19]}); continue; } r -= I_1;
        p0_transpose_item(A.in[21], FF, DM, (bf16*)(ws + WS_W2), scr, r, F.lane, CMapId{}, KSOne{});
    }
    for (int m = gw; m < MTOK + MMEM; m += NGW) {
        if (m < MTOK) { const float* xrow = m < TP ? A.in[0] + (size_t)m * DM : A.in[1] + (size_t)(m - TP) * DM; rms_row_to_bf16(xrow, A.in[4], (bf16*)(ws + WS_XN) + (size_t)m * DM, F.lane); }
        else { const int r = m - MTOK; const float* xrow = r < NMEM ? A.in[2] + (size_t)r * DM : A.in[3] + (size_t)(r - NMEM) * DM; rms_row_to_bf16(xrow, A.in[11], (bf16*)(ws + WS_XNMEM) + (size_t)r * DM, F.lane); }
    }
    float* rc = (float*)(ws + WS_ROPE); float* rs = rc + TP * 8;
    for (int i = (F.vcu * NWAVES * 64) + F.tid; i < TP * 8; i += F.G * NWAVES * 64) {
        const int pos = i >> 3, fi = i & 7;
        const float inv = exp2f(-(float)fi * 0.125f * 18.931568569324174f);
        const float ang = (float)pos * inv;
        const double rev = (double)ang * 0.15915494309189535; const float fr = (float)(rev - __builtin_rint(rev));
        rc[i] = __builtin_amdgcn_cosf(fr); rs[i] = __builtin_amdgcn_sinf(fr);
    }
}

template <int NR, class KF>
__device__ __forceinline__ void attn_item(const bf16* qrow, const bf16* Kb, const bf16* Vb, const KF& kf, bf16* orow, int lane) {
    float q[64];
#pragma unroll
    for (int c = 0; c < 8; ++c) { const v4u w = *(const v4u*)(qrow + 8 * c);
#pragma unroll
        for (int e = 0; e < 4; ++e) { q[8 * c + 2 * e] = bflo(w[e]); q[8 * c + 2 * e + 1] = bfhi(w[e]); } }
    float p[NR]; float lsum = 0.f;
#pragma unroll
    for (int r = 0; r < NR; ++r) {
        long ridx; float bias; const bool ok = kf(64 * r + lane, ridx, bias);
        const bf16* krow = Kb + ridx * 64; float s = 0.f;
#pragma unroll
        for (int c = 0; c < 8; ++c) { const v4u w = *(const v4u*)(krow + 8 * c);
#pragma unroll
            for (int e = 0; e < 4; ++e) s += q[8 * c + 2 * e] * bflo(w[e]) + q[8 * c + 2 * e + 1] * bfhi(w[e]); }
        p[r] = ok ? exp2f(s + bias) : 0.f; lsum += p[r];
    }
    lsum = wave_sum(lsum);
    float o = 0.f;
#pragma unroll
    for (int r = 0; r < NR; ++r) {
#pragma unroll 8
        for (int l = 0; l < 64; ++l) {
            long ridx; float bias; (void)kf(64 * r + l, ridx, bias);
            const float pj = __int_as_float(__builtin_amdgcn_readlane(__float_as_int(p[r]), l));
            o += pj * __uint_as_float((unsigned)Vb[ridx * 64 + lane] << 16);
        }
    }
    orow[lane] = (bf16)f2bf(o / lsum);
}
struct KeyA { long sb; int pos, T;
    __device__ __forceinline__ bool operator()(int j, long& ridx, float& bias) const { const int pat = j >= 258 ? 2 : (j >= 129 ? 1 : 0), idx = j - 129 * pat, dil = 1 << (2 * pat), kp = pos + (idx - 64) * dil;
        const bool ok = j < 387 && kp >= 0 && kp < T; ridx = sb + (ok ? kp : pos); bias = 0.f; return ok; } };
struct KeyB { long sb; int r, c, rs, cs; const float* rpb;
    __device__ __forceinline__ bool operator()(int j, long& ridx, float& bias) const { const int kr = (j >> 4) & 7, kc = j & 15; ridx = sb + (rs + kr) * 64 + cs + kc;
        bias = rpb[(rs + kr - r + 7) * 31 + (cs + kc - c + 15)] * LOG2E; return true; } };
struct KeyM { long b0;
    __device__ __forceinline__ bool operator()(int j, long& ridx, float& bias) const { ridx = b0 + (j & 255); bias = 0.f; return true; } };

__device__ __forceinline__ void attn_simple_phase(Frame& F, const Args& A) {
    const int gw = F.vcu * NWAVES + F.wave, NGW = F.G * NWAVES;
    const bf16* QKV = (const bf16*)(F.ws + WS_QKV); bf16* O = (bf16*)(F.ws + WS_O);
    const bf16* MK = (const bf16*)(F.ws + WS_MK); const bf16* MV = (const bf16*)(F.ws + WS_MV);
    for (int it = gw; it < MTOK * 16; it += NGW) {
        const int hh = it / MTOK, row = it - hh * MTOK;
        const int sbat = row < TP ? 0 : 1 + ((row - TP) >> 13);
        const long sb = row < TP ? 0 : TP + (long)(sbat - 1) * TS; const int T = row < TP ? TP : TS, pos = (int)(row - sb);
        if (hh < 6) {
            if (ATT_A_MFMA) continue;
            const int h = hh;
            attn_item<7>(QKV + ((size_t)(0 + h) * MTOK + row) * 64, QKV + (size_t)(6 + h) * MTOK * 64, QKV + (size_t)(12 + h) * MTOK * 64, KeyA{sb, pos, T}, O + (size_t)row * DM + h * 64, F.lane);
        } else if (hh < 12) {
            if (ATT_B_MFMA) continue;
            const int h = hh - 6, rows = T / 64, r = pos >> 6, c = pos & 63;
            int rs = r - 4; rs = rs < 0 ? 0 : (rs > rows - 8 ? rows - 8 : rs); int cs = c - 8; cs = cs < 0 ? 0 : (cs > 48 ? 48 : cs);
            attn_item<2>(QKV + ((size_t)(18 + h) * MTOK + row) * 64, QKV + (size_t)(24 + h) * MTOK * 64, QKV + (size_t)(30 + h) * MTOK * 64, KeyB{sb, r, c, rs, cs, A.in[10] + h * 15 * 31}, O + (size_t)row * DM + 384 + h * 64, F.lane);
        } else {
            if (ATT_M_MFMA) continue;
            const int h = hh - 12;
            attn_item<4>(QKV + ((size_t)(36 + h) * MTOK + row) * 64, MK, MV, KeyM{(long)(sbat * 4 + h) * NMEM}, O + (size_t)row * DM + 768 + h * 64, F.lane);
        }
    }
}
__device__ __forceinline__ void onorm_phase(Frame& F) {
    const int gw = F.vcu * NWAVES + F.wave, NGW = F.G * NWAVES;
    bf16* O = (bf16*)(F.ws + WS_O);
    for (int m = gw; m < MTOK; m += NGW) {
        v4u* p = (v4u*)(O + (size_t)m * DM) + 2 * F.lane; v4u w0 = p[0], w1 = p[1];
        float v[16];
#pragma unroll
        for (int e = 0; e < 4; ++e) { v[2 * e] = bflo(w0[e]); v[2 * e + 1] = bfhi(w0[e]); v[8 + 2 * e] = bflo(w1[e]); v[8 + 2 * e + 1] = bfhi(w1[e]); }
        float ss = 0.f;
#pragma unroll
        for (int e = 0; e < 16; ++e) ss += v[e] * v[e];
        const int grp = F.lane < 24 ? 0 : (F.lane < 48 ? 1 : 2);
        const float sa = wave_sum(grp == 0 ? ss : 0.f), sb = wave_sum(grp == 1 ? ss : 0.f), sm = wave_sum(grp == 2 ? ss : 0.f);
        const float r = grp == 0 ? rsqrtf(sa * (1.f / 384.f) + RMS_EPS) : (grp == 1 ? rsqrtf(sb * (1.f / 384.f) + RMS_EPS) : rsqrtf(sm * (1.f / 256.f) + RMS_EPS));
#pragma unroll
        for (int e = 0; e < 4; ++e) { w0[e] = pk2(v[2 * e] * r, v[2 * e + 1] * r); w1[e] = pk2(v[8 + 2 * e] * r, v[8 + 2 * e + 1] * r); }
        p[0] = w0; p[1] = w1;
    }
}


constexpr int N_AUNITS = (MTOK / 256) * 6;
constexpr int N_BJOBS = (MTOK / 128) * 6 * 4;
constexpr int N_MJOBS = (MTOK / 32) * 4;
constexpr int LA_ACC = 65536, LA_L = 131072;
constexpr int LW_STRIDE = 12288, LW_TBL = 8192;

struct SeqInfo { long sb; int T; int bat; };
__device__ __forceinline__ SeqInfo seq_of(int row) { SeqInfo s; if (row < TP) { s.sb = 0; s.T = TP; s.bat = 0; } else { const int b = (row - TP) >> 13; s.sb = TP + (long)b * TS; s.T = TS; s.bat = 1 + b; } return s; }

__device__ __forceinline__ void m_job(Frame& F, int jm) {
    const int h = jm / (MTOK / 32), row0 = (jm - h * (MTOK / 32)) * 32; const SeqInfo si = seq_of(row0);
    const bf16* QKV = (const bf16*)(F.ws + WS_QKV);
    const int r32 = F.lane & 31;
    att::bf16x8 qr[4]; att::load_q(qr, QKV + ((size_t)(36 + h) * MTOK + row0 + r32) * 64, F.lane);
    att::SpecM S{(const bf16*)(F.ws + WS_MK) + (size_t)(si.bat * 4 + h) * NMEM * 64, (const bf16*)(F.ws + WS_MV) + (size_t)(si.bat * 4 + h) * NMEM * 64};
    att::f32x16 o[2] = {}; float lsum = 0.f;
    att::lptr wb = (att::lptr)(F.lds + F.wave * LW_STRIDE);
    att::run_tiles(S, qr, o, lsum, wb, F.lane);
    bf16* O = (bf16*)(F.ws + WS_O) + (size_t)row0 * DM + 768 + 64 * h;
    att::store_out(o, lsum, wb, [=](int q) { return O + (size_t)q * DM; }, F.lane);
}
__device__ __forceinline__ void b_job(Frame& F, const Args& A, int jb) {
    const int g = jb & 3, rest = jb >> 2, h = rest / (MTOK / 128), rp = rest - h * (MTOK / 128);
    int r0, rows; long sb;
    if (rp < TP / 128) { r0 = 2 * rp; rows = TP / 64; sb = 0; } else { const int q = rp - TP / 128, b = q / (TS / 128); r0 = 2 * (q - b * (TS / 128)); rows = TS / 64; sb = TP + (long)b * TS; }
    const int r32 = F.lane & 31;
    const int rq = r0 + (r32 >> 4), c = 16 * g + (r32 & 15);
    int rlo = rq - 4; rlo = rlo < 0 ? 0 : (rlo > rows - 8 ? rows - 8 : rlo);
    int cs = c - 8; cs = cs < 0 ? 0 : (cs > 48 ? 48 : cs);
    int rk0 = r0 - 4; rk0 = rk0 < 0 ? 0 : (rk0 > rows - 8 ? rows - 8 : rk0);
    int rk1 = r0 + 1 - 4; rk1 = rk1 < 0 ? 0 : (rk1 > rows - 8 ? rows - 8 : rk1);
    const int w0 = g == 0 ? 0 : (g == 1 ? 8 : (g == 2 ? 24 : 32));
    att::lptr wb = (att::lptr)(F.lds + F.wave * LW_STRIDE);
    __attribute__((address_space(3))) float* tbl = (__attribute__((address_space(3))) float*)(wb + LW_TBL);
    const float* rpb = A.in[10] + h * 465;
    for (int idx = F.lane; idx < 465; idx += 64) { const int dr = idx / 31, dl = idx - dr * 31; tbl[dr * 64 + 16 + dl] = rpb[idx] * LOG2E; }
    asm volatile("" ::: "memory");
    const bf16* QKV = (const bf16*)(F.ws + WS_QKV);
    att::bf16x8 qr[4]; att::load_q(qr, QKV + ((size_t)(18 + h) * MTOK + sb + rq * 64 + c) * 64, F.lane);
    att::SpecB S{QKV + ((size_t)(24 + h) * MTOK + sb) * 64, QKV + ((size_t)(30 + h) * MTOK + sb) * 64, rk1 + 8 - rk0, rk0, w0, rlo, 7 - rq, w0 - cs, tbl + (31 + w0 - c)};
    att::f32x16 o[2] = {}; float lsum = 0.f;
    att::run_tiles(S, qr, o, lsum, wb, F.lane);
    bf16* O = (bf16*)(F.ws + WS_O) + (size_t)(sb + r0 * 64 + 16 * g) * DM + 384 + 64 * h;
    att::store_out(o, lsum, wb, [=](int q) { return O + (size_t)((q >> 4) * 64 + (q & 15)) * DM; }, F.lane);
}
template <class Spec, class QLoc> __device__ __forceinline__ void a_job(Frame& F, const Spec& S, const bf16* qrow, const QLoc& qloc) {
    att::bf16x8 qr[4]; att::load_q(qr, qrow, F.lane);
    att::f32x16 o[2] = {}; float lsum = 0.f;
    att::run_tiles(S, qr, o, lsum, (att::lptr)(F.lds + F.wave * 8192), F.lane);
    const int r32 = F.lane & 31, hi = F.lane >> 5;
    __attribute__((address_space(3))) float* acc = (__attribute__((address_space(3))) float*)(F.lds + LA_ACC);
    __attribute__((address_space(3))) float* ls = (__attribute__((address_space(3))) float*)(F.lds + LA_L);
#pragma unroll
    for (int r = 0; r < 16; ++r) { const int ql = qloc(att::creg(r) + 4 * hi);
#pragma unroll
        for (int dh = 0; dh < 2; ++dh) (void)__hip_atomic_fetch_add(acc + ql * 64 + dh * 32 + r32, o[dh][r], __ATOMIC_RELAXED, __HIP_MEMORY_SCOPE_WORKGROUP); }
    (void)__hip_atomic_fetch_add(ls + qloc(r32), lsum, __ATOMIC_RELAXED, __HIP_MEMORY_SCOPE_WORKGROUP);
}
__device__ __forceinline__ void a_unit(Frame& F, int ua) {
    const int h = ua / (MTOK / 256), row0 = (ua - h * (MTOK / 256)) * 256; const SeqInfo si = seq_of(row0);
    const int pq0 = (int)(row0 - si.sb), w = F.wave, r32 = F.lane & 31;
    { __attribute__((address_space(3))) att::f32x4* z = (__attribute__((address_space(3))) att::f32x4*)(F.lds + LA_ACC);
#pragma unroll
      for (int i = 0; i < 8; ++i) z[i * 512 + F.tid] = (att::f32x4){0.f, 0.f, 0.f, 0.f};
      if (F.tid < 64) z[4096 + F.tid] = (att::f32x4){0.f, 0.f, 0.f, 0.f}; }
    __syncthreads();
    const bf16* QKV = (const bf16*)(F.ws + WS_QKV);
    const bf16* Q = QKV + ((size_t)(0 + h) * MTOK + si.sb) * 64; const bf16* K = QKV + ((size_t)(6 + h) * MTOK + si.sb) * 64; const bf16* V = QKV + ((size_t)(12 + h) * MTOK + si.sb) * 64;
    {
        att::SpecA S{K, V, pq0 + 32 * w - 64, 1, si.T};
        a_job(F, S, Q + (size_t)(pq0 + 32 * w + r32) * 64, [=](int q) { return 32 * w + q; }); }
    {
        const int rho = w >> 1, hf = w & 1;
        att::SpecA S{K, V, pq0 + 4 * (32 * hf - 64) + rho, 4, si.T};
        a_job(F, S, Q + (size_t)(pq0 + 4 * (32 * hf + r32) + rho) * 64, [=](int q) { return 4 * (32 * hf + q) + rho; }); }
    {
        att::SpecA16 S{K, V, pq0 + 2 * w - 1024, si.T};
        a_job(F, S, Q + (size_t)(pq0 + 16 * (r32 & 15) + 2 * w + (r32 >> 4)) * 64, [=](int q) { return 16 * (q & 15) + 2 * w + (q >> 4); }); }
    __syncthreads();
    {
        const int q = 32 * w + (F.lane >> 1), dh = F.lane & 1;
        const __attribute__((address_space(3))) att::f32x4* a = (const __attribute__((address_space(3))) att::f32x4*)(F.lds + LA_ACC + (q * 64 + dh * 32) * 4);
        const float rl = 1.0f / ((const __attribute__((address_space(3))) float*)(F.lds + LA_L))[q];
        bf16* op = (bf16*)(F.ws + WS_O) + (size_t)(row0 + q) * DM + 64 * h + 32 * dh;
#pragma unroll
        for (int i = 0; i < 4; ++i) { const att::f32x4 x = a[2 * i], y = a[2 * i + 1]; v4u o; o.x = pk2(x[0] * rl, x[1] * rl); o.y = pk2(x[2] * rl, x[3] * rl); o.z = pk2(y[0] * rl, y[1] * rl); o.w = pk2(y[2] * rl, y[3] * rl); *(v4u*)(op + 8 * i) = o; }
    }
    __syncthreads();
}
__device__ __forceinline__ void attn_phase(Frame& F, const Args& A) {
#if ATT_A_MFMA
    for (int ua = blockIdx.x; ua < N_AUNITS; ua += F.G) a_unit(F, ua);
#endif
    __syncthreads();
    {
        const int c = blockIdx.x, w = F.wave, NJ = N_BJOBS + N_MJOBS;
        int j0, j1;
        if (F.G == 256) { if (c < 128) { j0 = (c * 8 + w) * 6; j1 = j0 + 6; } else { j0 = 6144 + ((c - 128) * 8 + w) * 9; j1 = j0 + 9; } }
        else { const int per = (NJ + F.G * 8 - 1) / (F.G * 8); j0 = (c * 8 + w) * per; j1 = j0 + per; if (j1 > NJ) j1 = NJ; }
        for (int j = j0; j < j1; ++j) {
            if (j < N_BJOBS) {
#if ATT_B_MFMA
                b_job(F, A, j);
#endif
            } else {
#if ATT_M_MFMA
                m_job(F, j - N_BJOBS);
#endif
            }
        }
    }
    __syncthreads();
}
__global__ void __launch_bounds__(NWAVES * 64, 2) skel_fwd(Args args) {
    extern __shared__ __attribute__((aligned(16))) unsigned char lds[];
    cg::grid_group grid = cg::this_grid();
    Frame F;
    F.lds = (LAS unsigned char*)lds;
    F.tid = threadIdx.x; F.lane = F.tid & 63; F.wave = __builtin_amdgcn_readfirstlane(F.tid >> 6);
    F.G = gridDim.x; { const int bx = blockIdx.x; F.vcu = (F.G % 8 == 0) ? (bx % 8) * (F.G / 8) + bx / 8 : bx; }
    F.out = args.out; F.ws = args.ws;
    unsigned char* ws = args.ws;
    const int lo = args.ph_lo, hi = args.ph_hi;
#define IN(k) (lo <= (k) && (k) < hi)
#define BOTH(k) (IN(k) && IN((k) + 1))
#define GRID_BAR() grid.sync()

    if (IN(0)) { p0_prologue(F, args); if (BOTH(0)) GRID_BAR(); }

    if (IN(1)) {
        {
            pg8::Gemm g{(const pg8::bf16_t*)(ws + WS_XN), (const pg8::bf16_t*)(ws + WS_WIN), MTOK, NQKV, DM}; pg8::StaticOrder S; S.init(MTOK, NQKV, F.G, (int)blockIdx.x);
            pg8::EpiQKV E{(pg8::bf16_t*)(ws + WS_QKV), args.in[6], args.in[7], args.in[8], args.in[9], args.in[13], (const float*)(ws + WS_ROPE), (const float*)(ws + WS_ROPE) + TP * 8};
            pg8::gemm_phase<pg8::EpiQKV, pg8::StaticOrder, true, true>(F.lds, g, S, E);
        }
        {
            pg8::Gemm g{(const pg8::bf16_t*)(ws + WS_XNMEM), (const pg8::bf16_t*)(ws + WS_WMEM), MMEM, 512, DM}; pg8::StaticOrder S; S.init(MMEM, 512, F.G, F.G - 1 - (int)blockIdx.x);
            pg8::EpiMemKV E{(pg8::bf16_t*)(ws + WS_MK), (pg8::bf16_t*)(ws + WS_MV), args.in[14]};
            pg8::gemm_phase<pg8::EpiMemKV, pg8::StaticOrder, true, true>(F.lds, g, S, E);
        }
        if (BOTH(1)) GRID_BAR();
    }

    if (IN(2)) { attn_phase(F, args); attn_simple_phase(F, args); if (BOTH(2)) GRID_BAR(); }

    if (IN(3)) { onorm_phase(F); if (BOTH(3)) GRID_BAR(); }

    if (IN(4)) {
        pg8::Gemm g{(const pg8::bf16_t*)(ws + WS_O), (const pg8::bf16_t*)(ws + WS_WOUT), MTOK, DM, DM}; pg8::StaticOrder S; S.init(MTOK, DM, F.G, (int)blockIdx.x);
        pg8::EpiX1 E{args.in[0], args.in[1], F.out, (pg8::bf16_t*)(ws + WS_X1B), (float*)(ws + WS_SSQF)};
        pg8::gemm_phase<pg8::EpiX1, pg8::StaticOrder, true, true>(F.lds, g, S, E);
        if (BOTH(4)) GRID_BAR();
    }

    if (IN(5)) {
        pg8::Gemm g{(const pg8::bf16_t*)(ws + WS_X1B), (const pg8::bf16_t*)(ws + WS_W1), MTOK, FF, DM}; pg8::StaticOrder S; S.init(MTOK, FF, F.G, (int)blockIdx.x);
        pg8::EpiH E{(pg8::bf16_t*)(ws + WS_H), (const float*)(ws + WS_SSQF)};
        pg8::gemm_phase<pg8::EpiH, pg8::StaticOrder, true, true>(F.lds, g, S, E);
        if (BOTH(5)) GRID_BAR();
    }

    if (IN(6)) {
        pg8::Gemm g{(const pg8::bf16_t*)(ws + WS_H), (const pg8::bf16_t*)(ws + WS_W2), MTOK, DM, FF}; pg8::StaticOrder S; S.init(MTOK, DM, F.G, (int)blockIdx.x);
        pg8::EpiOut E{F.out};
        pg8::gemm_phase<pg8::EpiOut, pg8::StaticOrder, true, true>(F.lds, g, S, E);
    }
#undef IN
#undef BOTH
}

extern "C" void kernel_launch(void* const* d_in, const int* in_sizes, int n_in, void* d_out, int out_size, void* d_ws, size_t ws_size, hipStream_t stream) {
    static int grid = 0;
    if (grid == 0) {
        if (n_in != 22 || in_sizes[0] != TP * DM || in_sizes[1] != NBS * TS * DM || out_size != MTOK * DM || ws_size < WS_END) {
            fprintf(stderr, "kernel_launch: unexpected shapes / workspace (n_in %d, in0 %d, out %d, ws %zu); nothing launched\n", n_in, n_in > 0 ? in_sizes[0] : -1, out_size, ws_size); grid = -1; return; }
        int dev = 0, cus = 0, per_cu = 0;
        if (hipGetDevice(&dev) != hipSuccess || hipDeviceGetAttribute(&cus, hipDeviceAttributeMultiprocessorCount, dev) != hipSuccess) { grid = -1; return; }
        if (hipFuncSetAttribute((const void*)skel_fwd, hipFuncAttributeMaxDynamicSharedMemorySize, LDS_BYTES) != hipSuccess) { fprintf(stderr, "kernel_launch: hipFuncSetAttribute failed\n"); grid = -1; return; }
        if (hipOccupancyMaxActiveBlocksPerMultiprocessor(&per_cu, (const void*)skel_fwd, NWAVES * 64, LDS_BYTES) != hipSuccess || per_cu < 1) { fprintf(stderr, "kernel_launch: occupancy query says %d\n", per_cu); (void)hipGetLastError(); grid = -1; return; }
        grid = cus * per_cu;
    }
    if (grid < 0) return;
    if (hipMemsetAsync((char*)d_ws + WS_CTL, 0, CTL_ZERO_BYTES, stream) != hipSuccess) return;
    Args a{};
    for (int i = 0; i < 22; ++i) a.in[i] = (const float*)d_in[i];
    a.out = (float*)d_out; a.ws = (unsigned char*)d_ws;
    if (N_LAUNCHES == 1) {
        a.ph_lo = 0; a.ph_hi = NPH;
        void* kargs[] = {&a};
        hipError_t e = hipLaunchCooperativeKernel((const void*)skel_fwd, dim3(grid), dim3(NWAVES * 64), kargs, LDS_BYTES, stream);
        if (e != hipSuccess) fprintf(stderr, "kernel_launch: cooperative launch failed: %s (grid %d)\n", hipGetErrorString(e), grid);
    } else {
        for (int li = 0; li < NPH; ++li) { a.ph_lo = li; a.ph_hi = li + 1; hipLaunchKernelGGL(skel_fwd, dim3(grid), dim3(NWAVES * 64), LDS_BYTES, stream, a); }
    }
}
```

```cpp
#include <hip/hip_runtime.h>
#include <hip/hip_cooperative_groups.h>
#include <cstdio>
#include <cstdint>
namespace cg = cooperative_groups;

constexpr int DM = 1024, TP = 16384, TS = 8192, NBS = 4, MTOK = TP + NBS * TS;
constexpr int NQKV = 2560, NHEADS = 40, FF = 4096, NMEM = 256, NBATCH = 1 + NBS, MMEM = NBATCH * NMEM;
constexpr float RMS_EPS = 1e-6f;
constexpr float LOG2E = 1.4426950408889634f;
constexpr float QSCALE = 0.125f * LOG2E;
#ifndef ATT_A_MFMA
#define ATT_A_MFMA 1
#endif
#ifndef ATT_B_MFMA
#define ATT_B_MFMA 1
#endif
#ifndef ATT_M_MFMA
#define ATT_M_MFMA 1
#endif
namespace pg8 {
#define PG8_LAS __attribute__((address_space(3)))
typedef unsigned short bf16_t;
typedef short bf16x8 __attribute__((ext_vector_type(8)));
typedef float f32x4 __attribute__((ext_vector_type(4)));
typedef unsigned u32x4 __attribute__((ext_vector_type(4)));
constexpr int BM = 256, BK = 64, HALF = 128, HTB = HALF * BK * 2  , STAGE_BYTES = 8 * HTB, NXCD = 8, WGM = 8;

__host__ __device__ __forceinline__ int lds_byte(int r, int c) { const int st = (r >> 4) * 2 + (c >> 5), rr = r & 15, cc = c & 31, ob = rr * 64 + cc * 2; return st * 1024 + (ob ^ (((ob >> 9) & 1) << 5)); }
__host__ __device__ __forceinline__ void stage_rc(int b, int& R, int& C) { const int st = b / 1024, sb = b % 1024, swz = sb ^ (((sb >> 9) & 1) << 5); R = (st >> 1) * 16 + swz / 64; C = (st & 1) * 32 + (swz % 64) / 2; }
__host__ __device__ __forceinline__ int perm32(int rho) { const int n = rho >> 4, i = rho & 15; return 8 * (i >> 2) + 4 * n + (i & 3); }

struct Unit { int pm, pn; };
struct Gemm { const bf16_t* A; const bf16_t* Bt; int M, N, K; };

struct StaticOrder {
    int nM, nN, nwg, G, c;
    __host__ __device__ void init(int M, int N, int G_, int c_) { nM = M / BM; nN = N / BM; nwg = nM * nN; G = G_; c = c_; }
    __host__ __device__ bool next(int i, Unit& u) const {
        const long L = (long)i * G + c; if (L >= nwg) return false;
        int wgid = (int)L; { const int q = nwg / NXCD, r = nwg % NXCD, xcd = wgid % NXCD, off = wgid / NXCD; wgid = (xcd < r ? xcd * (q + 1) : r * (q + 1) + (xcd - r) * q) + off; }
        const int nig = WGM * nN, gid = wgid / nig, fm = gid * WGM, gsz = (nM - fm) < WGM ? (nM - fm) : WGM;
        u.pm = fm + ((wgid % nig) % gsz); u.pn = (wgid % nig) / gsz; return true;
    }
    __device__ __forceinline__ void a_ready(const Unit&) const {}
    __device__ __forceinline__ void done(const Unit&) const {}
};

__device__ __forceinline__ unsigned cvt_pk_bf16(float lo, float hi) { unsigned r; asm volatile("v_cvt_pk_bf16_f32 %0, %1, %2" : "=v"(r) : "v"(lo), "v"(hi)); return r; }
typedef float f32x2 __attribute__((ext_vector_type(2)));
__device__ __forceinline__ float sq4(const f32x4 v) { return (v[0] * v[0] + v[1] * v[1]) + (v[2] * v[2] + v[3] * v[3]); }
__device__ __forceinline__ u32x4 pack8(const f32x4 a, const f32x4 b) { u32x4 w; w.x = cvt_pk_bf16(a[0], a[1]); w.y = cvt_pk_bf16(a[2], a[3]); w.z = cvt_pk_bf16(b[0], b[1]); w.w = cvt_pk_bf16(b[2], b[3]); return w; }

struct EpiQKV {
    static constexpr bool PERM = true, AFTER_DRAIN = false;
    bf16_t* QKV;
    const float *gqa, *gka, *gqb, *gkb, *gqm;
    const float *rc, *rs;
    __device__ __forceinline__ void operator()(const f32x4 (&acc)[2][2][4][2], const Unit& u, int wr, int wc, int fr, int fq) const {
        const int hidx = u.pn * 4 + wc;
        const float* gain = nullptr; bool rope = false; float qs = 1.f;
        if (hidx < 6) { gain = gqa; rope = true; qs = QSCALE; } else if (hidx < 12) { gain = gka; rope = true; } else if (hidx < 18) { } else if (hidx < 24) { gain = gqb; qs = QSCALE; }
        else if (hidx < 30) { gain = gkb; } else if (hidx < 36) { } else { gain = gqm; qs = QSCALE; }
        const bool rl = rope && fq < 2;
        f32x4 g[2][2];
#pragma unroll
        for (int bj = 0; bj < 2; ++bj)
#pragma unroll
            for (int n = 0; n < 2; ++n) { const int d0 = (rl && bj == 0) ? (8 * n + 4 * fq) : (32 * bj + 8 * fq + 4 * n); g[bj][n] = gain ? *(const f32x4*)(gain + d0) : (f32x4){1.f, 1.f, 1.f, 1.f}; }
        bf16_t* base = QKV + (size_t)hidx * MTOK * 64 + 8 * fq;
#pragma unroll
        for (int ai = 0; ai < 2; ++ai)
#pragma unroll
            for (int m = 0; m < 4; ++m) {
                const int row = u.pm * BM + ai * HALF + wr * 64 + m * 16 + fr;
                f32x4 v[2][2];
#pragma unroll
                for (int bj = 0; bj < 2; ++bj)
#pragma unroll
                    for (int n = 0; n < 2; ++n) v[bj][n] = acc[ai][bj][m][n];
                if (gain) {
                    float ss = (sq4(v[0][0]) + sq4(v[0][1])) + (sq4(v[1][0]) + sq4(v[1][1]));
                    ss += __shfl_xor(ss, 16); ss += __shfl_xor(ss, 32);
                    const float r = rsqrtf(ss * (1.f / 64.f) + RMS_EPS) * qs;
#pragma unroll
                    for (int bj = 0; bj < 2; ++bj)
#pragma unroll
                        for (int n = 0; n < 2; ++n) v[bj][n] = v[bj][n] * r * g[bj][n];
                    if (rope) {
                        const int pos = row < TP ? row : ((row - TP) & (TS - 1));
                        const f32x4 c = *(const f32x4*)(rc + pos * 8 + 4 * (fq & 1)), s = *(const f32x4*)(rs + pos * 8 + 4 * (fq & 1));
                        if (fq < 2) { const f32x4 x1 = v[0][0], x2 = v[0][1]; v[0][0] = x1 * c - x2 * s; v[0][1] = x2 * c + x1 * s; }
                    }
                }
                bf16_t* rowp = base + (size_t)row * 64;
                *(u32x4*)(rowp) = pack8(v[0][0], v[0][1]);
                *(u32x4*)(rowp + 32) = pack8(v[1][0], v[1][1]);
            }
    }
};
struct EpiMemKV {
    static constexpr bool PERM = true, AFTER_DRAIN = false;
    bf16_t* MK; bf16_t* MV; const float* gk;
    __device__ __forceinline__ void operator()(const f32x4 (&acc)[2][2][4][2], const Unit& u, int wr, int wc, int fr, int fq) const {
        const int hidx = u.pn * 4 + wc; const bool isk = hidx < 4; const int h = hidx & 3;
        f32x4 g[2][2];
#pragma unroll
        for (int bj = 0; bj < 2; ++bj)
#pragma unroll
            for (int n = 0; n < 2; ++n) g[bj][n] = isk ? *(const f32x4*)(gk + 32 * bj + 8 * fq + 4 * n) : (f32x4){1.f, 1.f, 1.f, 1.f};
        bf16_t* base = (isk ? MK : MV) + 8 * fq;
#pragma unroll
        for (int ai = 0; ai < 2; ++ai)
#pragma unroll
            for (int m = 0; m < 4; ++m) {
                const int row = u.pm * BM + ai * HALF + wr * 64 + m * 16 + fr;
                f32x4 v[2][2];
#pragma unroll
                for (int bj = 0; bj < 2; ++bj)
#pragma unroll
                    for (int n = 0; n < 2; ++n) v[bj][n] = acc[ai][bj][m][n];
                if (isk) {
                    float ss = (sq4(v[0][0]) + sq4(v[0][1])) + (sq4(v[1][0]) + sq4(v[1][1]));
                    ss += __shfl_xor(ss, 16); ss += __shfl_xor(ss, 32);
                    const float r = rsqrtf(ss * (1.f / 64.f) + RMS_EPS);
#pragma unroll
                    for (int bj = 0; bj < 2; ++bj)
#pragma unroll
                        for (int n = 0; n < 2; ++n) v[bj][n] = v[bj][n] * r * g[bj][n];
                }
                bf16_t* rowp = base + ((size_t)((row >> 8) * 4 + h) * NMEM + (row & 255)) * 64;
                *(u32x4*)(rowp) = pack8(v[0][0], v[0][1]);
                *(u32x4*)(rowp + 32) = pack8(v[1][0], v[1][1]);
            }
    }
};
struct EpiX1 {
    static constexpr bool PERM = true, AFTER_DRAIN = false;
    const float* xp; const float* xs; float* out; bf16_t* x1b; float* ssq;
    __device__ __forceinline__ void operator()(const f32x4 (&acc)[2][2][4][2], const Unit& u, int wr, int wc, int fr, int fq) const {
        const int col0 = u.pn * BM + wc * 32 + 8 * fq;
#pragma unroll
        for (int ai = 0; ai < 2; ++ai)
#pragma unroll
            for (int m = 0; m < 4; ++m) {
                const int row = u.pm * BM + ai * HALF + wr * 64 + m * 16 + fr;
                const float* xrow = (row < TP ? xp + (size_t)row * DM : xs + (size_t)(row - TP) * DM) + col0;
                float* orow = out + (size_t)row * DM + col0; bf16_t* brow = x1b + (size_t)row * DM + col0;
                float ss = 0.f;
#pragma unroll
                for (int bj = 0; bj < 2; ++bj) {
                    const f32x4 v0 = acc[ai][bj][m][0] + *(const f32x4*)(xrow + bj * HALF), v1 = acc[ai][bj][m][1] + *(const f32x4*)(xrow + bj * HALF + 4);
                    *(f32x4*)(orow + bj * HALF) = v0; *(f32x4*)(orow + bj * HALF + 4) = v1;
                    *(u32x4*)(brow + bj * HALF) = pack8(v0, v1);
                    ss += sq4(v0) + sq4(v1);
                }
                ss += __shfl_xor(ss, 16); ss += __shfl_xor(ss, 32);
                if (fq == 0) unsafeAtomicAdd(ssq + row, ss);
            }
    }
};
struct EpiH {
    static constexpr bool PERM = true, AFTER_DRAIN = false;
    bf16_t* H; const float* ssq;
    __device__ __forceinline__ void operator()(const f32x4 (&acc)[2][2][4][2], const Unit& u, int wr, int wc, int fr, int fq) const {
        const int col0 = u.pn * BM + wc * 32 + 8 * fq;
#pragma unroll
        for (int ai = 0; ai < 2; ++ai)
#pragma unroll
            for (int m = 0; m < 4; ++m) {
                const int row = u.pm * BM + ai * HALF + wr * 64 + m * 16 + fr;
                const float r = rsqrtf(ssq[row] * (1.f / DM) + RMS_EPS);
                bf16_t* hrow = H + (size_t)row * FF + col0;
#pragma unroll
                for (int bj = 0; bj < 2; ++bj) {
                    f32x4 v0 = acc[ai][bj][m][0] * r, v1 = acc[ai][bj][m][1] * r;
#pragma unroll
                    for (int e = 0; e < 4; ++e) { const float a = fmaxf(v0[e], 0.f), b = fmaxf(v1[e], 0.f); v0[e] = a * a; v1[e] = b * b; }
                    *(u32x4*)(hrow + bj * HALF) = pack8(v0, v1);
                }
            }
    }
};
struct EpiOut {
    static constexpr bool PERM = true, AFTER_DRAIN = false;
    float* out;
    __device__ __forceinline__ void operator()(const f32x4 (&acc)[2][2][4][2], const Unit& u, int wr, int wc, int fr, int fq) const {
        const int col0 = u.pn * BM + wc * 32 + 8 * fq;
#pragma unroll
        for (int ai = 0; ai < 2; ++ai)
#pragma unroll
            for (int m = 0; m < 4; ++m) {
                const int row = u.pm * BM + ai * HALF + wr * 64 + m * 16 + fr;
                float* orow = out + (size_t)row * DM + col0;
#pragma unroll
                for (int bj = 0; bj < 2; ++bj) {
                    const f32x4 v0 = acc[ai][bj][m][0] + *(const f32x4*)(orow + bj * HALF), v1 = acc[ai][bj][m][1] + *(const f32x4*)(orow + bj * HALF + 4);
                    *(f32x4*)(orow + bj * HALF) = v0; *(f32x4*)(orow + bj * HALF + 4) = v1;
                }
            }
    }
};

template <class Epi, class Sched, bool ALIGN_EPI = false, bool SP2 = false>
__device__ __forceinline__ void gemm_phase(PG8_LAS unsigned char* lds, const Gemm g, const Sched& S, const Epi& E) {
    const int tid = threadIdx.x, wid = __builtin_amdgcn_readfirstlane(tid >> 6), lane = tid & 63, wr = wid >> 2, wc = wid & 3, fr = lane & 15, fq = lane >> 4;
    const int K = g.K, nt = K / BK;
    unsigned voffA[2], voffB[2];
#pragma unroll
    for (int i = 0; i < 2; ++i) { int R, C; stage_rc(tid * 16 + i * 8192, R, C); const int Rb = Epi::PERM ? ((R & ~31) + perm32(R & 31)) : R;
        voffA[i] = (unsigned)(R * K + C) * 2u; voffB[i] = (unsigned)(Rb * K + C) * 2u; }
    const size_t kstep = (size_t)(BK * 2);
    const size_t hstep = (size_t)HALF * K * 2;
    const size_t tstep = 2 * hstep;
    const unsigned ldsw = (unsigned)wid * 1024u;
    const int aoff = lds_byte(wr * 64 + fr, fq * 8), boff = lds_byte(wc * 32 + fr, fq * 8);
#define PG8_SA(b, h) (((b) * 2 + (h)) * HTB)
#define PG8_SB(b, h) ((4 + (b) * 2 + (h)) * HTB)
#define PG8_STAGE(bufoff, gbase, voff) do { _Pragma("unroll") for (int _i = 0; _i < 2; ++_i) \
        __builtin_amdgcn_global_load_lds((const unsigned*)((const char*)(gbase) + (voff)[_i]), (PG8_LAS unsigned*)(lds + (bufoff) + ldsw + _i * 8192), 16, 0, 0); } while (0)
#define PG8_LDA(dst, b, h) do { _Pragma("unroll") for (int m = 0; m < 4; ++m) _Pragma("unroll") for (int k = 0; k < 2; ++k) dst[m][k] = *(const PG8_LAS bf16x8*)(lds + PG8_SA(b, h) + aoff + m * 2048 + k * 1024); } while (0)
#define PG8_LDB(dst, b, h) do { _Pragma("unroll") for (int n = 0; n < 2; ++n) _Pragma("unroll") for (int k = 0; k < 2; ++k) dst[n][k] = *(const PG8_LAS bf16x8*)(lds + PG8_SB(b, h) + boff + n * 2048 + k * 1024); } while (0)
#define PG8_MMA(ai, bj, At, Bt) do { __builtin_amdgcn_s_setprio(1); _Pragma("unroll") for (int m = 0; m < 4; ++m) _Pragma("unroll") for (int n = 0; n < 2; ++n) _Pragma("unroll") for (int k = 0; k < 2; ++k) \
        acc[ai][bj][m][n] = __builtin_amdgcn_mfma_f32_16x16x32_bf16(Bt[n][k], At[m][k], acc[ai][bj][m][n], 0, 0, 0); __builtin_amdgcn_s_setprio(0); } while (0)
#define PG8_WAIT_V(n) asm volatile("s_waitcnt vmcnt(" #n ")" ::: "memory")
#define PG8_WAIT_L(n) asm volatile("s_waitcnt lgkmcnt(" #n ")" ::: "memory")
#define PG8_BAR __builtin_amdgcn_s_barrier()
#define PG8_SCHED __builtin_amdgcn_sched_barrier(0)
    Unit cur, nxt; int ui = 0;
    if (!S.next(0, cur)) return;
    f32x4 acc[2][2][4][2];
#pragma unroll
    for (int a = 0; a < 2; ++a)
#pragma unroll
        for (int b = 0; b < 2; ++b)
#pragma unroll
            for (int m = 0; m < 4; ++m)
#pragma unroll
                for (int n = 0; n < 2; ++n) acc[a][b][m][n] = (f32x4){0.f, 0.f, 0.f, 0.f};
    bf16x8 At[4][2], B0[2][2], B1[2][2];
    const char* cA = (const char*)g.A + (size_t)cur.pm * tstep; const char* cB = (const char*)g.Bt + (size_t)cur.pn * tstep;
    S.a_ready(cur);
    if constexpr (SP2) {
        PG8_STAGE(PG8_SB(0, 0), cB, voffB); PG8_STAGE(PG8_SB(0, 1), cB + hstep, voffB); PG8_STAGE(PG8_SA(0, 0), cA, voffA); PG8_STAGE(PG8_SA(0, 1), cA + hstep, voffA);
        if (wr == 1) PG8_BAR;
        PG8_WAIT_V(2); PG8_BAR;
        PG8_STAGE(PG8_SB(1, 0), cB + kstep, voffB); PG8_STAGE(PG8_SA(1, 0), cA + kstep, voffA); PG8_STAGE(PG8_SB(1, 1), cB + hstep + kstep, voffB);
        PG8_WAIT_V(6); PG8_BAR;
    } else {
        PG8_STAGE(PG8_SB(0, 0), cB, voffB); PG8_STAGE(PG8_SA(0, 0), cA, voffA); PG8_STAGE(PG8_SB(0, 1), cB + hstep, voffB); PG8_STAGE(PG8_SA(0, 1), cA + hstep, voffA);
        if (wr == 1) PG8_BAR;
        PG8_WAIT_V(4); PG8_BAR;
        PG8_STAGE(PG8_SB(1, 0), cB + kstep, voffB); PG8_STAGE(PG8_SA(1, 0), cA + kstep, voffA); PG8_STAGE(PG8_SB(1, 1), cB + hstep + kstep, voffB);
        PG8_WAIT_V(6); PG8_BAR;
    }
    for (;;) {
        const bool has_next = S.next(ui + 1, nxt);
        const char* nA = has_next ? (const char*)g.A + (size_t)nxt.pm * tstep : cA; const char* nB = has_next ? (const char*)g.Bt + (size_t)nxt.pn * tstep : cB;
        for (int t = 0; t < nt; t += 2) {
            const bool last = (t == nt - 2);
            const char* a1 = cA + (size_t)(t + 1) * kstep;
            const char* a2 = last ? nA : cA + (size_t)(t + 2) * kstep; const char* b2 = last ? nB : cB + (size_t)(t + 2) * kstep;
            const char* a3 = a2 + kstep; const char* b3 = b2 + kstep;
            if (last && has_next) S.a_ready(nxt);
            if constexpr (SP2) {
            PG8_LDB(B0, 0, 0); PG8_LDB(B1, 0, 1); PG8_SCHED; PG8_LDA(At, 0, 0); PG8_STAGE(PG8_SA(1, 1), a1 + hstep, voffA);
            PG8_WAIT_V(8); PG8_WAIT_L(0); PG8_BAR; PG8_MMA(0, 0, At, B0); PG8_MMA(0, 1, At, B1); PG8_BAR; PG8_SCHED;
            PG8_LDA(At, 0, 1); PG8_STAGE(PG8_SB(0, 0), b2, voffB); PG8_STAGE(PG8_SB(0, 1), b2 + hstep, voffB); PG8_STAGE(PG8_SA(0, 0), a2, voffA);
            PG8_WAIT_V(8); PG8_WAIT_L(0); PG8_BAR; PG8_MMA(1, 0, At, B0); PG8_MMA(1, 1, At, B1); PG8_BAR; PG8_SCHED;
            PG8_LDB(B0, 1, 0); PG8_LDB(B1, 1, 1); PG8_SCHED; PG8_LDA(At, 1, 0); PG8_STAGE(PG8_SA(0, 1), a2 + hstep, voffA);
            PG8_WAIT_V(8); PG8_WAIT_L(0); PG8_BAR; PG8_MMA(0, 0, At, B0); PG8_MMA(0, 1, At, B1); PG8_BAR; PG8_SCHED;
            PG8_LDA(At, 1, 1); PG8_STAGE(PG8_SB(1, 0), b3, voffB); PG8_STAGE(PG8_SB(1, 1), b3 + hstep, voffB); PG8_STAGE(PG8_SA(1, 0), a3, voffA);
            PG8_WAIT_V(8); PG8_WAIT_L(0); PG8_BAR; PG8_MMA(1, 0, At, B0); PG8_MMA(1, 1, At, B1); PG8_BAR; PG8_SCHED;
            } else {
            PG8_LDB(B0, 0, 0); PG8_SCHED; PG8_LDA(At, 0, 0); PG8_STAGE(PG8_SA(1, 1), a1 + hstep, voffA);
            PG8_WAIT_L(8); PG8_BAR; PG8_WAIT_L(0); PG8_MMA(0, 0, At, B0); PG8_BAR; PG8_SCHED;
            PG8_LDB(B1, 0, 1); PG8_STAGE(PG8_SB(0, 0), b2, voffB);
            PG8_BAR; PG8_WAIT_L(0); PG8_MMA(0, 1, At, B1); PG8_BAR;
            PG8_LDA(At, 0, 1); PG8_STAGE(PG8_SA(0, 0), a2, voffA);
            PG8_BAR; PG8_WAIT_L(0); PG8_MMA(1, 0, At, B0); PG8_BAR; PG8_SCHED;
            PG8_STAGE(PG8_SB(0, 1), b2 + hstep, voffB);
            PG8_WAIT_V(6); PG8_BAR; PG8_MMA(1, 1, At, B1); PG8_BAR;
            PG8_LDB(B0, 1, 0); PG8_SCHED; PG8_LDA(At, 1, 0); PG8_STAGE(PG8_SA(0, 1), a2 + hstep, voffA);
            PG8_WAIT_L(8); PG8_BAR; PG8_WAIT_L(0); PG8_MMA(0, 0, At, B0); PG8_BAR; PG8_SCHED;
            PG8_LDB(B1, 1, 1); PG8_STAGE(PG8_SB(1, 0), b3, voffB);
            PG8_BAR; PG8_WAIT_L(0); PG8_MMA(0, 1, At, B1); PG8_BAR;
            PG8_LDA(At, 1, 1); PG8_STAGE(PG8_SA(1, 0), a3, voffA);
            PG8_BAR; PG8_WAIT_L(0); PG8_MMA(1, 0, At, B0); PG8_BAR; PG8_SCHED;
            PG8_STAGE(PG8_SB(1, 1), b3 + hstep, voffB);
            PG8_WAIT_V(6); PG8_BAR; PG8_MMA(1, 1, At, B1); PG8_BAR;
            }
        }
        if constexpr (ALIGN_EPI) { if (wr == 0) PG8_BAR; }
        if constexpr (!Epi::AFTER_DRAIN) { E(acc, cur, wr, wc, fr, fq); S.done(cur); }
        if (!has_next) break;
#pragma unroll
        for (int a = 0; a < 2; ++a)
#pragma unroll
            for (int b = 0; b < 2; ++b)
#pragma unroll
                for (int m = 0; m < 4; ++m)
#pragma unroll
                    for (int n = 0; n < 2; ++n) acc[a][b][m][n] = (f32x4){0.f, 0.f, 0.f, 0.f};
        cur = nxt; cA = nA; cB = nB; ++ui;
        if constexpr (ALIGN_EPI) { if (wr == 1) PG8_BAR; }
    }
    PG8_WAIT_V(0);
    if constexpr (!ALIGN_EPI) { if (wr == 0) PG8_BAR; }
    PG8_BAR;
    if constexpr (Epi::AFTER_DRAIN) { E.fused(acc, cur, wr, wc, fr, fq, lds, wid, lane); S.done(cur); }
#undef PG8_SA
#undef PG8_SB
#undef PG8_STAGE
#undef PG8_LDA
#undef PG8_LDB
#undef PG8_MMA
#undef PG8_WAIT_V
#undef PG8_WAIT_L
#undef PG8_BAR
#undef PG8_SCHED
}
}

constexpr int NWAVES = 8;
#ifndef MK_N_LAUNCHES
#define MK_N_LAUNCHES 1
#endif
constexpr int NPH = 7;
constexpr int N_LAUNCHES = MK_N_LAUNCHES;

constexpr size_t MiB = 1u << 20;
constexpr size_t WS_CTL = 0, WS_SSQF = 1 * MiB, CTL_ZERO_BYTES = 2 * MiB;
constexpr size_t WS_ROPE = 2 * MiB;
constexpr size_t WS_WIN = 3 * MiB, WS_WMEM = 8 * MiB, WS_WOUT = 9 * MiB, WS_W1 = 11 * MiB, WS_W2 = 19 * MiB;
constexpr size_t WS_XNMEM = 27 * MiB, WS_MK = 30 * MiB, WS_MV = 31 * MiB;
constexpr size_t WS_X1B = 32 * MiB;
constexpr size_t WS_XN = 128 * MiB, WS_O = 128 * MiB;
constexpr size_t WS_QKV = 224 * MiB;
constexpr size_t WS_H = 128 * MiB;
constexpr size_t WS_END = 512 * MiB;
static_assert(WS_QKV + (size_t)NHEADS * MTOK * 64 * 2 <= WS_END && WS_H + (size_t)MTOK * FF * 2 <= WS_END && WS_X1B + (size_t)MTOK * DM * 2 <= WS_XN && WS_XN + (size_t)MTOK * DM * 2 <= WS_QKV, "d_ws map");

constexpr int RING_BYTES = 131072;
constexpr int LDS_BYTES = 147456, LDS_MISC = LDS_BYTES - 128;
constexpr int CW_BAR = 4096;
constexpr int LDS_BYTES_UNUSED = 0;

#define LAS __attribute__((address_space(3)))
typedef unsigned short bf16;
typedef unsigned v4u __attribute__((ext_vector_type(4)));
typedef float f32x4 __attribute__((ext_vector_type(4)));
#define LDS_WAIT() asm volatile("s_waitcnt lgkmcnt(0)" ::: "memory")
__device__ __forceinline__ unsigned f2bf(float f) { unsigned u = __builtin_bit_cast(unsigned, f); return (u + 0x7fffu + ((u >> 16) & 1u)) >> 16; }
__device__ __forceinline__ unsigned pk2(float lo, float hi) { return f2bf(lo) | (f2bf(hi) << 16); }
__device__ __forceinline__ float bflo(unsigned w) { return __uint_as_float(w << 16); }
__device__ __forceinline__ float bfhi(unsigned w) { return __uint_as_float(w & 0xffff0000u); }
__device__ __forceinline__ float wave_sum(float v) {
#pragma unroll
    for (int o = 1; o < 64; o <<= 1) v += __shfl_xor(v, o);
    return v;
}

struct Frame {
    LAS unsigned char* lds;
    int tid, lane, wave, vcu, G;
    float* out; unsigned char* ws;
};
struct Args { const float* in[22]; float* out; unsigned char* ws; int ph_lo, ph_hi; };


namespace att {
typedef short bf16x8 __attribute__((ext_vector_type(8)));
typedef short s16x4 __attribute__((ext_vector_type(4)));
typedef short v4i16_t __attribute__((ext_vector_type(4)));
typedef float f32x16 __attribute__((ext_vector_type(16)));
typedef float f32x4 __attribute__((ext_vector_type(4)));
typedef unsigned u32x4 __attribute__((ext_vector_type(4)));
typedef float f32x2_t __attribute__((ext_vector_type(2))); typedef __bf16 bf16x2_t __attribute__((ext_vector_type(2)));
typedef __attribute__((address_space(3))) unsigned char* lptr;
__device__ __forceinline__ unsigned cvtpk(float lo, float hi) { f32x2_t v = {lo, hi}; bf16x2_t b = __builtin_convertvector(v, bf16x2_t); return __builtin_bit_cast(unsigned, b); }
__device__ __forceinline__ s16x4 vtr(lptr p) { return __builtin_bit_cast(s16x4, __builtin_amdgcn_ds_read_tr16_b64_v4i16((__attribute__((address_space(3))) v4i16_t*)p)); }
__device__ __forceinline__ int creg(int r) { return (r & 3) + 8 * (r >> 2); }
constexpr float NEG = -INFINITY;

template <class Spec> __device__ __forceinline__ void load_tile(const Spec& S, int t, bf16x8 (&kn)[4], u32x4 (&vn)[4], int lane) {
    const int r32 = lane & 31, hi = lane >> 5;
    const bf16* kp = S.krow(t, r32) + 8 * hi;
#pragma unroll
    for (int d0 = 0; d0 < 4; ++d0) kn[d0] = *(const bf16x8*)(kp + 16 * d0);
    const bf16* v0 = S.vrow(t, lane >> 2) + 8 * (lane & 3);
    const bf16* v1 = S.vrow(t, 16 + (lane >> 2)) + 8 * (lane & 3);
    vn[0] = *(const u32x4*)(v0); vn[1] = *(const u32x4*)(v1); vn[2] = *(const u32x4*)(v0 + 32); vn[3] = *(const u32x4*)(v1 + 32);
}
template <class Spec> __device__ __forceinline__ void run_tiles(const Spec& S, const bf16x8 (&qr)[4], f32x16 (&o)[2], float& lsum, lptr vbuf, int lane) {
    const int hi = lane >> 5;
    const int NT = S.ntiles();
    const int loff = ((lane >> 4) & 1) * 32 + (lane & 3) * 8 + (4 * hi + ((lane & 15) >> 2)) * 64;
    bf16x8 kn[4], kn2[4]; u32x4 vn[4], vn2[4];
    load_tile(S, 0, kn, vn, lane);
    if (NT > 1) load_tile(S, 1, kn2, vn2, lane);
    for (int t = 0; t < NT; ++t) {
        bf16x8 kf[4];
#pragma unroll
        for (int d0 = 0; d0 < 4; ++d0) kf[d0] = kn[d0];
        lptr vb = vbuf + (t & 1) * 4096;
#pragma unroll
        for (int j = 0; j < 4; ++j) *(__attribute__((address_space(3))) u32x4*)(vb + j * 1024 + lane * 16) = vn[j];
#pragma unroll
        for (int j = 0; j < 4; ++j) { kn[j] = kn2[j]; vn[j] = vn2[j]; }
        if (t + 2 < NT) load_tile(S, t + 2, kn2, vn2, lane);
        f32x16 p = {};
#pragma unroll
        for (int d0 = 0; d0 < 4; ++d0) p = __builtin_amdgcn_mfma_f32_32x32x16_bf16(kf[d0], qr[d0], p, 0, 0, 0);
        S.mask(t, p, lane);
        float sacc = 0.f;
#pragma unroll
        for (int r = 0; r < 16; ++r) { p[r] = __builtin_amdgcn_exp2f(p[r]); sacc += p[r]; }
        lsum += sacc;
        u32x4 pw0, pw1;
        pw0[0] = cvtpk(p[0], p[1]); pw0[1] = cvtpk(p[2], p[3]); pw0[2] = cvtpk(p[4], p[5]); pw0[3] = cvtpk(p[6], p[7]);
        pw1[0] = cvtpk(p[8], p[9]); pw1[1] = cvtpk(p[10], p[11]); pw1[2] = cvtpk(p[12], p[13]); pw1[3] = cvtpk(p[14], p[15]);
#pragma unroll
        for (int dh = 0; dh < 2; ++dh) {
            const s16x4 l0 = vtr(vb + dh * 2048 + loff), h0 = vtr(vb + dh * 2048 + 512 + loff), l1 = vtr(vb + dh * 2048 + 1024 + loff), h1 = vtr(vb + dh * 2048 + 1536 + loff);
            const bf16x8 f0 = {l0[0], l0[1], l0[2], l0[3], h0[0], h0[1], h0[2], h0[3]}, f1 = {l1[0], l1[1], l1[2], l1[3], h1[0], h1[1], h1[2], h1[3]};
            o[dh] = __builtin_amdgcn_mfma_f32_32x32x16_bf16(__builtin_bit_cast(bf16x8, pw0), f0, o[dh], 0, 0, 0);
            o[dh] = __builtin_amdgcn_mfma_f32_32x32x16_bf16(__builtin_bit_cast(bf16x8, pw1), f1, o[dh], 0, 0, 0);
        }
    }
}
__device__ __forceinline__ void load_q(bf16x8 (&qr)[4], const bf16* qrow, int lane) {
    const int hi = lane >> 5;
#pragma unroll
    for (int d0 = 0; d0 < 4; ++d0) qr[d0] = *(const bf16x8*)(qrow + 16 * d0 + 8 * hi);
}
template <class RowFn> __device__ __forceinline__ void store_out(const f32x16 (&o)[2], float lsum, lptr wbuf, const RowFn& orow, int lane) {
    const int r32 = lane & 31, hi = lane >> 5;
    lsum += __shfl_xor(lsum, 32);
    __attribute__((address_space(3))) float* ls = (__attribute__((address_space(3))) float*)(wbuf + 4096);
    if (hi == 0) ls[r32] = lsum;
    __attribute__((address_space(3))) unsigned short* stg = (__attribute__((address_space(3))) unsigned short*)wbuf;
    float rl[16];
#pragma unroll
    for (int g = 0; g < 4; ++g) { const f32x4 lv = *(__attribute__((address_space(3))) f32x4*)(ls + 8 * g + 4 * hi);
#pragma unroll
        for (int j = 0; j < 4; ++j) rl[4 * g + j] = 1.0f / lv[j]; }
#pragma unroll
    for (int r = 0; r < 16; ++r) { const int q = creg(r) + 4 * hi;
#pragma unroll
        for (int dh = 0; dh < 2; ++dh) stg[q * 64 + dh * 32 + r32] = (unsigned short)f2bf(o[dh][r] * rl[r]); }
#pragma unroll
    for (int i = 0; i < 4; ++i) { const int row = i * 8 + (lane >> 3), ch = lane & 7; const u32x4 v = *(__attribute__((address_space(3))) u32x4*)(stg + row * 64 + ch * 8); *(u32x4*)(orow(row) + ch * 8) = v; }
}

struct SpecM { const bf16* K; const bf16* V;
    __device__ __forceinline__ int ntiles() const { return 8; }
    __device__ __forceinline__ const bf16* krow(int t, int i) const { return K + (32 * t + i) * 64; }
    __device__ __forceinline__ const bf16* vrow(int t, int i) const { return V + (32 * t + i) * 64; }
    __device__ __forceinline__ void mask(int, f32x16&, int) const {}
};
struct SpecB { const bf16* K; const bf16* V;
    int nt, rk0, w0;
    int rlo, dr0;
    int cb;
    const __attribute__((address_space(3))) float* tb;
    __device__ __forceinline__ int ntiles() const { return nt; }
    __device__ __forceinline__ const bf16* krow(int t, int i) const { return K + ((rk0 + t) * 64 + w0 + i) * 64; }
    __device__ __forceinline__ const bf16* vrow(int t, int i) const { return V + ((rk0 + t) * 64 + w0 + i) * 64; }
    __device__ __forceinline__ void mask(int t, f32x16& p, int lane) const {
        const int hi = lane >> 5, rk = rk0 + t; const bool rok = (unsigned)(rk - rlo) < 8u;
        int dr = rk + dr0; dr = dr < 0 ? 0 : (dr > 14 ? 14 : dr);
        const __attribute__((address_space(3))) float* tp = tb + dr * 64 + 4 * hi; const int cbh = rok ? cb + 4 * hi : -4096;
#pragma unroll
        for (int r = 0; r < 16; ++r) { const bool ok = (unsigned)(cbh + creg(r)) < 16u; p[r] = ok ? p[r] + tp[creg(r)] : NEG; }
    }
};
struct SpecA { const bf16* K; const bf16* V;
    int kp0, dil, T;
    __device__ __forceinline__ int ntiles() const { return 5; }
    __device__ __forceinline__ int kpos(int t, int i) const { int p = kp0 + (32 * t + i) * dil; return p < 0 ? 0 : (p >= T ? T - 1 : p); }
    __device__ __forceinline__ const bf16* krow(int t, int i) const { return K + kpos(t, i) * 64; }
    __device__ __forceinline__ const bf16* vrow(int t, int i) const { return V + kpos(t, i) * 64; }
    __device__ __forceinline__ void mask(int t, f32x16& p, int lane) const {
        const int r32 = lane & 31, hi = lane >> 5;
        const int lo = kp0 + 32 * t * dil, hip = lo + 31 * dil;
        if (t == 0 || t == 4) {
            const int base = 32 * t - r32 + 4 * hi;
#pragma unroll
            for (int r = 0; r < 16; ++r) { if ((unsigned)(base + creg(r)) > 128u) p[r] = NEG; } }
        if (lo < 0 || hip >= T) {
            const int kb = lo + 4 * hi * dil;
#pragma unroll
            for (int r = 0; r < 16; ++r) { const int kp = kb + creg(r) * dil; if ((unsigned)kp >= (unsigned)T) p[r] = NEG; } }
    }
};
struct SpecA16 { const bf16* K; const bf16* V;
    int kp0, T;
    __device__ __forceinline__ int ntiles() const { return 9; }
    __device__ __forceinline__ int kpos(int t, int i) const { int p = kp0 + (16 * t + (i & 15)) * 16 + (i >> 4); return p < 0 ? 0 : (p >= T ? T - 1 : p); }
    __device__ __forceinline__ const bf16* krow(int t, int i) const { return K + kpos(t, i) * 64; }
    __device__ __forceinline__ const bf16* vrow(int t, int i) const { return V + kpos(t, i) * 64; }
    __device__ __forceinline__ void mask(int t, f32x16& p, int lane) const {
        const int r32 = lane & 31, hi = lane >> 5, cq = r32 >> 4, iq = r32 & 15;
        const int lo = kp0 + 256 * t, hip = lo + 15 * 16 + 1;
        const int b0 = cq == 0 ? 16 * t - iq + 4 * hi : -4096, b1 = cq == 1 ? 16 * t - iq + 4 * hi : -4096;
#pragma unroll
        for (int r = 0; r < 16; ++r) { if ((unsigned)((r < 8 ? b0 : b1) + (creg(r) & 15)) > 128u) p[r] = NEG; }
        if (lo < 0 || hip >= T) {
            const int kb = lo + 4 * hi * 16;
#pragma unroll
            for (int r = 0; r < 16; ++r) { const int kp = kb + (creg(r) & 15) * 16 + (r >> 3); if ((unsigned)kp >= (unsigned)T) p[r] = NEG; } }
    }
};
}
template <class CM, class KS>
__device__ __forceinline__ void p0_transpose_item(const float* W, int K, int N, bf16* WT, LAS float* scr, int item, int lane, CM cm, KS ks) {
    const int nblk = N / 32, kb = item / nblk, nb = item % nblk, k0 = 64 * kb, n0 = 32 * nb;
    const int sc = cm(n0 + (lane & 31));
#pragma unroll 8
    for (int i = 0; i < 32; ++i) { const int kk = 2 * i + (lane >> 5); scr[kk * 33 + (lane & 31)] = W[(size_t)(k0 + kk) * N + sc] * ks(k0 + kk); }
    LDS_WAIT(); asm volatile("" ::: "memory");
    const int c = lane & 7;
#pragma unroll
    for (int j = 0; j < 4; ++j) { const int n = (lane >> 3) + 8 * j; const LAS float* s = scr + (8 * c) * 33 + n;
        v4u o; o.x = pk2(s[0 * 33], s[1 * 33]); o.y = pk2(s[2 * 33], s[3 * 33]); o.z = pk2(s[4 * 33], s[5 * 33]); o.w = pk2(s[6 * 33], s[7 * 33]);
        *(v4u*)(WT + (size_t)(n0 + n) * K + k0 + 8 * c) = o; }
    LDS_WAIT(); asm volatile("" ::: "memory");
}
struct CMapHead { int nrope;
    __device__ __forceinline__ int operator()(int c) const { const int pn = c >> 8, bj = (c >> 7) & 1, hh = (c >> 5) & 3, p5 = c & 31, hidx = 4 * pn + hh; int p = 32 * bj + p5;
        if (hidx < nrope && p < 16) p = (p & 3) + 8 * ((p >> 2) & 1) + 4 * (p >> 3); return 64 * hidx + p; } };
struct CMapId { __device__ __forceinline__ int operator()(int c) const { return c; } };
struct KSOne { __device__ __forceinline__ float operator()(int) const { return 1.f; } };
struct KSVec { const float* g; __device__ __forceinline__ float operator()(int k) const { return g[k]; } };
struct KSOut { const float *a, *b, *m; __device__ __forceinline__ float operator()(int k) const { return k < 384 ? a[k] : (k < 768 ? b[k - 384] : m[k - 768]); } };

__device__ __forceinline__ void rms_row_to_bf16(const float* xrow, const float* g, bf16* orow, int lane) {
    const f32x4* xr = (const f32x4*)xrow + lane; const f32x4* gr = (const f32x4*)g + lane;
    f32x4 v[4]; float s = 0.f;
#pragma unroll
    for (int j = 0; j < 4; ++j) { v[j] = xr[64 * j]; s += (v[j].x * v[j].x + v[j].y * v[j].y) + (v[j].z * v[j].z + v[j].w * v[j].w); }
    const float rstd = rsqrtf(wave_sum(s) * (1.f / DM) + RMS_EPS);
    unsigned long long* o8 = (unsigned long long*)orow + lane;
#pragma unroll
    for (int j = 0; j < 4; ++j) { const f32x4 gg = gr[64 * j]; o8[64 * j] = (unsigned long long)pk2(v[j].x * rstd * gg.x, v[j].y * rstd * gg.y) | ((unsigned long long)pk2(v[j].z * rstd * gg.z, v[j].w * rstd * gg.w) << 32); }
}
__device__ __forceinline__ void p0_prologue(Frame& F, const Args& A) {
    LAS float* scr = (LAS float*)(F.lds + F.wave * 16384);
    const int gw = F.vcu * NWAVES + F.wave, NGW = F.G * NWAVES;
    unsigned char* ws = F.ws;
    constexpr int I_IN = (DM / 64) * (NQKV / 32), I_MEM = (DM / 64) * (512 / 32), I_OUT = (DM / 64) * (DM / 32), I_1 = (DM / 64) * (FF / 32), I_2 = (FF / 64) * (DM / 32);
    constexpr int NITEMS = I_IN + I_MEM + I_OUT + I_1 + I_2;
    for (int it = gw; it < NITEMS; it += NGW) {
        int r = it;
        if (r < I_IN) { p0_transpose_item(A.in[5], DM, NQKV, (bf16*)(ws + WS_WIN), scr, r, F.lane, CMapHead{12}, KSOne{}); continue; } r -= I_IN;
        if (r < I_MEM) { p0_transpose_item(A.in[12], DM, 512, (bf16*)(ws + WS_WMEM), scr, r, F.lane, CMapHead{0}, KSOne{}); continue; } r -= I_MEM;
        if (r < I_OUT) { p0_transpose_item(A.in[18], DM, DM, (bf16*)(ws + WS_WOUT), scr, r, F.lane, CMapId{}, KSOut{A.in[15], A.in[16], A.in[17]}); continue; } r -= I_OUT;
        if (r < I_1) { p0_transpose_item(A.in[20], DM, FF, (bf16*)(ws + WS_W1), scr, r, F.lane, CMapId{}, KSVec{A.in[19]}); continue; } r -= I_1;
        p0_transpose_item(A.in[21], FF, DM, (bf16*)(ws + WS_W2), scr, r, F.lane, CMapId{}, KSOne{});
    }
    for (int m = gw; m < MTOK + MMEM; m += NGW) {
        if (m < MTOK) { const float* xrow = m < TP ? A.in[0] + (size_t)m * DM : A.in[1] + (size_t)(m - TP) * DM; rms_row_to_bf16(xrow, A.in[4], (bf16*)(ws + WS_XN) + (size_t)m * DM, F.lane); }
        else { const int r = m - MTOK; const float* xrow = r < NMEM ? A.in[2] + (size_t)r * DM : A.in[3] + (size_t)(r - NMEM) * DM; rms_row_to_bf16(xrow, A.in[11], (bf16*)(ws + WS_XNMEM) + (size_t)r * DM, F.lane); }
    }
    float* rc = (float*)(ws + WS_ROPE); float* rs = rc + TP * 8;
    for (int i = (F.vcu * NWAVES * 64) + F.tid; i < TP * 8; i += F.G * NWAVES * 64) {
        const int pos = i >> 3, fi = i & 7;
        const float inv = exp2f(-(float)fi * 0.125f * 18.931568569324174f);
        const float ang = (float)pos * inv;
        const double rev = (double)ang * 0.15915494309189535; const float fr = (float)(rev - __builtin_rint(rev));
        rc[i] = __builtin_amdgcn_cosf(fr); rs[i] = __builtin_amdgcn_sinf(fr);
    }
}

template <int NR, class KF>
__device__ __forceinline__ void attn_item(const bf16* qrow, const bf16* Kb, const bf16* Vb, const KF& kf, bf16* orow, int lane) {
    float q[64];
#pragma unroll
    for (int c = 0; c < 8; ++c) { const v4u w = *(const v4u*)(qrow + 8 * c);
#pragma unroll
        for (int e = 0; e < 4; ++e) { q[8 * c + 2 * e] = bflo(w[e]); q[8 * c + 2 * e + 1] = bfhi(w[e]); } }
    float p[NR]; float lsum = 0.f;
#pragma unroll
    for (int r = 0; r < NR; ++r) {
        long ridx; float bias; const bool ok = kf(64 * r + lane, ridx, bias);
        const bf16* krow = Kb + ridx * 64; float s = 0.f;
#pragma unroll
        for (int c = 0; c < 8; ++c) { const v4u w = *(const v4u*)(krow + 8 * c);
#pragma unroll
            for (int e = 0; e < 4; ++e) s += q[8 * c + 2 * e] * bflo(w[e]) + q[8 * c + 2 * e + 1] * bfhi(w[e]); }
        p[r] = ok ? exp2f(s + bias) : 0.f; lsum += p[r];
    }
    lsum = wave_sum(lsum);
    float o = 0.f;
#pragma unroll
    for (int r = 0; r < NR; ++r) {
#pragma unroll 8
        for (int l = 0; l < 64; ++l) {
            long ridx; float bias; (void)kf(64 * r + l, ridx, bias);
            const float pj = __int_as_float(__builtin_amdgcn_readlane(__float_as_int(p[r]), l));
            o += pj * __uint_as_float((unsigned)Vb[ridx * 64 + lane] << 16);
        }
    }
    orow[lane] = (bf16)f2bf(o / lsum);
}
struct KeyA { long sb; int pos, T;
    __device__ __forceinline__ bool operator()(int j, long& ridx, float& bias) const { const int pat = j >= 258 ? 2 : (j >= 129 ? 1 : 0), idx = j - 129 * pat, dil = 1 << (2 * pat), kp = pos + (idx - 64) * dil;
        const bool ok = j < 387 && kp >= 0 && kp < T; ridx = sb + (ok ? kp : pos); bias = 0.f; return ok; } };
struct KeyB { long sb; int r, c, rs, cs; const float* rpb;
    __device__ __forceinline__ bool operator()(int j, long& ridx, float& bias) const { const int kr = (j >> 4) & 7, kc = j & 15; ridx = sb + (rs + kr) * 64 + cs + kc;
        bias = rpb[(rs + kr - r + 7) * 31 + (cs + kc - c + 15)] * LOG2E; return true; } };
struct KeyM { long b0;
    __device__ __forceinline__ bool operator()(int j, long& ridx, float& bias) const { ridx = b0 + (j & 255); bias = 0.f; return true; } };

__device__ __forceinline__ void attn_simple_phase(Frame& F, const Args& A) {
    const int gw = F.vcu * NWAVES + F.wave, NGW = F.G * NWAVES;
    const bf16* QKV = (const bf16*)(F.ws + WS_QKV); bf16* O = (bf16*)(F.ws + WS_O);
    const bf16* MK = (const bf16*)(F.ws + WS_MK); const bf16* MV = (const bf16*)(F.ws + WS_MV);
    for (int it = gw; it < MTOK * 16; it += NGW) {
        const int hh = it / MTOK, row = it - hh * MTOK;
        const int sbat = row < TP ? 0 : 1 + ((row - TP) >> 13);
        const long sb = row < TP ? 0 : TP + (long)(sbat - 1) * TS; const int T = row < TP ? TP : TS, pos = (int)(row - sb);
        if (hh < 6) {
            if (ATT_A_MFMA) continue;
            const int h = hh;
            attn_item<7>(QKV + ((size_t)(0 + h) * MTOK + row) * 64, QKV + (size_t)(6 + h) * MTOK * 64, QKV + (size_t)(12 + h) * MTOK * 64, KeyA{sb, pos, T}, O + (size_t)row * DM + h * 64, F.lane);
        } else if (hh < 12) {
            if (ATT_B_MFMA) continue;
            const int h = hh - 6, rows = T / 64, r = pos >> 6, c = pos & 63;
            int rs = r - 4; rs = rs < 0 ? 0 : (rs > rows - 8 ? rows - 8 : rs); int cs = c - 8; cs = cs < 0 ? 0 : (cs > 48 ? 48 : cs);
            attn_item<2>(QKV + ((size_t)(18 + h) * MTOK + row) * 64, QKV + (size_t)(24 + h) * MTOK * 64, QKV + (size_t)(30 + h) * MTOK * 64, KeyB{sb, r, c, rs, cs, A.in[10] + h * 15 * 31}, O + (size_t)row * DM + 384 + h * 64, F.lane);
        } else {
            if (ATT_M_MFMA) continue;
            const int h = hh - 12;
            attn_item<4>(QKV + ((size_t)(36 + h) * MTOK + row) * 64, MK, MV, KeyM{(long)(sbat * 4 + h) * NMEM}, O + (size_t)row * DM + 768 + h * 64, F.lane);
        }
    }
}
__device__ __forceinline__ void onorm_phase(Frame& F) {
    const int gw = F.vcu * NWAVES + F.wave, NGW = F.G * NWAVES;
    bf16* O = (bf16*)(F.ws + WS_O);
    for (int m = gw; m < MTOK; m += NGW) {
        v4u* p = (v4u*)(O + (size_t)m * DM) + 2 * F.lane; v4u w0 = p[0], w1 = p[1];
        float v[16];
#pragma unroll
        for (int e = 0; e < 4; ++e) { v[2 * e] = bflo(w0[e]); v[2 * e + 1] = bfhi(w0[e]); v[8 + 2 * e] = bflo(w1[e]); v[8 + 2 * e + 1] = bfhi(w1[e]); }
        float ss = 0.f;
#pragma unroll
        for (int e = 0; e < 16; ++e) ss += v[e] * v[e];
        const int grp = F.lane < 24 ? 0 : (F.lane < 48 ? 1 : 2);
        const float sa = wave_sum(grp == 0 ? ss : 0.f), sb = wave_sum(grp == 1 ? ss : 0.f), sm = wave_sum(grp == 2 ? ss : 0.f);
        const float r = grp == 0 ? rsqrtf(sa * (1.f / 384.f) + RMS_EPS) : (grp == 1 ? rsqrtf(sb * (1.f / 384.f) + RMS_EPS) : rsqrtf(sm * (1.f / 256.f) + RMS_EPS));
#pragma unroll
        for (int e = 0; e < 4; ++e) { w0[e] = pk2(v[2 * e] * r, v[2 * e + 1] * r); w1[e] = pk2(v[8 + 2 * e] * r, v[8 + 2 * e + 1] * r); }
        p[0] = w0; p[1] = w1;
    }
}


constexpr int N_AUNITS = (MTOK / 256) * 6;
constexpr int N_BJOBS = (MTOK / 128) * 6 * 4;
constexpr int N_MJOBS = (MTOK / 32) * 4;
constexpr int LA_ACC = 65536, LA_L = 131072;
constexpr int LW_STRIDE = 12288, LW_TBL = 8192;

struct SeqInfo { long sb; int T; int bat; };
__device__ __forceinline__ SeqInfo seq_of(int row) { SeqInfo s; if (row < TP) { s.sb = 0; s.T = TP; s.bat = 0; } else { const int b = (row - TP) >> 13; s.sb = TP + (long)b * TS; s.T = TS; s.bat = 1 + b; } return s; }

__device__ __forceinline__ void m_job(Frame& F, int jm) {
    const int h = jm / (MTOK / 32), row0 = (jm - h * (MTOK / 32)) * 32; const SeqInfo si = seq_of(row0);
    const bf16* QKV = (const bf16*)(F.ws + WS_QKV);
    const int r32 = F.lane & 31;
    att::bf16x8 qr[4]; att::load_q(qr, QKV + ((size_t)(36 + h) * MTOK + row0 + r32) * 64, F.lane);
    att::SpecM S{(const bf16*)(F.ws + WS_MK) + (size_t)(si.bat * 4 + h) * NMEM * 64, (const bf16*)(F.ws + WS_MV) + (size_t)(si.bat * 4 + h) * NMEM * 64};
    att::f32x16 o[2] = {}; float lsum = 0.f;
    att::lptr wb = (att::lptr)(F.lds + F.wave * LW_STRIDE);
    att::run_tiles(S, qr, o, lsum, wb, F.lane);
    bf16* O = (bf16*)(F.ws + WS_O) + (size_t)row0 * DM + 768 + 64 * h;
    att::store_out(o, lsum, wb, [=](int q) { return O + (size_t)q * DM; }, F.lane);
}
__device__ __forceinline__ void b_job(Frame& F, const Args& A, int jb) {
    const int g = jb & 3, rest = jb >> 2, h = rest / (MTOK / 128), rp = rest - h * (MTOK / 128);
    int r0, rows; long sb;
    if (rp < TP / 128) { r0 = 2 * rp; rows = TP / 64; sb = 0; } else { const int q = rp - TP / 128, b = q / (TS / 128); r0 = 2 * (q - b * (TS / 128)); rows = TS / 64; sb = TP + (long)b * TS; }
    const int r32 = F.lane & 31;
    const int rq = r0 + (r32 >> 4), c = 16 * g + (r32 & 15);
    int rlo = rq - 4; rlo = rlo < 0 ? 0 : (rlo > rows - 8 ? rows - 8 : rlo);
    int cs = c - 8; cs = cs < 0 ? 0 : (cs > 48 ? 48 : cs);
    int rk0 = r0 - 4; rk0 = rk0 < 0 ? 0 : (rk0 > rows - 8 ? rows - 8 : rk0);
    int rk1 = r0 + 1 - 4; rk1 = rk1 < 0 ? 0 : (rk1 > rows - 8 ? rows - 8 : rk1);
    const int w0 = g == 0 ? 0 : (g == 1 ? 8 : (g == 2 ? 24 : 32));
    att::lptr wb = (att::lptr)(F.lds + F.wave * LW_STRIDE);
    __attribute__((address_space(3))) float* tbl = (__attribute__((address_space(3))) float*)(wb + LW_TBL);
    const float* rpb = A.in[10] + h * 465;
    for (int idx = F.lane; idx < 465; idx += 64) { const int dr = idx / 31, dl = idx - dr * 31; tbl[dr * 64 + 16 + dl] = rpb[idx] * LOG2E; }
    asm volatile("" ::: "memory");
    const bf16* QKV = (const bf16*)(F.ws + WS_QKV);
    att::bf16x8 qr[4]; att::load_q(qr, QKV + ((size_t)(18 + h) * MTOK + sb + rq * 64 + c) * 64, F.lane);
    att::SpecB S{QKV + ((size_t)(24 + h) * MTOK + sb) * 64, QKV + ((size_t)(30 + h) * MTOK + sb) * 64, rk1 + 8 - rk0, rk0, w0, rlo, 7 - rq, w0 - cs, tbl + (31 + w0 - c)};
    att::f32x16 o[2] = {}; float lsum = 0.f;
    att::run_tiles(S, qr, o, lsum, wb, F.lane);
    bf16* O = (bf16*)(F.ws + WS_O) + (size_t)(sb + r0 * 64 + 16 * g) * DM + 384 + 64 * h;
    att::store_out(o, lsum, wb, [=](int q) { return O + (size_t)((q >> 4) * 64 + (q & 15)) * DM; }, F.lane);
}
template <class Spec, class QLoc> __device__ __forceinline__ void a_job(Frame& F, const Spec& S, const bf16* qrow, const QLoc& qloc) {
    att::bf16x8 qr[4]; att::load_q(qr, qrow, F.lane);
    att::f32x16 o[2] = {}; float lsum = 0.f;
    att::run_tiles(S, qr, o, lsum, (att::lptr)(F.lds + F.wave * 8192), F.lane);
    const int r32 = F.lane & 31, hi = F.lane >> 5;
    __attribute__((address_space(3))) float* acc = (__attribute__((address_space(3))) float*)(F.lds + LA_ACC);
    __attribute__((address_space(3))) float* ls = (__attribute__((address_space(3))) float*)(F.lds + LA_L);
#pragma unroll
    for (int r = 0; r < 16; ++r) { const int ql = qloc(att::creg(r) + 4 * hi);
#pragma unroll
        for (int dh = 0; dh < 2; ++dh) (void)__hip_atomic_fetch_add(acc + ql * 64 + dh * 32 + r32, o[dh][r], __ATOMIC_RELAXED, __HIP_MEMORY_SCOPE_WORKGROUP); }
    (void)__hip_atomic_fetch_add(ls + qloc(r32), lsum, __ATOMIC_RELAXED, __HIP_MEMORY_SCOPE_WORKGROUP);
}
__device__ __forceinline__ void a_unit(Frame& F, int ua) {
    const int h = ua / (MTOK / 256), row0 = (ua - h * (MTOK / 256)) * 256; const SeqInfo si = seq_of(row0);
    const int pq0 = (int)(row0 - si.sb), w = F.wave, r32 = F.lane & 31;
    { __attribute__((address_space(3))) att::f32x4* z = (__attribute__((address_space(3))) att::f32x4*)(F.lds + LA_ACC);
#pragma unroll
      for (int i = 0; i < 8; ++i) z[i * 512 + F.tid] = (att::f32x4){0.f, 0.f, 0.f, 0.f};
      if (F.tid < 64) z[4096 + F.tid] = (att::f32x4){0.f, 0.f, 0.f, 0.f}; }
    __syncthreads();
    const bf16* QKV = (const bf16*)(F.ws + WS_QKV);
    const bf16* Q = QKV + ((size_t)(0 + h) * MTOK + si.sb) * 64; const bf16* K = QKV + ((size_t)(6 + h) * MTOK + si.sb) * 64; const bf16* V = QKV + ((size_t)(12 + h) * MTOK + si.sb) * 64;
    {
        att::SpecA S{K, V, pq0 + 32 * w - 64, 1, si.T};
        a_job(F, S, Q + (size_t)(pq0 + 32 * w + r32) * 64, [=](int q) { return 32 * w + q; }); }
    {
        const int rho = w >> 1, hf = w & 1;
        att::SpecA S{K, V, pq0 + 4 * (32 * hf - 64) + rho, 4, si.T};
        a_job(F, S, Q + (size_t)(pq0 + 4 * (32 * hf + r32) + rho) * 64, [=](int q) { return 4 * (32 * hf + q) + rho; }); }
    {
        att::SpecA16 S{K, V, pq0 + 2 * w - 1024, si.T};
        a_job(F, S, Q + (size_t)(pq0 + 16 * (r32 & 15) + 2 * w + (r32 >> 4)) * 64, [=](int q) { return 16 * (q & 15) + 2 * w + (q >> 4); }); }
    __syncthreads();
    {
        const int q = 32 * w + (F.lane >> 1), dh = F.lane & 1;
        const __attribute__((address_space(3))) att::f32x4* a = (const __attribute__((address_space(3))) att::f32x4*)(F.lds + LA_ACC + (q * 64 + dh * 32) * 4);
        const float rl = 1.0f / ((const __attribute__((address_space(3))) float*)(F.lds + LA_L))[q];
        bf16* op = (bf16*)(F.ws + WS_O) + (size_t)(row0 + q) * DM + 64 * h + 32 * dh;
#pragma unroll
        for (int i = 0; i < 4; ++i) { const att::f32x4 x = a[2 * i], y = a[2 * i + 1]; v4u o; o.x = pk2(x[0] * rl, x[1] * rl); o.y = pk2(x[2] * rl, x[3] * rl); o.z = pk2(y[0] * rl, y[1] * rl); o.w = pk2(y[2] * rl, y[3] * rl); *(v4u*)(op + 8 * i) = o; }
    }
    __syncthreads();
}
__device__ __forceinline__ void attn_phase(Frame& F, const Args& A) {
    const bool blocked = (F.G == 256);
    const int xcd = blockIdx.x & 7, ci = blockIdx.x >> 3;
#if ATT_A_MFMA
    if (blocked) { for (int k = ci; k < N_AUNITS / 8; k += 32) a_unit(F, xcd * (N_AUNITS / 8) + k); }
    else { for (int ua = blockIdx.x; ua < N_AUNITS; ua += F.G) a_unit(F, ua); }
#endif
    __syncthreads();
    if (blocked) {
        const int widx = ci * 8 + F.wave;
        for (int k = 0; k < 9; ++k) {
            int l;
            if (k < 6) l = k * 256 + widx; else { if (ci < 16) break; l = 1536 + (k - 6) * 128 + (widx - 128); }
            if (l < N_BJOBS / 8) {
#if ATT_B_MFMA
                b_job(F, A, xcd * (N_BJOBS / 8) + l);
#endif
            } else {
#if ATT_M_MFMA
                m_job(F, xcd * (N_MJOBS / 8) + (l - N_BJOBS / 8));
#endif
            }
        }
    } else {
        const int NJ = N_BJOBS + N_MJOBS;
        for (int j = blockIdx.x * 8 + F.wave; j < NJ; j += F.G * 8) {
            if (j < N_BJOBS) {
#if ATT_B_MFMA
                b_job(F, A, j);
#endif
            } else {
#if ATT_M_MFMA
                m_job(F, j - N_BJOBS);
#endif
            }
        }
    }
    __syncthreads();
}
#define XB_TMO      128
#define XB_XCNT(j)  (256  + 64 * (j))
#define XB_XSUB(j)  (1280 + 64 * (j))
#define XB_XGEN(j)  (2304 + 64 * (j))
#define XB_TOP      3328
#define XB_TOPGEN   3392
#define XCD_BAR_WORDS 3456
#define XB_SPIN_CAP (1u << 18)

__device__ __forceinline__ unsigned xb_ld(unsigned* p)              { return __hip_atomic_load(p, __ATOMIC_RELAXED, __HIP_MEMORY_SCOPE_AGENT); }
__device__ __forceinline__ unsigned xb_add(unsigned* p, unsigned v) { return __hip_atomic_fetch_add(p, v, __ATOMIC_RELAXED, __HIP_MEMORY_SCOPE_AGENT); }
__device__ __forceinline__ unsigned xb_xcc_id() { return (unsigned)__builtin_amdgcn_s_getreg((3 << 11) | 20) & 0xFu; }
#define XB_SPIN(cond, bar) do { unsigned _sp = 0; while (cond) { __builtin_amdgcn_s_sleep(1); \
    if ((++_sp & 255u) == 0u) { if (xb_ld(&(bar)[XB_TMO])) break; if (_sp > XB_SPIN_CAP) { atomicAdd(&(bar)[XB_TMO], 1u); break; } } } } while (0)

struct XcdBarrier {
    unsigned* bar; unsigned x;
    volatile LAS unsigned* st;
};

__device__ __forceinline__ XcdBarrier xcd_barrier_post(unsigned* bar, volatile LAS unsigned* st) {
    XcdBarrier b; b.bar = bar; b.x = xb_xcc_id(); b.st = st;
    if (threadIdx.x == 0) (void)xb_add(&bar[XB_XCNT(b.x)], 1u);
    return b;
}
__device__ __forceinline__ void xcd_barrier_complete(unsigned* bar, unsigned x, unsigned& nloc, unsigned& nx) {
    const unsigned G = gridDim.x * gridDim.y * gridDim.z;
    unsigned sum, cnt, mine, sp = 0u;
    for (;;) {
        sum = 0u; cnt = 0u; mine = 0u;
#pragma unroll
        for (unsigned j = 0; j < 16; ++j) { const unsigned c = xb_ld(&bar[XB_XCNT(j)]); sum += c; cnt += (c > 0u) ? 1u : 0u; mine = (j == x) ? c : mine; }
        if (sum == G) break;
        __builtin_amdgcn_s_sleep(1);
        if ((++sp & 255u) == 0u) { if (xb_ld(&bar[XB_TMO])) break; if (sp > XB_SPIN_CAP) { atomicAdd(&bar[XB_TMO], 1u); break; } }
    }
    nloc = mine > 0u ? mine : 1u; nx = cnt > 0u ? cnt : 1u;
}

__device__ __forceinline__ void xcd_barrier(const XcdBarrier& b) {
    asm volatile("s_waitcnt vmcnt(0)" ::: "memory");
    __syncthreads();
    if (threadIdx.x == 0) {
        unsigned* bar = b.bar;
        __builtin_amdgcn_s_waitcnt(0);
        unsigned nloc = b.st[0], nx = b.st[1];
        if (nloc == 0u) { xcd_barrier_complete(bar, b.x, nloc, nx); b.st[0] = nloc; b.st[1] = nx; }
        const unsigned old = xb_add(&bar[XB_XSUB(b.x)], 1u);
        const unsigned gen = old / nloc;
        if (old + 1u == (gen + 1u) * nloc) {
            __builtin_amdgcn_fence(__ATOMIC_RELEASE, "agent");
            asm volatile("s_waitcnt vmcnt(0)" ::: "memory");
            const unsigned og = xb_add(&bar[XB_TOP], 1u);
            const unsigned tg = og / nx;
            if (og + 1u == (tg + 1u) * nx) xb_add(&bar[XB_TOPGEN], 1u);
            else XB_SPIN(xb_ld(&bar[XB_TOPGEN]) == tg, bar);
            __builtin_amdgcn_fence(__ATOMIC_ACQUIRE, "agent");
            xb_add(&bar[XB_XGEN(b.x)], 1u);
            asm volatile("s_waitcnt vmcnt(0)" ::: "memory");
        } else {
            XB_SPIN(xb_ld(&bar[XB_XGEN(b.x)]) == gen, bar);
            __builtin_amdgcn_fence(__ATOMIC_ACQUIRE, "agent");
            asm volatile("s_waitcnt vmcnt(0)" ::: "memory");
        }
    }
    __syncthreads();
}
__global__ void __launch_bounds__(NWAVES * 64, 2) skel_fwd(Args args) {
    extern __shared__ __attribute__((aligned(16))) unsigned char lds[];
    cg::grid_group grid = cg::this_grid();
    Frame F;
    F.lds = (LAS unsigned char*)lds;
    F.tid = threadIdx.x; F.lane = F.tid & 63; F.wave = __builtin_amdgcn_readfirstlane(F.tid >> 6);
    F.G = gridDim.x; { const int bx = blockIdx.x; F.vcu = (F.G % 8 == 0) ? (bx % 8) * (F.G / 8) + bx / 8 : bx; }
    F.out = args.out; F.ws = args.ws;
    unsigned char* ws = args.ws;
    const int lo = args.ph_lo, hi = args.ph_hi;
    volatile LAS unsigned* bst = (volatile LAS unsigned*)(F.lds + LDS_MISC);
    if (F.tid < 2) bst[F.tid] = 0u;
    __syncthreads();
    XcdBarrier bar = xcd_barrier_post((unsigned*)(ws + WS_CTL) + CW_BAR, bst);
    if (lo < 0) grid.sync();
#define IN(k) (lo <= (k) && (k) < hi)
#define BOTH(k) (IN(k) && IN((k) + 1))
#define GRID_BAR() xcd_barrier(bar)

    if (IN(0)) { p0_prologue(F, args); if (BOTH(0)) GRID_BAR(); }

    if (IN(1)) {
        {
            pg8::Gemm g{(const pg8::bf16_t*)(ws + WS_XN), (const pg8::bf16_t*)(ws + WS_WIN), MTOK, NQKV, DM}; pg8::StaticOrder S; S.init(MTOK, NQKV, F.G, (int)blockIdx.x);
            pg8::EpiQKV E{(pg8::bf16_t*)(ws + WS_QKV), args.in[6], args.in[7], args.in[8], args.in[9], args.in[13], (const float*)(ws + WS_ROPE), (const float*)(ws + WS_ROPE) + TP * 8};
            pg8::gemm_phase<pg8::EpiQKV, pg8::StaticOrder, true, true>(F.lds, g, S, E);
        }
        {
            pg8::Gemm g{(const pg8::bf16_t*)(ws + WS_XNMEM), (const pg8::bf16_t*)(ws + WS_WMEM), MMEM, 512, DM}; pg8::StaticOrder S; S.init(MMEM, 512, F.G, F.G - 1 - (int)blockIdx.x);
            pg8::EpiMemKV E{(pg8::bf16_t*)(ws + WS_MK), (pg8::bf16_t*)(ws + WS_MV), args.in[14]};
            pg8::gemm_phase<pg8::EpiMemKV, pg8::StaticOrder, true, true>(F.lds, g, S, E);
        }
        if (BOTH(1)) GRID_BAR();
    }

    if (IN(2)) { attn_phase(F, args); if (!(ATT_A_MFMA && ATT_B_MFMA && ATT_M_MFMA)) attn_simple_phase(F, args); if (BOTH(2)) GRID_BAR(); }

    if (IN(3)) { onorm_phase(F); if (BOTH(3)) GRID_BAR(); }

    if (IN(4)) {
        pg8::Gemm g{(const pg8::bf16_t*)(ws + WS_O), (const pg8::bf16_t*)(ws + WS_WOUT), MTOK, DM, DM}; pg8::StaticOrder S; S.init(MTOK, DM, F.G, (int)blockIdx.x);
        pg8::EpiX1 E{args.in[0], args.in[1], F.out, (pg8::bf16_t*)(ws + WS_X1B), (float*)(ws + WS_SSQF)};
        pg8::gemm_phase<pg8::EpiX1, pg8::StaticOrder, true, true>(F.lds, g, S, E);
        if (BOTH(4)) GRID_BAR();
    }

    if (IN(5)) {
        pg8::Gemm g{(const pg8::bf16_t*)(ws + WS_X1B), (const pg8::bf16_t*)(ws + WS_W1), MTOK, FF, DM}; pg8::StaticOrder S; S.init(MTOK, FF, F.G, (int)blockIdx.x);
        pg8::EpiH E{(pg8::bf16_t*)(ws + WS_H), (const float*)(ws + WS_SSQF)};
        pg8::gemm_phase<pg8::EpiH, pg8::StaticOrder, true, true>(F.lds, g, S, E);
        if (BOTH(5)) GRID_BAR();
    }

    if (IN(6)) {
        pg8::Gemm g{(const pg8::bf16_t*)(ws + WS_H), (const pg8::bf16_t*)(ws + WS_W2), MTOK, DM, FF}; pg8::StaticOrder S; S.init(MTOK, DM, F.G, (int)blockIdx.x);
        pg8::EpiOut E{F.out};
        pg8::gemm_phase<pg8::EpiOut, pg8::StaticOrder, true, true>(F.lds, g, S, E);
    }
#undef IN
#undef BOTH
}

extern "C" void kernel_launch(void* const* d_in, const int* in_sizes, int n_in, void* d_out, int out_size, void* d_ws, size_t ws_size, hipStream_t stream) {
    static int grid = 0;
    if (grid == 0) {
        if (n_in != 22 || in_sizes[0] != TP * DM || in_sizes[1] != NBS * TS * DM || out_size != MTOK * DM || ws_size < WS_END) {
            fprintf(stderr, "kernel_launch: unexpected shapes / workspace (n_in %d, in0 %d, out %d, ws %zu); nothing launched\n", n_in, n_in > 0 ? in_sizes[0] : -1, out_size, ws_size); grid = -1; return; }
        int dev = 0, cus = 0, per_cu = 0;
        if (hipGetDevice(&dev) != hipSuccess || hipDeviceGetAttribute(&cus, hipDeviceAttributeMultiprocessorCount, dev) != hipSuccess) { grid = -1; return; }
        if (hipFuncSetAttribute((const void*)skel_fwd, hipFuncAttributeMaxDynamicSharedMemorySize, LDS_BYTES) != hipSuccess) { fprintf(stderr, "kernel_launch: hipFuncSetAttribute failed\n"); grid = -1; return; }
        if (hipOccupancyMaxActiveBlocksPerMultiprocessor(&per_cu, (const void*)skel_fwd, NWAVES * 64, LDS_BYTES) != hipSuccess || per_cu < 1) { fprintf(stderr, "kernel_launch: occupancy query says %d\n", per_cu); (void)hipGetLastError(); grid = -1; return; }
        grid = cus * per_cu;
    }
    if (grid < 0) return;
    if (hipMemsetAsync((char*)d_ws + WS_CTL, 0, CTL_ZERO_BYTES, stream) != hipSuccess) return;
    Args a{};
    for (int i = 0; i < 22; ++i) a.in[i] = (const float*)d_in[i];
    a.out = (float*)d_out; a.ws = (unsigned char*)d_ws;
    if (N_LAUNCHES == 1) {
        a.ph_lo = 0; a.ph_hi = NPH;
        void* kargs[] = {&a};
        hipError_t e = hipLaunchCooperativeKernel((const void*)skel_fwd, dim3(grid), dim3(NWAVES * 64), kargs, LDS_BYTES, stream);
        if (e != hipSuccess) fprintf(stderr, "kernel_launch: cooperative launch failed: %s (grid %d)\n", hipGetErrorString(e), grid);
    } else {
        for (int li = 0; li < NPH; ++li) { a.ph_lo = li; a.ph_hi = li + 1; hipLaunchKernelGGL(skel_fwd, dim3(grid), dim3(NWAVES * 64), LDS_BYTES, stream, a); }
    }
}
```

```cpp
#include <hip/hip_runtime.h>
#include <hip/hip_cooperative_groups.h>
#include <cstdio>
#include <cstdint>
namespace cg = cooperative_groups;

constexpr int DM = 1024, TP = 16384, TS = 8192, NBS = 4, MTOK = TP + NBS * TS;
constexpr int NQKV = 2560, NHEADS = 40, FF = 4096, NMEM = 256, NBATCH = 1 + NBS, MMEM = NBATCH * NMEM;
constexpr float RMS_EPS = 1e-6f;
constexpr float LOG2E = 1.4426950408889634f;
constexpr float QSCALE = 0.125f * LOG2E;
#ifndef ATT_A_MFMA
#define ATT_A_MFMA 1
#endif
#ifndef ATT_B_MFMA
#define ATT_B_MFMA 1
#endif
#ifndef ATT_M_MFMA
#define ATT_M_MFMA 1
#endif
#ifndef PROBE_MODE
#define PROBE_MODE 0
#endif
#ifndef PROBE_WHAT
#define PROBE_WHAT 4
#endif
namespace pg8 {
#define PG8_LAS __attribute__((address_space(3)))
typedef unsigned short bf16_t;
typedef short bf16x8 __attribute__((ext_vector_type(8)));
typedef float f32x4 __attribute__((ext_vector_type(4)));
typedef unsigned u32x4 __attribute__((ext_vector_type(4)));
constexpr int BM = 256, BK = 64, HALF = 128, HTB = HALF * BK * 2  , STAGE_BYTES = 8 * HTB, NXCD = 8, WGM = 8;

__host__ __device__ __forceinline__ int lds_byte(int r, int c) { const int st = (r >> 4) * 2 + (c >> 5), rr = r & 15, cc = c & 31, ob = rr * 64 + cc * 2; return st * 1024 + (ob ^ (((ob >> 9) & 1) << 5)); }
__host__ __device__ __forceinline__ void stage_rc(int b, int& R, int& C) { const int st = b / 1024, sb = b % 1024, swz = sb ^ (((sb >> 9) & 1) << 5); R = (st >> 1) * 16 + swz / 64; C = (st & 1) * 32 + (swz % 64) / 2; }
__host__ __device__ __forceinline__ int perm32(int rho) { const int n = rho >> 4, i = rho & 15; return 8 * (i >> 2) + 4 * n + (i & 3); }

struct Unit { int pm, pn; };
struct Gemm { const bf16_t* A; const bf16_t* Bt; int M, N, K; };

struct StaticOrder {
    int nM, nN, nwg, G, c;
    __host__ __device__ void init(int M, int N, int G_, int c_) { nM = M / BM; nN = N / BM; nwg = nM * nN; G = G_; c = c_; }
    __host__ __device__ bool next(int i, Unit& u) const {
        const long L = (long)i * G + c; if (L >= nwg) return false;
        int wgid = (int)L; { const int q = nwg / NXCD, r = nwg % NXCD, xcd = wgid % NXCD, off = wgid / NXCD; wgid = (xcd < r ? xcd * (q + 1) : r * (q + 1) + (xcd - r) * q) + off; }
        const int nig = WGM * nN, gid = wgid / nig, fm = gid * WGM, gsz = (nM - fm) < WGM ? (nM - fm) : WGM;
        u.pm = fm + ((wgid % nig) % gsz); u.pn = (wgid % nig) / gsz; return true;
    }
    __device__ __forceinline__ void a_ready(const Unit&) const {}
    __device__ __forceinline__ void done(const Unit&) const {}
};

__device__ __forceinline__ unsigned cvt_pk_bf16(float lo, float hi) { unsigned r; asm volatile("v_cvt_pk_bf16_f32 %0, %1, %2" : "=v"(r) : "v"(lo), "v"(hi)); return r; }
typedef float f32x2 __attribute__((ext_vector_type(2)));
__device__ __forceinline__ float sq4(const f32x4 v) { return (v[0] * v[0] + v[1] * v[1]) + (v[2] * v[2] + v[3] * v[3]); }
__device__ __forceinline__ u32x4 pack8(const f32x4 a, const f32x4 b) { u32x4 w; w.x = cvt_pk_bf16(a[0], a[1]); w.y = cvt_pk_bf16(a[2], a[3]); w.z = cvt_pk_bf16(b[0], b[1]); w.w = cvt_pk_bf16(b[2], b[3]); return w; }

struct EpiQKV {
    static constexpr bool PERM = true, AFTER_DRAIN = false, KSCALE = false; static constexpr int KS_T1 = -1, KS_T2 = -1;
    bf16_t* QKV;
    const float *gqa, *gka, *gqb, *gkb, *gqm;
    const float *rc, *rs;
    __device__ __forceinline__ void operator()(const f32x4 (&acc)[2][2][4][2], const Unit& u, int wr, int wc, int fr, int fq) const {
        const int hidx = u.pn * 4 + wc;
        const float* gain = nullptr; bool rope = false; float qs = 1.f;
        if (hidx < 6) { gain = gqa; rope = true; qs = QSCALE; } else if (hidx < 12) { gain = gka; rope = true; } else if (hidx < 18) { } else if (hidx < 24) { gain = gqb; qs = QSCALE; }
        else if (hidx < 30) { gain = gkb; } else if (hidx < 36) { } else { gain = gqm; qs = QSCALE; }
        const bool rl = rope && fq < 2;
        f32x4 g[2][2];
#pragma unroll
        for (int bj = 0; bj < 2; ++bj)
#pragma unroll
            for (int n = 0; n < 2; ++n) { const int d0 = (rl && bj == 0) ? (8 * n + 4 * fq) : (32 * bj + 8 * fq + 4 * n); g[bj][n] = gain ? *(const f32x4*)(gain + d0) : (f32x4){1.f, 1.f, 1.f, 1.f}; }
        bf16_t* base = QKV + (size_t)hidx * MTOK * 64 + 8 * fq;
#pragma unroll
        for (int ai = 0; ai < 2; ++ai)
#pragma unroll
            for (int m = 0; m < 4; ++m) {
                const int row = u.pm * BM + ai * HALF + wr * 64 + m * 16 + fr;
                f32x4 v[2][2];
#pragma unroll
                for (int bj = 0; bj < 2; ++bj)
#pragma unroll
                    for (int n = 0; n < 2; ++n) v[bj][n] = acc[ai][bj][m][n];
                if (gain) {
                    float ss = (sq4(v[0][0]) + sq4(v[0][1])) + (sq4(v[1][0]) + sq4(v[1][1]));
                    ss += __shfl_xor(ss, 16); ss += __shfl_xor(ss, 32);
                    const float r = rsqrtf(ss * (1.f / 64.f) + RMS_EPS) * qs;
#pragma unroll
                    for (int bj = 0; bj < 2; ++bj)
#pragma unroll
                        for (int n = 0; n < 2; ++n) v[bj][n] = v[bj][n] * r * g[bj][n];
                    if (rope) {
                        const int pos = row < TP ? row : ((row - TP) & (TS - 1));
                        const f32x4 c = *(const f32x4*)(rc + pos * 8 + 4 * (fq & 1)), s = *(const f32x4*)(rs + pos * 8 + 4 * (fq & 1));
                        if (fq < 2) { const f32x4 x1 = v[0][0], x2 = v[0][1]; v[0][0] = x1 * c - x2 * s; v[0][1] = x2 * c + x1 * s; }
                    }
                }
                bf16_t* rowp = base + (size_t)row * 64;
                *(u32x4*)(rowp) = pack8(v[0][0], v[0][1]);
                *(u32x4*)(rowp + 32) = pack8(v[1][0], v[1][1]);
            }
    }
};
struct EpiMemKV {
    static constexpr bool PERM = true, AFTER_DRAIN = false, KSCALE = false; static constexpr int KS_T1 = -1, KS_T2 = -1;
    bf16_t* MK; bf16_t* MV; const float* gk;
    __device__ __forceinline__ void operator()(const f32x4 (&acc)[2][2][4][2], const Unit& u, int wr, int wc, int fr, int fq) const {
        const int hidx = u.pn * 4 + wc; const bool isk = hidx < 4; const int h = hidx & 3;
        f32x4 g[2][2];
#pragma unroll
        for (int bj = 0; bj < 2; ++bj)
#pragma unroll
            for (int n = 0; n < 2; ++n) g[bj][n] = isk ? *(const f32x4*)(gk + 32 * bj + 8 * fq + 4 * n) : (f32x4){1.f, 1.f, 1.f, 1.f};
        bf16_t* base = (isk ? MK : MV) + 8 * fq;
#pragma unroll
        for (int ai = 0; ai < 2; ++ai)
#pragma unroll
            for (int m = 0; m < 4; ++m) {
                const int row = u.pm * BM + ai * HALF + wr * 64 + m * 16 + fr;
                f32x4 v[2][2];
#pragma unroll
                for (int bj = 0; bj < 2; ++bj)
#pragma unroll
                    for (int n = 0; n < 2; ++n) v[bj][n] = acc[ai][bj][m][n];
                if (isk) {
                    float ss = (sq4(v[0][0]) + sq4(v[0][1])) + (sq4(v[1][0]) + sq4(v[1][1]));
                    ss += __shfl_xor(ss, 16); ss += __shfl_xor(ss, 32);
                    const float r = rsqrtf(ss * (1.f / 64.f) + RMS_EPS);
#pragma unroll
                    for (int bj = 0; bj < 2; ++bj)
#pragma unroll
                        for (int n = 0; n < 2; ++n) v[bj][n] = v[bj][n] * r * g[bj][n];
                }
                bf16_t* rowp = base + ((size_t)((row >> 8) * 4 + h) * NMEM + (row & 255)) * 64;
                *(u32x4*)(rowp) = pack8(v[0][0], v[0][1]);
                *(u32x4*)(rowp + 32) = pack8(v[1][0], v[1][1]);
            }
    }
};
struct EpiX1 {
    static constexpr bool PERM = true, AFTER_DRAIN = false, KSCALE = true; static constexpr int KS_T1 = 6, KS_T2 = 12;
    const float* xp; const float* xs; float* out; bf16_t* x1b; float* ssq; const float* ssqa;
    static constexpr int TBL_OFF = 131072;
    __device__ __forceinline__ void prep(const Unit& u, PG8_LAS unsigned char* lds, int idx, int tid) const {
        if (tid < BM) { const f32x4 q = *(const f32x4*)(ssqa + (size_t)(u.pm * BM + tid) * 4);
            const float sa = rsqrtf(q[0] * (1.f / 384.f) + RMS_EPS), sb = rsqrtf(q[1] * (1.f / 384.f) + RMS_EPS), sm = rsqrtf(q[2] * (1.f / 256.f) + RMS_EPS);
            *(PG8_LAS f32x4*)(lds + TBL_OFF + (idx & 1) * 4096 + tid * 16) = (f32x4){sa / sb, sb / sm, sm, 0.f}; }
    }
    __device__ __forceinline__ void kscale(f32x4 (&acc)[2][2][4][2], int t, int wr, int fr, PG8_LAS unsigned char* lds, int idx) const {
        const PG8_LAS float* tb = (const PG8_LAS float*)(lds + TBL_OFF + (idx & 1) * 4096) + ((t == KS_T1) ? 0 : 1);
#pragma unroll
        for (int ai = 0; ai < 2; ++ai)
#pragma unroll
            for (int m = 0; m < 4; ++m) {
                const float f = tb[(ai * HALF + wr * 64 + m * 16 + fr) * 4];
#pragma unroll
                for (int bj = 0; bj < 2; ++bj)
#pragma unroll
                    for (int n = 0; n < 2; ++n) acc[ai][bj][m][n] = acc[ai][bj][m][n] * f;
            }
    }
    __device__ __forceinline__ void epi(const f32x4 (&acc)[2][2][4][2], const Unit& u, int wr, int wc, int fr, int fq, PG8_LAS unsigned char* lds, int idx) const {
        const PG8_LAS float* tb = (const PG8_LAS float*)(lds + TBL_OFF + (idx & 1) * 4096) + 2;
        const int col0 = u.pn * BM + wc * 32 + 8 * fq;
#pragma unroll
        for (int ai = 0; ai < 2; ++ai)
#pragma unroll
            for (int m = 0; m < 4; ++m) {
                const int row = u.pm * BM + ai * HALF + wr * 64 + m * 16 + fr;
                const float sm = tb[(ai * HALF + wr * 64 + m * 16 + fr) * 4];
                const float* xrow = (row < TP ? xp + (size_t)row * DM : xs + (size_t)(row - TP) * DM) + col0;
                float* orow = out + (size_t)row * DM + col0; bf16_t* brow = x1b + (size_t)row * DM + col0;
                float ss = 0.f;
#pragma unroll
                for (int bj = 0; bj < 2; ++bj) {
                    const f32x4 v0 = acc[ai][bj][m][0] * sm + *(const f32x4*)(xrow + bj * HALF), v1 = acc[ai][bj][m][1] * sm + *(const f32x4*)(xrow + bj * HALF + 4);
                    *(f32x4*)(orow + bj * HALF) = v0; *(f32x4*)(orow + bj * HALF + 4) = v1;
                    *(u32x4*)(brow + bj * HALF) = pack8(v0, v1);
                    ss += sq4(v0) + sq4(v1);
                }
                ss += __shfl_xor(ss, 16); ss += __shfl_xor(ss, 32);
                if (fq == 0) unsafeAtomicAdd(ssq + row, ss);
            }
    }
};
struct EpiH {
    static constexpr bool PERM = true, AFTER_DRAIN = false, KSCALE = false; static constexpr int KS_T1 = -1, KS_T2 = -1;
    bf16_t* H; const float* ssq;
    __device__ __forceinline__ void operator()(const f32x4 (&acc)[2][2][4][2], const Unit& u, int wr, int wc, int fr, int fq) const {
        const int col0 = u.pn * BM + wc * 32 + 8 * fq;
#pragma unroll
        for (int ai = 0; ai < 2; ++ai)
#pragma unroll
            for (int m = 0; m < 4; ++m) {
                const int row = u.pm * BM + ai * HALF + wr * 64 + m * 16 + fr;
                const float r = rsqrtf(ssq[row] * (1.f / DM) + RMS_EPS);
                bf16_t* hrow = H + (size_t)row * FF + col0;
#pragma unroll
                for (int bj = 0; bj < 2; ++bj) {
                    f32x4 v0 = acc[ai][bj][m][0] * r, v1 = acc[ai][bj][m][1] * r;
#pragma unroll
                    for (int e = 0; e < 4; ++e) { const float a = fmaxf(v0[e], 0.f), b = fmaxf(v1[e], 0.f); v0[e] = a * a; v1[e] = b * b; }
                    *(u32x4*)(hrow + bj * HALF) = pack8(v0, v1);
                }
            }
    }
};
struct EpiOut {
    static constexpr bool PERM = true, AFTER_DRAIN = false, KSCALE = false; static constexpr int KS_T1 = -1, KS_T2 = -1;
    float* out;
    __device__ __forceinline__ void operator()(const f32x4 (&acc)[2][2][4][2], const Unit& u, int wr, int wc, int fr, int fq) const {
        const int col0 = u.pn * BM + wc * 32 + 8 * fq;
#pragma unroll
        for (int ai = 0; ai < 2; ++ai)
#pragma unroll
            for (int m = 0; m < 4; ++m) {
                const int row = u.pm * BM + ai * HALF + wr * 64 + m * 16 + fr;
                float* orow = out + (size_t)row * DM + col0;
#pragma unroll
                for (int bj = 0; bj < 2; ++bj) {
                    const f32x4 v0 = acc[ai][bj][m][0] + *(const f32x4*)(orow + bj * HALF), v1 = acc[ai][bj][m][1] + *(const f32x4*)(orow + bj * HALF + 4);
                    *(f32x4*)(orow + bj * HALF) = v0; *(f32x4*)(orow + bj * HALF + 4) = v1;
                }
            }
    }
};

template <class Epi, class Sched, bool ALIGN_EPI = false, bool SP2 = false>
__device__ __forceinline__ void gemm_phase(PG8_LAS unsigned char* lds, const Gemm g, const Sched& S, const Epi& E) {
    const int tid = threadIdx.x, wid = __builtin_amdgcn_readfirstlane(tid >> 6), lane = tid & 63, wr = wid >> 2, wc = wid & 3, fr = lane & 15, fq = lane >> 4;
    const int K = g.K, nt = K / BK;
    unsigned voffA[2], voffB[2];
#pragma unroll
    for (int i = 0; i < 2; ++i) { int R, C; stage_rc(tid * 16 + i * 8192, R, C); const int Rb = Epi::PERM ? ((R & ~31) + perm32(R & 31)) : R;
        voffA[i] = (unsigned)(R * K + C) * 2u; voffB[i] = (unsigned)(Rb * K + C) * 2u; }
    const size_t kstep = (size_t)(BK * 2);
    const size_t hstep = (size_t)HALF * K * 2;
    const size_t tstep = 2 * hstep;
    const unsigned ldsw = (unsigned)wid * 1024u;
    const int aoff = lds_byte(wr * 64 + fr, fq * 8), boff = lds_byte(wc * 32 + fr, fq * 8);
#define PG8_SA(b, h) (((b) * 2 + (h)) * HTB)
#define PG8_SB(b, h) ((4 + (b) * 2 + (h)) * HTB)
#define PG8_STAGE(bufoff, gbase, voff) do { _Pragma("unroll") for (int _i = 0; _i < 2; ++_i) \
        __builtin_amdgcn_global_load_lds((const unsigned*)((const char*)(gbase) + (voff)[_i]), (PG8_LAS unsigned*)(lds + (bufoff) + ldsw + _i * 8192), 16, 0, 0); } while (0)
#define PG8_LDA(dst, b, h) do { _Pragma("unroll") for (int m = 0; m < 4; ++m) _Pragma("unroll") for (int k = 0; k < 2; ++k) dst[m][k] = *(const PG8_LAS bf16x8*)(lds + PG8_SA(b, h) + aoff + m * 2048 + k * 1024); } while (0)
#define PG8_LDB(dst, b, h) do { _Pragma("unroll") for (int n = 0; n < 2; ++n) _Pragma("unroll") for (int k = 0; k < 2; ++k) dst[n][k] = *(const PG8_LAS bf16x8*)(lds + PG8_SB(b, h) + boff + n * 2048 + k * 1024); } while (0)
#define PG8_MMA(ai, bj, At, Bt) do { __builtin_amdgcn_s_setprio(1); _Pragma("unroll") for (int m = 0; m < 4; ++m) _Pragma("unroll") for (int n = 0; n < 2; ++n) _Pragma("unroll") for (int k = 0; k < 2; ++k) \
        acc[ai][bj][m][n] = __builtin_amdgcn_mfma_f32_16x16x32_bf16(Bt[n][k], At[m][k], acc[ai][bj][m][n], 0, 0, 0); __builtin_amdgcn_s_setprio(0); } while (0)
#define PG8_WAIT_V(n) asm volatile("s_waitcnt vmcnt(" #n ")" ::: "memory")
#define PG8_WAIT_L(n) asm volatile("s_waitcnt lgkmcnt(" #n ")" ::: "memory")
#define PG8_BAR __builtin_amdgcn_s_barrier()
#define PG8_SCHED __builtin_amdgcn_sched_barrier(0)
    Unit cur, nxt; int ui = 0;
    if (!S.next(0, cur)) return;
    f32x4 acc[2][2][4][2];
#pragma unroll
    for (int a = 0; a < 2; ++a)
#pragma unroll
        for (int b = 0; b < 2; ++b)
#pragma unroll
            for (int m = 0; m < 4; ++m)
#pragma unroll
                for (int n = 0; n < 2; ++n) acc[a][b][m][n] = (f32x4){0.f, 0.f, 0.f, 0.f};
    bf16x8 At[4][2], B0[2][2], B1[2][2];
    const char* cA = (const char*)g.A + (size_t)cur.pm * tstep; const char* cB = (const char*)g.Bt + (size_t)cur.pn * tstep;
    S.a_ready(cur);
    if constexpr (Epi::KSCALE) E.prep(cur, lds, 0, tid);
    if constexpr (SP2) {
        PG8_STAGE(PG8_SB(0, 0), cB, voffB); PG8_STAGE(PG8_SB(0, 1), cB + hstep, voffB); PG8_STAGE(PG8_SA(0, 0), cA, voffA); PG8_STAGE(PG8_SA(0, 1), cA + hstep, voffA);
        if (wr == 1) PG8_BAR;
        PG8_WAIT_V(2); PG8_BAR;
        PG8_STAGE(PG8_SB(1, 0), cB + kstep, voffB); PG8_STAGE(PG8_SA(1, 0), cA + kstep, voffA); PG8_STAGE(PG8_SB(1, 1), cB + hstep + kstep, voffB);
        PG8_WAIT_V(6); PG8_BAR;
    } else {
        PG8_STAGE(PG8_SB(0, 0), cB, voffB); PG8_STAGE(PG8_SA(0, 0), cA, voffA); PG8_STAGE(PG8_SB(0, 1), cB + hstep, voffB); PG8_STAGE(PG8_SA(0, 1), cA + hstep, voffA);
        if (wr == 1) PG8_BAR;
        PG8_WAIT_V(4); PG8_BAR;
        PG8_STAGE(PG8_SB(1, 0), cB + kstep, voffB); PG8_STAGE(PG8_SA(1, 0), cA + kstep, voffA); PG8_STAGE(PG8_SB(1, 1), cB + hstep + kstep, voffB);
        PG8_WAIT_V(6); PG8_BAR;
    }
    for (;;) {
        const bool has_next = S.next(ui + 1, nxt);
        const char* nA = has_next ? (const char*)g.A + (size_t)nxt.pm * tstep : cA; const char* nB = has_next ? (const char*)g.Bt + (size_t)nxt.pn * tstep : cB;
        for (int t = 0; t < nt; t += 2) {
            const bool last = (t == nt - 2);
            if constexpr (Epi::KSCALE) { if (t == Epi::KS_T1 || t == Epi::KS_T2) E.kscale(acc, t, wr, fr, lds, ui); }
            const char* a1 = cA + (size_t)(t + 1) * kstep;
            const char* a2 = last ? nA : cA + (size_t)(t + 2) * kstep; const char* b2 = last ? nB : cB + (size_t)(t + 2) * kstep;
            const char* a3 = a2 + kstep; const char* b3 = b2 + kstep;
            if (last && has_next) { S.a_ready(nxt); if constexpr (Epi::KSCALE) E.prep(nxt, lds, ui + 1, tid); }
            if constexpr (SP2) {
            PG8_LDB(B0, 0, 0); PG8_LDB(B1, 0, 1); PG8_SCHED; PG8_LDA(At, 0, 0); PG8_STAGE(PG8_SA(1, 1), a1 + hstep, voffA);
            PG8_WAIT_V(8); PG8_WAIT_L(0); PG8_BAR; PG8_MMA(0, 0, At, B0); PG8_MMA(0, 1, At, B1); PG8_BAR; PG8_SCHED;
            PG8_LDA(At, 0, 1); PG8_STAGE(PG8_SB(0, 0), b2, voffB); PG8_STAGE(PG8_SB(0, 1), b2 + hstep, voffB); PG8_STAGE(PG8_SA(0, 0), a2, voffA);
            PG8_WAIT_V(8); PG8_WAIT_L(0); PG8_BAR; PG8_MMA(1, 0, At, B0); PG8_MMA(1, 1, At, B1); PG8_BAR; PG8_SCHED;
            PG8_LDB(B0, 1, 0); PG8_LDB(B1, 1, 1); PG8_SCHED; PG8_LDA(At, 1, 0); PG8_STAGE(PG8_SA(0, 1), a2 + hstep, voffA);
            PG8_WAIT_V(8); PG8_WAIT_L(0); PG8_BAR; PG8_MMA(0, 0, At, B0); PG8_MMA(0, 1, At, B1); PG8_BAR; PG8_SCHED;
            PG8_LDA(At, 1, 1); PG8_STAGE(PG8_SB(1, 0), b3, voffB); PG8_STAGE(PG8_SB(1, 1), b3 + hstep, voffB); PG8_STAGE(PG8_SA(1, 0), a3, voffA);
            PG8_WAIT_V(8); PG8_WAIT_L(0); PG8_BAR; PG8_MMA(1, 0, At, B0); PG8_MMA(1, 1, At, B1); PG8_BAR; PG8_SCHED;
            } else {
            PG8_LDB(B0, 0, 0); PG8_SCHED; PG8_LDA(At, 0, 0); PG8_STAGE(PG8_SA(1, 1), a1 + hstep, voffA);
            PG8_WAIT_L(8); PG8_BAR; PG8_WAIT_L(0); PG8_MMA(0, 0, At, B0); PG8_BAR; PG8_SCHED;
            PG8_LDB(B1, 0, 1); PG8_STAGE(PG8_SB(0, 0), b2, voffB);
            PG8_BAR; PG8_WAIT_L(0); PG8_MMA(0, 1, At, B1); PG8_BAR;
            PG8_LDA(At, 0, 1); PG8_STAGE(PG8_SA(0, 0), a2, voffA);
            PG8_BAR; PG8_WAIT_L(0); PG8_MMA(1, 0, At, B0); PG8_BAR; PG8_SCHED;
            PG8_STAGE(PG8_SB(0, 1), b2 + hstep, voffB);
            PG8_WAIT_V(6); PG8_BAR; PG8_MMA(1, 1, At, B1); PG8_BAR;
            PG8_LDB(B0, 1, 0); PG8_SCHED; PG8_LDA(At, 1, 0); PG8_STAGE(PG8_SA(0, 1), a2 + hstep, voffA);
            PG8_WAIT_L(8); PG8_BAR; PG8_WAIT_L(0); PG8_MMA(0, 0, At, B0); PG8_BAR; PG8_SCHED;
            PG8_LDB(B1, 1, 1); PG8_STAGE(PG8_SB(1, 0), b3, voffB);
            PG8_BAR; PG8_WAIT_L(0); PG8_MMA(0, 1, At, B1); PG8_BAR;
            PG8_LDA(At, 1, 1); PG8_STAGE(PG8_SA(1, 0), a3, voffA);
            PG8_BAR; PG8_WAIT_L(0); PG8_MMA(1, 0, At, B0); PG8_BAR; PG8_SCHED;
            PG8_STAGE(PG8_SB(1, 1), b3 + hstep, voffB);
            PG8_WAIT_V(6); PG8_BAR; PG8_MMA(1, 1, At, B1); PG8_BAR;
            }
        }
        if constexpr (ALIGN_EPI) { if (wr == 0) PG8_BAR; }
        if constexpr (!Epi::AFTER_DRAIN) { if constexpr (Epi::KSCALE) E.epi(acc, cur, wr, wc, fr, fq, lds, ui); else E(acc, cur, wr, wc, fr, fq); S.done(cur); }
        if (!has_next) break;
#pragma unroll
        for (int a = 0; a < 2; ++a)
#pragma unroll
            for (int b = 0; b < 2; ++b)
#pragma unroll
                for (int m = 0; m < 4; ++m)
#pragma unroll
                    for (int n = 0; n < 2; ++n) acc[a][b][m][n] = (f32x4){0.f, 0.f, 0.f, 0.f};
        cur = nxt; cA = nA; cB = nB; ++ui;
        if constexpr (ALIGN_EPI) { if (wr == 1) PG8_BAR; }
    }
    PG8_WAIT_V(0);
    if constexpr (!ALIGN_EPI) { if (wr == 0) PG8_BAR; }
    PG8_BAR;
    if constexpr (Epi::AFTER_DRAIN) { E.fused(acc, cur, wr, wc, fr, fq, lds, wid, lane); S.done(cur); }
#undef PG8_SA
#undef PG8_SB
#undef PG8_STAGE
#undef PG8_LDA
#undef PG8_LDB
#undef PG8_MMA
#undef PG8_WAIT_V
#undef PG8_WAIT_L
#undef PG8_BAR
#undef PG8_SCHED
}
}

constexpr int NWAVES = 8;
#ifndef MK_N_LAUNCHES
#define MK_N_LAUNCHES 1
#endif
constexpr int NPH = 7;
constexpr int N_LAUNCHES = MK_N_LAUNCHES;

constexpr size_t MiB = 1u << 20;
constexpr size_t WS_CTL = 0, WS_SSQF = 1 * MiB, WS_SSQA = 1 * MiB + 256 * 1024, CTL_ZERO_BYTES = 2 * MiB;
constexpr size_t WS_ROPE = 2 * MiB;
constexpr size_t WS_WIN = 3 * MiB, WS_WMEM = 8 * MiB, WS_WOUT = 9 * MiB, WS_W1 = 11 * MiB, WS_W2 = 19 * MiB;
constexpr size_t WS_XNMEM = 27 * MiB, WS_MK = 30 * MiB, WS_MV = 31 * MiB;
constexpr size_t WS_X1B = 32 * MiB;
constexpr size_t WS_XN = 128 * MiB, WS_O = 128 * MiB;
constexpr size_t WS_QKV = 224 * MiB;
constexpr size_t WS_H = 128 * MiB;
constexpr size_t WS_END = 512 * MiB;
static_assert(WS_QKV + (size_t)NHEADS * MTOK * 64 * 2 <= WS_END && WS_H + (size_t)MTOK * FF * 2 <= WS_END && WS_X1B + (size_t)MTOK * DM * 2 <= WS_XN && WS_XN + (size_t)MTOK * DM * 2 <= WS_QKV, "d_ws map");

constexpr int RING_BYTES = 131072;
constexpr int LDS_BYTES = 147456, LDS_MISC = LDS_BYTES - 128;
constexpr int CW_BAR = 4096, CW_ARANK = 8192;
constexpr int LDS_BYTES_UNUSED = 0;

#define LAS __attribute__((address_space(3)))
typedef unsigned short bf16;
typedef unsigned v4u __attribute__((ext_vector_type(4)));
typedef float f32x4 __attribute__((ext_vector_type(4)));
#define LDS_WAIT() asm volatile("s_waitcnt lgkmcnt(0)" ::: "memory")
__device__ __forceinline__ unsigned f2bf(float f) { unsigned u = __builtin_bit_cast(unsigned, f); return (u + 0x7fffu + ((u >> 16) & 1u)) >> 16; }
__device__ __forceinline__ unsigned pk2(float lo, float hi) { return f2bf(lo) | (f2bf(hi) << 16); }
__device__ __forceinline__ float bflo(unsigned w) { return __uint_as_float(w << 16); }
__device__ __forceinline__ float bfhi(unsigned w) { return __uint_as_float(w & 0xffff0000u); }
__device__ __forceinline__ float wave_sum(float v) {
#pragma unroll
    for (int o = 1; o < 64; o <<= 1) v += __shfl_xor(v, o);
    return v;
}

struct Frame {
    LAS unsigned char* lds;
    int tid, lane, wave, vcu, G, tm, what; bool nostore;
    float* out; unsigned char* ws;
};
struct Args { const float* in[22]; float* out; unsigned char* ws; int ph_lo, ph_hi; };


namespace att {
typedef short bf16x8 __attribute__((ext_vector_type(8)));
typedef short s16x4 __attribute__((ext_vector_type(4)));
typedef short v4i16_t __attribute__((ext_vector_type(4)));
typedef float f32x16 __attribute__((ext_vector_type(16)));
typedef float f32x4 __attribute__((ext_vector_type(4)));
typedef unsigned u32x4 __attribute__((ext_vector_type(4)));
typedef float f32x2_t __attribute__((ext_vector_type(2))); typedef __bf16 bf16x2_t __attribute__((ext_vector_type(2)));
typedef __attribute__((address_space(3))) unsigned char* lptr;
__device__ __forceinline__ unsigned cvtpk(float lo, float hi) { f32x2_t v = {lo, hi}; bf16x2_t b = __builtin_convertvector(v, bf16x2_t); return __builtin_bit_cast(unsigned, b); }
__device__ __forceinline__ s16x4 vtr(lptr p) { return __builtin_bit_cast(s16x4, __builtin_amdgcn_ds_read_tr16_b64_v4i16((__attribute__((address_space(3))) v4i16_t*)p)); }
__device__ __forceinline__ int creg(int r) { return (r & 3) + 8 * (r >> 2); }
constexpr float NEG = -INFINITY;

constexpr int VDH = 2112, TILE_V = 4096, TILE_BYTES = TILE_V + 2 * VDH;
template <class Spec> __device__ __forceinline__ void load_tile(const Spec& S, int t, u32x4 (&kn)[4], u32x4 (&vn)[4], int lane) {
#pragma unroll
    for (int j = 0; j < 4; ++j) { const int row = 8 * j + (lane >> 3); kn[j] = *(const u32x4*)(S.krow(t, row) + 8 * (lane & 7)); vn[j] = *(const u32x4*)(S.vrow(t, row) + 8 * (lane & 7)); }
}
template <int NJ, class Spec> __device__ __forceinline__ void run_tiles(const Spec& S, const bf16x8 (&qr)[NJ][4], f32x16 (&o)[NJ][2], float (&lsum)[NJ], lptr tb, int lane) {
    const int r32 = lane & 31, hi = lane >> 5;
    const int NT = S.ntiles();
    const int loff = TILE_V + ((lane >> 4) & 1) * 32 + (lane & 3) * 8 + (4 * hi + ((lane & 15) >> 2)) * 64;
    const int wrow = lane >> 3, wc = lane & 7;
    const int vwoff = TILE_V + (wc >> 2) * VDH + wrow * 64 + (wc & 3) * 16;
    u32x4 kn[4], vn[4];
    load_tile(S, 0, kn, vn, lane);
    for (int t = 0; t < NT; ++t) {
#pragma unroll
        for (int j = 0; j < 4; ++j) { const int row = 8 * j + wrow;
            *(__attribute__((address_space(3))) u32x4*)(tb + row * 128 + ((wc ^ ((row >> 1) & 7)) * 16)) = kn[j];
            *(__attribute__((address_space(3))) u32x4*)(tb + vwoff + j * 512) = vn[j]; }
        if (t + 1 < NT) load_tile(S, t + 1, kn, vn, lane);
        bf16x8 kf[4];
#pragma unroll
        for (int d0 = 0; d0 < 4; ++d0) kf[d0] = *(__attribute__((address_space(3))) bf16x8*)(tb + r32 * 128 + (((2 * d0 + hi) ^ ((r32 >> 1) & 7)) * 16));
        bf16x8 vf[2][2];
#pragma unroll
        for (int dh = 0; dh < 2; ++dh)
#pragma unroll
            for (int ks = 0; ks < 2; ++ks) { const s16x4 l0 = vtr(tb + dh * VDH + ks * 1024 + loff), h0 = vtr(tb + dh * VDH + ks * 1024 + 512 + loff);
                vf[dh][ks] = (bf16x8){l0[0], l0[1], l0[2], l0[3], h0[0], h0[1], h0[2], h0[3]}; }
#pragma unroll
        for (int jb = 0; jb < NJ; ++jb) {
            if (NJ > 1 && !S.active(jb, t)) continue;
            f32x16 p = {};
#pragma unroll
            for (int d0 = 0; d0 < 4; ++d0) p = __builtin_amdgcn_mfma_f32_32x32x16_bf16(kf[d0], qr[jb][d0], p, 0, 0, 0);
            S.mask(jb, t, p, lane);
            float sacc = 0.f;
#pragma unroll
            for (int r = 0; r < 16; ++r) { p[r] = __builtin_amdgcn_exp2f(p[r]); sacc += p[r]; }
            lsum[jb] += sacc;
            u32x4 pw0, pw1;
            pw0[0] = cvtpk(p[0], p[1]); pw0[1] = cvtpk(p[2], p[3]); pw0[2] = cvtpk(p[4], p[5]); pw0[3] = cvtpk(p[6], p[7]);
            pw1[0] = cvtpk(p[8], p[9]); pw1[1] = cvtpk(p[10], p[11]); pw1[2] = cvtpk(p[12], p[13]); pw1[3] = cvtpk(p[14], p[15]);
#pragma unroll
            for (int dh = 0; dh < 2; ++dh) {
                o[jb][dh] = __builtin_amdgcn_mfma_f32_32x32x16_bf16(__builtin_bit_cast(bf16x8, pw0), vf[dh][0], o[jb][dh], 0, 0, 0);
                o[jb][dh] = __builtin_amdgcn_mfma_f32_32x32x16_bf16(__builtin_bit_cast(bf16x8, pw1), vf[dh][1], o[jb][dh], 0, 0, 0);
            }
        }
    }
}
__device__ __forceinline__ void load_q(bf16x8 (&qr)[4], const bf16* qrow, int lane) {
    const int hi = lane >> 5;
#pragma unroll
    for (int d0 = 0; d0 < 4; ++d0) qr[d0] = *(const bf16x8*)(qrow + 16 * d0 + 8 * hi);
}
template <class RowFn, class SsqFn> __device__ __forceinline__ void store_out(const f32x16 (&o)[2], float lsum, lptr wbuf, const RowFn& orow, const SsqFn& ssqp, int lane, bool nostore = false) {
    const int r32 = lane & 31, hi = lane >> 5;
    lsum += __shfl_xor(lsum, 32);
    __attribute__((address_space(3))) float* ls = (__attribute__((address_space(3))) float*)(wbuf + 4096);
    if (hi == 0) ls[r32] = lsum;
    __attribute__((address_space(3))) unsigned short* stg = (__attribute__((address_space(3))) unsigned short*)wbuf;
    float rl[16];
#pragma unroll
    for (int g = 0; g < 4; ++g) { const f32x4 lv = *(__attribute__((address_space(3))) f32x4*)(ls + 8 * g + 4 * hi);
#pragma unroll
        for (int j = 0; j < 4; ++j) rl[4 * g + j] = __builtin_amdgcn_rcpf(lv[j]); }
#pragma unroll
    for (int r = 0; r < 16; ++r) { const int q = creg(r) + 4 * hi;
#pragma unroll
        for (int dh = 0; dh < 2; ++dh) stg[q * 64 + dh * 32 + r32] = (unsigned short)f2bf(o[dh][r] * rl[r]); }
#pragma unroll
    for (int i = 0; i < 4; ++i) { const int row = i * 8 + (lane >> 3), ch = lane & 7; const u32x4 v = *(__attribute__((address_space(3))) u32x4*)(stg + row * 64 + ch * 8);
        float ss = 0.f;
#pragma unroll
        for (int e = 0; e < 4; ++e) { const float a = bflo(v[e]), b = bfhi(v[e]); ss += a * a + b * b; }
        ss += __shfl_xor(ss, 1); ss += __shfl_xor(ss, 2); ss += __shfl_xor(ss, 4);
        if (!nostore) { *(u32x4*)(orow(row) + ch * 8) = v; if (ch == 0) unsafeAtomicAdd(ssqp(row), ss); } }
}

struct SpecM { const bf16* K; const bf16* V; int tm;
    __device__ __forceinline__ int ntiles() const { return 8; }
    __device__ __forceinline__ const bf16* krow(int t, int i) const { return K + (32 * (t & tm) + i) * 64; }
    __device__ __forceinline__ const bf16* vrow(int t, int i) const { return V + (32 * (t & tm) + i) * 64; }
    __device__ __forceinline__ bool active(int, int) const { return true; }
    __device__ __forceinline__ void mask(int, int, f32x16&, int) const {}
};
struct SpecB { const bf16* K; const bf16* V;
    int nt, rk0, w0;
    int rlo, dr0;
    int cb;
    const __attribute__((address_space(3))) float* tb;
    int tm;
    __device__ __forceinline__ int ntiles() const { return nt; }
    __device__ __forceinline__ const bf16* krow(int t, int i) const { return K + ((rk0 + (t & tm)) * 64 + w0 + i) * 64; }
    __device__ __forceinline__ const bf16* vrow(int t, int i) const { return V + ((rk0 + (t & tm)) * 64 + w0 + i) * 64; }
    __device__ __forceinline__ bool active(int, int) const { return true; }
    __device__ __forceinline__ void mask(int, int t, f32x16& p, int lane) const {
        const int hi = lane >> 5, rk = rk0 + t; const bool rok = (unsigned)(rk - rlo) < 8u;
        int dr = rk + dr0; dr = dr < 0 ? 0 : (dr > 14 ? 14 : dr);
        const __attribute__((address_space(3))) float* tp = tb + dr * 64 + 4 * hi; const int cbh = rok ? cb + 4 * hi : -4096;
#pragma unroll
        for (int h8 = 0; h8 < 2; ++h8) {
            float bv[8];
#pragma unroll
            for (int r = 0; r < 8; ++r) bv[r] = tp[creg(8 * h8 + r)];
#pragma unroll
            for (int r = 0; r < 8; ++r) { const float sb = p[8 * h8 + r] + bv[r]; p[8 * h8 + r] = ((unsigned)(cbh + creg(8 * h8 + r)) < 16u) ? sb : NEG; }
            asm volatile("" ::: "memory");
        }
    }
};
struct SpecA { const bf16* K; const bf16* V;
    int kp0, qs, tstep, imask, ishift, nt, T, tm;
    __device__ __forceinline__ int ntiles() const { return nt; }
    __device__ __forceinline__ int kpos(int t, int i) const { int p = kp0 + (tstep * (t & tm) + (i & imask)) * qs + (i >> ishift); return p < 0 ? 0 : (p >= T ? T - 1 : p); }
    __device__ __forceinline__ const bf16* krow(int t, int i) const { return K + kpos(t, i) * 64; }
    __device__ __forceinline__ const bf16* vrow(int t, int i) const { return V + kpos(t, i) * 64; }
    __device__ __forceinline__ bool active(int, int) const { return true; }
    __device__ __forceinline__ void mask(int, int t, f32x16& p, int lane) const {
        const int r32 = lane & 31, hi = lane >> 5, cq = r32 >> ishift, iq = r32 & imask;
        const int lo = kp0 + tstep * t * qs, hip = lo + imask * qs + (31 >> ishift);
        if (t == 0 || t == nt - 1 || ishift == 4) {
            const int base = tstep * t - iq + 4 * hi;
            const int b0 = (cq == 0) ? base : -4096, b1 = (cq == (16 >> ishift) ? base : -4096);
#pragma unroll
            for (int r = 0; r < 16; ++r) { if ((unsigned)((r < 8 ? b0 : b1) + (creg(r) & imask)) > 128u) p[r] = NEG; } }
        if (lo < 0 || hip >= T) {
            const int kb = lo + 4 * hi * qs;
#pragma unroll
            for (int r = 0; r < 16; ++r) { const int kp = kb + (creg(r) & imask) * qs + (creg(r) >> ishift); if ((unsigned)kp >= (unsigned)T) p[r] = NEG; } }
    }
};
}
template <class CM, class KS>
__device__ __forceinline__ void p0_transpose_item(const float* W, int K, int N, bf16* WT, LAS float* scr, int item, int lane, CM cm, KS ks) {
    const int nblk = N / 32, kb = item / nblk, nb = item % nblk, k0 = 64 * kb, n0 = 32 * nb;
    const int sc = cm(n0 + (lane & 31));
#pragma unroll 8
    for (int i = 0; i < 32; ++i) { const int kk = 2 * i + (lane >> 5); scr[kk * 33 + (lane & 31)] = W[(size_t)(k0 + kk) * N + sc] * ks(k0 + kk); }
    LDS_WAIT(); asm volatile("" ::: "memory");
    const int c = lane & 7;
#pragma unroll
    for (int j = 0; j < 4; ++j) { const int n = (lane >> 3) + 8 * j; const LAS float* s = scr + (8 * c) * 33 + n;
        v4u o; o.x = pk2(s[0 * 33], s[1 * 33]); o.y = pk2(s[2 * 33], s[3 * 33]); o.z = pk2(s[4 * 33], s[5 * 33]); o.w = pk2(s[6 * 33], s[7 * 33]);
        *(v4u*)(WT + (size_t)(n0 + n) * K + k0 + 8 * c) = o; }
    LDS_WAIT(); asm volatile("" ::: "memory");
}
struct CMapHead { int nrope;
    __device__ __forceinline__ int operator()(int c) const { const int pn = c >> 8, bj = (c >> 7) & 1, hh = (c >> 5) & 3, p5 = c & 31, hidx = 4 * pn + hh; int p = 32 * bj + p5;
        if (hidx < nrope && p < 16) p = (p & 3) + 8 * ((p >> 2) & 1) + 4 * (p >> 3); return 64 * hidx + p; } };
struct CMapId { __device__ __forceinline__ int operator()(int c) const { return c; } };
struct KSOne { __device__ __forceinline__ float operator()(int) const { return 1.f; } };
struct KSVec { const float* g; __device__ __forceinline__ float operator()(int k) const { return g[k]; } };
struct KSOut { const float *a, *b, *m; __device__ __forceinline__ float operator()(int k) const { return k < 384 ? a[k] : (k < 768 ? b[k - 384] : m[k - 768]); } };

__device__ __forceinline__ void rms_row_to_bf16(const float* xrow, const float* g, bf16* orow, int lane) {
    const f32x4* xr = (const f32x4*)xrow + lane; const f32x4* gr = (const f32x4*)g + lane;
    f32x4 v[4]; float s = 0.f;
#pragma unroll
    for (int j = 0; j < 4; ++j) { v[j] = xr[64 * j]; s += (v[j].x * v[j].x + v[j].y * v[j].y) + (v[j].z * v[j].z + v[j].w * v[j].w); }
    const float rstd = rsqrtf(wave_sum(s) * (1.f / DM) + RMS_EPS);
    unsigned long long* o8 = (unsigned long long*)orow + lane;
#pragma unroll
    for (int j = 0; j < 4; ++j) { const f32x4 gg = gr[64 * j]; o8[64 * j] = (unsigned long long)pk2(v[j].x * rstd * gg.x, v[j].y * rstd * gg.y) | ((unsigned long long)pk2(v[j].z * rstd * gg.z, v[j].w * rstd * gg.w) << 32); }
}
__device__ __forceinline__ void p0_prologue(Frame& F, const Args& A) {
    LAS float* scr = (LAS float*)(F.lds + F.wave * 16384);
    const int gw = F.vcu * NWAVES + F.wave, NGW = F.G * NWAVES;
    unsigned char* ws = F.ws;
    constexpr int I_IN = (DM / 64) * (NQKV / 32), I_MEM = (DM / 64) * (512 / 32), I_OUT = (DM / 64) * (DM / 32), I_1 = (DM / 64) * (FF / 32), I_2 = (FF / 64) * (DM / 32);
    constexpr int NITEMS = I_IN + I_MEM + I_OUT + I_1 + I_2;
    for (int it = gw; it < NITEMS; it += NGW) {
        int r = it;
        if (r < I_IN) { p0_transpose_item(A.in[5], DM, NQKV, (bf16*)(ws + WS_WIN), scr, r, F.lane, CMapHead{12}, KSOne{}); continue; } r -= I_IN;
        if (r < I_MEM) { p0_transpose_item(A.in[12], DM, 512, (bf16*)(ws + WS_WMEM), scr, r, F.lane, CMapHead{0}, KSOne{}); continue; } r -= I_MEM;
        if (r < I_OUT) { p0_transpose_item(A.in[18], DM, DM, (bf16*)(ws + WS_WOUT), scr, r, F.lane, CMapId{}, KSOut{A.in[15], A.in[16], A.in[17]}); continue; } r -= I_OUT;
        if (r < I_1) { p0_transpose_item(A.in[20], DM, FF, (bf16*)(ws + WS_W1), scr, r, F.lane, CMapId{}, KSVec{A.in[19]}); continue; } r -= I_1;
        p0_transpose_item(A.in[21], FF, DM, (bf16*)(ws + WS_W2), scr, r, F.lane, CMapId{}, KSOne{});
    }
    for (int m = gw; m < MTOK + MMEM; m += NGW) {
        if (m < MTOK) { const float* xrow = m < TP ? A.in[0] + (size_t)m * DM : A.in[1] + (size_t)(m - TP) * DM; rms_row_to_bf16(xrow, A.in[4], (bf16*)(ws + WS_XN) + (size_t)m * DM, F.lane); }
        else { const int r = m - MTOK; const float* xrow = r < NMEM ? A.in[2] + (size_t)r * DM : A.in[3] + (size_t)(r - NMEM) * DM; rms_row_to_bf16(xrow, A.in[11], (bf16*)(ws + WS_XNMEM) + (size_t)r * DM, F.lane); }
    }
    float* rc = (float*)(ws + WS_ROPE); float* rs = rc + TP * 8;
    for (int i = (F.vcu * NWAVES * 64) + F.tid; i < TP * 8; i += F.G * NWAVES * 64) {
        const int pos = i >> 3, fi = i & 7;
        const float inv = exp2f(-(float)fi * 0.125f * 18.931568569324174f);
        const float ang = (float)pos * inv;
        const double rev = (double)ang * 0.15915494309189535; const float fr = (float)(rev - __builtin_rint(rev));
        rc[i] = __builtin_amdgcn_cosf(fr); rs[i] = __builtin_amdgcn_sinf(fr);
    }
}

template <int NR, class KF>
__device__ __forceinline__ void attn_item(const bf16* qrow, const bf16* Kb, const bf16* Vb, const KF& kf, bf16* orow, int lane) {
    float q[64];
#pragma unroll
    for (int c = 0; c < 8; ++c) { const v4u w = *(const v4u*)(qrow + 8 * c);
#pragma unroll
        for (int e = 0; e < 4; ++e) { q[8 * c + 2 * e] = bflo(w[e]); q[8 * c + 2 * e + 1] = bfhi(w[e]); } }
    float p[NR]; float lsum = 0.f;
#pragma unroll
    for (int r = 0; r < NR; ++r) {
        long ridx; float bias; const bool ok = kf(64 * r + lane, ridx, bias);
        const bf16* krow = Kb + ridx * 64; float s = 0.f;
#pragma unroll
        for (int c = 0; c < 8; ++c) { const v4u w = *(const v4u*)(krow + 8 * c);
#pragma unroll
            for (int e = 0; e < 4; ++e) s += q[8 * c + 2 * e] * bflo(w[e]) + q[8 * c + 2 * e + 1] * bfhi(w[e]); }
        p[r] = ok ? exp2f(s + bias) : 0.f; lsum += p[r];
    }
    lsum = wave_sum(lsum);
    float o = 0.f;
#pragma unroll
    for (int r = 0; r < NR; ++r) {
#pragma unroll 8
        for (int l = 0; l < 64; ++l) {
            long ridx; float bias; (void)kf(64 * r + l, ridx, bias);
            const float pj = __int_as_float(__builtin_amdgcn_readlane(__float_as_int(p[r]), l));
            o += pj * __uint_as_float((unsigned)Vb[ridx * 64 + lane] << 16);
        }
    }
    orow[lane] = (bf16)f2bf(o / lsum);
}
struct KeyA { long sb; int pos, T;
    __device__ __forceinline__ bool operator()(int j, long& ridx, float& bias) const { const int pat = j >= 258 ? 2 : (j >= 129 ? 1 : 0), idx = j - 129 * pat, dil = 1 << (2 * pat), kp = pos + (idx - 64) * dil;
        const bool ok = j < 387 && kp >= 0 && kp < T; ridx = sb + (ok ? kp : pos); bias = 0.f; return ok; } };
struct KeyB { long sb; int r, c, rs, cs; const float* rpb;
    __device__ __forceinline__ bool operator()(int j, long& ridx, float& bias) const { const int kr = (j >> 4) & 7, kc = j & 15; ridx = sb + (rs + kr) * 64 + cs + kc;
        bias = rpb[(rs + kr - r + 7) * 31 + (cs + kc - c + 15)] * LOG2E; return true; } };
struct KeyM { long b0;
    __device__ __forceinline__ bool operator()(int j, long& ridx, float& bias) const { ridx = b0 + (j & 255); bias = 0.f; return true; } };

__device__ __forceinline__ void attn_simple_phase(Frame& F, const Args& A) {
    const int gw = F.vcu * NWAVES + F.wave, NGW = F.G * NWAVES;
    const bf16* QKV = (const bf16*)(F.ws + WS_QKV); bf16* O = (bf16*)(F.ws + WS_O);
    const bf16* MK = (const bf16*)(F.ws + WS_MK); const bf16* MV = (const bf16*)(F.ws + WS_MV);
    for (int it = gw; it < MTOK * 16; it += NGW) {
        const int hh = it / MTOK, row = it - hh * MTOK;
        const int sbat = row < TP ? 0 : 1 + ((row - TP) >> 13);
        const long sb = row < TP ? 0 : TP + (long)(sbat - 1) * TS; const int T = row < TP ? TP : TS, pos = (int)(row - sb);
        if (hh < 6) {
            if (ATT_A_MFMA) continue;
            const int h = hh;
            attn_item<7>(QKV + ((size_t)(0 + h) * MTOK + row) * 64, QKV + (size_t)(6 + h) * MTOK * 64, QKV + (size_t)(12 + h) * MTOK * 64, KeyA{sb, pos, T}, O + (size_t)row * DM + h * 64, F.lane);
        } else if (hh < 12) {
            if (ATT_B_MFMA) continue;
            const int h = hh - 6, rows = T / 64, r = pos >> 6, c = pos & 63;
            int rs = r - 4; rs = rs < 0 ? 0 : (rs > rows - 8 ? rows - 8 : rs); int cs = c - 8; cs = cs < 0 ? 0 : (cs > 48 ? 48 : cs);
            attn_item<2>(QKV + ((size_t)(18 + h) * MTOK + row) * 64, QKV + (size_t)(24 + h) * MTOK * 64, QKV + (size_t)(30 + h) * MTOK * 64, KeyB{sb, r, c, rs, cs, A.in[10] + h * 15 * 31}, O + (size_t)row * DM + 384 + h * 64, F.lane);
        } else {
            if (ATT_M_MFMA) continue;
            const int h = hh - 12;
            attn_item<4>(QKV + ((size_t)(36 + h) * MTOK + row) * 64, MK, MV, KeyM{(long)(sbat * 4 + h) * NMEM}, O + (size_t)row * DM + 768 + h * 64, F.lane);
        }
    }
}
__device__ __forceinline__ void onorm_phase(Frame& F) {
    const int gw = F.vcu * NWAVES + F.wave, NGW = F.G * NWAVES;
    bf16* O = (bf16*)(F.ws + WS_O);
    for (int m = gw; m < MTOK; m += NGW) {
        v4u* p = (v4u*)(O + (size_t)m * DM) + 2 * F.lane; v4u w0 = p[0], w1 = p[1];
        float v[16];
#pragma unroll
        for (int e = 0; e < 4; ++e) { v[2 * e] = bflo(w0[e]); v[2 * e + 1] = bfhi(w0[e]); v[8 + 2 * e] = bflo(w1[e]); v[8 + 2 * e + 1] = bfhi(w1[e]); }
        float ss = 0.f;
#pragma unroll
        for (int e = 0; e < 16; ++e) ss += v[e] * v[e];
        const int grp = F.lane < 24 ? 0 : (F.lane < 48 ? 1 : 2);
        const float sa = wave_sum(grp == 0 ? ss : 0.f), sb = wave_sum(grp == 1 ? ss : 0.f), sm = wave_sum(grp == 2 ? ss : 0.f);
        const float r = grp == 0 ? rsqrtf(sa * (1.f / 384.f) + RMS_EPS) : (grp == 1 ? rsqrtf(sb * (1.f / 384.f) + RMS_EPS) : rsqrtf(sm * (1.f / 256.f) + RMS_EPS));
#pragma unroll
        for (int e = 0; e < 4; ++e) { w0[e] = pk2(v[2 * e] * r, v[2 * e + 1] * r); w1[e] = pk2(v[8 + 2 * e] * r, v[8 + 2 * e + 1] * r); }
        p[0] = w0; p[1] = w1;
    }
}

#define XB_TMO      128
#define XB_XCNT(j)  (256  + 64 * (j))
#define XB_XSUB(j)  (1280 + 64 * (j))
#define XB_XGEN(j)  (2304 + 64 * (j))
#define XB_TOP      3328
#define XB_TOPGEN   3392
#define XCD_BAR_WORDS 3456
#define XB_SPIN_CAP (1u << 18)

__device__ __forceinline__ unsigned xb_ld(unsigned* p)              { return __hip_atomic_load(p, __ATOMIC_RELAXED, __HIP_MEMORY_SCOPE_AGENT); }
__device__ __forceinline__ unsigned xb_add(unsigned* p, unsigned v) { return __hip_atomic_fetch_add(p, v, __ATOMIC_RELAXED, __HIP_MEMORY_SCOPE_AGENT); }
__device__ __forceinline__ unsigned xb_xcc_id() { return (unsigned)__builtin_amdgcn_s_getreg((3 << 11) | 20) & 0xFu; }
#define XB_SPIN(cond, bar) do { unsigned _sp = 0; while (cond) { __builtin_amdgcn_s_sleep(1); \
    if ((++_sp & 255u) == 0u) { if (xb_ld(&(bar)[XB_TMO])) break; if (_sp > XB_SPIN_CAP) { atomicAdd(&(bar)[XB_TMO], 1u); break; } } } } while (0)

struct XcdBarrier {
    unsigned* bar; unsigned x;
    volatile LAS unsigned* st;
};

__device__ __forceinline__ XcdBarrier xcd_barrier_post(unsigned* bar, volatile LAS unsigned* st) {
    XcdBarrier b; b.bar = bar; b.x = xb_xcc_id(); b.st = st;
    if (threadIdx.x == 0) (void)xb_add(&bar[XB_XCNT(b.x)], 1u);
    return b;
}
__device__ __forceinline__ void xcd_barrier_complete(unsigned* bar, unsigned x, unsigned& nloc, unsigned& nx) {
    const unsigned G = gridDim.x * gridDim.y * gridDim.z;
    unsigned sum, cnt, mine, sp = 0u;
    for (;;) {
        sum = 0u; cnt = 0u; mine = 0u;
#pragma unroll
        for (unsigned j = 0; j < 16; ++j) { const unsigned c = xb_ld(&bar[XB_XCNT(j)]); sum += c; cnt += (c > 0u) ? 1u : 0u; mine = (j == x) ? c : mine; }
        if (sum == G) break;
        __builtin_amdgcn_s_sleep(1);
        if ((++sp & 255u) == 0u) { if (xb_ld(&bar[XB_TMO])) break; if (sp > XB_SPIN_CAP) { atomicAdd(&bar[XB_TMO], 1u); break; } }
    }
    nloc = mine > 0u ? mine : 1u; nx = cnt > 0u ? cnt : 1u;
}

__device__ __forceinline__ void xcd_barrier(const XcdBarrier& b) {
    asm volatile("s_waitcnt vmcnt(0)" ::: "memory");
    __syncthreads();
    if (threadIdx.x == 0) {
        unsigned* bar = b.bar;
        __builtin_amdgcn_s_waitcnt(0);
        unsigned nloc = b.st[0], nx = b.st[1];
        if (nloc == 0u) { xcd_barrier_complete(bar, b.x, nloc, nx); b.st[0] = nloc; b.st[1] = nx; }
        const unsigned old = xb_add(&bar[XB_XSUB(b.x)], 1u);
        const unsigned gen = old / nloc;
        if (old + 1u == (gen + 1u) * nloc) {
            __builtin_amdgcn_fence(__ATOMIC_RELEASE, "agent");
            asm volatile("s_waitcnt vmcnt(0)" ::: "memory");
            const unsigned og = xb_add(&bar[XB_TOP], 1u);
            const unsigned tg = og / nx;
            if (og + 1u == (tg + 1u) * nx) xb_add(&bar[XB_TOPGEN], 1u);
            else XB_SPIN(xb_ld(&bar[XB_TOPGEN]) == tg, bar);
            __builtin_amdgcn_fence(__ATOMIC_ACQUIRE, "agent");
            xb_add(&bar[XB_XGEN(b.x)], 1u);
            asm volatile("s_waitcnt vmcnt(0)" ::: "memory");
        } else {
            XB_SPIN(xb_ld(&bar[XB_XGEN(b.x)]) == gen, bar);
            __builtin_amdgcn_fence(__ATOMIC_ACQUIRE, "agent");
            asm volatile("s_waitcnt vmcnt(0)" ::: "memory");
        }
    }
    __syncthreads();
}

constexpr int N_AUNITS = (MTOK / 256) * 6;
constexpr int N_BJOBS = (MTOK / 128) * 6 * 4;
constexpr int N_MJOBS = (MTOK / 32) * 4;
constexpr int LA_WSTRIDE = 8320, LA_ACC = 69632, LA_L = LA_ACC + 65536;
constexpr int LW_STRIDE = 12544, LW_TBL = 8448;

struct SeqInfo { long sb; int T; int bat; };
__device__ __forceinline__ SeqInfo seq_of(int row) { SeqInfo s; if (row < TP) { s.sb = 0; s.T = TP; s.bat = 0; } else { const int b = (row - TP) >> 13; s.sb = TP + (long)b * TS; s.T = TS; s.bat = 1 + b; } return s; }

__device__ __forceinline__ void m_job(Frame& F, int jm) {
    const int h = jm / (MTOK / 32), row0 = (jm - h * (MTOK / 32)) * 32; const SeqInfo si = seq_of(row0);
    const bf16* QKV = (const bf16*)(F.ws + WS_QKV);
    const int r32 = F.lane & 31;
    att::bf16x8 qr[1][4]; att::load_q(qr[0], QKV + ((size_t)(36 + h) * MTOK + row0 + r32) * 64, F.lane);
    att::SpecM S{(const bf16*)(F.ws + WS_MK) + (size_t)(si.bat * 4 + h) * NMEM * 64, (const bf16*)(F.ws + WS_MV) + (size_t)(si.bat * 4 + h) * NMEM * 64, F.tm};
    att::f32x16 o[1][2] = {}; float lsum[1] = {0.f};
    att::lptr wb = (att::lptr)(F.lds + F.wave * LW_STRIDE);
    att::run_tiles<1>(S, qr, o, lsum, wb, F.lane);
    bf16* O = (bf16*)(F.ws + WS_O) + (size_t)row0 * DM + 768 + 64 * h; float* SQ = (float*)(F.ws + WS_SSQA) + (size_t)row0 * 4 + 2;
    att::store_out(o[0], lsum[0], wb, [=](int q) { return O + (size_t)q * DM; }, [=](int q) { return SQ + (size_t)q * 4; }, F.lane, F.nostore);
}
__device__ __forceinline__ void b_job(Frame& F, const Args& A, int jb) {
    const int g = jb & 3, rest = jb >> 2, h = rest / (MTOK / 128), rp = rest - h * (MTOK / 128);
    int r0, rows; long sb;
    if (rp < TP / 128) { r0 = 2 * rp; rows = TP / 64; sb = 0; } else { const int q = rp - TP / 128, b = q / (TS / 128); r0 = 2 * (q - b * (TS / 128)); rows = TS / 64; sb = TP + (long)b * TS; }
    const int r32 = F.lane & 31;
    const int rq = r0 + (r32 >> 4), c = 16 * g + (r32 & 15);
    int rlo = rq - 4; rlo = rlo < 0 ? 0 : (rlo > rows - 8 ? rows - 8 : rlo);
    int cs = c - 8; cs = cs < 0 ? 0 : (cs > 48 ? 48 : cs);
    int rk0 = r0 - 4; rk0 = rk0 < 0 ? 0 : (rk0 > rows - 8 ? rows - 8 : rk0);
    int rk1 = r0 + 1 - 4; rk1 = rk1 < 0 ? 0 : (rk1 > rows - 8 ? rows - 8 : rk1);
    const int w0 = g == 0 ? 0 : (g == 1 ? 8 : (g == 2 ? 24 : 32));
    att::lptr wb = (att::lptr)(F.lds + F.wave * LW_STRIDE);
    __attribute__((address_space(3))) float* tbl = (__attribute__((address_space(3))) float*)(wb + LW_TBL);
    const float* rpb = A.in[10] + h * 465;
    if (F.lane < 31) {
#pragma unroll 5
        for (int dr = 0; dr < 15; ++dr) tbl[dr * 64 + 16 + F.lane] = rpb[dr * 31 + F.lane] * LOG2E; }
    asm volatile("" ::: "memory");
    const bf16* QKV = (const bf16*)(F.ws + WS_QKV);
    att::bf16x8 qr[1][4]; att::load_q(qr[0], QKV + ((size_t)(18 + h) * MTOK + sb + rq * 64 + c) * 64, F.lane);
    att::SpecB S{QKV + ((size_t)(24 + h) * MTOK + sb) * 64, QKV + ((size_t)(30 + h) * MTOK + sb) * 64, rk1 + 8 - rk0, rk0, w0, rlo, 7 - rq, w0 - cs, tbl + (31 + w0 - c), F.tm};
    att::f32x16 o[1][2] = {}; float lsum[1] = {0.f};
    att::run_tiles<1>(S, qr, o, lsum, wb, F.lane);
    bf16* O = (bf16*)(F.ws + WS_O) + (size_t)(sb + r0 * 64 + 16 * g) * DM + 384 + 64 * h; float* SQ = (float*)(F.ws + WS_SSQA) + (size_t)(sb + r0 * 64 + 16 * g) * 4 + 1;
    att::store_out(o[0], lsum[0], wb, [=](int q) { return O + (size_t)((q >> 4) * 64 + (q & 15)) * DM; }, [=](int q) { return SQ + (size_t)((q >> 4) * 64 + (q & 15)) * 4; }, F.lane, F.nostore);
}
template <class Spec, class QLoc> __device__ __forceinline__ void a_job(Frame& F, const Spec& S, const bf16* qrow, const QLoc& qloc) {
    att::bf16x8 qr[1][4]; att::load_q(qr[0], qrow, F.lane);
    att::f32x16 o1[1][2] = {}; float lsum1[1] = {0.f};
    att::run_tiles<1>(S, qr, o1, lsum1, (att::lptr)(F.lds + F.wave * LA_WSTRIDE), F.lane);
    const att::f32x16 (&o)[2] = o1[0]; const float lsum = lsum1[0];
    const int r32 = F.lane & 31, hi = F.lane >> 5;
    __attribute__((address_space(3))) float* acc = (__attribute__((address_space(3))) float*)(F.lds + LA_ACC);
    __attribute__((address_space(3))) float* ls = (__attribute__((address_space(3))) float*)(F.lds + LA_L);
#pragma unroll
    for (int r = 0; r < 16; ++r) { const int ql = qloc(att::creg(r) + 4 * hi);
#pragma unroll
        for (int dh = 0; dh < 2; ++dh) (void)__hip_atomic_fetch_add(acc + ql * 64 + dh * 32 + r32, o[dh][r], __ATOMIC_RELAXED, __HIP_MEMORY_SCOPE_WORKGROUP); }
    (void)__hip_atomic_fetch_add(ls + qloc(r32), lsum, __ATOMIC_RELAXED, __HIP_MEMORY_SCOPE_WORKGROUP);
}
__device__ __forceinline__ void a_unit(Frame& F, int ua) {
    const int h = ua / (MTOK / 256), row0 = (ua - h * (MTOK / 256)) * 256; const SeqInfo si = seq_of(row0);
    const int pq0 = (int)(row0 - si.sb), w = F.wave, r32 = F.lane & 31;
    { __attribute__((address_space(3))) att::f32x4* z = (__attribute__((address_space(3))) att::f32x4*)(F.lds + LA_ACC);
#pragma unroll
      for (int i = 0; i < 8; ++i) z[i * 512 + F.tid] = (att::f32x4){0.f, 0.f, 0.f, 0.f};
      if (F.tid < 64) z[4096 + F.tid] = (att::f32x4){0.f, 0.f, 0.f, 0.f}; }
    __syncthreads();
    const bf16* QKV = (const bf16*)(F.ws + WS_QKV);
    const bf16* Q = QKV + ((size_t)(0 + h) * MTOK + si.sb) * 64; const bf16* K = QKV + ((size_t)(6 + h) * MTOK + si.sb) * 64; const bf16* V = QKV + ((size_t)(12 + h) * MTOK + si.sb) * 64;
    for (int pat = 0; pat < 3; ++pat) {
        const int qs = pat == 0 ? 1 : (pat == 1 ? 4 : 16), qb = pat == 0 ? 32 * w : (pat == 1 ? 128 * (w & 1) + (w >> 1) : 2 * w);
        const int imask = pat == 2 ? 15 : 31, ishift = pat == 2 ? 4 : 5;
        att::SpecA S{K, V, pq0 + qb - 64 * qs, qs, pat == 2 ? 16 : 32, imask, ishift, pat == 2 ? 9 : 5, si.T, F.tm};
        a_job(F, S, Q + (size_t)(pq0 + qb + (r32 & imask) * qs + (r32 >> ishift)) * 64, [=](int q) { return qb + (q & imask) * qs + (q >> ishift); });
    }
    __syncthreads();
    {
        const int q = 32 * w + (F.lane >> 1), dh = F.lane & 1;
        const __attribute__((address_space(3))) att::f32x4* a = (const __attribute__((address_space(3))) att::f32x4*)(F.lds + LA_ACC + (q * 64 + dh * 32) * 4);
        const float rl = __builtin_amdgcn_rcpf(((const __attribute__((address_space(3))) float*)(F.lds + LA_L))[q]);
        bf16* op = (bf16*)(F.ws + WS_O) + (size_t)(row0 + q) * DM + 64 * h + 32 * dh;
        float ss = 0.f;
#pragma unroll
        for (int i = 0; i < 4; ++i) { const att::f32x4 x = a[2 * i], y = a[2 * i + 1]; v4u o; o.x = pk2(x[0] * rl, x[1] * rl); o.y = pk2(x[2] * rl, x[3] * rl); o.z = pk2(y[0] * rl, y[1] * rl); o.w = pk2(y[2] * rl, y[3] * rl);
#pragma unroll
            for (int e = 0; e < 4; ++e) { const float u0 = bflo(o[e]), u1 = bfhi(o[e]); ss += u0 * u0 + u1 * u1; }
            if (!F.nostore) *(v4u*)(op + 8 * i) = o; }
        ss += __shfl_xor(ss, 1);
        if (!F.nostore && dh == 0) unsafeAtomicAdd((float*)(F.ws + WS_SSQA) + (size_t)(row0 + q) * 4 + 0, ss);
    }
    __syncthreads();
}
__device__ __forceinline__ void attn_phase(Frame& F, const Args& A) {
    volatile LAS unsigned* ast = (volatile LAS unsigned*)(F.lds + LDS_MISC + 16);
    if (F.tid == 0) {
        unsigned* barw = (unsigned*)(F.ws + WS_CTL) + CW_BAR; const unsigned myx = xb_xcc_id();
        bool ok = (F.G == 256); unsigned chunk = 0, npop = 0;
        for (unsigned j = 0; j < 16; ++j) { const unsigned cnt = xb_ld(&barw[XB_XCNT(j)]); if (cnt) { ++npop; if (cnt != 32u) ok = false; if (j < myx) ++chunk; } }
        if (npop != 8u) ok = false;
        unsigned rank = 0;
        if (ok) rank = xb_add((unsigned*)(F.ws + WS_CTL) + CW_ARANK + 64 * myx, 1u);
        ast[0] = ok ? 1u : 0u; ast[1] = chunk; ast[2] = rank;
    }
    __syncthreads();
    const bool blocked = ast[0] != 0u;
    const int xcd = (int)ast[1], ci = (int)ast[2];
#if ATT_A_MFMA
    if (!(F.what & 1)) {} else if (blocked) { for (int k = ci; k < N_AUNITS / 8; k += 32) a_unit(F, xcd * (N_AUNITS / 8) + k); }
    else { for (int ua = blockIdx.x; ua < N_AUNITS; ua += F.G) a_unit(F, ua); }
#endif
    __syncthreads();
    if (blocked) {
        const int widx = ci * 8 + F.wave;
        for (int k = 0; k < 9; ++k) {
            int l;
            if (k < 6) l = k * 256 + widx; else { if (ci < 16) break; l = 1536 + (k - 6) * 128 + (widx - 128); }
            if (l < N_BJOBS / 8) {
#if ATT_B_MFMA
                if (F.what & 2) b_job(F, A, xcd * (N_BJOBS / 8) + l);
#endif
            } else {
#if ATT_M_MFMA
                if (F.what & 4) m_job(F, xcd * (N_MJOBS / 8) + (l - N_BJOBS / 8));
#endif
            }
        }
    } else {
        const int NJ = N_BJOBS + N_MJOBS;
        for (int j = blockIdx.x * 8 + F.wave; j < NJ; j += F.G * 8) {
            if (j < N_BJOBS) {
#if ATT_B_MFMA
                b_job(F, A, j);
#endif
            } else {
#if ATT_M_MFMA
                m_job(F, j - N_BJOBS);
#endif
            }
        }
    }
    __syncthreads();
}
__global__ void __launch_bounds__(NWAVES * 64, 2) skel_fwd(Args args) {
    extern __shared__ __attribute__((aligned(16))) unsigned char lds[];
    cg::grid_group grid = cg::this_grid();
    Frame F;
    F.lds = (LAS unsigned char*)lds;
    F.tid = threadIdx.x; F.lane = F.tid & 63; F.wave = __builtin_amdgcn_readfirstlane(F.tid >> 6);
    F.G = gridDim.x; { const int bx = blockIdx.x; F.vcu = (F.G % 8 == 0) ? (bx % 8) * (F.G / 8) + bx / 8 : bx; }
    F.out = args.out; F.ws = args.ws; F.tm = -1; F.nostore = false; F.what = 7;
    unsigned char* ws = args.ws;
    const int lo = args.ph_lo, hi = args.ph_hi;
    volatile LAS unsigned* bst = (volatile LAS unsigned*)(F.lds + LDS_MISC);
    if (F.tid < 2) bst[F.tid] = 0u;
    __syncthreads();
    XcdBarrier bar = xcd_barrier_post((unsigned*)(ws + WS_CTL) + CW_BAR, bst);
    if (lo < 0) grid.sync();
#define IN(k) (lo <= (k) && (k) < hi)
#define BOTH(k) (IN(k) && IN((k) + 1))
#define GRID_BAR() xcd_barrier(bar)

    if (IN(0)) { p0_prologue(F, args); if (BOTH(0)) GRID_BAR(); }

    if (IN(1)) {
        {
            pg8::Gemm g{(const pg8::bf16_t*)(ws + WS_XN), (const pg8::bf16_t*)(ws + WS_WIN), MTOK, NQKV, DM}; pg8::StaticOrder S; S.init(MTOK, NQKV, F.G, (int)blockIdx.x);
            pg8::EpiQKV E{(pg8::bf16_t*)(ws + WS_QKV), args.in[6], args.in[7], args.in[8], args.in[9], args.in[13], (const float*)(ws + WS_ROPE), (const float*)(ws + WS_ROPE) + TP * 8};
            pg8::gemm_phase<pg8::EpiQKV, pg8::StaticOrder, true, true>(F.lds, g, S, E);
        }
        {
            pg8::Gemm g{(const pg8::bf16_t*)(ws + WS_XNMEM), (const pg8::bf16_t*)(ws + WS_WMEM), MMEM, 512, DM}; pg8::StaticOrder S; S.init(MMEM, 512, F.G, F.G - 1 - (int)blockIdx.x);
            pg8::EpiMemKV E{(pg8::bf16_t*)(ws + WS_MK), (pg8::bf16_t*)(ws + WS_MV), args.in[14]};
            pg8::gemm_phase<pg8::EpiMemKV, pg8::StaticOrder, true, true>(F.lds, g, S, E);
        }
        if (BOTH(1)) GRID_BAR();
    }

    if (IN(2)) { attn_phase(F, args); if (PROBE_MODE) { F.nostore = true; F.tm = (PROBE_MODE & 2) ? 0 : -1; F.what = PROBE_WHAT; attn_phase(F, args); F.nostore = false; F.tm = -1; F.what = 7; } if (!(ATT_A_MFMA && ATT_B_MFMA && ATT_M_MFMA)) attn_simple_phase(F, args); if (BOTH(2)) GRID_BAR(); }


    if (IN(4)) {
        pg8::Gemm g{(const pg8::bf16_t*)(ws + WS_O), (const pg8::bf16_t*)(ws + WS_WOUT), MTOK, DM, DM}; pg8::StaticOrder S; S.init(MTOK, DM, F.G, (int)blockIdx.x);
        pg8::EpiX1 E{args.in[0], args.in[1], F.out, (pg8::bf16_t*)(ws + WS_X1B), (float*)(ws + WS_SSQF), (const float*)(ws + WS_SSQA)};
        pg8::gemm_phase<pg8::EpiX1, pg8::StaticOrder, true, true>(F.lds, g, S, E);
        if (BOTH(4)) GRID_BAR();
    }

    if (IN(5)) {
        pg8::Gemm g{(const pg8::bf16_t*)(ws + WS_X1B), (const pg8::bf16_t*)(ws + WS_W1), MTOK, FF, DM}; pg8::StaticOrder S; S.init(MTOK, FF, F.G, (int)blockIdx.x);
        pg8::EpiH E{(pg8::bf16_t*)(ws + WS_H), (const float*)(ws + WS_SSQF)};
        pg8::gemm_phase<pg8::EpiH, pg8::StaticOrder, true, true>(F.lds, g, S, E);
        if (BOTH(5)) GRID_BAR();
    }

    if (IN(6)) {
        pg8::Gemm g{(const pg8::bf16_t*)(ws + WS_H), (const pg8::bf16_t*)(ws + WS_W2), MTOK, DM, FF}; pg8::StaticOrder S; S.init(MTOK, DM, F.G, (int)blockIdx.x);
        pg8::EpiOut E{F.out};
        pg8::gemm_phase<pg8::EpiOut, pg8::StaticOrder, true, true>(F.lds, g, S, E);
    }
#undef IN
#undef BOTH
}

extern "C" void kernel_launch(void* const* d_in, const int* in_sizes, int n_in, void* d_out, int out_size, void* d_ws, size_t ws_size, hipStream_t stream) {
    static int grid = 0;
    if (grid == 0) {
        if (n_in != 22 || in_sizes[0] != TP * DM || in_sizes[1] != NBS * TS * DM || out_size != MTOK * DM || ws_size < WS_END) {
            fprintf(stderr, "kernel_launch: unexpected shapes / workspace (n_in %d, in0 %d, out %d, ws %zu); nothing launched\n", n_in, n_in > 0 ? in_sizes[0] : -1, out_size, ws_size); grid = -1; return; }
        int dev = 0, cus = 0, per_cu = 0;
        if (hipGetDevice(&dev) != hipSuccess || hipDeviceGetAttribute(&cus, hipDeviceAttributeMultiprocessorCount, dev) != hipSuccess) { grid = -1; return; }
        if (hipFuncSetAttribute((const void*)skel_fwd, hipFuncAttributeMaxDynamicSharedMemorySize, LDS_BYTES) != hipSuccess) { fprintf(stderr, "kernel_launch: hipFuncSetAttribute failed\n"); grid = -1; return; }
        if (hipOccupancyMaxActiveBlocksPerMultiprocessor(&per_cu, (const void*)skel_fwd, NWAVES * 64, LDS_BYTES) != hipSuccess || per_cu < 1) { fprintf(stderr, "kernel_launch: occupancy query says %d\n", per_cu); (void)hipGetLastError(); grid = -1; return; }
        grid = cus * per_cu;
    }
    if (grid < 0) return;
    if (hipMemsetAsync((char*)d_ws + WS_CTL, 0, CTL_ZERO_BYTES, stream) != hipSuccess) return;
    Args a{};
    for (int i = 0; i < 22; ++i) a.in[i] = (const float*)d_in[i];
    a.out = (float*)d_out; a.ws = (unsigned char*)d_ws;
    if (N_LAUNCHES == 1) {
        a.ph_lo = 0; a.ph_hi = NPH;
        void* kargs[] = {&a};
        hipError_t e = hipLaunchCooperativeKernel((const void*)skel_fwd, dim3(grid), dim3(NWAVES * 64), kargs, LDS_BYTES, stream);
        if (e != hipSuccess) fprintf(stderr, "kernel_launch: cooperative launch failed: %s (grid %d)\n", hipGetErrorString(e), grid);
    } else {
        for (int li = 0; li < NPH; ++li) { a.ph_lo = li; a.ph_hi = li + 1; hipLaunchKernelGGL(skel_fwd, dim3(grid), dim3(NWAVES * 64), LDS_BYTES, stream, a); }
    }
}
```

```cpp
#include <hip/hip_runtime.h>
#include <hip/hip_cooperative_groups.h>
#include <cstdio>
#include <cstdint>
namespace cg = cooperative_groups;

constexpr int DM = 1024, TP = 16384, TS = 8192, NBS = 4, MTOK = TP + NBS * TS;
constexpr int NQKV = 2560, NHEADS = 40, FF = 4096, NMEM = 256, NBATCH = 1 + NBS, MMEM = NBATCH * NMEM;
constexpr float RMS_EPS = 1e-6f;
constexpr float LOG2E = 1.4426950408889634f;
constexpr float QSCALE = 0.125f * LOG2E;
#ifndef ATT_A_MFMA
#define ATT_A_MFMA 1
#endif
#ifndef ATT_B_MFMA
#define ATT_B_MFMA 1
#endif
#ifndef ATT_M_MFMA
#define ATT_M_MFMA 1
#endif
#ifndef PROBE_MODE
#define PROBE_MODE 0
#endif
#ifndef PROBE_WHAT
#define PROBE_WHAT 4
#endif
#ifndef ATT_V2
#define ATT_V2 1
#endif
namespace pg8 {
#define PG8_LAS __attribute__((address_space(3)))
typedef unsigned short bf16_t;
typedef short bf16x8 __attribute__((ext_vector_type(8)));
typedef float f32x4 __attribute__((ext_vector_type(4)));
typedef unsigned u32x4 __attribute__((ext_vector_type(4)));
constexpr int BM = 256, BK = 64, HALF = 128, HTB = HALF * BK * 2  , STAGE_BYTES = 8 * HTB, NXCD = 8, WGM = 8;

__host__ __device__ __forceinline__ int lds_byte(int r, int c) { const int st = (r >> 4) * 2 + (c >> 5), rr = r & 15, cc = c & 31, ob = rr * 64 + cc * 2; return st * 1024 + (ob ^ (((ob >> 9) & 1) << 5)); }
__host__ __device__ __forceinline__ void stage_rc(int b, int& R, int& C) { const int st = b / 1024, sb = b % 1024, swz = sb ^ (((sb >> 9) & 1) << 5); R = (st >> 1) * 16 + swz / 64; C = (st & 1) * 32 + (swz % 64) / 2; }
__host__ __device__ __forceinline__ int perm32(int rho) { const int n = rho >> 4, i = rho & 15; return 8 * (i >> 2) + 4 * n + (i & 3); }

struct Unit { int pm, pn; };
struct Gemm { const bf16_t* A; const bf16_t* Bt; int M, N, K; };

struct StaticOrder {
    int nM, nN, nwg, G, c;
    __host__ __device__ void init(int M, int N, int G_, int c_) { nM = M / BM; nN = N / BM; nwg = nM * nN; G = G_; c = c_; }
    __host__ __device__ bool next(int i, Unit& u) const {
        const long L = (long)i * G + c; if (L >= nwg) return false;
        int wgid = (int)L; { const int q = nwg / NXCD, r = nwg % NXCD, xcd = wgid % NXCD, off = wgid / NXCD; wgid = (xcd < r ? xcd * (q + 1) : r * (q + 1) + (xcd - r) * q) + off; }
        const int nig = WGM * nN, gid = wgid / nig, fm = gid * WGM, gsz = (nM - fm) < WGM ? (nM - fm) : WGM;
        u.pm = fm + ((wgid % nig) % gsz); u.pn = (wgid % nig) / gsz; return true;
    }
    __device__ __forceinline__ void a_ready(const Unit&) const {}
    __device__ __forceinline__ void done(const Unit&) const {}
};

__device__ __forceinline__ unsigned cvt_pk_bf16(float lo, float hi) { unsigned r; asm volatile("v_cvt_pk_bf16_f32 %0, %1, %2" : "=v"(r) : "v"(lo), "v"(hi)); return r; }
typedef float f32x2 __attribute__((ext_vector_type(2)));
__device__ __forceinline__ float sq4(const f32x4 v) { return (v[0] * v[0] + v[1] * v[1]) + (v[2] * v[2] + v[3] * v[3]); }
__device__ __forceinline__ u32x4 pack8(const f32x4 a, const f32x4 b) { u32x4 w; w.x = cvt_pk_bf16(a[0], a[1]); w.y = cvt_pk_bf16(a[2], a[3]); w.z = cvt_pk_bf16(b[0], b[1]); w.w = cvt_pk_bf16(b[2], b[3]); return w; }

struct EpiQKV {
    static constexpr bool PERM = true, AFTER_DRAIN = false, KSCALE = false; static constexpr int KS_T1 = -1, KS_T2 = -1;
    bf16_t* QKV;
    const float *gqa, *gka, *gqb, *gkb, *gqm;
    const float *rc, *rs;
    __device__ __forceinline__ void operator()(const f32x4 (&acc)[2][2][4][2], const Unit& u, int wr, int wc, int fr, int fq) const {
        const int hidx = u.pn * 4 + wc;
        const float* gain = nullptr; bool rope = false; float qs = 1.f;
        if (hidx < 6) { gain = gqa; rope = true; qs = QSCALE; } else if (hidx < 12) { gain = gka; rope = true; } else if (hidx < 18) { } else if (hidx < 24) { gain = gqb; qs = QSCALE; }
        else if (hidx < 30) { gain = gkb; } else if (hidx < 36) { } else { gain = gqm; qs = QSCALE; }
        const bool rl = rope && fq < 2;
        f32x4 g[2][2];
#pragma unroll
        for (int bj = 0; bj < 2; ++bj)
#pragma unroll
            for (int n = 0; n < 2; ++n) { const int d0 = (rl && bj == 0) ? (8 * n + 4 * fq) : (32 * bj + 8 * fq + 4 * n); g[bj][n] = gain ? *(const f32x4*)(gain + d0) : (f32x4){1.f, 1.f, 1.f, 1.f}; }
        bf16_t* base = QKV + (size_t)hidx * MTOK * 64 + 8 * fq;
#pragma unroll
        for (int ai = 0; ai < 2; ++ai)
#pragma unroll
            for (int m = 0; m < 4; ++m) {
                const int row = u.pm * BM + ai * HALF + wr * 64 + m * 16 + fr;
                f32x4 v[2][2];
#pragma unroll
                for (int bj = 0; bj < 2; ++bj)
#pragma unroll
                    for (int n = 0; n < 2; ++n) v[bj][n] = acc[ai][bj][m][n];
                if (gain) {
                    float ss = (sq4(v[0][0]) + sq4(v[0][1])) + (sq4(v[1][0]) + sq4(v[1][1]));
                    ss += __shfl_xor(ss, 16); ss += __shfl_xor(ss, 32);
                    const float r = rsqrtf(ss * (1.f / 64.f) + RMS_EPS) * qs;
#pragma unroll
                    for (int bj = 0; bj < 2; ++bj)
#pragma unroll
                        for (int n = 0; n < 2; ++n) v[bj][n] = v[bj][n] * r * g[bj][n];
                    if (rope) {
                        const int pos = row < TP ? row : ((row - TP) & (TS - 1));
                        const f32x4 c = *(const f32x4*)(rc + pos * 8 + 4 * (fq & 1)), s = *(const f32x4*)(rs + pos * 8 + 4 * (fq & 1));
                        if (fq < 2) { const f32x4 x1 = v[0][0], x2 = v[0][1]; v[0][0] = x1 * c - x2 * s; v[0][1] = x2 * c + x1 * s; }
                    }
                }
                bf16_t* rowp = base + (size_t)row * 64;
                *(u32x4*)(rowp) = pack8(v[0][0], v[0][1]);
                *(u32x4*)(rowp + 32) = pack8(v[1][0], v[1][1]);
            }
    }
};
struct EpiMemKV {
    static constexpr bool PERM = true, AFTER_DRAIN = false, KSCALE = false; static constexpr int KS_T1 = -1, KS_T2 = -1;
    bf16_t* MK; bf16_t* MV; const float* gk;
    __device__ __forceinline__ void operator()(const f32x4 (&acc)[2][2][4][2], const Unit& u, int wr, int wc, int fr, int fq) const {
        const int hidx = u.pn * 4 + wc; const bool isk = hidx < 4; const int h = hidx & 3;
        f32x4 g[2][2];
#pragma unroll
        for (int bj = 0; bj < 2; ++bj)
#pragma unroll
            for (int n = 0; n < 2; ++n) g[bj][n] = isk ? *(const f32x4*)(gk + 32 * bj + 8 * fq + 4 * n) : (f32x4){1.f, 1.f, 1.f, 1.f};
        bf16_t* base = (isk ? MK : MV) + 8 * fq;
#pragma unroll
        for (int ai = 0; ai < 2; ++ai)
#pragma unroll
            for (int m = 0; m < 4; ++m) {
                const int row = u.pm * BM + ai * HALF + wr * 64 + m * 16 + fr;
                f32x4 v[2][2];
#pragma unroll
                for (int bj = 0; bj < 2; ++bj)
#pragma unroll
                    for (int n = 0; n < 2; ++n) v[bj][n] = acc[ai][bj][m][n];
                if (isk) {
                    float ss = (sq4(v[0][0]) + sq4(v[0][1])) + (sq4(v[1][0]) + sq4(v[1][1]));
                    ss += __shfl_xor(ss, 16); ss += __shfl_xor(ss, 32);
                    const float r = rsqrtf(ss * (1.f / 64.f) + RMS_EPS);
#pragma unroll
                    for (int bj = 0; bj < 2; ++bj)
#pragma unroll
                        for (int n = 0; n < 2; ++n) v[bj][n] = v[bj][n] * r * g[bj][n];
                }
                bf16_t* rowp = base + ((size_t)((row >> 8) * 4 + h) * NMEM + (row & 255)) * 64;
                *(u32x4*)(rowp) = pack8(v[0][0], v[0][1]);
                *(u32x4*)(rowp + 32) = pack8(v[1][0], v[1][1]);
            }
    }
};
struct EpiX1 {
    static constexpr bool PERM = true, AFTER_DRAIN = false, KSCALE = true; static constexpr int KS_T1 = 6, KS_T2 = 12;
    const float* xp; const float* xs; float* out; bf16_t* x1b; float* ssq; const float* ssqa;
    static constexpr int TBL_OFF = 131072;
    __device__ __forceinline__ void prep(const Unit& u, PG8_LAS unsigned char* lds, int idx, int tid) const {
        if (tid < BM) { const f32x4 q = *(const f32x4*)(ssqa + (size_t)(u.pm * BM + tid) * 4);
            const float sa = rsqrtf(q[0] * (1.f / 384.f) + RMS_EPS), sb = rsqrtf(q[1] * (1.f / 384.f) + RMS_EPS), sm = rsqrtf(q[2] * (1.f / 256.f) + RMS_EPS);
            *(PG8_LAS f32x4*)(lds + TBL_OFF + (idx & 1) * 4096 + tid * 16) = (f32x4){sa / sb, sb / sm, sm, 0.f}; }
    }
    __device__ __forceinline__ void kscale(f32x4 (&acc)[2][2][4][2], int t, int wr, int fr, PG8_LAS unsigned char* lds, int idx) const {
        const PG8_LAS float* tb = (const PG8_LAS float*)(lds + TBL_OFF + (idx & 1) * 4096) + ((t == KS_T1) ? 0 : 1);
#pragma unroll
        for (int ai = 0; ai < 2; ++ai)
#pragma unroll
            for (int m = 0; m < 4; ++m) {
                const float f = tb[(ai * HALF + wr * 64 + m * 16 + fr) * 4];
#pragma unroll
                for (int bj = 0; bj < 2; ++bj)
#pragma unroll
                    for (int n = 0; n < 2; ++n) acc[ai][bj][m][n] = acc[ai][bj][m][n] * f;
            }
    }
    __device__ __forceinline__ void epi(const f32x4 (&acc)[2][2][4][2], const Unit& u, int wr, int wc, int fr, int fq, PG8_LAS unsigned char* lds, int idx) const {
        const PG8_LAS float* tb = (const PG8_LAS float*)(lds + TBL_OFF + (idx & 1) * 4096) + 2;
        const int col0 = u.pn * BM + wc * 32 + 8 * fq;
#pragma unroll
        for (int ai = 0; ai < 2; ++ai)
#pragma unroll
            for (int m = 0; m < 4; ++m) {
                const int row = u.pm * BM + ai * HALF + wr * 64 + m * 16 + fr;
                const float sm = tb[(ai * HALF + wr * 64 + m * 16 + fr) * 4];
                const float* xrow = (row < TP ? xp + (size_t)row * DM : xs + (size_t)(row - TP) * DM) + col0;
                float* orow = out + (size_t)row * DM + col0; bf16_t* brow = x1b + (size_t)row * DM + col0;
                float ss = 0.f;
#pragma unroll
                for (int bj = 0; bj < 2; ++bj) {
                    const f32x4 v0 = acc[ai][bj][m][0] * sm + *(const f32x4*)(xrow + bj * HALF), v1 = acc[ai][bj][m][1] * sm + *(const f32x4*)(xrow + bj * HALF + 4);
                    *(f32x4*)(orow + bj * HALF) = v0; *(f32x4*)(orow + bj * HALF + 4) = v1;
                    *(u32x4*)(brow + bj * HALF) = pack8(v0, v1);
                    ss += sq4(v0) + sq4(v1);
                }
                ss += __shfl_xor(ss, 16); ss += __shfl_xor(ss, 32);
                if (fq == 0) unsafeAtomicAdd(ssq + row, ss);
            }
    }
};
struct EpiH {
    static constexpr bool PERM = true, AFTER_DRAIN = false, KSCALE = false; static constexpr int KS_T1 = -1, KS_T2 = -1;
    bf16_t* H; const float* ssq;
    __device__ __forceinline__ void operator()(const f32x4 (&acc)[2][2][4][2], const Unit& u, int wr, int wc, int fr, int fq) const {
        const int col0 = u.pn * BM + wc * 32 + 8 * fq;
#pragma unroll
        for (int ai = 0; ai < 2; ++ai)
#pragma unroll
            for (int m = 0; m < 4; ++m) {
                const int row = u.pm * BM + ai * HALF + wr * 64 + m * 16 + fr;
                const float r = rsqrtf(ssq[row] * (1.f / DM) + RMS_EPS);
                bf16_t* hrow = H + (size_t)row * FF + col0;
#pragma unroll
                for (int bj = 0; bj < 2; ++bj) {
                    f32x4 v0 = acc[ai][bj][m][0] * r, v1 = acc[ai][bj][m][1] * r;
#pragma unroll
                    for (int e = 0; e < 4; ++e) { const float a = fmaxf(v0[e], 0.f), b = fmaxf(v1[e], 0.f); v0[e] = a * a; v1[e] = b * b; }
                    *(u32x4*)(hrow + bj * HALF) = pack8(v0, v1);
                }
            }
    }
};
struct EpiOut {
    static constexpr bool PERM = true, AFTER_DRAIN = false, KSCALE = false; static constexpr int KS_T1 = -1, KS_T2 = -1;
    float* out;
    __device__ __forceinline__ void operator()(const f32x4 (&acc)[2][2][4][2], const Unit& u, int wr, int wc, int fr, int fq) const {
        const int col0 = u.pn * BM + wc * 32 + 8 * fq;
#pragma unroll
        for (int ai = 0; ai < 2; ++ai)
#pragma unroll
            for (int m = 0; m < 4; ++m) {
                const int row = u.pm * BM + ai * HALF + wr * 64 + m * 16 + fr;
                float* orow = out + (size_t)row * DM + col0;
#pragma unroll
                for (int bj = 0; bj < 2; ++bj) {
                    const f32x4 v0 = acc[ai][bj][m][0] + *(const f32x4*)(orow + bj * HALF), v1 = acc[ai][bj][m][1] + *(const f32x4*)(orow + bj * HALF + 4);
                    *(f32x4*)(orow + bj * HALF) = v0; *(f32x4*)(orow + bj * HALF + 4) = v1;
                }
            }
    }
};

template <class Epi, class Sched, bool ALIGN_EPI = false, bool SP2 = false>
__device__ __forceinline__ void gemm_phase(PG8_LAS unsigned char* lds, const Gemm g, const Sched& S, const Epi& E) {
    const int tid = threadIdx.x, wid = __builtin_amdgcn_readfirstlane(tid >> 6), lane = tid & 63, wr = wid >> 2, wc = wid & 3, fr = lane & 15, fq = lane >> 4;
    const int K = g.K, nt = K / BK;
    unsigned voffA[2], voffB[2];
#pragma unroll
    for (int i = 0; i < 2; ++i) { int R, C; stage_rc(tid * 16 + i * 8192, R, C); const int Rb = Epi::PERM ? ((R & ~31) + perm32(R & 31)) : R;
        voffA[i] = (unsigned)(R * K + C) * 2u; voffB[i] = (unsigned)(Rb * K + C) * 2u; }
    const size_t kstep = (size_t)(BK * 2);
    const size_t hstep = (size_t)HALF * K * 2;
    const size_t tstep = 2 * hstep;
    const unsigned ldsw = (unsigned)wid * 1024u;
    const int aoff = lds_byte(wr * 64 + fr, fq * 8), boff = lds_byte(wc * 32 + fr, fq * 8);
#define PG8_SA(b, h) (((b) * 2 + (h)) * HTB)
#define PG8_SB(b, h) ((4 + (b) * 2 + (h)) * HTB)
#define PG8_STAGE(bufoff, gbase, voff) do { _Pragma("unroll") for (int _i = 0; _i < 2; ++_i) \
        __builtin_amdgcn_global_load_lds((const unsigned*)((const char*)(gbase) + (voff)[_i]), (PG8_LAS unsigned*)(lds + (bufoff) + ldsw + _i * 8192), 16, 0, 0); } while (0)
#define PG8_LDA(dst, b, h) do { _Pragma("unroll") for (int m = 0; m < 4; ++m) _Pragma("unroll") for (int k = 0; k < 2; ++k) dst[m][k] = *(const PG8_LAS bf16x8*)(lds + PG8_SA(b, h) + aoff + m * 2048 + k * 1024); } while (0)
#define PG8_LDB(dst, b, h) do { _Pragma("unroll") for (int n = 0; n < 2; ++n) _Pragma("unroll") for (int k = 0; k < 2; ++k) dst[n][k] = *(const PG8_LAS bf16x8*)(lds + PG8_SB(b, h) + boff + n * 2048 + k * 1024); } while (0)
#define PG8_MMA(ai, bj, At, Bt) do { __builtin_amdgcn_s_setprio(1); _Pragma("unroll") for (int m = 0; m < 4; ++m) _Pragma("unroll") for (int n = 0; n < 2; ++n) _Pragma("unroll") for (int k = 0; k < 2; ++k) \
        acc[ai][bj][m][n] = __builtin_amdgcn_mfma_f32_16x16x32_bf16(Bt[n][k], At[m][k], acc[ai][bj][m][n], 0, 0, 0); __builtin_amdgcn_s_setprio(0); } while (0)
#define PG8_WAIT_V(n) asm volatile("s_waitcnt vmcnt(" #n ")" ::: "memory")
#define PG8_WAIT_L(n) asm volatile("s_waitcnt lgkmcnt(" #n ")" ::: "memory")
#define PG8_BAR __builtin_amdgcn_s_barrier()
#define PG8_SCHED __builtin_amdgcn_sched_barrier(0)
    Unit cur, nxt; int ui = 0;
    if (!S.next(0, cur)) return;
    f32x4 acc[2][2][4][2];
#pragma unroll
    for (int a = 0; a < 2; ++a)
#pragma unroll
        for (int b = 0; b < 2; ++b)
#pragma unroll
            for (int m = 0; m < 4; ++m)
#pragma unroll
                for (int n = 0; n < 2; ++n) acc[a][b][m][n] = (f32x4){0.f, 0.f, 0.f, 0.f};
    bf16x8 At[4][2], B0[2][2], B1[2][2];
    const char* cA = (const char*)g.A + (size_t)cur.pm * tstep; const char* cB = (const char*)g.Bt + (size_t)cur.pn * tstep;
    S.a_ready(cur);
    if constexpr (Epi::KSCALE) E.prep(cur, lds, 0, tid);
    if constexpr (SP2) {
        PG8_STAGE(PG8_SB(0, 0), cB, voffB); PG8_STAGE(PG8_SB(0, 1), cB + hstep, voffB); PG8_STAGE(PG8_SA(0, 0), cA, voffA); PG8_STAGE(PG8_SA(0, 1), cA + hstep, voffA);
        if (wr == 1) PG8_BAR;
        PG8_WAIT_V(2); PG8_BAR;
        PG8_STAGE(PG8_SB(1, 0), cB + kstep, voffB); PG8_STAGE(PG8_SA(1, 0), cA + kstep, voffA); PG8_STAGE(PG8_SB(1, 1), cB + hstep + kstep, voffB);
        PG8_WAIT_V(6); PG8_BAR;
    } else {
        PG8_STAGE(PG8_SB(0, 0), cB, voffB); PG8_STAGE(PG8_SA(0, 0), cA, voffA); PG8_STAGE(PG8_SB(0, 1), cB + hstep, voffB); PG8_STAGE(PG8_SA(0, 1), cA + hstep, voffA);
        if (wr == 1) PG8_BAR;
        PG8_WAIT_V(4); PG8_BAR;
        PG8_STAGE(PG8_SB(1, 0), cB + kstep, voffB); PG8_STAGE(PG8_SA(1, 0), cA + kstep, voffA); PG8_STAGE(PG8_SB(1, 1), cB + hstep + kstep, voffB);
        PG8_WAIT_V(6); PG8_BAR;
    }
    for (;;) {
        const bool has_next = S.next(ui + 1, nxt);
        const char* nA = has_next ? (const char*)g.A + (size_t)nxt.pm * tstep : cA; const char* nB = has_next ? (const char*)g.Bt + (size_t)nxt.pn * tstep : cB;
        for (int t = 0; t < nt; t += 2) {
            const bool last = (t == nt - 2);
            if constexpr (Epi::KSCALE) { if (t == Epi::KS_T1 || t == Epi::KS_T2) E.kscale(acc, t, wr, fr, lds, ui); }
            const char* a1 = cA + (size_t)(t + 1) * kstep;
            const char* a2 = last ? nA : cA + (size_t)(t + 2) * kstep; const char* b2 = last ? nB : cB + (size_t)(t + 2) * kstep;
            const char* a3 = a2 + kstep; const char* b3 = b2 + kstep;
            if (last && has_next) { S.a_ready(nxt); if constexpr (Epi::KSCALE) E.prep(nxt, lds, ui + 1, tid); }
            if constexpr (SP2) {
            PG8_LDB(B0, 0, 0); PG8_LDB(B1, 0, 1); PG8_SCHED; PG8_LDA(At, 0, 0); PG8_STAGE(PG8_SA(1, 1), a1 + hstep, voffA);
            PG8_WAIT_V(8); PG8_WAIT_L(0); PG8_BAR; PG8_MMA(0, 0, At, B0); PG8_MMA(0, 1, At, B1); PG8_BAR; PG8_SCHED;
            PG8_LDA(At, 0, 1); PG8_STAGE(PG8_SB(0, 0), b2, voffB); PG8_STAGE(PG8_SB(0, 1), b2 + hstep, voffB); PG8_STAGE(PG8_SA(0, 0), a2, voffA);
            PG8_WAIT_V(8); PG8_WAIT_L(0); PG8_BAR; PG8_MMA(1, 0, At, B0); PG8_MMA(1, 1, At, B1); PG8_BAR; PG8_SCHED;
            PG8_LDB(B0, 1, 0); PG8_LDB(B1, 1, 1); PG8_SCHED; PG8_LDA(At, 1, 0); PG8_STAGE(PG8_SA(0, 1), a2 + hstep, voffA);
            PG8_WAIT_V(8); PG8_WAIT_L(0); PG8_BAR; PG8_MMA(0, 0, At, B0); PG8_MMA(0, 1, At, B1); PG8_BAR; PG8_SCHED;
            PG8_LDA(At, 1, 1); PG8_STAGE(PG8_SB(1, 0), b3, voffB); PG8_STAGE(PG8_SB(1, 1), b3 + hstep, voffB); PG8_STAGE(PG8_SA(1, 0), a3, voffA);
            PG8_WAIT_V(8); PG8_WAIT_L(0); PG8_BAR; PG8_MMA(1, 0, At, B0); PG8_MMA(1, 1, At, B1); PG8_BAR; PG8_SCHED;
            } else {
            PG8_LDB(B0, 0, 0); PG8_SCHED; PG8_LDA(At, 0, 0); PG8_STAGE(PG8_SA(1, 1), a1 + hstep, voffA);
            PG8_WAIT_L(8); PG8_BAR; PG8_WAIT_L(0); PG8_MMA(0, 0, At, B0); PG8_BAR; PG8_SCHED;
            PG8_LDB(B1, 0, 1); PG8_STAGE(PG8_SB(0, 0), b2, voffB);
            PG8_BAR; PG8_WAIT_L(0); PG8_MMA(0, 1, At, B1); PG8_BAR;
            PG8_LDA(At, 0, 1); PG8_STAGE(PG8_SA(0, 0), a2, voffA);
            PG8_BAR; PG8_WAIT_L(0); PG8_MMA(1, 0, At, B0); PG8_BAR; PG8_SCHED;
            PG8_STAGE(PG8_SB(0, 1), b2 + hstep, voffB);
            PG8_WAIT_V(6); PG8_BAR; PG8_MMA(1, 1, At, B1); PG8_BAR;
            PG8_LDB(B0, 1, 0); PG8_SCHED; PG8_LDA(At, 1, 0); PG8_STAGE(PG8_SA(0, 1), a2 + hstep, voffA);
            PG8_WAIT_L(8); PG8_BAR; PG8_WAIT_L(0); PG8_MMA(0, 0, At, B0); PG8_BAR; PG8_SCHED;
            PG8_LDB(B1, 1, 1); PG8_STAGE(PG8_SB(1, 0), b3, voffB);
            PG8_BAR; PG8_WAIT_L(0); PG8_MMA(0, 1, At, B1); PG8_BAR;
            PG8_LDA(At, 1, 1); PG8_STAGE(PG8_SA(1, 0), a3, voffA);
            PG8_BAR; PG8_WAIT_L(0); PG8_MMA(1, 0, At, B0); PG8_BAR; PG8_SCHED;
            PG8_STAGE(PG8_SB(1, 1), b3 + hstep, voffB);
            PG8_WAIT_V(6); PG8_BAR; PG8_MMA(1, 1, At, B1); PG8_BAR;
            }
        }
        if constexpr (ALIGN_EPI) { if (wr == 0) PG8_BAR; }
        if constexpr (!Epi::AFTER_DRAIN) { if constexpr (Epi::KSCALE) E.epi(acc, cur, wr, wc, fr, fq, lds, ui); else E(acc, cur, wr, wc, fr, fq); S.done(cur); }
        if (!has_next) break;
#pragma unroll
        for (int a = 0; a < 2; ++a)
#pragma unroll
            for (int b = 0; b < 2; ++b)
#pragma unroll
                for (int m = 0; m < 4; ++m)
#pragma unroll
                    for (int n = 0; n < 2; ++n) acc[a][b][m][n] = (f32x4){0.f, 0.f, 0.f, 0.f};
        cur = nxt; cA = nA; cB = nB; ++ui;
        if constexpr (ALIGN_EPI) { if (wr == 1) PG8_BAR; }
    }
    PG8_WAIT_V(0);
    if constexpr (!ALIGN_EPI) { if (wr == 0) PG8_BAR; }
    PG8_BAR;
    if constexpr (Epi::AFTER_DRAIN) { E.fused(acc, cur, wr, wc, fr, fq, lds, wid, lane); S.done(cur); }
#undef PG8_SA
#undef PG8_SB
#undef PG8_STAGE
#undef PG8_LDA
#undef PG8_LDB
#undef PG8_MMA
#undef PG8_WAIT_V
#undef PG8_WAIT_L
#undef PG8_BAR
#undef PG8_SCHED
}
}

constexpr int NWAVES = 8;
#ifndef MK_N_LAUNCHES
#define MK_N_LAUNCHES 1
#endif
constexpr int NPH = 7;
constexpr int N_LAUNCHES = MK_N_LAUNCHES;

constexpr size_t MiB = 1u << 20;
constexpr size_t WS_CTL = 0, WS_SSQF = 1 * MiB, WS_SSQA = 1 * MiB + 256 * 1024, CTL_ZERO_BYTES = 2 * MiB;
constexpr size_t WS_ROPE = 2 * MiB;
constexpr size_t WS_WIN = 3 * MiB, WS_WMEM = 8 * MiB, WS_WOUT = 9 * MiB, WS_W1 = 11 * MiB, WS_W2 = 19 * MiB;
constexpr size_t WS_XNMEM = 27 * MiB, WS_MK = 30 * MiB, WS_MV = 31 * MiB;
constexpr size_t WS_X1B = 32 * MiB;
constexpr size_t WS_XN = 128 * MiB, WS_O = 128 * MiB;
constexpr size_t WS_QKV = 224 * MiB;
constexpr size_t WS_H = 128 * MiB;
constexpr size_t WS_END = 512 * MiB;
static_assert(WS_QKV + (size_t)NHEADS * MTOK * 64 * 2 <= WS_END && WS_H + (size_t)MTOK * FF * 2 <= WS_END && WS_X1B + (size_t)MTOK * DM * 2 <= WS_XN && WS_XN + (size_t)MTOK * DM * 2 <= WS_QKV, "d_ws map");

constexpr int RING_BYTES = 131072;
constexpr int LDS_BYTES = 147456, LDS_MISC = LDS_BYTES - 128;
constexpr int CW_BAR = 4096, CW_ARANK = 8192;
constexpr int LDS_BYTES_UNUSED = 0;

#define LAS __attribute__((address_space(3)))
typedef unsigned short bf16;
typedef unsigned v4u __attribute__((ext_vector_type(4)));
typedef float f32x4 __attribute__((ext_vector_type(4)));
#define LDS_WAIT() asm volatile("s_waitcnt lgkmcnt(0)" ::: "memory")
__device__ __forceinline__ unsigned f2bf(float f) { unsigned u = __builtin_bit_cast(unsigned, f); return (u + 0x7fffu + ((u >> 16) & 1u)) >> 16; }
__device__ __forceinline__ unsigned pk2(float lo, float hi) { return f2bf(lo) | (f2bf(hi) << 16); }
__device__ __forceinline__ float bflo(unsigned w) { return __uint_as_float(w << 16); }
__device__ __forceinline__ float bfhi(unsigned w) { return __uint_as_float(w & 0xffff0000u); }
__device__ __forceinline__ float wave_sum(float v) {
#pragma unroll
    for (int o = 1; o < 64; o <<= 1) v += __shfl_xor(v, o);
    return v;
}

struct Frame {
    LAS unsigned char* lds;
    int tid, lane, wave, vcu, G, tm, what; bool nostore;
    float* out; unsigned char* ws;
};
struct Args { const float* in[22]; float* out; unsigned char* ws; int ph_lo, ph_hi; };


namespace att {
typedef short bf16x8 __attribute__((ext_vector_type(8)));
typedef short s16x4 __attribute__((ext_vector_type(4)));
typedef short v4i16_t __attribute__((ext_vector_type(4)));
typedef float f32x16 __attribute__((ext_vector_type(16)));
typedef float f32x4 __attribute__((ext_vector_type(4)));
typedef unsigned u32x4 __attribute__((ext_vector_type(4)));
typedef float f32x2_t __attribute__((ext_vector_type(2))); typedef __bf16 bf16x2_t __attribute__((ext_vector_type(2)));
typedef __attribute__((address_space(3))) unsigned char* lptr;
__device__ __forceinline__ unsigned cvtpk(float lo, float hi) { f32x2_t v = {lo, hi}; bf16x2_t b = __builtin_convertvector(v, bf16x2_t); return __builtin_bit_cast(unsigned, b); }
__device__ __forceinline__ s16x4 vtr(lptr p) { return __builtin_bit_cast(s16x4, __builtin_amdgcn_ds_read_tr16_b64_v4i16((__attribute__((address_space(3))) v4i16_t*)p)); }
__device__ __forceinline__ int creg(int r) { return (r & 3) + 8 * (r >> 2); }
constexpr float NEG = -INFINITY;

constexpr int VDH = 2112, TILE_V = 4096, TILE_BYTES = TILE_V + 2 * VDH;
template <class Spec> __device__ __forceinline__ void load_tile(const Spec& S, int t, u32x4 (&kn)[4], u32x4 (&vn)[4], int lane) {
#pragma unroll
    for (int j = 0; j < 4; ++j) { const int row = 8 * j + (lane >> 3); kn[j] = *(const u32x4*)(S.krow(t, row) + 8 * (lane & 7)); vn[j] = *(const u32x4*)(S.vrow(t, row) + 8 * (lane & 7)); }
}
template <int NJ, class Spec> __device__ __forceinline__ void run_tiles(const Spec& S, const bf16x8 (&qr)[NJ][4], f32x16 (&o)[NJ][2], float (&lsum)[NJ], lptr tb, int lane) {
    const int r32 = lane & 31, hi = lane >> 5;
    const int NT = S.ntiles();
    const int loff = TILE_V + ((lane >> 4) & 1) * 32 + (lane & 3) * 8 + (4 * hi + ((lane & 15) >> 2)) * 64;
    const int wrow = lane >> 3, wc = lane & 7;
    const int vwoff = TILE_V + (wc >> 2) * VDH + wrow * 64 + (wc & 3) * 16;
    u32x4 kn[4], vn[4];
    load_tile(S, 0, kn, vn, lane);
    for (int t = 0; t < NT; ++t) {
#pragma unroll
        for (int j = 0; j < 4; ++j) { const int row = 8 * j + wrow;
            *(__attribute__((address_space(3))) u32x4*)(tb + row * 128 + ((wc ^ ((row >> 1) & 7)) * 16)) = kn[j];
            *(__attribute__((address_space(3))) u32x4*)(tb + vwoff + j * 512) = vn[j]; }
        if (t + 1 < NT) load_tile(S, t + 1, kn, vn, lane);
        bf16x8 kf[4];
#pragma unroll
        for (int d0 = 0; d0 < 4; ++d0) kf[d0] = *(__attribute__((address_space(3))) bf16x8*)(tb + r32 * 128 + (((2 * d0 + hi) ^ ((r32 >> 1) & 7)) * 16));
        bf16x8 vf[2][2];
#pragma unroll
        for (int dh = 0; dh < 2; ++dh)
#pragma unroll
            for (int ks = 0; ks < 2; ++ks) { const s16x4 l0 = vtr(tb + dh * VDH + ks * 1024 + loff), h0 = vtr(tb + dh * VDH + ks * 1024 + 512 + loff);
                vf[dh][ks] = (bf16x8){l0[0], l0[1], l0[2], l0[3], h0[0], h0[1], h0[2], h0[3]}; }
#pragma unroll
        for (int jb = 0; jb < NJ; ++jb) {
            if (NJ > 1 && !S.active(jb, t)) continue;
            f32x16 p = {};
#pragma unroll
            for (int d0 = 0; d0 < 4; ++d0) p = __builtin_amdgcn_mfma_f32_32x32x16_bf16(kf[d0], qr[jb][d0], p, 0, 0, 0);
            S.mask(jb, t, p, lane);
            float sacc = 0.f;
#pragma unroll
            for (int r = 0; r < 16; ++r) { p[r] = __builtin_amdgcn_exp2f(p[r]); sacc += p[r]; }
            lsum[jb] += sacc;
            u32x4 pw0, pw1;
            pw0[0] = cvtpk(p[0], p[1]); pw0[1] = cvtpk(p[2], p[3]); pw0[2] = cvtpk(p[4], p[5]); pw0[3] = cvtpk(p[6], p[7]);
            pw1[0] = cvtpk(p[8], p[9]); pw1[1] = cvtpk(p[10], p[11]); pw1[2] = cvtpk(p[12], p[13]); pw1[3] = cvtpk(p[14], p[15]);
#pragma unroll
            for (int dh = 0; dh < 2; ++dh) {
                o[jb][dh] = __builtin_amdgcn_mfma_f32_32x32x16_bf16(__builtin_bit_cast(bf16x8, pw0), vf[dh][0], o[jb][dh], 0, 0, 0);
                o[jb][dh] = __builtin_amdgcn_mfma_f32_32x32x16_bf16(__builtin_bit_cast(bf16x8, pw1), vf[dh][1], o[jb][dh], 0, 0, 0);
            }
        }
    }
}
__device__ __forceinline__ void load_q(bf16x8 (&qr)[4], const bf16* qrow, int lane) {
    const int hi = lane >> 5;
#pragma unroll
    for (int d0 = 0; d0 < 4; ++d0) qr[d0] = *(const bf16x8*)(qrow + 16 * d0 + 8 * hi);
}
template <class RowFn, class SsqFn> __device__ __forceinline__ void store_out(const f32x16 (&o)[2], float lsum, lptr wbuf, const RowFn& orow, const SsqFn& ssqp, int lane, bool nostore = false) {
    const int r32 = lane & 31, hi = lane >> 5;
    lsum += __shfl_xor(lsum, 32);
    __attribute__((address_space(3))) float* ls = (__attribute__((address_space(3))) float*)(wbuf + 4096);
    if (hi == 0) ls[r32] = lsum;
    __attribute__((address_space(3))) unsigned short* stg = (__attribute__((address_space(3))) unsigned short*)wbuf;
    float rl[16];
#pragma unroll
    for (int g = 0; g < 4; ++g) { const f32x4 lv = *(__attribute__((address_space(3))) f32x4*)(ls + 8 * g + 4 * hi);
#pragma unroll
        for (int j = 0; j < 4; ++j) rl[4 * g + j] = __builtin_amdgcn_rcpf(lv[j]); }
#pragma unroll
    for (int r = 0; r < 16; ++r) { const int q = creg(r) + 4 * hi;
#pragma unroll
        for (int dh = 0; dh < 2; ++dh) stg[q * 64 + dh * 32 + r32] = (unsigned short)f2bf(o[dh][r] * rl[r]); }
#pragma unroll
    for (int i = 0; i < 4; ++i) { const int row = i * 8 + (lane >> 3), ch = lane & 7; const u32x4 v = *(__attribute__((address_space(3))) u32x4*)(stg + row * 64 + ch * 8);
        float ss = 0.f;
#pragma unroll
        for (int e = 0; e < 4; ++e) { const float a = bflo(v[e]), b = bfhi(v[e]); ss += a * a + b * b; }
        ss += __shfl_xor(ss, 1); ss += __shfl_xor(ss, 2); ss += __shfl_xor(ss, 4);
        if (!nostore) { *(u32x4*)(orow(row) + ch * 8) = v; if (ch == 0) unsafeAtomicAdd(ssqp(row), ss); } }
}

struct SpecM { const bf16* K; const bf16* V; int tm;
    __device__ __forceinline__ int ntiles() const { return 8; }
    __device__ __forceinline__ const bf16* krow(int t, int i) const { return K + (32 * (t & tm) + i) * 64; }
    __device__ __forceinline__ const bf16* vrow(int t, int i) const { return V + (32 * (t & tm) + i) * 64; }
    __device__ __forceinline__ bool active(int, int) const { return true; }
    __device__ __forceinline__ void mask(int, int, f32x16&, int) const {}
};
struct SpecB { const bf16* K; const bf16* V;
    int nt, rk0, w0;
    int rlo, dr0;
    int cb;
    const __attribute__((address_space(3))) float* tb;
    int tm;
    __device__ __forceinline__ int ntiles() const { return nt; }
    __device__ __forceinline__ const bf16* krow(int t, int i) const { return K + ((rk0 + (t & tm)) * 64 + w0 + i) * 64; }
    __device__ __forceinline__ const bf16* vrow(int t, int i) const { return V + ((rk0 + (t & tm)) * 64 + w0 + i) * 64; }
    __device__ __forceinline__ bool active(int, int) const { return true; }
    __device__ __forceinline__ void mask(int, int t, f32x16& p, int lane) const {
        const int hi = lane >> 5, rk = rk0 + t; const bool rok = (unsigned)(rk - rlo) < 8u;
        int dr = rk + dr0; dr = dr < 0 ? 0 : (dr > 14 ? 14 : dr);
        const __attribute__((address_space(3))) float* tp = tb + dr * 64 + 4 * hi; const int cbh = rok ? cb + 4 * hi : -4096;
#pragma unroll
        for (int h8 = 0; h8 < 2; ++h8) {
            float bv[8];
#pragma unroll
            for (int r = 0; r < 8; ++r) bv[r] = tp[creg(8 * h8 + r)];
#pragma unroll
            for (int r = 0; r < 8; ++r) { const float sb = p[8 * h8 + r] + bv[r]; p[8 * h8 + r] = ((unsigned)(cbh + creg(8 * h8 + r)) < 16u) ? sb : NEG; }
            asm volatile("" ::: "memory");
        }
    }
};
struct SpecA { const bf16* K; const bf16* V;
    int kp0, qs, tstep, imask, ishift, nt, T, tm;
    __device__ __forceinline__ int ntiles() const { return nt; }
    __device__ __forceinline__ int kpos(int t, int i) const { int p = kp0 + (tstep * (t & tm) + (i & imask)) * qs + (i >> ishift); return p < 0 ? 0 : (p >= T ? T - 1 : p); }
    __device__ __forceinline__ const bf16* krow(int t, int i) const { return K + kpos(t, i) * 64; }
    __device__ __forceinline__ const bf16* vrow(int t, int i) const { return V + kpos(t, i) * 64; }
    __device__ __forceinline__ bool active(int, int) const { return true; }
    __device__ __forceinline__ void mask(int, int t, f32x16& p, int lane) const {
        const int r32 = lane & 31, hi = lane >> 5, cq = r32 >> ishift, iq = r32 & imask;
        const int lo = kp0 + tstep * t * qs, hip = lo + imask * qs + (31 >> ishift);
        if (t == 0 || t == nt - 1 || ishift == 4) {
            const int base = tstep * t - iq + 4 * hi;
            const int b0 = (cq == 0) ? base : -4096, b1 = (cq == (16 >> ishift) ? base : -4096);
#pragma unroll
            for (int r = 0; r < 16; ++r) { if ((unsigned)((r < 8 ? b0 : b1) + (creg(r) & imask)) > 128u) p[r] = NEG; } }
        if (lo < 0 || hip >= T) {
            const int kb = lo + 4 * hi * qs;
#pragma unroll
            for (int r = 0; r < 16; ++r) { const int kp = kb + (creg(r) & imask) * qs + (creg(r) >> ishift); if ((unsigned)kp >= (unsigned)T) p[r] = NEG; } }
    }
};
}
template <class CM, class KS>
__device__ __forceinline__ void p0_transpose_item(const float* W, int K, int N, bf16* WT, LAS float* scr, int item, int lane, CM cm, KS ks) {
    const int nblk = N / 32, kb = item / nblk, nb = item % nblk, k0 = 64 * kb, n0 = 32 * nb;
    const int sc = cm(n0 + (lane & 31));
#pragma unroll 8
    for (int i = 0; i < 32; ++i) { const int kk = 2 * i + (lane >> 5); scr[kk * 33 + (lane & 31)] = W[(size_t)(k0 + kk) * N + sc] * ks(k0 + kk); }
    LDS_WAIT(); asm volatile("" ::: "memory");
    const int c = lane & 7;
#pragma unroll
    for (int j = 0; j < 4; ++j) { const int n = (lane >> 3) + 8 * j; const LAS float* s = scr + (8 * c) * 33 + n;
        v4u o; o.x = pk2(s[0 * 33], s[1 * 33]); o.y = pk2(s[2 * 33], s[3 * 33]); o.z = pk2(s[4 * 33], s[5 * 33]); o.w = pk2(s[6 * 33], s[7 * 33]);
        *(v4u*)(WT + (size_t)(n0 + n) * K + k0 + 8 * c) = o; }
    LDS_WAIT(); asm volatile("" ::: "memory");
}
struct CMapHead { int nrope;
    __device__ __forceinline__ int operator()(int c) const { const int pn = c >> 8, bj = (c >> 7) & 1, hh = (c >> 5) & 3, p5 = c & 31, hidx = 4 * pn + hh; int p = 32 * bj + p5;
        if (hidx < nrope && p < 16) p = (p & 3) + 8 * ((p >> 2) & 1) + 4 * (p >> 3); return 64 * hidx + p; } };
struct CMapId { __device__ __forceinline__ int operator()(int c) const { return c; } };
struct KSOne { __device__ __forceinline__ float operator()(int) const { return 1.f; } };
struct KSVec { const float* g; __device__ __forceinline__ float operator()(int k) const { return g[k]; } };
struct KSOut { const float *a, *b, *m; __device__ __forceinline__ float operator()(int k) const { return k < 384 ? a[k] : (k < 768 ? b[k - 384] : m[k - 768]); } };

__device__ __forceinline__ void rms_row_to_bf16(const float* xrow, const float* g, bf16* orow, int lane) {
    const f32x4* xr = (const f32x4*)xrow + lane; const f32x4* gr = (const f32x4*)g + lane;
    f32x4 v[4]; float s = 0.f;
#pragma unroll
    for (int j = 0; j < 4; ++j) { v[j] = xr[64 * j]; s += (v[j].x * v[j].x + v[j].y * v[j].y) + (v[j].z * v[j].z + v[j].w * v[j].w); }
    const float rstd = rsqrtf(wave_sum(s) * (1.f / DM) + RMS_EPS);
    unsigned long long* o8 = (unsigned long long*)orow + lane;
#pragma unroll
    for (int j = 0; j < 4; ++j) { const f32x4 gg = gr[64 * j]; o8[64 * j] = (unsigned long long)pk2(v[j].x * rstd * gg.x, v[j].y * rstd * gg.y) | ((unsigned long long)pk2(v[j].z * rstd * gg.z, v[j].w * rstd * gg.w) << 32); }
}
__device__ __forceinline__ void p0_prologue(Frame& F, const Args& A) {
    LAS float* scr = (LAS float*)(F.lds + F.wave * 16384);
    const int gw = F.vcu * NWAVES + F.wave, NGW = F.G * NWAVES;
    unsigned char* ws = F.ws;
    constexpr int I_IN = (DM / 64) * (NQKV / 32), I_MEM = (DM / 64) * (512 / 32), I_OUT = (DM / 64) * (DM / 32), I_1 = (DM / 64) * (FF / 32), I_2 = (FF / 64) * (DM / 32);
    constexpr int NITEMS = I_IN + I_MEM + I_OUT + I_1 + I_2;
    for (int it = gw; it < NITEMS; it += NGW) {
        int r = it;
        if (r < I_IN) { p0_transpose_item(A.in[5], DM, NQKV, (bf16*)(ws + WS_WIN), scr, r, F.lane, CMapHead{12}, KSOne{}); continue; } r -= I_IN;
        if (r < I_MEM) { p0_transpose_item(A.in[12], DM, 512, (bf16*)(ws + WS_WMEM), scr, r, F.lane, CMapHead{0}, KSOne{}); continue; } r -= I_MEM;
        if (r < I_OUT) { p0_transpose_item(A.in[18], DM, DM, (bf16*)(ws + WS_WOUT), scr, r, F.lane, CMapId{}, KSOut{A.in[15], A.in[16], A.in[17]}); continue; } r -= I_OUT;
        if (r < I_1) { p0_transpose_item(A.in[20], DM, FF, (bf16*)(ws + WS_W1), scr, r, F.lane, CMapId{}, KSVec{A.in[19]}); continue; } r -= I_1;
        p0_transpose_item(A.in[21], FF, DM, (bf16*)(ws + WS_W2), scr, r, F.lane, CMapId{}, KSOne{});
    }
    for (int m = gw; m < MTOK + MMEM; m += NGW) {
        if (m < MTOK) { const float* xrow = m < TP ? A.in[0] + (size_t)m * DM : A.in[1] + (size_t)(m - TP) * DM; rms_row_to_bf16(xrow, A.in[4], (bf16*)(ws + WS_XN) + (size_t)m * DM, F.lane); }
        else { const int r = m - MTOK; const float* xrow = r < NMEM ? A.in[2] + (size_t)r * DM : A.in[3] + (size_t)(r - NMEM) * DM; rms_row_to_bf16(xrow, A.in[11], (bf16*)(ws + WS_XNMEM) + (size_t)r * DM, F.lane); }
    }
    float* rc = (float*)(ws + WS_ROPE); float* rs = rc + TP * 8;
    for (int i = (F.vcu * NWAVES * 64) + F.tid; i < TP * 8; i += F.G * NWAVES * 64) {
        const int pos = i >> 3, fi = i & 7;
        const float inv = exp2f(-(float)fi * 0.125f * 18.931568569324174f);
        const float ang = (float)pos * inv;
        const double rev = (double)ang * 0.15915494309189535; const float fr = (float)(rev - __builtin_rint(rev));
        rc[i] = __builtin_amdgcn_cosf(fr); rs[i] = __builtin_amdgcn_sinf(fr);
    }
}

template <int NR, class KF>
__device__ __forceinline__ void attn_item(const bf16* qrow, const bf16* Kb, const bf16* Vb, const KF& kf, bf16* orow, int lane) {
    float q[64];
#pragma unroll
    for (int c = 0; c < 8; ++c) { const v4u w = *(const v4u*)(qrow + 8 * c);
#pragma unroll
        for (int e = 0; e < 4; ++e) { q[8 * c + 2 * e] = bflo(w[e]); q[8 * c + 2 * e + 1] = bfhi(w[e]); } }
    float p[NR]; float lsum = 0.f;
#pragma unroll
    for (int r = 0; r < NR; ++r) {
        long ridx; float bias; const bool ok = kf(64 * r + lane, ridx, bias);
        const bf16* krow = Kb + ridx * 64; float s = 0.f;
#pragma unroll
        for (int c = 0; c < 8; ++c) { const v4u w = *(const v4u*)(krow + 8 * c);
#pragma unroll
            for (int e = 0; e < 4; ++e) s += q[8 * c + 2 * e] * bflo(w[e]) + q[8 * c + 2 * e + 1] * bfhi(w[e]); }
        p[r] = ok ? exp2f(s + bias) : 0.f; lsum += p[r];
    }
    lsum = wave_sum(lsum);
    float o = 0.f;
#pragma unroll
    for (int r = 0; r < NR; ++r) {
#pragma unroll 8
        for (int l = 0; l < 64; ++l) {
            long ridx; float bias; (void)kf(64 * r + l, ridx, bias);
            const float pj = __int_as_float(__builtin_amdgcn_readlane(__float_as_int(p[r]), l));
            o += pj * __uint_as_float((unsigned)Vb[ridx * 64 + lane] << 16);
        }
    }
    orow[lane] = (bf16)f2bf(o / lsum);
}
struct KeyA { long sb; int pos, T;
    __device__ __forceinline__ bool operator()(int j, long& ridx, float& bias) const { const int pat = j >= 258 ? 2 : (j >= 129 ? 1 : 0), idx = j - 129 * pat, dil = 1 << (2 * pat), kp = pos + (idx - 64) * dil;
        const bool ok = j < 387 && kp >= 0 && kp < T; ridx = sb + (ok ? kp : pos); bias = 0.f; return ok; } };
struct KeyB { long sb; int r, c, rs, cs; const float* rpb;
    __device__ __forceinline__ bool operator()(int j, long& ridx, float& bias) const { const int kr = (j >> 4) & 7, kc = j & 15; ridx = sb + (rs + kr) * 64 + cs + kc;
        bias = rpb[(rs + kr - r + 7) * 31 + (cs + kc - c + 15)] * LOG2E; return true; } };
struct KeyM { long b0;
    __device__ __forceinline__ bool operator()(int j, long& ridx, float& bias) const { ridx = b0 + (j & 255); bias = 0.f; return true; } };

__device__ __forceinline__ void attn_simple_phase(Frame& F, const Args& A) {
    const int gw = F.vcu * NWAVES + F.wave, NGW = F.G * NWAVES;
    const bf16* QKV = (const bf16*)(F.ws + WS_QKV); bf16* O = (bf16*)(F.ws + WS_O);
    const bf16* MK = (const bf16*)(F.ws + WS_MK); const bf16* MV = (const bf16*)(F.ws + WS_MV);
    for (int it = gw; it < MTOK * 16; it += NGW) {
        const int hh = it / MTOK, row = it - hh * MTOK;
        const int sbat = row < TP ? 0 : 1 + ((row - TP) >> 13);
        const long sb = row < TP ? 0 : TP + (long)(sbat - 1) * TS; const int T = row < TP ? TP : TS, pos = (int)(row - sb);
        if (hh < 6) {
            if (ATT_A_MFMA) continue;
            const int h = hh;
            attn_item<7>(QKV + ((size_t)(0 + h) * MTOK + row) * 64, QKV + (size_t)(6 + h) * MTOK * 64, QKV + (size_t)(12 + h) * MTOK * 64, KeyA{sb, pos, T}, O + (size_t)row * DM + h * 64, F.lane);
        } else if (hh < 12) {
            if (ATT_B_MFMA) continue;
            const int h = hh - 6, rows = T / 64, r = pos >> 6, c = pos & 63;
            int rs = r - 4; rs = rs < 0 ? 0 : (rs > rows - 8 ? rows - 8 : rs); int cs = c - 8; cs = cs < 0 ? 0 : (cs > 48 ? 48 : cs);
            attn_item<2>(QKV + ((size_t)(18 + h) * MTOK + row) * 64, QKV + (size_t)(24 + h) * MTOK * 64, QKV + (size_t)(30 + h) * MTOK * 64, KeyB{sb, r, c, rs, cs, A.in[10] + h * 15 * 31}, O + (size_t)row * DM + 384 + h * 64, F.lane);
        } else {
            if (ATT_M_MFMA) continue;
            const int h = hh - 12;
            attn_item<4>(QKV + ((size_t)(36 + h) * MTOK + row) * 64, MK, MV, KeyM{(long)(sbat * 4 + h) * NMEM}, O + (size_t)row * DM + 768 + h * 64, F.lane);
        }
    }
}
__device__ __forceinline__ void onorm_phase(Frame& F) {
    const int gw = F.vcu * NWAVES + F.wave, NGW = F.G * NWAVES;
    bf16* O = (bf16*)(F.ws + WS_O);
    for (int m = gw; m < MTOK; m += NGW) {
        v4u* p = (v4u*)(O + (size_t)m * DM) + 2 * F.lane; v4u w0 = p[0], w1 = p[1];
        float v[16];
#pragma unroll
        for (int e = 0; e < 4; ++e) { v[2 * e] = bflo(w0[e]); v[2 * e + 1] = bfhi(w0[e]); v[8 + 2 * e] = bflo(w1[e]); v[8 + 2 * e + 1] = bfhi(w1[e]); }
        float ss = 0.f;
#pragma unroll
        for (int e = 0; e < 16; ++e) ss += v[e] * v[e];
        const int grp = F.lane < 24 ? 0 : (F.lane < 48 ? 1 : 2);
        const float sa = wave_sum(grp == 0 ? ss : 0.f), sb = wave_sum(grp == 1 ? ss : 0.f), sm = wave_sum(grp == 2 ? ss : 0.f);
        const float r = grp == 0 ? rsqrtf(sa * (1.f / 384.f) + RMS_EPS) : (grp == 1 ? rsqrtf(sb * (1.f / 384.f) + RMS_EPS) : rsqrtf(sm * (1.f / 256.f) + RMS_EPS));
#pragma unroll
        for (int e = 0; e < 4; ++e) { w0[e] = pk2(v[2 * e] * r, v[2 * e + 1] * r); w1[e] = pk2(v[8 + 2 * e] * r, v[8 + 2 * e + 1] * r); }
        p[0] = w0; p[1] = w1;
    }
}

#define XB_TMO      128
#define XB_XCNT(j)  (256  + 64 * (j))
#define XB_XSUB(j)  (1280 + 64 * (j))
#define XB_XGEN(j)  (2304 + 64 * (j))
#define XB_TOP      3328
#define XB_TOPGEN   3392
#define XCD_BAR_WORDS 3456
#define XB_SPIN_CAP (1u << 18)

__device__ __forceinline__ unsigned xb_ld(unsigned* p)              { return __hip_atomic_load(p, __ATOMIC_RELAXED, __HIP_MEMORY_SCOPE_AGENT); }
__device__ __forceinline__ unsigned xb_add(unsigned* p, unsigned v) { return __hip_atomic_fetch_add(p, v, __ATOMIC_RELAXED, __HIP_MEMORY_SCOPE_AGENT); }
__device__ __forceinline__ unsigned xb_xcc_id() { return (unsigned)__builtin_amdgcn_s_getreg((3 << 11) | 20) & 0xFu; }
#define XB_SPIN(cond, bar) do { unsigned _sp = 0; while (cond) { __builtin_amdgcn_s_sleep(1); \
    if ((++_sp & 255u) == 0u) { if (xb_ld(&(bar)[XB_TMO])) break; if (_sp > XB_SPIN_CAP) { atomicAdd(&(bar)[XB_TMO], 1u); break; } } } } while (0)

struct XcdBarrier {
    unsigned* bar; unsigned x;
    volatile LAS unsigned* st;
};

__device__ __forceinline__ XcdBarrier xcd_barrier_post(unsigned* bar, volatile LAS unsigned* st) {
    XcdBarrier b; b.bar = bar; b.x = xb_xcc_id(); b.st = st;
    if (threadIdx.x == 0) (void)xb_add(&bar[XB_XCNT(b.x)], 1u);
    return b;
}
__device__ __forceinline__ void xcd_barrier_complete(unsigned* bar, unsigned x, unsigned& nloc, unsigned& nx) {
    const unsigned G = gridDim.x * gridDim.y * gridDim.z;
    unsigned sum, cnt, mine, sp = 0u;
    for (;;) {
        sum = 0u; cnt = 0u; mine = 0u;
#pragma unroll
        for (unsigned j = 0; j < 16; ++j) { const unsigned c = xb_ld(&bar[XB_XCNT(j)]); sum += c; cnt += (c > 0u) ? 1u : 0u; mine = (j == x) ? c : mine; }
        if (sum == G) break;
        __builtin_amdgcn_s_sleep(1);
        if ((++sp & 255u) == 0u) { if (xb_ld(&bar[XB_TMO])) break; if (sp > XB_SPIN_CAP) { atomicAdd(&bar[XB_TMO], 1u); break; } }
    }
    nloc = mine > 0u ? mine : 1u; nx = cnt > 0u ? cnt : 1u;
}

__device__ __forceinline__ void xcd_barrier(const XcdBarrier& b) {
    asm volatile("s_waitcnt vmcnt(0)" ::: "memory");
    __syncthreads();
    if (threadIdx.x == 0) {
        unsigned* bar = b.bar;
        __builtin_amdgcn_s_waitcnt(0);
        unsigned nloc = b.st[0], nx = b.st[1];
        if (nloc == 0u) { xcd_barrier_complete(bar, b.x, nloc, nx); b.st[0] = nloc; b.st[1] = nx; }
        const unsigned old = xb_add(&bar[XB_XSUB(b.x)], 1u);
        const unsigned gen = old / nloc;
        if (old + 1u == (gen + 1u) * nloc) {
            __builtin_amdgcn_fence(__ATOMIC_RELEASE, "agent");
            asm volatile("s_waitcnt vmcnt(0)" ::: "memory");
            const unsigned og = xb_add(&bar[XB_TOP], 1u);
            const unsigned tg = og / nx;
            if (og + 1u == (tg + 1u) * nx) xb_add(&bar[XB_TOPGEN], 1u);
            else XB_SPIN(xb_ld(&bar[XB_TOPGEN]) == tg, bar);
            __builtin_amdgcn_fence(__ATOMIC_ACQUIRE, "agent");
            xb_add(&bar[XB_XGEN(b.x)], 1u);
            asm volatile("s_waitcnt vmcnt(0)" ::: "memory");
        } else {
            XB_SPIN(xb_ld(&bar[XB_XGEN(b.x)]) == gen, bar);
            __builtin_amdgcn_fence(__ATOMIC_ACQUIRE, "agent");
            asm volatile("s_waitcnt vmcnt(0)" ::: "memory");
        }
    }
    __syncthreads();
}

constexpr int N_AUNITS = (MTOK / 256) * 6;
constexpr int N_BJOBS = (MTOK / 128) * 6 * 4;
constexpr int N_MJOBS = (MTOK / 32) * 4;
constexpr int LA_WSTRIDE = 8320, LA_ACC = 69632, LA_L = LA_ACC + 65536;
constexpr int LW_STRIDE = 12544, LW_TBL = 8448;

struct SeqInfo { long sb; int T; int bat; };
__device__ __forceinline__ SeqInfo seq_of(int row) { SeqInfo s; if (row < TP) { s.sb = 0; s.T = TP; s.bat = 0; } else { const int b = (row - TP) >> 13; s.sb = TP + (long)b * TS; s.T = TS; s.bat = 1 + b; } return s; }

__device__ __forceinline__ void m_job(Frame& F, int jm) {
    const int h = jm / (MTOK / 32), row0 = (jm - h * (MTOK / 32)) * 32; const SeqInfo si = seq_of(row0);
    const bf16* QKV = (const bf16*)(F.ws + WS_QKV);
    const int r32 = F.lane & 31;
    att::bf16x8 qr[1][4]; att::load_q(qr[0], QKV + ((size_t)(36 + h) * MTOK + row0 + r32) * 64, F.lane);
    att::SpecM S{(const bf16*)(F.ws + WS_MK) + (size_t)(si.bat * 4 + h) * NMEM * 64, (const bf16*)(F.ws + WS_MV) + (size_t)(si.bat * 4 + h) * NMEM * 64, F.tm};
    att::f32x16 o[1][2] = {}; float lsum[1] = {0.f};
    att::lptr wb = (att::lptr)(F.lds + F.wave * LW_STRIDE);
    att::run_tiles<1>(S, qr, o, lsum, wb, F.lane);
    bf16* O = (bf16*)(F.ws + WS_O) + (size_t)row0 * DM + 768 + 64 * h; float* SQ = (float*)(F.ws + WS_SSQA) + (size_t)row0 * 4 + 2;
    att::store_out(o[0], lsum[0], wb, [=](int q) { return O + (size_t)q * DM; }, [=](int q) { return SQ + (size_t)q * 4; }, F.lane, F.nostore);
}
__device__ __forceinline__ void b_job(Frame& F, const Args& A, int jb) {
    const int g = jb & 3, rest = jb >> 2, h = rest / (MTOK / 128), rp = rest - h * (MTOK / 128);
    int r0, rows; long sb;
    if (rp < TP / 128) { r0 = 2 * rp; rows = TP / 64; sb = 0; } else { const int q = rp - TP / 128, b = q / (TS / 128); r0 = 2 * (q - b * (TS / 128)); rows = TS / 64; sb = TP + (long)b * TS; }
    const int r32 = F.lane & 31;
    const int rq = r0 + (r32 >> 4), c = 16 * g + (r32 & 15);
    int rlo = rq - 4; rlo = rlo < 0 ? 0 : (rlo > rows - 8 ? rows - 8 : rlo);
    int cs = c - 8; cs = cs < 0 ? 0 : (cs > 48 ? 48 : cs);
    int rk0 = r0 - 4; rk0 = rk0 < 0 ? 0 : (rk0 > rows - 8 ? rows - 8 : rk0);
    int rk1 = r0 + 1 - 4; rk1 = rk1 < 0 ? 0 : (rk1 > rows - 8 ? rows - 8 : rk1);
    const int w0 = g == 0 ? 0 : (g == 1 ? 8 : (g == 2 ? 24 : 32));
    att::lptr wb = (att::lptr)(F.lds + F.wave * LW_STRIDE);
    __attribute__((address_space(3))) float* tbl = (__attribute__((address_space(3))) float*)(wb + LW_TBL);
    const float* rpb = A.in[10] + h * 465;
    if (F.lane < 31) {
#pragma unroll 5
        for (int dr = 0; dr < 15; ++dr) tbl[dr * 64 + 16 + F.lane] = rpb[dr * 31 + F.lane] * LOG2E; }
    asm volatile("" ::: "memory");
    const bf16* QKV = (const bf16*)(F.ws + WS_QKV);
    att::bf16x8 qr[1][4]; att::load_q(qr[0], QKV + ((size_t)(18 + h) * MTOK + sb + rq * 64 + c) * 64, F.lane);
    att::SpecB S{QKV + ((size_t)(24 + h) * MTOK + sb) * 64, QKV + ((size_t)(30 + h) * MTOK + sb) * 64, rk1 + 8 - rk0, rk0, w0, rlo, 7 - rq, w0 - cs, tbl + (31 + w0 - c), F.tm};
    att::f32x16 o[1][2] = {}; float lsum[1] = {0.f};
    att::run_tiles<1>(S, qr, o, lsum, wb, F.lane);
    bf16* O = (bf16*)(F.ws + WS_O) + (size_t)(sb + r0 * 64 + 16 * g) * DM + 384 + 64 * h; float* SQ = (float*)(F.ws + WS_SSQA) + (size_t)(sb + r0 * 64 + 16 * g) * 4 + 1;
    att::store_out(o[0], lsum[0], wb, [=](int q) { return O + (size_t)((q >> 4) * 64 + (q & 15)) * DM; }, [=](int q) { return SQ + (size_t)((q >> 4) * 64 + (q & 15)) * 4; }, F.lane, F.nostore);
}
template <class Spec, class QLoc> __device__ __forceinline__ void a_job(Frame& F, const Spec& S, const bf16* qrow, const QLoc& qloc) {
    att::bf16x8 qr[1][4]; att::load_q(qr[0], qrow, F.lane);
    att::f32x16 o1[1][2] = {}; float lsum1[1] = {0.f};
    att::run_tiles<1>(S, qr, o1, lsum1, (att::lptr)(F.lds + F.wave * LA_WSTRIDE), F.lane);
    const att::f32x16 (&o)[2] = o1[0]; const float lsum = lsum1[0];
    const int r32 = F.lane & 31, hi = F.lane >> 5;
    __attribute__((address_space(3))) float* acc = (__attribute__((address_space(3))) float*)(F.lds + LA_ACC);
    __attribute__((address_space(3))) float* ls = (__attribute__((address_space(3))) float*)(F.lds + LA_L);
#pragma unroll
    for (int r = 0; r < 16; ++r) { const int ql = qloc(att::creg(r) + 4 * hi);
#pragma unroll
        for (int dh = 0; dh < 2; ++dh) (void)__hip_atomic_fetch_add(acc + ql * 64 + dh * 32 + r32, o[dh][r], __ATOMIC_RELAXED, __HIP_MEMORY_SCOPE_WORKGROUP); }
    (void)__hip_atomic_fetch_add(ls + qloc(r32), lsum, __ATOMIC_RELAXED, __HIP_MEMORY_SCOPE_WORKGROUP);
}
__device__ __forceinline__ void a_unit(Frame& F, int ua) {
    const int h = ua / (MTOK / 256), row0 = (ua - h * (MTOK / 256)) * 256; const SeqInfo si = seq_of(row0);
    const int pq0 = (int)(row0 - si.sb), w = F.wave, r32 = F.lane & 31;
    { __attribute__((address_space(3))) att::f32x4* z = (__attribute__((address_space(3))) att::f32x4*)(F.lds + LA_ACC);
#pragma unroll
      for (int i = 0; i < 8; ++i) z[i * 512 + F.tid] = (att::f32x4){0.f, 0.f, 0.f, 0.f};
      if (F.tid < 64) z[4096 + F.tid] = (att::f32x4){0.f, 0.f, 0.f, 0.f}; }
    __syncthreads();
    const bf16* QKV = (const bf16*)(F.ws + WS_QKV);
    const bf16* Q = QKV + ((size_t)(0 + h) * MTOK + si.sb) * 64; const bf16* K = QKV + ((size_t)(6 + h) * MTOK + si.sb) * 64; const bf16* V = QKV + ((size_t)(12 + h) * MTOK + si.sb) * 64;
    for (int pat = 0; pat < 3; ++pat) {
        const int qs = pat == 0 ? 1 : (pat == 1 ? 4 : 16), qb = pat == 0 ? 32 * w : (pat == 1 ? 128 * (w & 1) + (w >> 1) : 2 * w);
        const int imask = pat == 2 ? 15 : 31, ishift = pat == 2 ? 4 : 5;
        att::SpecA S{K, V, pq0 + qb - 64 * qs, qs, pat == 2 ? 16 : 32, imask, ishift, pat == 2 ? 9 : 5, si.T, F.tm};
        a_job(F, S, Q + (size_t)(pq0 + qb + (r32 & imask) * qs + (r32 >> ishift)) * 64, [=](int q) { return qb + (q & imask) * qs + (q >> ishift); });
    }
    __syncthreads();
    {
        const int q = 32 * w + (F.lane >> 1), dh = F.lane & 1;
        const __attribute__((address_space(3))) att::f32x4* a = (const __attribute__((address_space(3))) att::f32x4*)(F.lds + LA_ACC + (q * 64 + dh * 32) * 4);
        const float rl = __builtin_amdgcn_rcpf(((const __attribute__((address_space(3))) float*)(F.lds + LA_L))[q]);
        bf16* op = (bf16*)(F.ws + WS_O) + (size_t)(row0 + q) * DM + 64 * h + 32 * dh;
        float ss = 0.f;
#pragma unroll
        for (int i = 0; i < 4; ++i) { const att::f32x4 x = a[2 * i], y = a[2 * i + 1]; v4u o; o.x = pk2(x[0] * rl, x[1] * rl); o.y = pk2(x[2] * rl, x[3] * rl); o.z = pk2(y[0] * rl, y[1] * rl); o.w = pk2(y[2] * rl, y[3] * rl);
#pragma unroll
            for (int e = 0; e < 4; ++e) { const float u0 = bflo(o[e]), u1 = bfhi(o[e]); ss += u0 * u0 + u1 * u1; }
            if (!F.nostore) *(v4u*)(op + 8 * i) = o; }
        ss += __shfl_xor(ss, 1);
        if (!F.nostore && dh == 0) unsafeAtomicAdd((float*)(F.ws + WS_SSQA) + (size_t)(row0 + q) * 4 + 0, ss);
    }
    __syncthreads();
}
__device__ __forceinline__ void attn_phase(Frame& F, const Args& A) {
    volatile LAS unsigned* ast = (volatile LAS unsigned*)(F.lds + LDS_MISC + 16);
    if (F.tid == 0) {
        unsigned* barw = (unsigned*)(F.ws + WS_CTL) + CW_BAR; const unsigned myx = xb_xcc_id();
        bool ok = (F.G == 256); unsigned chunk = 0, npop = 0;
        for (unsigned j = 0; j < 16; ++j) { const unsigned cnt = xb_ld(&barw[XB_XCNT(j)]); if (cnt) { ++npop; if (cnt != 32u) ok = false; if (j < myx) ++chunk; } }
        if (npop != 8u) ok = false;
        unsigned rank = 0;
        if (ok) rank = xb_add((unsigned*)(F.ws + WS_CTL) + CW_ARANK + 64 * myx, 1u);
        ast[0] = ok ? 1u : 0u; ast[1] = chunk; ast[2] = rank;
    }
    __syncthreads();
    const bool blocked = ast[0] != 0u;
    const int xcd = (int)ast[1], ci = (int)ast[2];
#if ATT_A_MFMA
    if (!(F.what & 1)) {} else if (blocked) { for (int k = ci; k < N_AUNITS / 8; k += 32) a_unit(F, xcd * (N_AUNITS / 8) + k); }
    else { for (int ua = blockIdx.x; ua < N_AUNITS; ua += F.G) a_unit(F, ua); }
#endif
    __syncthreads();
    if (blocked) {
        const int widx = ci * 8 + F.wave;
        for (int k = 0; k < 9; ++k) {
            int l;
            if (k < 6) l = k * 256 + widx; else { if (ci < 16) break; l = 1536 + (k - 6) * 128 + (widx - 128); }
            if (l < N_BJOBS / 8) {
#if ATT_B_MFMA
                if (F.what & 2) b_job(F, A, xcd * (N_BJOBS / 8) + l);
#endif
            } else {
#if ATT_M_MFMA
                if (F.what & 4) m_job(F, xcd * (N_MJOBS / 8) + (l - N_BJOBS / 8));
#endif
            }
        }
    } else {
        const int NJ = N_BJOBS + N_MJOBS;
        for (int j = blockIdx.x * 8 + F.wave; j < NJ; j += F.G * 8) {
            if (j < N_BJOBS) {
#if ATT_B_MFMA
                b_job(F, A, j);
#endif
            } else {
#if ATT_M_MFMA
                m_job(F, j - N_BJOBS);
#endif
            }
        }
    }
    __syncthreads();
}

namespace att2 {
using att::bf16x8; using att::s16x4; using att::f32x16; using att::f32x4; using att::u32x4; using att::lptr; using att::creg; using att::cvtpk; using att::vtr; using att::NEG;
constexpr int NS = 3, SLOT = 32768, TILE = 16384, TV = 8192, VDH64 = 4096;
constexpr int L_RING = 0, L_WSCR = NS * SLOT, WSCR = 4352, L_TBL = L_WSCR + 8 * WSCR, TBLB = 3840, L_END = L_TBL + 2 * TBLB;
static_assert(L_END <= LDS_MISC, "attention LDS map");
#define ATT2_WAITBAR(N) asm volatile("s_waitcnt vmcnt(" #N ") lgkmcnt(0)\n\ts_barrier" ::: "memory")

struct TileSrc { const bf16* K; const bf16* V; int p0, qs, T; };
__device__ __forceinline__ void dma_tile(LAS unsigned char* tile, const TileSrc& s, int w, int lane) {
    { const int row = 8 * w + (lane >> 3); int p = s.p0 + row * s.qs; p = p < 0 ? 0 : (p >= s.T ? s.T - 1 : p);
      __builtin_amdgcn_global_load_lds((const unsigned*)(s.K + (size_t)p * 64 + 8 * ((lane & 7) ^ ((row >> 1) & 7))), (LAS unsigned*)(tile + w * 1024), 16, 0, 0); }
    { const int row = 16 * (w & 3) + (lane >> 2); int p = s.p0 + row * s.qs; p = p < 0 ? 0 : (p >= s.T ? s.T - 1 : p);
      __builtin_amdgcn_global_load_lds((const unsigned*)(s.V + (size_t)p * 64 + 32 * (w >> 2) + 8 * (lane & 3)), (LAS unsigned*)(tile + TV + (w >> 2) * VDH64 + (w & 3) * 1024), 16, 0, 0); }
}
__device__ __forceinline__ f32x16 qk_sub(lptr tile, int roff, const bf16x8 (&qr)[4], int lane) {
    const int r32 = lane & 31, hi = lane >> 5, row = roff + r32;
    lptr kp = tile + row * 128; const int sw = (row >> 1) & 7;
    f32x16 p = {};
#pragma unroll
    for (int d0 = 0; d0 < 4; ++d0) { const bf16x8 kf = *(__attribute__((address_space(3))) bf16x8*)(kp + (((2 * d0 + hi) ^ sw) * 16)); p = __builtin_amdgcn_mfma_f32_32x32x16_bf16(kf, qr[d0], p, 0, 0, 0); }
    return p;
}
__device__ __forceinline__ void pv_sub(lptr tile, int roff, f32x16& p, f32x16 (&o)[2], float& lsum, int lane) {
    const int hi = lane >> 5;
    float sacc = 0.f;
#pragma unroll
    for (int r = 0; r < 16; ++r) { p[r] = __builtin_amdgcn_exp2f(p[r]); sacc += p[r]; }
    lsum += sacc;
    u32x4 pw0, pw1;
    pw0[0] = cvtpk(p[0], p[1]); pw0[1] = cvtpk(p[2], p[3]); pw0[2] = cvtpk(p[4], p[5]); pw0[3] = cvtpk(p[6], p[7]);
    pw1[0] = cvtpk(p[8], p[9]); pw1[1] = cvtpk(p[10], p[11]); pw1[2] = cvtpk(p[12], p[13]); pw1[3] = cvtpk(p[14], p[15]);
    lptr vp = tile + TV + (roff + 4 * hi + ((lane & 15) >> 2)) * 64 + ((lane >> 4) & 1) * 32 + (lane & 3) * 8;
#pragma unroll
    for (int dh = 0; dh < 2; ++dh) {
        const s16x4 l0 = vtr(vp + dh * VDH64), h0 = vtr(vp + dh * VDH64 + 512), l1 = vtr(vp + dh * VDH64 + 1024), h1 = vtr(vp + dh * VDH64 + 1536);
        const bf16x8 f0 = {l0[0], l0[1], l0[2], l0[3], h0[0], h0[1], h0[2], h0[3]}, f1 = {l1[0], l1[1], l1[2], l1[3], h1[0], h1[1], h1[2], h1[3]};
        o[dh] = __builtin_amdgcn_mfma_f32_32x32x16_bf16(__builtin_bit_cast(bf16x8, pw0), f0, o[dh], 0, 0, 0);
        o[dh] = __builtin_amdgcn_mfma_f32_32x32x16_bf16(__builtin_bit_cast(bf16x8, pw1), f1, o[dh], 0, 0, 0);
    }
}
__device__ __forceinline__ void mask_band(f32x16& p, int rel, int kr0, int L, int lane) {
    const int r32 = lane & 31, hi = lane >> 5;
    if (rel == 0 || rel == 4) { const int base = 32 * rel - r32 + 4 * hi;
#pragma unroll
        for (int r = 0; r < 16; ++r) { if ((unsigned)(base + creg(r)) > 128u) p[r] = NEG; } }
    if (kr0 < 0 || kr0 + 31 >= L) { const int kb = kr0 + 4 * hi;
#pragma unroll
        for (int r = 0; r < 16; ++r) { if ((unsigned)(kb + creg(r)) >= (unsigned)L) p[r] = NEG; } }
}
__device__ __forceinline__ void stage_rows(const f32x16 (&o)[2], float lsum, bool normalise, lptr scr, int lane) {
    const int r32 = lane & 31, hi = lane >> 5;
    lsum += __shfl_xor(lsum, 32);
    __attribute__((address_space(3))) float* ls = (__attribute__((address_space(3))) float*)(scr + 4096);
    if (hi == 0) ls[r32] = lsum;
    __attribute__((address_space(3))) unsigned short* stg = (__attribute__((address_space(3))) unsigned short*)scr;
    float rl[16];
#pragma unroll
    for (int g = 0; g < 4; ++g) { const f32x4 lv = *(__attribute__((address_space(3))) f32x4*)(ls + 8 * g + 4 * hi);
#pragma unroll
        for (int j = 0; j < 4; ++j) rl[4 * g + j] = normalise ? __builtin_amdgcn_rcpf(lv[j]) : 1.f; }
#pragma unroll
    for (int r = 0; r < 16; ++r) { const int q = creg(r) + 4 * hi;
#pragma unroll
        for (int dh = 0; dh < 2; ++dh) stg[q * 64 + dh * 32 + r32] = (unsigned short)f2bf(o[dh][r] * rl[r]); }
}
template <class RowFn, class SsqFn> __device__ __forceinline__ void out_final(const f32x16 (&o)[2], float lsum, lptr scr, const RowFn& orow, const SsqFn& ssqp, int lane) {
    stage_rows(o, lsum, true, scr, lane);
    __attribute__((address_space(3))) unsigned short* stg = (__attribute__((address_space(3))) unsigned short*)scr;
#pragma unroll
    for (int i = 0; i < 4; ++i) { const int row = i * 8 + (lane >> 3), ch = lane & 7; const u32x4 v = *(__attribute__((address_space(3))) u32x4*)(stg + row * 64 + ch * 8);
        float ss = 0.f;
#pragma unroll
        for (int e = 0; e < 4; ++e) { const float a = bflo(v[e]), b = bfhi(v[e]); ss += a * a + b * b; }
        ss += __shfl_xor(ss, 1); ss += __shfl_xor(ss, 2); ss += __shfl_xor(ss, 4);
        *(u32x4*)(orow(row) + ch * 8) = v; if (ch == 0) unsafeAtomicAdd(ssqp(row), ss); }
}
}

constexpr int N2_M = (MTOK / 256) * 4;
constexpr int N2_B = (MTOK / 128) * 3;
constexpr int N2_A = (MTOK / 512) * 6;
constexpr size_t WS_PART = WS_X1B;
constexpr size_t WS_PARTL = WS_PART + (size_t)2 * MTOK * 384 * 2;
static_assert(WS_PARTL + (size_t)2 * MTOK * 8 * 4 <= WS_XN, "partials fit the X1B region");

__device__ __forceinline__ void att2_unit_M(Frame& F, int um) {
    const int h = um / (MTOK / 256), row0 = (um - h * (MTOK / 256)) * 256; const SeqInfo si = seq_of(row0);
    const int w = F.wave, lane = F.lane, r32 = lane & 31;
    const bf16* QKV = (const bf16*)(F.ws + WS_QKV);
    att2::TileSrc ts{(const bf16*)(F.ws + WS_MK) + (size_t)(si.bat * 4 + h) * NMEM * 64, (const bf16*)(F.ws + WS_MV) + (size_t)(si.bat * 4 + h) * NMEM * 64, 0, 1, NMEM};
    LAS unsigned char* ring = F.lds + att2::L_RING;
    att2::dma_tile(ring, ts, w, lane); ts.p0 = 64; att2::dma_tile(ring + att2::SLOT, ts, w, lane);
    att::bf16x8 qr[4]; att::load_q(qr, QKV + ((size_t)(36 + h) * MTOK + row0 + 32 * w + r32) * 64, lane);
    att::f32x16 o[2] = {}; float lsum = 0.f;
#pragma unroll 1
    for (int s = 0; s < 4; ++s) {
        if (s < 3) { ATT2_WAITBAR(2); } else { ATT2_WAITBAR(0); }
        if (s + 2 < 4) { ts.p0 = 64 * (s + 2); att2::dma_tile(ring + ((s + 2) % att2::NS) * att2::SLOT, ts, w, lane); }
        att::lptr tile = (att::lptr)(ring + (s % att2::NS) * att2::SLOT);
        att::f32x16 pa = att2::qk_sub(tile, 0, qr, lane), pb = att2::qk_sub(tile, 32, qr, lane);
        att2::pv_sub(tile, 0, pa, o, lsum, lane); att2::pv_sub(tile, 32, pb, o, lsum, lane);
    }
    bf16* O = (bf16*)(F.ws + WS_O) + (size_t)(row0 + 32 * w) * DM + 768 + 64 * h; float* SQ = (float*)(F.ws + WS_SSQA) + (size_t)(row0 + 32 * w) * 4 + 2;
    att2::out_final(o, lsum, (att::lptr)(F.lds + att2::L_WSCR + w * att2::WSCR), [=](int q) { return O + (size_t)q * DM; }, [=](int q) { return SQ + (size_t)q * 4; }, lane);
    ATT2_WAITBAR(0);
}

__device__ __forceinline__ void att2_unit_B(Frame& F, const Args& A, int ub) {
    const int hp = ub / (MTOK / 128), rp = ub - hp * (MTOK / 128);
    int r0, rows; long sb; int T;
    if (rp < TP / 128) { r0 = 2 * rp; rows = TP / 64; sb = 0; T = TP; } else { const int q = rp - TP / 128, b = q / (TS / 128); r0 = 2 * (q - b * (TS / 128)); rows = TS / 64; sb = TP + (long)b * TS; T = TS; }
    const int w = F.wave, lane = F.lane, r32 = lane & 31, hi = lane >> 5;
    const int hd = w >> 2, g = w & 3, h = 2 * hp + hd;
    const int rq = r0 + (r32 >> 4), c = 16 * g + (r32 & 15);
    int rlo = rq - 4; rlo = rlo < 0 ? 0 : (rlo > rows - 8 ? rows - 8 : rlo);
    int cs = c - 8; cs = cs < 0 ? 0 : (cs > 48 ? 48 : cs);
    int rk0 = r0 - 4; rk0 = rk0 < 0 ? 0 : (rk0 > rows - 8 ? rows - 8 : rk0);
    int rk1 = r0 + 1 - 4; rk1 = rk1 < 0 ? 0 : (rk1 > rows - 8 ? rows - 8 : rk1);
    const int nst = rk1 + 8 - rk0;
    const int w0 = g == 0 ? 0 : (g == 1 ? 8 : (g == 2 ? 24 : 32));
    const bf16* QKV = (const bf16*)(F.ws + WS_QKV);
    att2::TileSrc tx{QKV + ((size_t)(24 + 2 * hp) * MTOK + sb) * 64, QKV + ((size_t)(30 + 2 * hp) * MTOK + sb) * 64, rk0 * 64, 1, T};
    att2::TileSrc ty{QKV + ((size_t)(25 + 2 * hp) * MTOK + sb) * 64, QKV + ((size_t)(31 + 2 * hp) * MTOK + sb) * 64, rk0 * 64, 1, T};
    LAS unsigned char* ring = F.lds + att2::L_RING;
    att2::dma_tile(ring, tx, w, lane); att2::dma_tile(ring + att2::TILE, ty, w, lane);
    tx.p0 += 64; ty.p0 += 64; att2::dma_tile(ring + att2::SLOT, tx, w, lane); att2::dma_tile(ring + att2::SLOT + att2::TILE, ty, w, lane);
    { const int th = F.tid >> 8, tl = F.tid & 255;
      __attribute__((address_space(3))) float* tbl = (__attribute__((address_space(3))) float*)(F.lds + att2::L_TBL + th * att2::TBLB);
      const float* rpb = A.in[10] + (2 * hp + th) * 465;
      for (int idx = tl; idx < 465; idx += 256) { const int dr = idx / 31, dl = idx - dr * 31; tbl[dr * 64 + 16 + dl] = rpb[idx] * LOG2E; } }
    att::bf16x8 qr[4]; att::load_q(qr, QKV + ((size_t)(18 + h) * MTOK + sb + rq * 64 + c) * 64, lane);
    att::f32x16 o[2] = {}; float lsum = 0.f;
    const __attribute__((address_space(3))) float* tb = (const __attribute__((address_space(3))) float*)(F.lds + att2::L_TBL + hd * att2::TBLB) + (31 + w0 - c) + 4 * hi;
    const int cb = w0 - cs + 4 * hi, dr0 = 7 - rq;
#pragma unroll 1
    for (int s = 0; s < nst; ++s) {
        if (s + 1 < nst) { ATT2_WAITBAR(4); } else { ATT2_WAITBAR(0); }
        if (s + 2 < nst) { tx.p0 += 64; ty.p0 += 64; LAS unsigned char* sl = ring + ((s + 2) % att2::NS) * att2::SLOT; att2::dma_tile(sl, tx, w, lane); att2::dma_tile(sl + att2::TILE, ty, w, lane); }
        att::lptr tile = (att::lptr)(ring + (s % att2::NS) * att2::SLOT + hd * att2::TILE);
        att::f32x16 p = att2::qk_sub(tile, w0, qr, lane);
        { const int rk = rk0 + s; const bool rok = (unsigned)(rk - rlo) < 8u;
          int dr = rk + dr0; dr = dr < 0 ? 0 : (dr > 14 ? 14 : dr);
          const __attribute__((address_space(3))) float* tp = tb + dr * 64; const int cbh = rok ? cb : -4096;
#pragma unroll
          for (int r = 0; r < 16; ++r) { const float sbv = p[r] + tp[att::creg(r)]; p[r] = ((unsigned)(cbh + att::creg(r)) < 16u) ? sbv : att::NEG; } }
        att2::pv_sub(tile, w0, p, o, lsum, lane);
    }
    bf16* O = (bf16*)(F.ws + WS_O) + (size_t)(sb + r0 * 64 + 16 * g) * DM + 384 + 64 * h; float* SQ = (float*)(F.ws + WS_SSQA) + (size_t)(sb + r0 * 64 + 16 * g) * 4 + 1;
    att2::out_final(o, lsum, (att::lptr)(F.lds + att2::L_WSCR + w * att2::WSCR), [=](int q) { return O + (size_t)((q >> 4) * 64 + (q & 15)) * DM; }, [=](int q) { return SQ + (size_t)((q >> 4) * 64 + (q & 15)) * 4; }, lane);
    ATT2_WAITBAR(0);
}

struct BandU { long sb; int T, qs, L, cls, s0; };
__device__ __forceinline__ BandU band_unit(int tt, int qs) {
    BandU u; int j, nt; if (tt < TP / 256) { u.sb = 0; u.T = TP; j = tt; nt = TP / 256; } else { const int q = tt - TP / 256, b = q / (TS / 256); u.sb = TP + (long)b * TS; u.T = TS; j = q - b * (TS / 256); nt = TS / 256; }
    const int nb = nt / qs; u.qs = qs; u.L = u.T / qs; u.cls = j / nb; u.s0 = 256 * (j - u.cls * nb); return u;
}
__device__ __forceinline__ void att2_unit_A(Frame& F, int ud, int pat) {
    const int h = ud / (MTOK / 512), tt = 2 * (ud - h * (MTOK / 512)), qs = pat == 0 ? 16 : (pat == 1 ? 4 : 1);
    const BandU ux = band_unit(tt, qs), uy = band_unit(tt + 1, qs);
    const int w = F.wave, lane = F.lane, r32 = lane & 31;
    const bf16* QKV = (const bf16*)(F.ws + WS_QKV);
    const bf16* Qh = QKV + (size_t)(0 + h) * MTOK * 64; const bf16* Kh = QKV + (size_t)(6 + h) * MTOK * 64; const bf16* Vh = QKV + (size_t)(12 + h) * MTOK * 64;
    att2::TileSrc tx{Kh + ux.sb * 64, Vh + ux.sb * 64, 0, qs, ux.T}, ty{Kh + uy.sb * 64, Vh + uy.sb * 64, 0, qs, uy.T};
    const int px = ux.cls + (ux.s0 - 64) * qs, py = uy.cls + (uy.s0 - 64) * qs;
    LAS unsigned char* ring = F.lds + att2::L_RING;
#define ATT2_ISSUE(st) do { LAS unsigned char* sl_ = ring + ((st) % att2::NS) * att2::SLOT; tx.p0 = px + 64 * (st) * qs; ty.p0 = py + 64 * (((st) + 3) % 6) * qs; \
        att2::dma_tile(sl_, tx, w, lane); att2::dma_tile(sl_ + att2::TILE, ty, w, lane); } while (0)
    ATT2_ISSUE(0); ATT2_ISSUE(1);
    att::bf16x8 qx[4], qy[4];
    att::load_q(qx, Qh + (size_t)(ux.sb + ux.cls + (ux.s0 + 32 * w + r32) * qs) * 64, lane);
    att::load_q(qy, Qh + (size_t)(uy.sb + uy.cls + (uy.s0 + 32 * w + r32) * qs) * 64, lane);
    att::f32x16 ox[2] = {}, oy[2] = {}; float lx = 0.f, ly = 0.f;
#pragma unroll 1
    for (int s = 0; s < 6; ++s) {
        if (s < 5) { ATT2_WAITBAR(4); } else { ATT2_WAITBAR(0); }
        if (s + 2 < 6) ATT2_ISSUE(s + 2);
        att::lptr tX = (att::lptr)(ring + (s % att2::NS) * att2::SLOT), tY = tX + att2::TILE;
        const int sy = (s + 3) % 6;
#pragma unroll
        for (int hf = 0; hf < 2; ++hf) {
            const int gx = 2 * s + hf, gy = 2 * sy + hf;
            const bool ax = (unsigned)(gx - w) <= 4u, ay = (unsigned)(gy - w) <= 4u;
            att::f32x16 pxx, pyy;
            if (ax) pxx = att2::qk_sub(tX, 32 * hf, qx, lane);
            if (ay) pyy = att2::qk_sub(tY, 32 * hf, qy, lane);
            if (ax) { att2::mask_band(pxx, gx - w, ux.s0 - 64 + 32 * gx, ux.L, lane); att2::pv_sub(tX, 32 * hf, pxx, ox, lx, lane); }
            if (ay) { att2::mask_band(pyy, gy - w, uy.s0 - 64 + 32 * gy, uy.L, lane); att2::pv_sub(tY, 32 * hf, pyy, oy, ly, lane); }
        }
    }
#undef ATT2_ISSUE
    att::lptr scr = (att::lptr)(F.lds + att2::L_WSCR + w * att2::WSCR);
    __attribute__((address_space(3))) unsigned short* stg = (__attribute__((address_space(3))) unsigned short*)scr;
    __attribute__((address_space(3))) float* ls = (__attribute__((address_space(3))) float*)(scr + 4096);
    bf16* PB = (bf16*)(F.ws + WS_PART); float* PL = (float*)(F.ws + WS_PARTL);
#pragma unroll
    for (int side = 0; side < 2; ++side) {
        const BandU& u = side ? uy : ux;
        const long tok0 = u.sb + u.cls + (long)(u.s0 + 32 * w) * qs;
        att2::stage_rows(side ? oy : ox, side ? ly : lx, false, scr, lane);
        if (pat < 2) {
#pragma unroll
            for (int i = 0; i < 4; ++i) { const int row = i * 8 + (lane >> 3), ch = lane & 7; const att::u32x4 v = *(__attribute__((address_space(3))) att::u32x4*)(stg + row * 64 + ch * 8);
                *(att::u32x4*)(PB + ((size_t)pat * MTOK + tok0 + (long)row * qs) * 384 + 64 * h + ch * 8) = v; }
            if (lane < 32) PL[((size_t)pat * MTOK + tok0 + (long)lane * qs) * 8 + h] = ls[lane];
        } else {
#pragma unroll
            for (int i = 0; i < 4; ++i) { const int row = i * 8 + (lane >> 3), ch = lane & 7; const long tok = tok0 + row;
                const att::u32x4 v = *(__attribute__((address_space(3))) att::u32x4*)(stg + row * 64 + ch * 8);
                const att::u32x4 a = *(const att::u32x4*)(PB + ((size_t)tok) * 384 + 64 * h + ch * 8), b = *(const att::u32x4*)(PB + ((size_t)MTOK + tok) * 384 + 64 * h + ch * 8);
                const float rl = __builtin_amdgcn_rcpf(ls[row] + PL[(size_t)tok * 8 + h] + PL[((size_t)MTOK + tok) * 8 + h]);
                att::u32x4 ov; float ss = 0.f;
#pragma unroll
                for (int e = 0; e < 4; ++e) { const float x0 = (bflo(v[e]) + bflo(a[e]) + bflo(b[e])) * rl, x1 = (bfhi(v[e]) + bfhi(a[e]) + bfhi(b[e])) * rl; ov[e] = pk2(x0, x1);
                    const float y0 = bflo(ov[e]), y1 = bfhi(ov[e]); ss += y0 * y0 + y1 * y1; }
                ss += __shfl_xor(ss, 1); ss += __shfl_xor(ss, 2); ss += __shfl_xor(ss, 4);
                *(att::u32x4*)((bf16*)(F.ws + WS_O) + (size_t)tok * DM + 64 * h + ch * 8) = ov;
                if (ch == 0) unsafeAtomicAdd((float*)(F.ws + WS_SSQA) + (size_t)tok * 4 + 0, ss); }
        }
    }
    ATT2_WAITBAR(0);
}
__device__ __forceinline__ void att2_phase_a(Frame& F, const Args& A) {
    const int NU = 2 * N2_A + N2_B;
    for (int u = blockIdx.x; u < NU; u += F.G) {
        const int k = (u + (u >> 8)) & 3, i = u >> 2;
        if (k == 0) att2_unit_A(F, i, 0); else if (k == 1) att2_unit_A(F, i, 1); else att2_unit_B(F, A, 2 * i + (k - 2));
    }
}
__device__ __forceinline__ void att2_phase_b(Frame& F, const Args& A) {
    const int NU = N2_A + N2_M;
    for (int u = blockIdx.x; u < NU; u += F.G) {
        const int gq = u / 7, k = u - 7 * gq;
        if (k < 3) att2_unit_A(F, 3 * gq + k, 2); else att2_unit_M(F, 4 * gq + (k - 3));
    }
}
__global__ void __launch_bounds__(NWAVES * 64, 2) skel_fwd(Args args) {
    extern __shared__ __attribute__((aligned(16))) unsigned char lds[];
    cg::grid_group grid = cg::this_grid();
    Frame F;
    F.lds = (LAS unsigned char*)lds;
    F.tid = threadIdx.x; F.lane = F.tid & 63; F.wave = __builtin_amdgcn_readfirstlane(F.tid >> 6);
    F.G = gridDim.x; { const int bx = blockIdx.x; F.vcu = (F.G % 8 == 0) ? (bx % 8) * (F.G / 8) + bx / 8 : bx; }
    F.out = args.out; F.ws = args.ws; F.tm = -1; F.nostore = false; F.what = 7;
    unsigned char* ws = args.ws;
    const int lo = args.ph_lo, hi = args.ph_hi;
    volatile LAS unsigned* bst = (volatile LAS unsigned*)(F.lds + LDS_MISC);
    if (F.tid < 2) bst[F.tid] = 0u;
    __syncthreads();
    XcdBarrier bar = xcd_barrier_post((unsigned*)(ws + WS_CTL) + CW_BAR, bst);
    if (lo < 0) grid.sync();
#define IN(k) (lo <= (k) && (k) < hi)
#define BOTH(k) (IN(k) && IN((k) + 1))
#define GRID_BAR() xcd_barrier(bar)

    if (IN(0)) { p0_prologue(F, args); if (BOTH(0)) GRID_BAR(); }

    if (IN(1)) {
        {
            pg8::Gemm g{(const pg8::bf16_t*)(ws + WS_XN), (const pg8::bf16_t*)(ws + WS_WIN), MTOK, NQKV, DM}; pg8::StaticOrder S; S.init(MTOK, NQKV, F.G, (int)blockIdx.x);
            pg8::EpiQKV E{(pg8::bf16_t*)(ws + WS_QKV), args.in[6], args.in[7], args.in[8], args.in[9], args.in[13], (const float*)(ws + WS_ROPE), (const float*)(ws + WS_ROPE) + TP * 8};
            pg8::gemm_phase<pg8::EpiQKV, pg8::StaticOrder, true, true>(F.lds, g, S, E);
        }
        {
            pg8::Gemm g{(const pg8::bf16_t*)(ws + WS_XNMEM), (const pg8::bf16_t*)(ws + WS_WMEM), MMEM, 512, DM}; pg8::StaticOrder S; S.init(MMEM, 512, F.G, F.G - 1 - (int)blockIdx.x);
            pg8::EpiMemKV E{(pg8::bf16_t*)(ws + WS_MK), (pg8::bf16_t*)(ws + WS_MV), args.in[14]};
            pg8::gemm_phase<pg8::EpiMemKV, pg8::StaticOrder, true, true>(F.lds, g, S, E);
        }
        if (BOTH(1)) GRID_BAR();
    }

#if ATT_V2
    if (IN(2)) { att2_phase_a(F, args); if (BOTH(2)) GRID_BAR(); }
    if (IN(3)) { att2_phase_b(F, args); if (BOTH(3)) GRID_BAR(); }
#else
    if (IN(2)) { attn_phase(F, args); if (PROBE_MODE) { F.nostore = true; F.tm = (PROBE_MODE & 2) ? 0 : -1; F.what = PROBE_WHAT; attn_phase(F, args); F.nostore = false; F.tm = -1; F.what = 7; } if (!(ATT_A_MFMA && ATT_B_MFMA && ATT_M_MFMA)) attn_simple_phase(F, args); if (BOTH(2)) GRID_BAR(); }

    if (IN(3)) { if (BOTH(3)) GRID_BAR(); }
#endif

    if (IN(4)) {
        pg8::Gemm g{(const pg8::bf16_t*)(ws + WS_O), (const pg8::bf16_t*)(ws + WS_WOUT), MTOK, DM, DM}; pg8::StaticOrder S; S.init(MTOK, DM, F.G, (int)blockIdx.x);
        pg8::EpiX1 E{args.in[0], args.in[1], F.out, (pg8::bf16_t*)(ws + WS_X1B), (float*)(ws + WS_SSQF), (const float*)(ws + WS_SSQA)};
        pg8::gemm_phase<pg8::EpiX1, pg8::StaticOrder, true, true>(F.lds, g, S, E);
        if (BOTH(4)) GRID_BAR();
    }

    if (IN(5)) {
        pg8::Gemm g{(const pg8::bf16_t*)(ws + WS_X1B), (const pg8::bf16_t*)(ws + WS_W1), MTOK, FF, DM}; pg8::StaticOrder S; S.init(MTOK, FF, F.G, (int)blockIdx.x);
        pg8::EpiH E{(pg8::bf16_t*)(ws + WS_H), (const float*)(ws + WS_SSQF)};
        pg8::gemm_phase<pg8::EpiH, pg8::StaticOrder, true, true>(F.lds, g, S, E);
        if (BOTH(5)) GRID_BAR();
    }

    if (IN(6)) {
        pg8::Gemm g{(const pg8::bf16_t*)(ws + WS_H), (const pg8::bf16_t*)(ws + WS_W2), MTOK, DM, FF}; pg8::StaticOrder S; S.init(MTOK, DM, F.G, (int)blockIdx.x);
        pg8::EpiOut E{F.out};
        pg8::gemm_phase<pg8::EpiOut, pg8::StaticOrder, true, true>(F.lds, g, S, E);
    }
#undef IN
#undef BOTH
}

extern "C" void kernel_launch(void* const* d_in, const int* in_sizes, int n_in, void* d_out, int out_size, void* d_ws, size_t ws_size, hipStream_t stream) {
    static int grid = 0;
    if (grid == 0) {
        if (n_in != 22 || in_sizes[0] != TP * DM || in_sizes[1] != NBS * TS * DM || out_size != MTOK * DM || ws_size < WS_END) {
            fprintf(stderr, "kernel_launch: unexpected shapes / workspace (n_in %d, in0 %d, out %d, ws %zu); nothing launched\n", n_in, n_in > 0 ? in_sizes[0] : -1, out_size, ws_size); grid = -1; return; }
        int dev = 0, cus = 0, per_cu = 0;
        if (hipGetDevice(&dev) != hipSuccess || hipDeviceGetAttribute(&cus, hipDeviceAttributeMultiprocessorCount, dev) != hipSuccess) { grid = -1; return; }
        if (hipFuncSetAttribute((const void*)skel_fwd, hipFuncAttributeMaxDynamicSharedMemorySize, LDS_BYTES) != hipSuccess) { fprintf(stderr, "kernel_launch: hipFuncSetAttribute failed\n"); grid = -1; return; }
        if (hipOccupancyMaxActiveBlocksPerMultiprocessor(&per_cu, (const void*)skel_fwd, NWAVES * 64, LDS_BYTES) != hipSuccess || per_cu < 1) { fprintf(stderr, "kernel_launch: occupancy query says %d\n", per_cu); (void)hipGetLastError(); grid = -1; return; }
        grid = cus * per_cu;
    }
    if (grid < 0) return;
    if (hipMemsetAsync((char*)d_ws + WS_CTL, 0, CTL_ZERO_BYTES, stream) != hipSuccess) return;
    Args a{};
    for (int i = 0; i < 22; ++i) a.in[i] = (const float*)d_in[i];
    a.out = (float*)d_out; a.ws = (unsigned char*)d_ws;
    if (N_LAUNCHES == 1) {
        a.ph_lo = 0; a.ph_hi = NPH;
        void* kargs[] = {&a};
        hipError_t e = hipLaunchCooperativeKernel((const void*)skel_fwd, dim3(grid), dim3(NWAVES * 64), kargs, LDS_BYTES, stream);
        if (e != hipSuccess) fprintf(stderr, "kernel_launch: cooperative launch failed: %s (grid %d)\n", hipGetErrorString(e), grid);
    } else {
        for (int li = 0; li < NPH; ++li) { a.ph_lo = li; a.ph_hi = li + 1; hipLaunchKernelGGL(skel_fwd, dim3(grid), dim3(NWAVES * 64), LDS_BYTES, stream, a); }
    }
}
```

```cpp
#include <hip/hip_runtime.h>
#include <hip/hip_cooperative_groups.h>
#include <cstdio>
#include <cstdint>
namespace cg = cooperative_groups;

constexpr int DM = 1024, TP = 16384, TS = 8192, NBS = 4, MTOK = TP + NBS * TS;
constexpr int NQKV = 2560, NHEADS = 40, FF = 4096, NMEM = 256, NBATCH = 1 + NBS, MMEM = NBATCH * NMEM;
constexpr float RMS_EPS = 1e-6f;
constexpr float LOG2E = 1.4426950408889634f;
constexpr float QSCALE = 0.125f * LOG2E;
#ifndef ATT_A_MFMA
#define ATT_A_MFMA 1
#endif
#ifndef ATT_B_MFMA
#define ATT_B_MFMA 1
#endif
#ifndef ATT_M_MFMA
#define ATT_M_MFMA 1
#endif
#ifndef PROBE_MODE
#define PROBE_MODE 0
#endif
#ifndef PROBE_WHAT
#define PROBE_WHAT 4
#endif
#ifndef ATT_V2
#define ATT_V2 1
#endif
#ifndef PROBE_SEQ
#define PROBE_SEQ 0
#endif
namespace pg8 {
#define PG8_LAS __attribute__((address_space(3)))
typedef unsigned short bf16_t;
typedef short bf16x8 __attribute__((ext_vector_type(8)));
typedef float f32x4 __attribute__((ext_vector_type(4)));
typedef unsigned u32x4 __attribute__((ext_vector_type(4)));
constexpr int BM = 256, BK = 64, HALF = 128, HTB = HALF * BK * 2  , STAGE_BYTES = 8 * HTB, NXCD = 8, WGM = 8;

__host__ __device__ __forceinline__ int lds_byte(int r, int c) { const int st = (r >> 4) * 2 + (c >> 5), rr = r & 15, cc = c & 31, ob = rr * 64 + cc * 2; return st * 1024 + (ob ^ (((ob >> 9) & 1) << 5)); }
__host__ __device__ __forceinline__ void stage_rc(int b, int& R, int& C) { const int st = b / 1024, sb = b % 1024, swz = sb ^ (((sb >> 9) & 1) << 5); R = (st >> 1) * 16 + swz / 64; C = (st & 1) * 32 + (swz % 64) / 2; }
__host__ __device__ __forceinline__ int perm32(int rho) { const int n = rho >> 4, i = rho & 15; return 8 * (i >> 2) + 4 * n + (i & 3); }

struct Unit { int pm, pn; };
struct Gemm { const bf16_t* A; const bf16_t* Bt; int M, N, K; };

struct StaticOrder {
    int nM, nN, nwg, G, c;
    __host__ __device__ void init(int M, int N, int G_, int c_) { nM = M / BM; nN = N / BM; nwg = nM * nN; G = G_; c = c_; }
    __host__ __device__ bool next(int i, Unit& u) const {
        const long L = (long)i * G + c; if (L >= nwg) return false;
        int wgid = (int)L; { const int q = nwg / NXCD, r = nwg % NXCD, xcd = wgid % NXCD, off = wgid / NXCD; wgid = (xcd < r ? xcd * (q + 1) : r * (q + 1) + (xcd - r) * q) + off; }
        const int nig = WGM * nN, gid = wgid / nig, fm = gid * WGM, gsz = (nM - fm) < WGM ? (nM - fm) : WGM;
        u.pm = fm + ((wgid % nig) % gsz); u.pn = (wgid % nig) / gsz; return true;
    }
    __device__ __forceinline__ void a_ready(const Unit&) const {}
    __device__ __forceinline__ void done(const Unit&) const {}
};

__device__ __forceinline__ unsigned cvt_pk_bf16(float lo, float hi) { unsigned r; asm volatile("v_cvt_pk_bf16_f32 %0, %1, %2" : "=v"(r) : "v"(lo), "v"(hi)); return r; }
typedef float f32x2 __attribute__((ext_vector_type(2)));
__device__ __forceinline__ float sq4(const f32x4 v) { return (v[0] * v[0] + v[1] * v[1]) + (v[2] * v[2] + v[3] * v[3]); }
__device__ __forceinline__ u32x4 pack8(const f32x4 a, const f32x4 b) { u32x4 w; w.x = cvt_pk_bf16(a[0], a[1]); w.y = cvt_pk_bf16(a[2], a[3]); w.z = cvt_pk_bf16(b[0], b[1]); w.w = cvt_pk_bf16(b[2], b[3]); return w; }

struct EpiQKV {
    static constexpr bool PERM = true, AFTER_DRAIN = false, KSCALE = false; static constexpr int KS_T1 = -1, KS_T2 = -1;
    bf16_t* QKV;
    const float *gqa, *gka, *gqb, *gkb, *gqm;
    const float *rc, *rs;
    __device__ __forceinline__ void operator()(const f32x4 (&acc)[2][2][4][2], const Unit& u, int wr, int wc, int fr, int fq) const {
        const int hidx = u.pn * 4 + wc;
        const float* gain = nullptr; bool rope = false; float qs = 1.f;
        if (hidx < 6) { gain = gqa; rope = true; qs = QSCALE; } else if (hidx < 12) { gain = gka; rope = true; } else if (hidx < 18) { } else if (hidx < 24) { gain = gqb; qs = QSCALE; }
        else if (hidx < 30) { gain = gkb; } else if (hidx < 36) { } else { gain = gqm; qs = QSCALE; }
        const bool rl = rope && fq < 2;
        f32x4 g[2][2];
#pragma unroll
        for (int bj = 0; bj < 2; ++bj)
#pragma unroll
            for (int n = 0; n < 2; ++n) { const int d0 = (rl && bj == 0) ? (8 * n + 4 * fq) : (32 * bj + 8 * fq + 4 * n); g[bj][n] = gain ? *(const f32x4*)(gain + d0) : (f32x4){1.f, 1.f, 1.f, 1.f}; }
        bf16_t* base = QKV + (size_t)hidx * MTOK * 64 + 8 * fq;
#pragma unroll
        for (int ai = 0; ai < 2; ++ai)
#pragma unroll
            for (int m = 0; m < 4; ++m) {
                const int row = u.pm * BM + ai * HALF + wr * 64 + m * 16 + fr;
                f32x4 v[2][2];
#pragma unroll
                for (int bj = 0; bj < 2; ++bj)
#pragma unroll
                    for (int n = 0; n < 2; ++n) v[bj][n] = acc[ai][bj][m][n];
                if (gain) {
                    float ss = (sq4(v[0][0]) + sq4(v[0][1])) + (sq4(v[1][0]) + sq4(v[1][1]));
                    ss += __shfl_xor(ss, 16); ss += __shfl_xor(ss, 32);
                    const float r = rsqrtf(ss * (1.f / 64.f) + RMS_EPS) * qs;
#pragma unroll
                    for (int bj = 0; bj < 2; ++bj)
#pragma unroll
                        for (int n = 0; n < 2; ++n) v[bj][n] = v[bj][n] * r * g[bj][n];
                    if (rope) {
                        const int pos = row < TP ? row : ((row - TP) & (TS - 1));
                        const f32x4 c = *(const f32x4*)(rc + pos * 8 + 4 * (fq & 1)), s = *(const f32x4*)(rs + pos * 8 + 4 * (fq & 1));
                        if (fq < 2) { const f32x4 x1 = v[0][0], x2 = v[0][1]; v[0][0] = x1 * c - x2 * s; v[0][1] = x2 * c + x1 * s; }
                    }
                }
                bf16_t* rowp = base + (size_t)row * 64;
                *(u32x4*)(rowp) = pack8(v[0][0], v[0][1]);
                *(u32x4*)(rowp + 32) = pack8(v[1][0], v[1][1]);
            }
    }
};
struct EpiMemKV {
    static constexpr bool PERM = true, AFTER_DRAIN = false, KSCALE = false; static constexpr int KS_T1 = -1, KS_T2 = -1;
    bf16_t* MK; bf16_t* MV; const float* gk;
    __device__ __forceinline__ void operator()(const f32x4 (&acc)[2][2][4][2], const Unit& u, int wr, int wc, int fr, int fq) const {
        const int hidx = u.pn * 4 + wc; const bool isk = hidx < 4; const int h = hidx & 3;
        f32x4 g[2][2];
#pragma unroll
        for (int bj = 0; bj < 2; ++bj)
#pragma unroll
            for (int n = 0; n < 2; ++n) g[bj][n] = isk ? *(const f32x4*)(gk + 32 * bj + 8 * fq + 4 * n) : (f32x4){1.f, 1.f, 1.f, 1.f};
        bf16_t* base = (isk ? MK : MV) + 8 * fq;
#pragma unroll
        for (int ai = 0; ai < 2; ++ai)
#pragma unroll
            for (int m = 0; m < 4; ++m) {
                const int row = u.pm * BM + ai * HALF + wr * 64 + m * 16 + fr;
                f32x4 v[2][2];
#pragma unroll
                for (int bj = 0; bj < 2; ++bj)
#pragma unroll
                    for (int n = 0; n < 2; ++n) v[bj][n] = acc[ai][bj][m][n];
                if (isk) {
                    float ss = (sq4(v[0][0]) + sq4(v[0][1])) + (sq4(v[1][0]) + sq4(v[1][1]));
                    ss += __shfl_xor(ss, 16); ss += __shfl_xor(ss, 32);
                    const float r = rsqrtf(ss * (1.f / 64.f) + RMS_EPS);
#pragma unroll
                    for (int bj = 0; bj < 2; ++bj)
#pragma unroll
                        for (int n = 0; n < 2; ++n) v[bj][n] = v[bj][n] * r * g[bj][n];
                }
                bf16_t* rowp = base + ((size_t)((row >> 8) * 4 + h) * NMEM + (row & 255)) * 64;
                *(u32x4*)(rowp) = pack8(v[0][0], v[0][1]);
                *(u32x4*)(rowp + 32) = pack8(v[1][0], v[1][1]);
            }
    }
};
struct EpiX1 {
    static constexpr bool PERM = true, AFTER_DRAIN = false, KSCALE = true; static constexpr int KS_T1 = 6, KS_T2 = 12;
    const float* xp; const float* xs; float* out; bf16_t* x1b; float* ssq; const float* ssqa;
    static constexpr int TBL_OFF = 131072;
    __device__ __forceinline__ void prep(const Unit& u, PG8_LAS unsigned char* lds, int idx, int tid) const {
        if (tid < BM) { const f32x4 q = *(const f32x4*)(ssqa + (size_t)(u.pm * BM + tid) * 4);
            const float sa = rsqrtf(q[0] * (1.f / 384.f) + RMS_EPS), sb = rsqrtf(q[1] * (1.f / 384.f) + RMS_EPS), sm = rsqrtf(q[2] * (1.f / 256.f) + RMS_EPS);
            *(PG8_LAS f32x4*)(lds + TBL_OFF + (idx & 1) * 4096 + tid * 16) = (f32x4){sa / sb, sb / sm, sm, 0.f}; }
    }
    __device__ __forceinline__ void kscale(f32x4 (&acc)[2][2][4][2], int t, int wr, int fr, PG8_LAS unsigned char* lds, int idx) const {
        const PG8_LAS float* tb = (const PG8_LAS float*)(lds + TBL_OFF + (idx & 1) * 4096) + ((t == KS_T1) ? 0 : 1);
#pragma unroll
        for (int ai = 0; ai < 2; ++ai)
#pragma unroll
            for (int m = 0; m < 4; ++m) {
                const float f = tb[(ai * HALF + wr * 64 + m * 16 + fr) * 4];
#pragma unroll
                for (int bj = 0; bj < 2; ++bj)
#pragma unroll
                    for (int n = 0; n < 2; ++n) acc[ai][bj][m][n] = acc[ai][bj][m][n] * f;
            }
    }
    __device__ __forceinline__ void epi(const f32x4 (&acc)[2][2][4][2], const Unit& u, int wr, int wc, int fr, int fq, PG8_LAS unsigned char* lds, int idx) const {
        const PG8_LAS float* tb = (const PG8_LAS float*)(lds + TBL_OFF + (idx & 1) * 4096) + 2;
        const int col0 = u.pn * BM + wc * 32 + 8 * fq;
#pragma unroll
        for (int ai = 0; ai < 2; ++ai)
#pragma unroll
            for (int m = 0; m < 4; ++m) {
                const int row = u.pm * BM + ai * HALF + wr * 64 + m * 16 + fr;
                const float sm = tb[(ai * HALF + wr * 64 + m * 16 + fr) * 4];
                const float* xrow = (row < TP ? xp + (size_t)row * DM : xs + (size_t)(row - TP) * DM) + col0;
                bf16_t* brow = x1b + (size_t)row * DM + col0;
                float ss = 0.f;
#pragma unroll
                for (int bj = 0; bj < 2; ++bj) {
                    const f32x4 v0 = acc[ai][bj][m][0] * sm + *(const f32x4*)(xrow + bj * HALF), v1 = acc[ai][bj][m][1] * sm + *(const f32x4*)(xrow + bj * HALF + 4);
                    *(u32x4*)(brow + bj * HALF) = pack8(v0, v1);
                    ss += sq4(v0) + sq4(v1);
                }
                ss += __shfl_xor(ss, 16); ss += __shfl_xor(ss, 32);
                if (fq == 0) unsafeAtomicAdd(ssq + row, ss);
            }
    }
};
struct EpiH {
    static constexpr bool PERM = true, AFTER_DRAIN = false, KSCALE = false; static constexpr int KS_T1 = -1, KS_T2 = -1;
    bf16_t* H; const float* ssq; int mode;
    __device__ __forceinline__ void operator()(const f32x4 (&acc)[2][2][4][2], const Unit& u, int wr, int wc, int fr, int fq) const {
        if (mode == 2) return;
        const int col0 = u.pn * BM + wc * 32 + 8 * fq;
#pragma unroll
        for (int ai = 0; ai < 2; ++ai)
#pragma unroll
            for (int m = 0; m < 4; ++m) {
                const int row = u.pm * BM + ai * HALF + wr * 64 + m * 16 + fr;
                const float r = rsqrtf(ssq[row] * (1.f / DM) + RMS_EPS);
                bf16_t* hrow = H + (size_t)row * FF + col0;
#pragma unroll
                for (int bj = 0; bj < 2; ++bj) {
                    f32x4 v0 = acc[ai][bj][m][0] * r, v1 = acc[ai][bj][m][1] * r;
#pragma unroll
                    for (int e = 0; e < 4; ++e) { const float a = fmaxf(v0[e], 0.f), b = fmaxf(v1[e], 0.f); v0[e] = a * a; v1[e] = b * b; }
                    const u32x4 pk = pack8(v0, v1); if (mode == 0) *(u32x4*)(hrow + bj * HALF) = pk; else asm volatile("" :: "v"(pk));
                }
            }
    }
};
struct EpiOut {
    static constexpr bool PERM = true, AFTER_DRAIN = false, KSCALE = false; static constexpr int KS_T1 = -1, KS_T2 = -1;
    float* out; const bf16_t* x1b;
    __device__ __forceinline__ void operator()(const f32x4 (&acc)[2][2][4][2], const Unit& u, int wr, int wc, int fr, int fq) const {
        const int col0 = u.pn * BM + wc * 32 + 8 * fq;
#pragma unroll
        for (int ai = 0; ai < 2; ++ai)
#pragma unroll
            for (int m = 0; m < 4; ++m) {
                const int row = u.pm * BM + ai * HALF + wr * 64 + m * 16 + fr;
                float* orow = out + (size_t)row * DM + col0; const bf16_t* brow = x1b + (size_t)row * DM + col0;
#pragma unroll
                for (int bj = 0; bj < 2; ++bj) {
                    const u32x4 r = *(const u32x4*)(brow + bj * HALF);
                    const f32x4 r0 = {__uint_as_float(r.x << 16), __uint_as_float(r.x & 0xffff0000u), __uint_as_float(r.y << 16), __uint_as_float(r.y & 0xffff0000u)};
                    const f32x4 r1 = {__uint_as_float(r.z << 16), __uint_as_float(r.z & 0xffff0000u), __uint_as_float(r.w << 16), __uint_as_float(r.w & 0xffff0000u)};
                    *(f32x4*)(orow + bj * HALF) = acc[ai][bj][m][0] + r0; *(f32x4*)(orow + bj * HALF + 4) = acc[ai][bj][m][1] + r1;
                }
            }
    }
};

template <class Epi, class Sched, bool ALIGN_EPI = false, bool SP2 = false>
__device__ __forceinline__ void gemm_phase(PG8_LAS unsigned char* lds, const Gemm g, const Sched& S, const Epi& E) {
    const int tid = threadIdx.x, wid = __builtin_amdgcn_readfirstlane(tid >> 6), lane = tid & 63, wr = wid >> 2, wc = wid & 3, fr = lane & 15, fq = lane >> 4;
    const int K = g.K, nt = K / BK;
    unsigned voffA[2], voffB[2];
#pragma unroll
    for (int i = 0; i < 2; ++i) { int R, C; stage_rc(tid * 16 + i * 8192, R, C); const int Rb = Epi::PERM ? ((R & ~31) + perm32(R & 31)) : R;
        voffA[i] = (unsigned)(R * K + C) * 2u; voffB[i] = (unsigned)(Rb * K + C) * 2u; }
    const size_t kstep = (size_t)(BK * 2);
    const size_t hstep = (size_t)HALF * K * 2;
    const size_t tstep = 2 * hstep;
    const unsigned ldsw = (unsigned)wid * 1024u;
    const int aoff = lds_byte(wr * 64 + fr, fq * 8), boff = lds_byte(wc * 32 + fr, fq * 8);
#define PG8_SA(b, h) (((b) * 2 + (h)) * HTB)
#define PG8_SB(b, h) ((4 + (b) * 2 + (h)) * HTB)
#define PG8_STAGE(bufoff, gbase, voff) do { _Pragma("unroll") for (int _i = 0; _i < 2; ++_i) \
        __builtin_amdgcn_global_load_lds((const unsigned*)((const char*)(gbase) + (voff)[_i]), (PG8_LAS unsigned*)(lds + (bufoff) + ldsw + _i * 8192), 16, 0, 0); } while (0)
#define PG8_LDA(dst, b, h) do { _Pragma("unroll") for (int m = 0; m < 4; ++m) _Pragma("unroll") for (int k = 0; k < 2; ++k) dst[m][k] = *(const PG8_LAS bf16x8*)(lds + PG8_SA(b, h) + aoff + m * 2048 + k * 1024); } while (0)
#define PG8_LDB(dst, b, h) do { _Pragma("unroll") for (int n = 0; n < 2; ++n) _Pragma("unroll") for (int k = 0; k < 2; ++k) dst[n][k] = *(const PG8_LAS bf16x8*)(lds + PG8_SB(b, h) + boff + n * 2048 + k * 1024); } while (0)
#define PG8_MMA(ai, bj, At, Bt) do { __builtin_amdgcn_s_setprio(1); _Pragma("unroll") for (int m = 0; m < 4; ++m) _Pragma("unroll") for (int n = 0; n < 2; ++n) _Pragma("unroll") for (int k = 0; k < 2; ++k) \
        acc[ai][bj][m][n] = __builtin_amdgcn_mfma_f32_16x16x32_bf16(Bt[n][k], At[m][k], acc[ai][bj][m][n], 0, 0, 0); __builtin_amdgcn_s_setprio(0); } while (0)
#define PG8_WAIT_V(n) asm volatile("s_waitcnt vmcnt(" #n ")" ::: "memory")
#define PG8_WAIT_L(n) asm volatile("s_waitcnt lgkmcnt(" #n ")" ::: "memory")
#define PG8_BAR __builtin_amdgcn_s_barrier()
#define PG8_SCHED __builtin_amdgcn_sched_barrier(0)
    Unit cur, nxt; int ui = 0;
    if (!S.next(0, cur)) return;
    f32x4 acc[2][2][4][2];
#pragma unroll
    for (int a = 0; a < 2; ++a)
#pragma unroll
        for (int b = 0; b < 2; ++b)
#pragma unroll
            for (int m = 0; m < 4; ++m)
#pragma unroll
                for (int n = 0; n < 2; ++n) acc[a][b][m][n] = (f32x4){0.f, 0.f, 0.f, 0.f};
    bf16x8 At[4][2], B0[2][2], B1[2][2];
    const char* cA = (const char*)g.A + (size_t)cur.pm * tstep; const char* cB = (const char*)g.Bt + (size_t)cur.pn * tstep;
    S.a_ready(cur);
    if constexpr (Epi::KSCALE) E.prep(cur, lds, 0, tid);
    if constexpr (SP2) {
        PG8_STAGE(PG8_SB(0, 0), cB, voffB); PG8_STAGE(PG8_SB(0, 1), cB + hstep, voffB); PG8_STAGE(PG8_SA(0, 0), cA, voffA); PG8_STAGE(PG8_SA(0, 1), cA + hstep, voffA);
        if (wr == 1) PG8_BAR;
        PG8_WAIT_V(2); PG8_BAR;
        PG8_STAGE(PG8_SB(1, 0), cB + kstep, voffB); PG8_STAGE(PG8_SA(1, 0), cA + kstep, voffA); PG8_STAGE(PG8_SB(1, 1), cB + hstep + kstep, voffB);
        PG8_WAIT_V(6); PG8_BAR;
    } else {
        PG8_STAGE(PG8_SB(0, 0), cB, voffB); PG8_STAGE(PG8_SA(0, 0), cA, voffA); PG8_STAGE(PG8_SB(0, 1), cB + hstep, voffB); PG8_STAGE(PG8_SA(0, 1), cA + hstep, voffA);
        if (wr == 1) PG8_BAR;
        PG8_WAIT_V(4); PG8_BAR;
        PG8_STAGE(PG8_SB(1, 0), cB + kstep, voffB); PG8_STAGE(PG8_SA(1, 0), cA + kstep, voffA); PG8_STAGE(PG8_SB(1, 1), cB + hstep + kstep, voffB);
        PG8_WAIT_V(6); PG8_BAR;
    }
    for (;;) {
        const bool has_next = S.next(ui + 1, nxt);
        const char* nA = has_next ? (const char*)g.A + (size_t)nxt.pm * tstep : cA; const char* nB = has_next ? (const char*)g.Bt + (size_t)nxt.pn * tstep : cB;
        for (int t = 0; t < nt; t += 2) {
            const bool last = (t == nt - 2);
            if constexpr (Epi::KSCALE) { if (t == Epi::KS_T1 || t == Epi::KS_T2) E.kscale(acc, t, wr, fr, lds, ui); }
            const char* a1 = cA + (size_t)(t + 1) * kstep;
            const char* a2 = last ? nA : cA + (size_t)(t + 2) * kstep; const char* b2 = last ? nB : cB + (size_t)(t + 2) * kstep;
            const char* a3 = a2 + kstep; const char* b3 = b2 + kstep;
            if (last && has_next) { S.a_ready(nxt); if constexpr (Epi::KSCALE) E.prep(nxt, lds, ui + 1, tid); }
            if constexpr (SP2) {
            PG8_LDB(B0, 0, 0); PG8_LDB(B1, 0, 1); PG8_SCHED; PG8_LDA(At, 0, 0); PG8_STAGE(PG8_SA(1, 1), a1 + hstep, voffA);
            PG8_WAIT_V(8); PG8_WAIT_L(0); PG8_BAR; PG8_MMA(0, 0, At, B0); PG8_MMA(0, 1, At, B1); PG8_BAR; PG8_SCHED;
            PG8_LDA(At, 0, 1); PG8_STAGE(PG8_SB(0, 0), b2, voffB); PG8_STAGE(PG8_SB(0, 1), b2 + hstep, voffB); PG8_STAGE(PG8_SA(0, 0), a2, voffA);
            PG8_WAIT_V(8); PG8_WAIT_L(0); PG8_BAR; PG8_MMA(1, 0, At, B0); PG8_MMA(1, 1, At, B1); PG8_BAR; PG8_SCHED;
            PG8_LDB(B0, 1, 0); PG8_LDB(B1, 1, 1); PG8_SCHED; PG8_LDA(At, 1, 0); PG8_STAGE(PG8_SA(0, 1), a2 + hstep, voffA);
            PG8_WAIT_V(8); PG8_WAIT_L(0); PG8_BAR; PG8_MMA(0, 0, At, B0); PG8_MMA(0, 1, At, B1); PG8_BAR; PG8_SCHED;
            PG8_LDA(At, 1, 1); PG8_STAGE(PG8_SB(1, 0), b3, voffB); PG8_STAGE(PG8_SB(1, 1), b3 + hstep, voffB); PG8_STAGE(PG8_SA(1, 0), a3, voffA);
            PG8_WAIT_V(8); PG8_WAIT_L(0); PG8_BAR; PG8_MMA(1, 0, At, B0); PG8_MMA(1, 1, At, B1); PG8_BAR; PG8_SCHED;
            } else {
            PG8_LDB(B0, 0, 0); PG8_SCHED; PG8_LDA(At, 0, 0); PG8_STAGE(PG8_SA(1, 1), a1 + hstep, voffA);
            PG8_WAIT_L(8); PG8_BAR; PG8_WAIT_L(0); PG8_MMA(0, 0, At, B0); PG8_BAR; PG8_SCHED;
            PG8_LDB(B1, 0, 1); PG8_STAGE(PG8_SB(0, 0), b2, voffB);
            PG8_BAR; PG8_WAIT_L(0); PG8_MMA(0, 1, At, B1); PG8_BAR;
            PG8_LDA(At, 0, 1); PG8_STAGE(PG8_SA(0, 0), a2, voffA);
            PG8_BAR; PG8_WAIT_L(0); PG8_MMA(1, 0, At, B0); PG8_BAR; PG8_SCHED;
            PG8_STAGE(PG8_SB(0, 1), b2 + hstep, voffB);
            PG8_WAIT_V(6); PG8_BAR; PG8_MMA(1, 1, At, B1); PG8_BAR;
            PG8_LDB(B0, 1, 0); PG8_SCHED; PG8_LDA(At, 1, 0); PG8_STAGE(PG8_SA(0, 1), a2 + hstep, voffA);
            PG8_WAIT_L(8); PG8_BAR; PG8_WAIT_L(0); PG8_MMA(0, 0, At, B0); PG8_BAR; PG8_SCHED;
            PG8_LDB(B1, 1, 1); PG8_STAGE(PG8_SB(1, 0), b3, voffB);
            PG8_BAR; PG8_WAIT_L(0); PG8_MMA(0, 1, At, B1); PG8_BAR;
            PG8_LDA(At, 1, 1); PG8_STAGE(PG8_SA(1, 0), a3, voffA);
            PG8_BAR; PG8_WAIT_L(0); PG8_MMA(1, 0, At, B0); PG8_BAR; PG8_SCHED;
            PG8_STAGE(PG8_SB(1, 1), b3 + hstep, voffB);
            PG8_WAIT_V(6); PG8_BAR; PG8_MMA(1, 1, At, B1); PG8_BAR;
            }
        }
        if constexpr (ALIGN_EPI) { if (wr == 0) PG8_BAR; }
        if constexpr (!Epi::AFTER_DRAIN) { if constexpr (Epi::KSCALE) E.epi(acc, cur, wr, wc, fr, fq, lds, ui); else E(acc, cur, wr, wc, fr, fq); S.done(cur); }
        if (!has_next) break;
#pragma unroll
        for (int a = 0; a < 2; ++a)
#pragma unroll
            for (int b = 0; b < 2; ++b)
#pragma unroll
                for (int m = 0; m < 4; ++m)
#pragma unroll
                    for (int n = 0; n < 2; ++n) acc[a][b][m][n] = (f32x4){0.f, 0.f, 0.f, 0.f};
        cur = nxt; cA = nA; cB = nB; ++ui;
        if constexpr (ALIGN_EPI) { if (wr == 1) PG8_BAR; }
    }
    PG8_WAIT_V(0);
    if constexpr (!ALIGN_EPI) { if (wr == 0) PG8_BAR; }
    PG8_BAR;
    if constexpr (Epi::AFTER_DRAIN) { E.fused(acc, cur, wr, wc, fr, fq, lds, wid, lane); S.done(cur); }
#undef PG8_SA
#undef PG8_SB
#undef PG8_STAGE
#undef PG8_LDA
#undef PG8_LDB
#undef PG8_MMA
#undef PG8_WAIT_V
#undef PG8_WAIT_L
#undef PG8_BAR
#undef PG8_SCHED
}
}

constexpr int NWAVES = 8;
#ifndef MK_N_LAUNCHES
#define MK_N_LAUNCHES 1
#endif
constexpr int NPH = 7;
constexpr int N_LAUNCHES = MK_N_LAUNCHES;

constexpr size_t MiB = 1u << 20;
constexpr size_t WS_CTL = 0, WS_SSQF = 1 * MiB, WS_SSQA = 1 * MiB + 256 * 1024, CTL_ZERO_BYTES = 2 * MiB;
constexpr size_t WS_ROPE = 2 * MiB;
constexpr size_t WS_WIN = 3 * MiB, WS_WMEM = 8 * MiB, WS_WOUT = 9 * MiB, WS_W1 = 11 * MiB, WS_W2 = 19 * MiB;
constexpr size_t WS_XNMEM = 27 * MiB, WS_MK = 30 * MiB, WS_MV = 31 * MiB;
constexpr size_t WS_X1B = 32 * MiB;
constexpr size_t WS_XN = 128 * MiB, WS_O = 128 * MiB;
constexpr size_t WS_QKV = 224 * MiB;
constexpr size_t WS_H = 128 * MiB;
constexpr size_t WS_END = 512 * MiB;
static_assert(WS_QKV + (size_t)NHEADS * MTOK * 64 * 2 <= WS_END && WS_H + (size_t)MTOK * FF * 2 <= WS_END && WS_X1B + (size_t)MTOK * DM * 2 <= WS_XN && WS_XN + (size_t)MTOK * DM * 2 <= WS_QKV, "d_ws map");

constexpr int RING_BYTES = 131072;
constexpr int LDS_BYTES = 147456, LDS_MISC = LDS_BYTES - 128;
constexpr int CW_BAR = 4096, CW_ARANK = 8192;
constexpr int LDS_BYTES_UNUSED = 0;

#define LAS __attribute__((address_space(3)))
typedef unsigned short bf16;
typedef unsigned v4u __attribute__((ext_vector_type(4)));
typedef float f32x4 __attribute__((ext_vector_type(4)));
#define LDS_WAIT() asm volatile("s_waitcnt lgkmcnt(0)" ::: "memory")
__device__ __forceinline__ unsigned f2bf(float f) { unsigned u = __builtin_bit_cast(unsigned, f); return (u + 0x7fffu + ((u >> 16) & 1u)) >> 16; }
__device__ __forceinline__ unsigned pk2(float lo, float hi) { return f2bf(lo) | (f2bf(hi) << 16); }
__device__ __forceinline__ float bflo(unsigned w) { return __uint_as_float(w << 16); }
__device__ __forceinline__ float bfhi(unsigned w) { return __uint_as_float(w & 0xffff0000u); }
__device__ __forceinline__ float wave_sum(float v) {
#pragma unroll
    for (int o = 1; o < 64; o <<= 1) v += __shfl_xor(v, o);
    return v;
}

struct Frame {
    LAS unsigned char* lds;
    int tid, lane, wave, vcu, G, tm, what; bool nostore;
    float* out; unsigned char* ws;
};
struct Args { const float* in[22]; float* out; unsigned char* ws; int ph_lo, ph_hi; };


namespace att {
typedef short bf16x8 __attribute__((ext_vector_type(8)));
typedef short s16x4 __attribute__((ext_vector_type(4)));
typedef short v4i16_t __attribute__((ext_vector_type(4)));
typedef float f32x16 __attribute__((ext_vector_type(16)));
typedef float f32x4 __attribute__((ext_vector_type(4)));
typedef unsigned u32x4 __attribute__((ext_vector_type(4)));
typedef float f32x2_t __attribute__((ext_vector_type(2))); typedef __bf16 bf16x2_t __attribute__((ext_vector_type(2)));
typedef __attribute__((address_space(3))) unsigned char* lptr;
__device__ __forceinline__ unsigned cvtpk(float lo, float hi) { f32x2_t v = {lo, hi}; bf16x2_t b = __builtin_convertvector(v, bf16x2_t); return __builtin_bit_cast(unsigned, b); }
__device__ __forceinline__ s16x4 vtr(lptr p) { return __builtin_bit_cast(s16x4, __builtin_amdgcn_ds_read_tr16_b64_v4i16((__attribute__((address_space(3))) v4i16_t*)p)); }
__device__ __forceinline__ int creg(int r) { return (r & 3) + 8 * (r >> 2); }
constexpr float NEG = -INFINITY;

constexpr int VDH = 2112, TILE_V = 4096, TILE_BYTES = TILE_V + 2 * VDH;
template <class Spec> __device__ __forceinline__ void load_tile(const Spec& S, int t, u32x4 (&kn)[4], u32x4 (&vn)[4], int lane) {
#pragma unroll
    for (int j = 0; j < 4; ++j) { const int row = 8 * j + (lane >> 3); kn[j] = *(const u32x4*)(S.krow(t, row) + 8 * (lane & 7)); vn[j] = *(const u32x4*)(S.vrow(t, row) + 8 * (lane & 7)); }
}
template <int NJ, class Spec> __device__ __forceinline__ void run_tiles(const Spec& S, const bf16x8 (&qr)[NJ][4], f32x16 (&o)[NJ][2], float (&lsum)[NJ], lptr tb, int lane) {
    const int r32 = lane & 31, hi = lane >> 5;
    const int NT = S.ntiles();
    const int loff = TILE_V + ((lane >> 4) & 1) * 32 + (lane & 3) * 8 + (4 * hi + ((lane & 15) >> 2)) * 64;
    const int wrow = lane >> 3, wc = lane & 7;
    const int vwoff = TILE_V + (wc >> 2) * VDH + wrow * 64 + (wc & 3) * 16;
    u32x4 kn[4], vn[4];
    load_tile(S, 0, kn, vn, lane);
    for (int t = 0; t < NT; ++t) {
#pragma unroll
        for (int j = 0; j < 4; ++j) { const int row = 8 * j + wrow;
            *(__attribute__((address_space(3))) u32x4*)(tb + row * 128 + ((wc ^ ((row >> 1) & 7)) * 16)) = kn[j];
            *(__attribute__((address_space(3))) u32x4*)(tb + vwoff + j * 512) = vn[j]; }
        if (t + 1 < NT) load_tile(S, t + 1, kn, vn, lane);
        bf16x8 kf[4];
#pragma unroll
        for (int d0 = 0; d0 < 4; ++d0) kf[d0] = *(__attribute__((address_space(3))) bf16x8*)(tb + r32 * 128 + (((2 * d0 + hi) ^ ((r32 >> 1) & 7)) * 16));
        bf16x8 vf[2][2];
#pragma unroll
        for (int dh = 0; dh < 2; ++dh)
#pragma unroll
            for (int ks = 0; ks < 2; ++ks) { const s16x4 l0 = vtr(tb + dh * VDH + ks * 1024 + loff), h0 = vtr(tb + dh * VDH + ks * 1024 + 512 + loff);
                vf[dh][ks] = (bf16x8){l0[0], l0[1], l0[2], l0[3], h0[0], h0[1], h0[2], h0[3]}; }
#pragma unroll
        for (int jb = 0; jb < NJ; ++jb) {
            if (NJ > 1 && !S.active(jb, t)) continue;
            f32x16 p = {};
#pragma unroll
            for (int d0 = 0; d0 < 4; ++d0) p = __builtin_amdgcn_mfma_f32_32x32x16_bf16(kf[d0], qr[jb][d0], p, 0, 0, 0);
            S.mask(jb, t, p, lane);
            float sacc = 0.f;
#pragma unroll
            for (int r = 0; r < 16; ++r) { p[r] = __builtin_amdgcn_exp2f(p[r]); sacc += p[r]; }
            lsum[jb] += sacc;
            u32x4 pw0, pw1;
            pw0[0] = cvtpk(p[0], p[1]); pw0[1] = cvtpk(p[2], p[3]); pw0[2] = cvtpk(p[4], p[5]); pw0[3] = cvtpk(p[6], p[7]);
            pw1[0] = cvtpk(p[8], p[9]); pw1[1] = cvtpk(p[10], p[11]); pw1[2] = cvtpk(p[12], p[13]); pw1[3] = cvtpk(p[14], p[15]);
#pragma unroll
            for (int dh = 0; dh < 2; ++dh) {
                o[jb][dh] = __builtin_amdgcn_mfma_f32_32x32x16_bf16(__builtin_bit_cast(bf16x8, pw0), vf[dh][0], o[jb][dh], 0, 0, 0);
                o[jb][dh] = __builtin_amdgcn_mfma_f32_32x32x16_bf16(__builtin_bit_cast(bf16x8, pw1), vf[dh][1], o[jb][dh], 0, 0, 0);
            }
        }
    }
}
__device__ __forceinline__ void load_q(bf16x8 (&qr)[4], const bf16* qrow, int lane) {
    const int hi = lane >> 5;
#pragma unroll
    for (int d0 = 0; d0 < 4; ++d0) qr[d0] = *(const bf16x8*)(qrow + 16 * d0 + 8 * hi);
}
template <class RowFn, class SsqFn> __device__ __forceinline__ void store_out(const f32x16 (&o)[2], float lsum, lptr wbuf, const RowFn& orow, const SsqFn& ssqp, int lane, bool nostore = false) {
    const int r32 = lane & 31, hi = lane >> 5;
    lsum += __shfl_xor(lsum, 32);
    __attribute__((address_space(3))) float* ls = (__attribute__((address_space(3))) float*)(wbuf + 4096);
    if (hi == 0) ls[r32] = lsum;
    __attribute__((address_space(3))) unsigned short* stg = (__attribute__((address_space(3))) unsigned short*)wbuf;
    float rl[16];
#pragma unroll
    for (int g = 0; g < 4; ++g) { const f32x4 lv = *(__attribute__((address_space(3))) f32x4*)(ls + 8 * g + 4 * hi);
#pragma unroll
        for (int j = 0; j < 4; ++j) rl[4 * g + j] = __builtin_amdgcn_rcpf(lv[j]); }
#pragma unroll
    for (int r = 0; r < 16; ++r) { const int q = creg(r) + 4 * hi;
#pragma unroll
        for (int dh = 0; dh < 2; ++dh) stg[q * 64 + dh * 32 + r32] = (unsigned short)f2bf(o[dh][r] * rl[r]); }
#pragma unroll
    for (int i = 0; i < 4; ++i) { const int row = i * 8 + (lane >> 3), ch = lane & 7; const u32x4 v = *(__attribute__((address_space(3))) u32x4*)(stg + row * 64 + ch * 8);
        float ss = 0.f;
#pragma unroll
        for (int e = 0; e < 4; ++e) { const float a = bflo(v[e]), b = bfhi(v[e]); ss += a * a + b * b; }
        ss += __shfl_xor(ss, 1); ss += __shfl_xor(ss, 2); ss += __shfl_xor(ss, 4);
        if (!nostore) { *(u32x4*)(orow(row) + ch * 8) = v; if (ch == 0) unsafeAtomicAdd(ssqp(row), ss); } }
}

struct SpecM { const bf16* K; const bf16* V; int tm;
    __device__ __forceinline__ int ntiles() const { return 8; }
    __device__ __forceinline__ const bf16* krow(int t, int i) const { return K + (32 * (t & tm) + i) * 64; }
    __device__ __forceinline__ const bf16* vrow(int t, int i) const { return V + (32 * (t & tm) + i) * 64; }
    __device__ __forceinline__ bool active(int, int) const { return true; }
    __device__ __forceinline__ void mask(int, int, f32x16&, int) const {}
};
struct SpecB { const bf16* K; const bf16* V;
    int nt, rk0, w0;
    int rlo, dr0;
    int cb;
    const __attribute__((address_space(3))) float* tb;
    int tm;
    __device__ __forceinline__ int ntiles() const { return nt; }
    __device__ __forceinline__ const bf16* krow(int t, int i) const { return K + ((rk0 + (t & tm)) * 64 + w0 + i) * 64; }
    __device__ __forceinline__ const bf16* vrow(int t, int i) const { return V + ((rk0 + (t & tm)) * 64 + w0 + i) * 64; }
    __device__ __forceinline__ bool active(int, int) const { return true; }
    __device__ __forceinline__ void mask(int, int t, f32x16& p, int lane) const {
        const int hi = lane >> 5, rk = rk0 + t; const bool rok = (unsigned)(rk - rlo) < 8u;
        int dr = rk + dr0; dr = dr < 0 ? 0 : (dr > 14 ? 14 : dr);
        const __attribute__((address_space(3))) float* tp = tb + dr * 64 + 4 * hi; const int cbh = rok ? cb + 4 * hi : -4096;
#pragma unroll
        for (int h8 = 0; h8 < 2; ++h8) {
            float bv[8];
#pragma unroll
            for (int r = 0; r < 8; ++r) bv[r] = tp[creg(8 * h8 + r)];
#pragma unroll
            for (int r = 0; r < 8; ++r) { const float sb = p[8 * h8 + r] + bv[r]; p[8 * h8 + r] = ((unsigned)(cbh + creg(8 * h8 + r)) < 16u) ? sb : NEG; }
            asm volatile("" ::: "memory");
        }
    }
};
struct SpecA { const bf16* K; const bf16* V;
    int kp0, qs, tstep, imask, ishift, nt, T, tm;
    __device__ __forceinline__ int ntiles() const { return nt; }
    __device__ __forceinline__ int kpos(int t, int i) const { int p = kp0 + (tstep * (t & tm) + (i & imask)) * qs + (i >> ishift); return p < 0 ? 0 : (p >= T ? T - 1 : p); }
    __device__ __forceinline__ const bf16* krow(int t, int i) const { return K + kpos(t, i) * 64; }
    __device__ __forceinline__ const bf16* vrow(int t, int i) const { return V + kpos(t, i) * 64; }
    __device__ __forceinline__ bool active(int, int) const { return true; }
    __device__ __forceinline__ void mask(int, int t, f32x16& p, int lane) const {
        const int r32 = lane & 31, hi = lane >> 5, cq = r32 >> ishift, iq = r32 & imask;
        const int lo = kp0 + tstep * t * qs, hip = lo + imask * qs + (31 >> ishift);
        if (t == 0 || t == nt - 1 || ishift == 4) {
            const int base = tstep * t - iq + 4 * hi;
            const int b0 = (cq == 0) ? base : -4096, b1 = (cq == (16 >> ishift) ? base : -4096);
#pragma unroll
            for (int r = 0; r < 16; ++r) { if ((unsigned)((r < 8 ? b0 : b1) + (creg(r) & imask)) > 128u) p[r] = NEG; } }
        if (lo < 0 || hip >= T) {
            const int kb = lo + 4 * hi * qs;
#pragma unroll
            for (int r = 0; r < 16; ++r) { const int kp = kb + (creg(r) & imask) * qs + (creg(r) >> ishift); if ((unsigned)kp >= (unsigned)T) p[r] = NEG; } }
    }
};
}
template <class CM, class KS>
__device__ __forceinline__ void p0_transpose_item(const float* W, int K, int N, bf16* WT, LAS float* scr, int item, int lane, CM cm, KS ks) {
    const int nblk = N / 32, kb = item / nblk, nb = item % nblk, k0 = 64 * kb, n0 = 32 * nb;
    const int sc = cm(n0 + (lane & 31));
#pragma unroll 8
    for (int i = 0; i < 32; ++i) { const int kk = 2 * i + (lane >> 5); scr[kk * 33 + (lane & 31)] = W[(size_t)(k0 + kk) * N + sc] * ks(k0 + kk); }
    LDS_WAIT(); asm volatile("" ::: "memory");
    const int c = lane & 7;
#pragma unroll
    for (int j = 0; j < 4; ++j) { const int n = (lane >> 3) + 8 * j; const LAS float* s = scr + (8 * c) * 33 + n;
        v4u o; o.x = pk2(s[0 * 33], s[1 * 33]); o.y = pk2(s[2 * 33], s[3 * 33]); o.z = pk2(s[4 * 33], s[5 * 33]); o.w = pk2(s[6 * 33], s[7 * 33]);
        *(v4u*)(WT + (size_t)(n0 + n) * K + k0 + 8 * c) = o; }
    LDS_WAIT(); asm volatile("" ::: "memory");
}
struct CMapHead { int nrope;
    __device__ __forceinline__ int operator()(int c) const { const int pn = c >> 8, bj = (c >> 7) & 1, hh = (c >> 5) & 3, p5 = c & 31, hidx = 4 * pn + hh; int p = 32 * bj + p5;
        if (hidx < nrope && p < 16) p = (p & 3) + 8 * ((p >> 2) & 1) + 4 * (p >> 3); return 64 * hidx + p; } };
struct CMapId { __device__ __forceinline__ int operator()(int c) const { return c; } };
struct KSOne { __device__ __forceinline__ float operator()(int) const { return 1.f; } };
struct KSVec { const float* g; __device__ __forceinline__ float operator()(int k) const { return g[k]; } };
struct KSOut { const float *a, *b, *m; __device__ __forceinline__ float operator()(int k) const { return k < 384 ? a[k] : (k < 768 ? b[k - 384] : m[k - 768]); } };

__device__ __forceinline__ void rms_row_to_bf16(const float* xrow, const float* g, bf16* orow, int lane) {
    const f32x4* xr = (const f32x4*)xrow + lane; const f32x4* gr = (const f32x4*)g + lane;
    f32x4 v[4]; float s = 0.f;
#pragma unroll
    for (int j = 0; j < 4; ++j) { v[j] = xr[64 * j]; s += (v[j].x * v[j].x + v[j].y * v[j].y) + (v[j].z * v[j].z + v[j].w * v[j].w); }
    const float rstd = rsqrtf(wave_sum(s) * (1.f / DM) + RMS_EPS);
    unsigned long long* o8 = (unsigned long long*)orow + lane;
#pragma unroll
    for (int j = 0; j < 4; ++j) { const f32x4 gg = gr[64 * j]; o8[64 * j] = (unsigned long long)pk2(v[j].x * rstd * gg.x, v[j].y * rstd * gg.y) | ((unsigned long long)pk2(v[j].z * rstd * gg.z, v[j].w * rstd * gg.w) << 32); }
}
__device__ __forceinline__ void p0_prologue(Frame& F, const Args& A) {
    LAS float* scr = (LAS float*)(F.lds + F.wave * 16384);
    const int gw = F.vcu * NWAVES + F.wave, NGW = F.G * NWAVES;
    unsigned char* ws = F.ws;
    constexpr int I_IN = (DM / 64) * (NQKV / 32), I_MEM = (DM / 64) * (512 / 32), I_OUT = (DM / 64) * (DM / 32), I_1 = (DM / 64) * (FF / 32), I_2 = (FF / 64) * (DM / 32);
    constexpr int NITEMS = I_IN + I_MEM + I_OUT + I_1 + I_2;
    for (int it = gw; it < NITEMS; it += NGW) {
        int r = it;
        if (r < I_IN) { p0_transpose_item(A.in[5], DM, NQKV, (bf16*)(ws + WS_WIN), scr, r, F.lane, CMapHead{12}, KSOne{}); continue; } r -= I_IN;
        if (r < I_MEM) { p0_transpose_item(A.in[12], DM, 512, (bf16*)(ws + WS_WMEM), scr, r, F.lane, CMapHead{0}, KSOne{}); continue; } r -= I_MEM;
        if (r < I_OUT) { p0_transpose_item(A.in[18], DM, DM, (bf16*)(ws + WS_WOUT), scr, r, F.lane, CMapId{}, KSOut{A.in[15], A.in[16], A.in[17]}); continue; } r -= I_OUT;
        if (r < I_1) { p0_transpose_item(A.in[20], DM, FF, (bf16*)(ws + WS_W1), scr, r, F.lane, CMapId{}, KSVec{A.in[19]}); continue; } r -= I_1;
        p0_transpose_item(A.in[21], FF, DM, (bf16*)(ws + WS_W2), scr, r, F.lane, CMapId{}, KSOne{});
    }
    for (int m = gw; m < MTOK + MMEM; m += NGW) {
        if (m < MTOK) { const float* xrow = m < TP ? A.in[0] + (size_t)m * DM : A.in[1] + (size_t)(m - TP) * DM; rms_row_to_bf16(xrow, A.in[4], (bf16*)(ws + WS_XN) + (size_t)m * DM, F.lane); }
        else { const int r = m - MTOK; const float* xrow = r < NMEM ? A.in[2] + (size_t)r * DM : A.in[3] + (size_t)(r - NMEM) * DM; rms_row_to_bf16(xrow, A.in[11], (bf16*)(ws + WS_XNMEM) + (size_t)r * DM, F.lane); }
    }
    float* rc = (float*)(ws + WS_ROPE); float* rs = rc + TP * 8;
    for (int i = (F.vcu * NWAVES * 64) + F.tid; i < TP * 8; i += F.G * NWAVES * 64) {
        const int pos = i >> 3, fi = i & 7;
        const float inv = exp2f(-(float)fi * 0.125f * 18.931568569324174f);
        const float ang = (float)pos * inv;
        const double rev = (double)ang * 0.15915494309189535; const float fr = (float)(rev - __builtin_rint(rev));
        rc[i] = __builtin_amdgcn_cosf(fr); rs[i] = __builtin_amdgcn_sinf(fr);
    }
}

template <int NR, class KF>
__device__ __forceinline__ void attn_item(const bf16* qrow, const bf16* Kb, const bf16* Vb, const KF& kf, bf16* orow, int lane) {
    float q[64];
#pragma unroll
    for (int c = 0; c < 8; ++c) { const v4u w = *(const v4u*)(qrow + 8 * c);
#pragma unroll
        for (int e = 0; e < 4; ++e) { q[8 * c + 2 * e] = bflo(w[e]); q[8 * c + 2 * e + 1] = bfhi(w[e]); } }
    float p[NR]; float lsum = 0.f;
#pragma unroll
    for (int r = 0; r < NR; ++r) {
        long ridx; float bias; const bool ok = kf(64 * r + lane, ridx, bias);
        const bf16* krow = Kb + ridx * 64; float s = 0.f;
#pragma unroll
        for (int c = 0; c < 8; ++c) { const v4u w = *(const v4u*)(krow + 8 * c);
#pragma unroll
            for (int e = 0; e < 4; ++e) s += q[8 * c + 2 * e] * bflo(w[e]) + q[8 * c + 2 * e + 1] * bfhi(w[e]); }
        p[r] = ok ? exp2f(s + bias) : 0.f; lsum += p[r];
    }
    lsum = wave_sum(lsum);
    float o = 0.f;
#pragma unroll
    for (int r = 0; r < NR; ++r) {
#pragma unroll 8
        for (int l = 0; l < 64; ++l) {
            long ridx; float bias; (void)kf(64 * r + l, ridx, bias);
            const float pj = __int_as_float(__builtin_amdgcn_readlane(__float_as_int(p[r]), l));
            o += pj * __uint_as_float((unsigned)Vb[ridx * 64 + lane] << 16);
        }
    }
    orow[lane] = (bf16)f2bf(o / lsum);
}
struct KeyA { long sb; int pos, T;
    __device__ __forceinline__ bool operator()(int j, long& ridx, float& bias) const { const int pat = j >= 258 ? 2 : (j >= 129 ? 1 : 0), idx = j - 129 * pat, dil = 1 << (2 * pat), kp = pos + (idx - 64) * dil;
        const bool ok = j < 387 && kp >= 0 && kp < T; ridx = sb + (ok ? kp : pos); bias = 0.f; return ok; } };
struct KeyB { long sb; int r, c, rs, cs; const float* rpb;
    __device__ __forceinline__ bool operator()(int j, long& ridx, float& bias) const { const int kr = (j >> 4) & 7, kc = j & 15; ridx = sb + (rs + kr) * 64 + cs + kc;
        bias = rpb[(rs + kr - r + 7) * 31 + (cs + kc - c + 15)] * LOG2E; return true; } };
struct KeyM { long b0;
    __device__ __forceinline__ bool operator()(int j, long& ridx, float& bias) const { ridx = b0 + (j & 255); bias = 0.f; return true; } };

__device__ __forceinline__ void attn_simple_phase(Frame& F, const Args& A) {
    const int gw = F.vcu * NWAVES + F.wave, NGW = F.G * NWAVES;
    const bf16* QKV = (const bf16*)(F.ws + WS_QKV); bf16* O = (bf16*)(F.ws + WS_O);
    const bf16* MK = (const bf16*)(F.ws + WS_MK); const bf16* MV = (const bf16*)(F.ws + WS_MV);
    for (int it = gw; it < MTOK * 16; it += NGW) {
        const int hh = it / MTOK, row = it - hh * MTOK;
        const int sbat = row < TP ? 0 : 1 + ((row - TP) >> 13);
        const long sb = row < TP ? 0 : TP + (long)(sbat - 1) * TS; const int T = row < TP ? TP : TS, pos = (int)(row - sb);
        if (hh < 6) {
            if (ATT_A_MFMA) continue;
            const int h = hh;
            attn_item<7>(QKV + ((size_t)(0 + h) * MTOK + row) * 64, QKV + (size_t)(6 + h) * MTOK * 64, QKV + (size_t)(12 + h) * MTOK * 64, KeyA{sb, pos, T}, O + (size_t)row * DM + h * 64, F.lane);
        } else if (hh < 12) {
            if (ATT_B_MFMA) continue;
            const int h = hh - 6, rows = T / 64, r = pos >> 6, c = pos & 63;
            int rs = r - 4; rs = rs < 0 ? 0 : (rs > rows - 8 ? rows - 8 : rs); int cs = c - 8; cs = cs < 0 ? 0 : (cs > 48 ? 48 : cs);
            attn_item<2>(QKV + ((size_t)(18 + h) * MTOK + row) * 64, QKV + (size_t)(24 + h) * MTOK * 64, QKV + (size_t)(30 + h) * MTOK * 64, KeyB{sb, r, c, rs, cs, A.in[10] + h * 15 * 31}, O + (size_t)row * DM + 384 + h * 64, F.lane);
        } else {
            if (ATT_M_MFMA) continue;
            const int h = hh - 12;
            attn_item<4>(QKV + ((size_t)(36 + h) * MTOK + row) * 64, MK, MV, KeyM{(long)(sbat * 4 + h) * NMEM}, O + (size_t)row * DM + 768 + h * 64, F.lane);
        }
    }
}
__device__ __forceinline__ void onorm_phase(Frame& F) {
    const int gw = F.vcu * NWAVES + F.wave, NGW = F.G * NWAVES;
    bf16* O = (bf16*)(F.ws + WS_O);
    for (int m = gw; m < MTOK; m += NGW) {
        v4u* p = (v4u*)(O + (size_t)m * DM) + 2 * F.lane; v4u w0 = p[0], w1 = p[1];
        float v[16];
#pragma unroll
        for (int e = 0; e < 4; ++e) { v[2 * e] = bflo(w0[e]); v[2 * e + 1] = bfhi(w0[e]); v[8 + 2 * e] = bflo(w1[e]); v[8 + 2 * e + 1] = bfhi(w1[e]); }
        float ss = 0.f;
#pragma unroll
        for (int e = 0; e < 16; ++e) ss += v[e] * v[e];
        const int grp = F.lane < 24 ? 0 : (F.lane < 48 ? 1 : 2);
        const float sa = wave_sum(grp == 0 ? ss : 0.f), sb = wave_sum(grp == 1 ? ss : 0.f), sm = wave_sum(grp == 2 ? ss : 0.f);
        const float r = grp == 0 ? rsqrtf(sa * (1.f / 384.f) + RMS_EPS) : (grp == 1 ? rsqrtf(sb * (1.f / 384.f) + RMS_EPS) : rsqrtf(sm * (1.f / 256.f) + RMS_EPS));
#pragma unroll
        for (int e = 0; e < 4; ++e) { w0[e] = pk2(v[2 * e] * r, v[2 * e + 1] * r); w1[e] = pk2(v[8 + 2 * e] * r, v[8 + 2 * e + 1] * r); }
        p[0] = w0; p[1] = w1;
    }
}

#define XB_TMO      128
#define XB_XCNT(j)  (256  + 64 * (j))
#define XB_XSUB(j)  (1280 + 64 * (j))
#define XB_XGEN(j)  (2304 + 64 * (j))
#define XB_TOP      3328
#define XB_TOPGEN   3392
#define XCD_BAR_WORDS 3456
#define XB_SPIN_CAP (1u << 18)

__device__ __forceinline__ unsigned xb_ld(unsigned* p)              { return __hip_atomic_load(p, __ATOMIC_RELAXED, __HIP_MEMORY_SCOPE_AGENT); }
__device__ __forceinline__ unsigned xb_add(unsigned* p, unsigned v) { return __hip_atomic_fetch_add(p, v, __ATOMIC_RELAXED, __HIP_MEMORY_SCOPE_AGENT); }
__device__ __forceinline__ unsigned xb_xcc_id() { return (unsigned)__builtin_amdgcn_s_getreg((3 << 11) | 20) & 0xFu; }
#define XB_SPIN(cond, bar) do { unsigned _sp = 0; while (cond) { __builtin_amdgcn_s_sleep(1); \
    if ((++_sp & 255u) == 0u) { if (xb_ld(&(bar)[XB_TMO])) break; if (_sp > XB_SPIN_CAP) { atomicAdd(&(bar)[XB_TMO], 1u); break; } } } } while (0)

struct XcdBarrier {
    unsigned* bar; unsigned x;
    volatile LAS unsigned* st;
};

__device__ __forceinline__ XcdBarrier xcd_barrier_post(unsigned* bar, volatile LAS unsigned* st) {
    XcdBarrier b; b.bar = bar; b.x = xb_xcc_id(); b.st = st;
    if (threadIdx.x == 0) (void)xb_add(&bar[XB_XCNT(b.x)], 1u);
    return b;
}
__device__ __forceinline__ void xcd_barrier_complete(unsigned* bar, unsigned x, unsigned& nloc, unsigned& nx) {
    const unsigned G = gridDim.x * gridDim.y * gridDim.z;
    unsigned sum, cnt, mine, sp = 0u;
    for (;;) {
        sum = 0u; cnt = 0u; mine = 0u;
#pragma unroll
        for (unsigned j = 0; j < 16; ++j) { const unsigned c = xb_ld(&bar[XB_XCNT(j)]); sum += c; cnt += (c > 0u) ? 1u : 0u; mine = (j == x) ? c : mine; }
        if (sum == G) break;
        __builtin_amdgcn_s_sleep(1);
        if ((++sp & 255u) == 0u) { if (xb_ld(&bar[XB_TMO])) break; if (sp > XB_SPIN_CAP) { atomicAdd(&bar[XB_TMO], 1u); break; } }
    }
    nloc = mine > 0u ? mine : 1u; nx = cnt > 0u ? cnt : 1u;
}

__device__ __forceinline__ void xcd_barrier(const XcdBarrier& b) {
    asm volatile("s_waitcnt vmcnt(0)" ::: "memory");
    __syncthreads();
    if (threadIdx.x == 0) {
        unsigned* bar = b.bar;
        __builtin_amdgcn_s_waitcnt(0);
        unsigned nloc = b.st[0], nx = b.st[1];
        if (nloc == 0u) { xcd_barrier_complete(bar, b.x, nloc, nx); b.st[0] = nloc; b.st[1] = nx; }
        const unsigned old = xb_add(&bar[XB_XSUB(b.x)], 1u);
        const unsigned gen = old / nloc;
        if (old + 1u == (gen + 1u) * nloc) {
            __builtin_amdgcn_fence(__ATOMIC_RELEASE, "agent");
            asm volatile("s_waitcnt vmcnt(0)" ::: "memory");
            const unsigned og = xb_add(&bar[XB_TOP], 1u);
            const unsigned tg = og / nx;
            if (og + 1u == (tg + 1u) * nx) xb_add(&bar[XB_TOPGEN], 1u);
            else XB_SPIN(xb_ld(&bar[XB_TOPGEN]) == tg, bar);
            __builtin_amdgcn_fence(__ATOMIC_ACQUIRE, "agent");
            xb_add(&bar[XB_XGEN(b.x)], 1u);
            asm volatile("s_waitcnt vmcnt(0)" ::: "memory");
        } else {
            XB_SPIN(xb_ld(&bar[XB_XGEN(b.x)]) == gen, bar);
            __builtin_amdgcn_fence(__ATOMIC_ACQUIRE, "agent");
            asm volatile("s_waitcnt vmcnt(0)" ::: "memory");
        }
    }
    __syncthreads();
}

constexpr int N_AUNITS = (MTOK / 256) * 6;
constexpr int N_BJOBS = (MTOK / 128) * 6 * 4;
constexpr int N_MJOBS = (MTOK / 32) * 4;
constexpr int LA_WSTRIDE = 8320, LA_ACC = 69632, LA_L = LA_ACC + 65536;
constexpr int LW_STRIDE = 12544, LW_TBL = 8448;

struct SeqInfo { long sb; int T; int bat; };
__device__ __forceinline__ SeqInfo seq_of(int row) { SeqInfo s; if (row < TP) { s.sb = 0; s.T = TP; s.bat = 0; } else { const int b = (row - TP) >> 13; s.sb = TP + (long)b * TS; s.T = TS; s.bat = 1 + b; } return s; }

__device__ __forceinline__ void m_job(Frame& F, int jm) {
    const int h = jm / (MTOK / 32), row0 = (jm - h * (MTOK / 32)) * 32; const SeqInfo si = seq_of(row0);
    const bf16* QKV = (const bf16*)(F.ws + WS_QKV);
    const int r32 = F.lane & 31;
    att::bf16x8 qr[1][4]; att::load_q(qr[0], QKV + ((size_t)(36 + h) * MTOK + row0 + r32) * 64, F.lane);
    att::SpecM S{(const bf16*)(F.ws + WS_MK) + (size_t)(si.bat * 4 + h) * NMEM * 64, (const bf16*)(F.ws + WS_MV) + (size_t)(si.bat * 4 + h) * NMEM * 64, F.tm};
    att::f32x16 o[1][2] = {}; float lsum[1] = {0.f};
    att::lptr wb = (att::lptr)(F.lds + F.wave * LW_STRIDE);
    att::run_tiles<1>(S, qr, o, lsum, wb, F.lane);
    bf16* O = (bf16*)(F.ws + WS_O) + (size_t)row0 * DM + 768 + 64 * h; float* SQ = (float*)(F.ws + WS_SSQA) + (size_t)row0 * 4 + 2;
    att::store_out(o[0], lsum[0], wb, [=](int q) { return O + (size_t)q * DM; }, [=](int q) { return SQ + (size_t)q * 4; }, F.lane, F.nostore);
}
__device__ __forceinline__ void b_job(Frame& F, const Args& A, int jb) {
    const int g = jb & 3, rest = jb >> 2, h = rest / (MTOK / 128), rp = rest - h * (MTOK / 128);
    int r0, rows; long sb;
    if (rp < TP / 128) { r0 = 2 * rp; rows = TP / 64; sb = 0; } else { const int q = rp - TP / 128, b = q / (TS / 128); r0 = 2 * (q - b * (TS / 128)); rows = TS / 64; sb = TP + (long)b * TS; }
    const int r32 = F.lane & 31;
    const int rq = r0 + (r32 >> 4), c = 16 * g + (r32 & 15);
    int rlo = rq - 4; rlo = rlo < 0 ? 0 : (rlo > rows - 8 ? rows - 8 : rlo);
    int cs = c - 8; cs = cs < 0 ? 0 : (cs > 48 ? 48 : cs);
    int rk0 = r0 - 4; rk0 = rk0 < 0 ? 0 : (rk0 > rows - 8 ? rows - 8 : rk0);
    int rk1 = r0 + 1 - 4; rk1 = rk1 < 0 ? 0 : (rk1 > rows - 8 ? rows - 8 : rk1);
    const int w0 = g == 0 ? 0 : (g == 1 ? 8 : (g == 2 ? 24 : 32));
    att::lptr wb = (att::lptr)(F.lds + F.wave * LW_STRIDE);
    __attribute__((address_space(3))) float* tbl = (__attribute__((address_space(3))) float*)(wb + LW_TBL);
    const float* rpb = A.in[10] + h * 465;
    if (F.lane < 31) {
#pragma unroll 5
        for (int dr = 0; dr < 15; ++dr) tbl[dr * 64 + 16 + F.lane] = rpb[dr * 31 + F.lane] * LOG2E; }
    asm volatile("" ::: "memory");
    const bf16* QKV = (const bf16*)(F.ws + WS_QKV);
    att::bf16x8 qr[1][4]; att::load_q(qr[0], QKV + ((size_t)(18 + h) * MTOK + sb + rq * 64 + c) * 64, F.lane);
    att::SpecB S{QKV + ((size_t)(24 + h) * MTOK + sb) * 64, QKV + ((size_t)(30 + h) * MTOK + sb) * 64, rk1 + 8 - rk0, rk0, w0, rlo, 7 - rq, w0 - cs, tbl + (31 + w0 - c), F.tm};
    att::f32x16 o[1][2] = {}; float lsum[1] = {0.f};
    att::run_tiles<1>(S, qr, o, lsum, wb, F.lane);
    bf16* O = (bf16*)(F.ws + WS_O) + (size_t)(sb + r0 * 64 + 16 * g) * DM + 384 + 64 * h; float* SQ = (float*)(F.ws + WS_SSQA) + (size_t)(sb + r0 * 64 + 16 * g) * 4 + 1;
    att::store_out(o[0], lsum[0], wb, [=](int q) { return O + (size_t)((q >> 4) * 64 + (q & 15)) * DM; }, [=](int q) { return SQ + (size_t)((q >> 4) * 64 + (q & 15)) * 4; }, F.lane, F.nostore);
}
template <class Spec, class QLoc> __device__ __forceinline__ void a_job(Frame& F, const Spec& S, const bf16* qrow, const QLoc& qloc) {
    att::bf16x8 qr[1][4]; att::load_q(qr[0], qrow, F.lane);
    att::f32x16 o1[1][2] = {}; float lsum1[1] = {0.f};
    att::run_tiles<1>(S, qr, o1, lsum1, (att::lptr)(F.lds + F.wave * LA_WSTRIDE), F.lane);
    const att::f32x16 (&o)[2] = o1[0]; const float lsum = lsum1[0];
    const int r32 = F.lane & 31, hi = F.lane >> 5;
    __attribute__((address_space(3))) float* acc = (__attribute__((address_space(3))) float*)(F.lds + LA_ACC);
    __attribute__((address_space(3))) float* ls = (__attribute__((address_space(3))) float*)(F.lds + LA_L);
#pragma unroll
    for (int r = 0; r < 16; ++r) { const int ql = qloc(att::creg(r) + 4 * hi);
#pragma unroll
        for (int dh = 0; dh < 2; ++dh) (void)__hip_atomic_fetch_add(acc + ql * 64 + dh * 32 + r32, o[dh][r], __ATOMIC_RELAXED, __HIP_MEMORY_SCOPE_WORKGROUP); }
    (void)__hip_atomic_fetch_add(ls + qloc(r32), lsum, __ATOMIC_RELAXED, __HIP_MEMORY_SCOPE_WORKGROUP);
}
__device__ __forceinline__ void a_unit(Frame& F, int ua) {
    const int h = ua / (MTOK / 256), row0 = (ua - h * (MTOK / 256)) * 256; const SeqInfo si = seq_of(row0);
    const int pq0 = (int)(row0 - si.sb), w = F.wave, r32 = F.lane & 31;
    { __attribute__((address_space(3))) att::f32x4* z = (__attribute__((address_space(3))) att::f32x4*)(F.lds + LA_ACC);
#pragma unroll
      for (int i = 0; i < 8; ++i) z[i * 512 + F.tid] = (att::f32x4){0.f, 0.f, 0.f, 0.f};
      if (F.tid < 64) z[4096 + F.tid] = (att::f32x4){0.f, 0.f, 0.f, 0.f}; }
    __syncthreads();
    const bf16* QKV = (const bf16*)(F.ws + WS_QKV);
    const bf16* Q = QKV + ((size_t)(0 + h) * MTOK + si.sb) * 64; const bf16* K = QKV + ((size_t)(6 + h) * MTOK + si.sb) * 64; const bf16* V = QKV + ((size_t)(12 + h) * MTOK + si.sb) * 64;
    for (int pat = 0; pat < 3; ++pat) {
        const int qs = pat == 0 ? 1 : (pat == 1 ? 4 : 16), qb = pat == 0 ? 32 * w : (pat == 1 ? 128 * (w & 1) + (w >> 1) : 2 * w);
        const int imask = pat == 2 ? 15 : 31, ishift = pat == 2 ? 4 : 5;
        att::SpecA S{K, V, pq0 + qb - 64 * qs, qs, pat == 2 ? 16 : 32, imask, ishift, pat == 2 ? 9 : 5, si.T, F.tm};
        a_job(F, S, Q + (size_t)(pq0 + qb + (r32 & imask) * qs + (r32 >> ishift)) * 64, [=](int q) { return qb + (q & imask) * qs + (q >> ishift); });
    }
    __syncthreads();
    {
        const int q = 32 * w + (F.lane >> 1), dh = F.lane & 1;
        const __attribute__((address_space(3))) att::f32x4* a = (const __attribute__((address_space(3))) att::f32x4*)(F.lds + LA_ACC + (q * 64 + dh * 32) * 4);
        const float rl = __builtin_amdgcn_rcpf(((const __attribute__((address_space(3))) float*)(F.lds + LA_L))[q]);
        bf16* op = (bf16*)(F.ws + WS_O) + (size_t)(row0 + q) * DM + 64 * h + 32 * dh;
        float ss = 0.f;
#pragma unroll
        for (int i = 0; i < 4; ++i) { const att::f32x4 x = a[2 * i], y = a[2 * i + 1]; v4u o; o.x = pk2(x[0] * rl, x[1] * rl); o.y = pk2(x[2] * rl, x[3] * rl); o.z = pk2(y[0] * rl, y[1] * rl); o.w = pk2(y[2] * rl, y[3] * rl);
#pragma unroll
            for (int e = 0; e < 4; ++e) { const float u0 = bflo(o[e]), u1 = bfhi(o[e]); ss += u0 * u0 + u1 * u1; }
            if (!F.nostore) *(v4u*)(op + 8 * i) = o; }
        ss += __shfl_xor(ss, 1);
        if (!F.nostore && dh == 0) unsafeAtomicAdd((float*)(F.ws + WS_SSQA) + (size_t)(row0 + q) * 4 + 0, ss);
    }
    __syncthreads();
}
__device__ __forceinline__ void attn_phase(Frame& F, const Args& A) {
    volatile LAS unsigned* ast = (volatile LAS unsigned*)(F.lds + LDS_MISC + 16);
    if (F.tid == 0) {
        unsigned* barw = (unsigned*)(F.ws + WS_CTL) + CW_BAR; const unsigned myx = xb_xcc_id();
        bool ok = (F.G == 256); unsigned chunk = 0, npop = 0;
        for (unsigned j = 0; j < 16; ++j) { const unsigned cnt = xb_ld(&barw[XB_XCNT(j)]); if (cnt) { ++npop; if (cnt != 32u) ok = false; if (j < myx) ++chunk; } }
        if (npop != 8u) ok = false;
        unsigned rank = 0;
        if (ok) rank = xb_add((unsigned*)(F.ws + WS_CTL) + CW_ARANK + 64 * myx, 1u);
        ast[0] = ok ? 1u : 0u; ast[1] = chunk; ast[2] = rank;
    }
    __syncthreads();
    const bool blocked = ast[0] != 0u;
    const int xcd = (int)ast[1], ci = (int)ast[2];
#if ATT_A_MFMA
    if (!(F.what & 1)) {} else if (blocked) { for (int k = ci; k < N_AUNITS / 8; k += 32) a_unit(F, xcd * (N_AUNITS / 8) + k); }
    else { for (int ua = blockIdx.x; ua < N_AUNITS; ua += F.G) a_unit(F, ua); }
#endif
    __syncthreads();
    if (blocked) {
        const int widx = ci * 8 + F.wave;
        for (int k = 0; k < 9; ++k) {
            int l;
            if (k < 6) l = k * 256 + widx; else { if (ci < 16) break; l = 1536 + (k - 6) * 128 + (widx - 128); }
            if (l < N_BJOBS / 8) {
#if ATT_B_MFMA
                if (F.what & 2) b_job(F, A, xcd * (N_BJOBS / 8) + l);
#endif
            } else {
#if ATT_M_MFMA
                if (F.what & 4) m_job(F, xcd * (N_MJOBS / 8) + (l - N_BJOBS / 8));
#endif
            }
        }
    } else {
        const int NJ = N_BJOBS + N_MJOBS;
        for (int j = blockIdx.x * 8 + F.wave; j < NJ; j += F.G * 8) {
            if (j < N_BJOBS) {
#if ATT_B_MFMA
                b_job(F, A, j);
#endif
            } else {
#if ATT_M_MFMA
                m_job(F, j - N_BJOBS);
#endif
            }
        }
    }
    __syncthreads();
}

namespace att2 {
using att::bf16x8; using att::s16x4; using att::f32x16; using att::f32x4; using att::u32x4; using att::lptr; using att::creg; using att::cvtpk; using att::vtr; using att::NEG;
constexpr int NS = 3, SLOT = 32768, TILE = 16384, TV = 8192, VDH64 = 4096;
constexpr int L_RING = 0, L_WSCR = NS * SLOT, WSCR = 4352, L_TBL = L_WSCR + 8 * WSCR, TBLB = 3840, L_END = L_TBL + 2 * TBLB;
static_assert(L_END <= LDS_MISC, "attention LDS map");
#define ATT2_WAITBAR(N) asm volatile("s_waitcnt vmcnt(" #N ") lgkmcnt(0)\n\ts_barrier" ::: "memory")

struct TileSrc { const bf16* K; const bf16* V; int p0, qs, T, pm; };
__device__ __forceinline__ void dma_tile(LAS unsigned char* tile, const TileSrc& s, int w, int lane) {
    { const int row = 8 * w + (lane >> 3); int p = s.p0 + row * s.qs; p = p < 0 ? 0 : (p >= s.T ? s.T - 1 : p); p &= s.pm;
      __builtin_amdgcn_global_load_lds((const unsigned*)(s.K + (size_t)p * 64 + 8 * ((lane & 7) ^ ((row >> 1) & 7))), (LAS unsigned*)(tile + w * 1024), 16, 0, 0); }
    { const int row = 16 * (w & 3) + (lane >> 2); int p = s.p0 + row * s.qs; p = p < 0 ? 0 : (p >= s.T ? s.T - 1 : p); p &= s.pm;
      __builtin_amdgcn_global_load_lds((const unsigned*)(s.V + (size_t)p * 64 + 32 * (w >> 2) + 8 * (lane & 3)), (LAS unsigned*)(tile + TV + (w >> 2) * VDH64 + (w & 3) * 1024), 16, 0, 0); }
}
__device__ __forceinline__ f32x16 qk_sub(lptr tile, int roff, const bf16x8 (&qr)[4], int lane) {
    const int r32 = lane & 31, hi = lane >> 5, row = roff + r32;
    lptr kp = tile + row * 128; const int sw = (row >> 1) & 7;
    f32x16 p = {};
#pragma unroll
    for (int d0 = 0; d0 < 4; ++d0) { const bf16x8 kf = *(__attribute__((address_space(3))) bf16x8*)(kp + (((2 * d0 + hi) ^ sw) * 16)); p = __builtin_amdgcn_mfma_f32_32x32x16_bf16(kf, qr[d0], p, 0, 0, 0); }
    return p;
}
__device__ __forceinline__ void pv_sub(lptr tile, int roff, f32x16& p, f32x16 (&o)[2], float& lsum, int lane) {
    const int hi = lane >> 5;
    float sacc = 0.f;
#pragma unroll
    for (int r = 0; r < 16; ++r) { p[r] = __builtin_amdgcn_exp2f(p[r]); sacc += p[r]; }
    lsum += sacc;
    u32x4 pw0, pw1;
    pw0[0] = cvtpk(p[0], p[1]); pw0[1] = cvtpk(p[2], p[3]); pw0[2] = cvtpk(p[4], p[5]); pw0[3] = cvtpk(p[6], p[7]);
    pw1[0] = cvtpk(p[8], p[9]); pw1[1] = cvtpk(p[10], p[11]); pw1[2] = cvtpk(p[12], p[13]); pw1[3] = cvtpk(p[14], p[15]);
    lptr vp = tile + TV + (roff + 4 * hi + ((lane & 15) >> 2)) * 64 + ((lane >> 4) & 1) * 32 + (lane & 3) * 8;
#pragma unroll
    for (int dh = 0; dh < 2; ++dh) {
        const s16x4 l0 = vtr(vp + dh * VDH64), h0 = vtr(vp + dh * VDH64 + 512), l1 = vtr(vp + dh * VDH64 + 1024), h1 = vtr(vp + dh * VDH64 + 1536);
        const bf16x8 f0 = {l0[0], l0[1], l0[2], l0[3], h0[0], h0[1], h0[2], h0[3]}, f1 = {l1[0], l1[1], l1[2], l1[3], h1[0], h1[1], h1[2], h1[3]};
        o[dh] = __builtin_amdgcn_mfma_f32_32x32x16_bf16(__builtin_bit_cast(bf16x8, pw0), f0, o[dh], 0, 0, 0);
        o[dh] = __builtin_amdgcn_mfma_f32_32x32x16_bf16(__builtin_bit_cast(bf16x8, pw1), f1, o[dh], 0, 0, 0);
    }
}
__device__ __forceinline__ void mask_band(f32x16& p, int rel, int kr0, int L, int lane) {
    const int r32 = lane & 31, hi = lane >> 5;
    if (rel == 0 || rel == 4) { const int base = 32 * rel - r32 + 4 * hi;
#pragma unroll
        for (int r = 0; r < 16; ++r) { if ((unsigned)(base + creg(r)) > 128u) p[r] = NEG; } }
    if (kr0 < 0 || kr0 + 31 >= L) { const int kb = kr0 + 4 * hi;
#pragma unroll
        for (int r = 0; r < 16; ++r) { if ((unsigned)(kb + creg(r)) >= (unsigned)L) p[r] = NEG; } }
}
__device__ __forceinline__ void stage_rows(const f32x16 (&o)[2], float lsum, bool normalise, lptr scr, int lane) {
    const int r32 = lane & 31, hi = lane >> 5;
    lsum += __shfl_xor(lsum, 32);
    __attribute__((address_space(3))) float* ls = (__attribute__((address_space(3))) float*)(scr + 4096);
    if (hi == 0) ls[r32] = lsum;
    __attribute__((address_space(3))) unsigned short* stg = (__attribute__((address_space(3))) unsigned short*)scr;
    float rl[16];
#pragma unroll
    for (int g = 0; g < 4; ++g) { const f32x4 lv = *(__attribute__((address_space(3))) f32x4*)(ls + 8 * g + 4 * hi);
#pragma unroll
        for (int j = 0; j < 4; ++j) rl[4 * g + j] = normalise ? __builtin_amdgcn_rcpf(lv[j]) : 1.f; }
#pragma unroll
    for (int r = 0; r < 16; ++r) { const int q = creg(r) + 4 * hi;
#pragma unroll
        for (int dh = 0; dh < 2; ++dh) stg[q * 64 + dh * 32 + r32] = (unsigned short)f2bf(o[dh][r] * rl[r]); }
}
template <class RowFn, class SsqFn> __device__ __forceinline__ void out_final(const f32x16 (&o)[2], float lsum, lptr scr, const RowFn& orow, const SsqFn& ssqp, int lane) {
    stage_rows(o, lsum, true, scr, lane);
    __attribute__((address_space(3))) unsigned short* stg = (__attribute__((address_space(3))) unsigned short*)scr;
#pragma unroll
    for (int i = 0; i < 4; ++i) { const int row = i * 8 + (lane >> 3), ch = lane & 7; const u32x4 v = *(__attribute__((address_space(3))) u32x4*)(stg + row * 64 + ch * 8);
        float ss = 0.f;
#pragma unroll
        for (int e = 0; e < 4; ++e) { const float a = bflo(v[e]), b = bfhi(v[e]); ss += a * a + b * b; }
        ss += __shfl_xor(ss, 1); ss += __shfl_xor(ss, 2); ss += __shfl_xor(ss, 4);
        *(u32x4*)(orow(row) + ch * 8) = v; if (ch == 0) unsafeAtomicAdd(ssqp(row), ss); }
}
}

constexpr int N2_M = (MTOK / 256) * 4;
constexpr int N2_B = (MTOK / 128) * 3;
constexpr int N2_A = (MTOK / 512) * 6;
constexpr size_t WS_PART = WS_X1B;
constexpr size_t WS_PARTL = WS_PART + (size_t)2 * MTOK * 384 * 2;
static_assert(WS_PARTL + (size_t)2 * MTOK * 8 * 4 <= WS_XN, "partials fit the X1B region");

__device__ __forceinline__ void att2_unit_M(Frame& F, int um) {
    const int h = um / (MTOK / 256), row0 = (um - h * (MTOK / 256)) * 256; const SeqInfo si = seq_of(row0);
    const int w = F.wave, lane = F.lane, r32 = lane & 31;
    const bf16* QKV = (const bf16*)(F.ws + WS_QKV);
    att2::TileSrc ts{(const bf16*)(F.ws + WS_MK) + (size_t)(si.bat * 4 + h) * NMEM * 64, (const bf16*)(F.ws + WS_MV) + (size_t)(si.bat * 4 + h) * NMEM * 64, 0, 1, NMEM, F.tm};
    LAS unsigned char* ring = F.lds + att2::L_RING;
    att2::dma_tile(ring, ts, w, lane); ts.p0 = 64; att2::dma_tile(ring + att2::SLOT, ts, w, lane);
    att::bf16x8 qr[4]; att::load_q(qr, QKV + ((size_t)(36 + h) * MTOK + row0 + 32 * w + r32) * 64, lane);
    att::f32x16 o[2] = {}; float lsum = 0.f;
#pragma unroll 1
    for (int s = 0; s < 4; ++s) {
        if (s < 3) { ATT2_WAITBAR(2); } else { ATT2_WAITBAR(0); }
        if (s + 2 < 4) { ts.p0 = 64 * (s + 2); att2::dma_tile(ring + ((s + 2) % att2::NS) * att2::SLOT, ts, w, lane); }
        att::lptr tile = (att::lptr)(ring + (s % att2::NS) * att2::SLOT);
        att::f32x16 pa = att2::qk_sub(tile, 0, qr, lane), pb = att2::qk_sub(tile, 32, qr, lane);
        att2::pv_sub(tile, 0, pa, o, lsum, lane); att2::pv_sub(tile, 32, pb, o, lsum, lane);
    }
    bf16* O = (bf16*)(F.ws + WS_O) + (size_t)(row0 + 32 * w) * DM + 768 + 64 * h; float* SQ = (float*)(F.ws + WS_SSQA) + (size_t)(row0 + 32 * w) * 4 + 2;
    att2::out_final(o, lsum, (att::lptr)(F.lds + att2::L_WSCR + w * att2::WSCR), [=](int q) { return O + (size_t)q * DM; }, [=](int q) { return SQ + (size_t)q * 4; }, lane);
    ATT2_WAITBAR(0);
}

__device__ __forceinline__ void att2_unit_B(Frame& F, const Args& A, int ub) {
    const int hp = ub / (MTOK / 128), rp = ub - hp * (MTOK / 128);
    int r0, rows; long sb; int T;
    if (rp < TP / 128) { r0 = 2 * rp; rows = TP / 64; sb = 0; T = TP; } else { const int q = rp - TP / 128, b = q / (TS / 128); r0 = 2 * (q - b * (TS / 128)); rows = TS / 64; sb = TP + (long)b * TS; T = TS; }
    const int w = F.wave, lane = F.lane, r32 = lane & 31, hi = lane >> 5;
    const int hd = w >> 2, g = w & 3, h = 2 * hp + hd;
    const int rq = r0 + (r32 >> 4), c = 16 * g + (r32 & 15);
    int rlo = rq - 4; rlo = rlo < 0 ? 0 : (rlo > rows - 8 ? rows - 8 : rlo);
    int cs = c - 8; cs = cs < 0 ? 0 : (cs > 48 ? 48 : cs);
    int rk0 = r0 - 4; rk0 = rk0 < 0 ? 0 : (rk0 > rows - 8 ? rows - 8 : rk0);
    int rk1 = r0 + 1 - 4; rk1 = rk1 < 0 ? 0 : (rk1 > rows - 8 ? rows - 8 : rk1);
    const int nst = rk1 + 8 - rk0;
    const int w0 = g == 0 ? 0 : (g == 1 ? 8 : (g == 2 ? 24 : 32));
    const bf16* QKV = (const bf16*)(F.ws + WS_QKV);
    att2::TileSrc tx{QKV + ((size_t)(24 + 2 * hp) * MTOK + sb) * 64, QKV + ((size_t)(30 + 2 * hp) * MTOK + sb) * 64, rk0 * 64, 1, T, F.tm};
    att2::TileSrc ty{QKV + ((size_t)(25 + 2 * hp) * MTOK + sb) * 64, QKV + ((size_t)(31 + 2 * hp) * MTOK + sb) * 64, rk0 * 64, 1, T, F.tm};
    LAS unsigned char* ring = F.lds + att2::L_RING;
    att2::dma_tile(ring, tx, w, lane); att2::dma_tile(ring + att2::TILE, ty, w, lane);
    tx.p0 += 64; ty.p0 += 64; att2::dma_tile(ring + att2::SLOT, tx, w, lane); att2::dma_tile(ring + att2::SLOT + att2::TILE, ty, w, lane);
    { const int th = F.tid >> 8, tl = F.tid & 255;
      __attribute__((address_space(3))) float* tbl = (__attribute__((address_space(3))) float*)(F.lds + att2::L_TBL + th * att2::TBLB);
      const float* rpb = A.in[10] + (2 * hp + th) * 465;
      for (int idx = tl; idx < 465; idx += 256) { const int dr = idx / 31, dl = idx - dr * 31; tbl[dr * 64 + 16 + dl] = rpb[idx] * LOG2E; } }
    att::bf16x8 qr[4]; att::load_q(qr, QKV + ((size_t)(18 + h) * MTOK + sb + rq * 64 + c) * 64, lane);
    att::f32x16 o[2] = {}; float lsum = 0.f;
    const __attribute__((address_space(3))) float* tb = (const __attribute__((address_space(3))) float*)(F.lds + att2::L_TBL + hd * att2::TBLB) + (31 + w0 - c) + 4 * hi;
    const int cb = w0 - cs + 4 * hi, dr0 = 7 - rq;
#pragma unroll 1
    for (int s = 0; s < nst; ++s) {
        if (s + 1 < nst) { ATT2_WAITBAR(4); } else { ATT2_WAITBAR(0); }
        if (s + 2 < nst) { tx.p0 += 64; ty.p0 += 64; LAS unsigned char* sl = ring + ((s + 2) % att2::NS) * att2::SLOT; att2::dma_tile(sl, tx, w, lane); att2::dma_tile(sl + att2::TILE, ty, w, lane); }
        att::lptr tile = (att::lptr)(ring + (s % att2::NS) * att2::SLOT + hd * att2::TILE);
        att::f32x16 p = att2::qk_sub(tile, w0, qr, lane);
        { const int rk = rk0 + s; const bool rok = (unsigned)(rk - rlo) < 8u;
          int dr = rk + dr0; dr = dr < 0 ? 0 : (dr > 14 ? 14 : dr);
          const __attribute__((address_space(3))) float* tp = tb + dr * 64; const int cbh = rok ? cb : -4096;
#pragma unroll
          for (int r = 0; r < 16; ++r) { const float sbv = p[r] + tp[att::creg(r)]; p[r] = ((unsigned)(cbh + att::creg(r)) < 16u) ? sbv : att::NEG; } }
        att2::pv_sub(tile, w0, p, o, lsum, lane);
    }
    bf16* O = (bf16*)(F.ws + WS_O) + (size_t)(sb + r0 * 64 + 16 * g) * DM + 384 + 64 * h; float* SQ = (float*)(F.ws + WS_SSQA) + (size_t)(sb + r0 * 64 + 16 * g) * 4 + 1;
    att2::out_final(o, lsum, (att::lptr)(F.lds + att2::L_WSCR + w * att2::WSCR), [=](int q) { return O + (size_t)((q >> 4) * 64 + (q & 15)) * DM; }, [=](int q) { return SQ + (size_t)((q >> 4) * 64 + (q & 15)) * 4; }, lane);
    ATT2_WAITBAR(0);
}

struct BandU { long sb; int T, qs, L, cls, s0; };
__device__ __forceinline__ BandU band_unit(int tt, int qs) {
    BandU u; int j, nt; if (tt < TP / 256) { u.sb = 0; u.T = TP; j = tt; nt = TP / 256; } else { const int q = tt - TP / 256, b = q / (TS / 256); u.sb = TP + (long)b * TS; u.T = TS; j = q - b * (TS / 256); nt = TS / 256; }
    const int nb = nt / qs; u.qs = qs; u.L = u.T / qs; u.cls = j / nb; u.s0 = 256 * (j - u.cls * nb); return u;
}
__device__ __forceinline__ void att2_unit_A(Frame& F, int ud, int pat) {
    const int h = ud / (MTOK / 512), tt = 2 * (ud - h * (MTOK / 512)), qs = pat == 0 ? 16 : (pat == 1 ? 4 : 1);
    const BandU ux = band_unit(tt, qs), uy = band_unit(tt + 1, qs);
    const int w = F.wave, lane = F.lane, r32 = lane & 31;
    const bf16* QKV = (const bf16*)(F.ws + WS_QKV);
    const bf16* Qh = QKV + (size_t)(0 + h) * MTOK * 64; const bf16* Kh = QKV + (size_t)(6 + h) * MTOK * 64; const bf16* Vh = QKV + (size_t)(12 + h) * MTOK * 64;
    att2::TileSrc tx{Kh + ux.sb * 64, Vh + ux.sb * 64, 0, qs, ux.T, F.tm}, ty{Kh + uy.sb * 64, Vh + uy.sb * 64, 0, qs, uy.T, F.tm};
    const int px = ux.cls + (ux.s0 - 64) * qs, py = uy.cls + (uy.s0 - 64) * qs;
    LAS unsigned char* ring = F.lds + att2::L_RING;
#define ATT2_ISSUE(st) do { LAS unsigned char* sl_ = ring + ((st) % att2::NS) * att2::SLOT; tx.p0 = px + 64 * (st) * qs; ty.p0 = py + 64 * (((st) + 3) % 6) * qs; \
        att2::dma_tile(sl_, tx, w, lane); att2::dma_tile(sl_ + att2::TILE, ty, w, lane); } while (0)
    ATT2_ISSUE(0); ATT2_ISSUE(1);
    att::bf16x8 qx[4], qy[4];
    att::load_q(qx, Qh + (size_t)(ux.sb + ux.cls + (ux.s0 + 32 * w + r32) * qs) * 64, lane);
    att::load_q(qy, Qh + (size_t)(uy.sb + uy.cls + (uy.s0 + 32 * w + r32) * qs) * 64, lane);
    att::f32x16 ox[2] = {}, oy[2] = {}; float lx = 0.f, ly = 0.f;
#pragma unroll 1
    for (int s = 0; s < 6; ++s) {
        if (s < 5) { ATT2_WAITBAR(4); } else { ATT2_WAITBAR(0); }
        if (s + 2 < 6) ATT2_ISSUE(s + 2);
        att::lptr tX = (att::lptr)(ring + (s % att2::NS) * att2::SLOT), tY = tX + att2::TILE;
        const int sy = (s + 3) % 6;
#pragma unroll
        for (int hf = 0; hf < 2; ++hf) {
            const int gx = 2 * s + hf, gy = 2 * sy + hf;
            const bool ax = (unsigned)(gx - w) <= 4u, ay = (unsigned)(gy - w) <= 4u;
            att::f32x16 pxx, pyy;
            if (ax) pxx = att2::qk_sub(tX, 32 * hf, qx, lane);
            if (ay) pyy = att2::qk_sub(tY, 32 * hf, qy, lane);
            if (ax) { att2::mask_band(pxx, gx - w, ux.s0 - 64 + 32 * gx, ux.L, lane); att2::pv_sub(tX, 32 * hf, pxx, ox, lx, lane); }
            if (ay) { att2::mask_band(pyy, gy - w, uy.s0 - 64 + 32 * gy, uy.L, lane); att2::pv_sub(tY, 32 * hf, pyy, oy, ly, lane); }
        }
    }
#undef ATT2_ISSUE
    att::lptr scr = (att::lptr)(F.lds + att2::L_WSCR + w * att2::WSCR);
    __attribute__((address_space(3))) unsigned short* stg = (__attribute__((address_space(3))) unsigned short*)scr;
    __attribute__((address_space(3))) float* ls = (__attribute__((address_space(3))) float*)(scr + 4096);
    bf16* PB = (bf16*)(F.ws + WS_PART); float* PL = (float*)(F.ws + WS_PARTL);
#pragma unroll
    for (int side = 0; side < 2; ++side) {
        const BandU& u = side ? uy : ux;
        const long tok0 = u.sb + u.cls + (long)(u.s0 + 32 * w) * qs;
        att2::stage_rows(side ? oy : ox, side ? ly : lx, false, scr, lane);
        if (pat < 2) {
#pragma unroll
            for (int i = 0; i < 4; ++i) { const int row = i * 8 + (lane >> 3), ch = lane & 7; const att::u32x4 v = *(__attribute__((address_space(3))) att::u32x4*)(stg + row * 64 + ch * 8);
                *(att::u32x4*)(PB + ((size_t)pat * MTOK + tok0 + (long)row * qs) * 384 + 64 * h + ch * 8) = v; }
            if (lane < 32) PL[((size_t)pat * MTOK + tok0 + (long)lane * qs) * 8 + h] = ls[lane];
        } else {
#pragma unroll
            for (int i = 0; i < 4; ++i) { const int row = i * 8 + (lane >> 3), ch = lane & 7; const long tok = tok0 + row;
                const att::u32x4 v = *(__attribute__((address_space(3))) att::u32x4*)(stg + row * 64 + ch * 8);
                const att::u32x4 a = *(const att::u32x4*)(PB + ((size_t)tok) * 384 + 64 * h + ch * 8), b = *(const att::u32x4*)(PB + ((size_t)MTOK + tok) * 384 + 64 * h + ch * 8);
                const float rl = __builtin_amdgcn_rcpf(ls[row] + PL[(size_t)tok * 8 + h] + PL[((size_t)MTOK + tok) * 8 + h]);
                att::u32x4 ov; float ss = 0.f;
#pragma unroll
                for (int e = 0; e < 4; ++e) { const float x0 = (bflo(v[e]) + bflo(a[e]) + bflo(b[e])) * rl, x1 = (bfhi(v[e]) + bfhi(a[e]) + bfhi(b[e])) * rl; ov[e] = pk2(x0, x1);
                    const float y0 = bflo(ov[e]), y1 = bfhi(ov[e]); ss += y0 * y0 + y1 * y1; }
                ss += __shfl_xor(ss, 1); ss += __shfl_xor(ss, 2); ss += __shfl_xor(ss, 4);
                *(att::u32x4*)((bf16*)(F.ws + WS_O) + (size_t)tok * DM + 64 * h + ch * 8) = ov;
                if (ch == 0) unsafeAtomicAdd((float*)(F.ws + WS_SSQA) + (size_t)tok * 4 + 0, ss); }
        }
    }
    ATT2_WAITBAR(0);
}
__device__ __forceinline__ void att2_phase_a(Frame& F, const Args& A) {
    const int NU = 2 * N2_A + N2_B;
    const bool blk = (F.G == 256); const int per = NU / 8;
    const int xcd = blockIdx.x & 7, ci = blockIdx.x >> 3;
    for (int j = blk ? ci : (int)blockIdx.x; j < (blk ? per : NU); j += blk ? 32 : F.G) {
        const int u = blk ? xcd * per + j : j;
        const int k = u & 3, i = u >> 2;
        if (k == 0) att2_unit_A(F, i, 0); else if (k == 1) att2_unit_A(F, i, 1); else att2_unit_B(F, A, 2 * i + (k - 2));
    }
}
__device__ __forceinline__ void att2_phase_b(Frame& F, const Args& A) {
    const int NU = N2_A + N2_M;
    const bool blk = (F.G == 256); const int per = NU / 8;
    const int xcd = blockIdx.x & 7, ci = blockIdx.x >> 3;
    for (int j = blk ? ci : (int)blockIdx.x; j < (blk ? per : NU); j += blk ? 32 : F.G) {
        const int u = blk ? xcd * per + j : j;
        const int gq = u / 7, k = u - 7 * gq;
        if (k < 3) att2_unit_A(F, 3 * gq + k, 2); else att2_unit_M(F, 4 * gq + (k - 3));
    }
}
__global__ void __launch_bounds__(NWAVES * 64, 2) skel_fwd(Args args) {
    extern __shared__ __attribute__((aligned(16))) unsigned char lds[];
    cg::grid_group grid = cg::this_grid();
    Frame F;
    F.lds = (LAS unsigned char*)lds;
    F.tid = threadIdx.x; F.lane = F.tid & 63; F.wave = __builtin_amdgcn_readfirstlane(F.tid >> 6);
    F.G = gridDim.x; { const int bx = blockIdx.x; F.vcu = (F.G % 8 == 0) ? (bx % 8) * (F.G / 8) + bx / 8 : bx; }
    F.out = args.out; F.ws = args.ws; F.tm = -1; F.nostore = false; F.what = 7;
    unsigned char* ws = args.ws;
    const int lo = args.ph_lo, hi = args.ph_hi & 255; if (args.ph_hi >> 8) F.tm = 63;
    volatile LAS unsigned* bst = (volatile LAS unsigned*)(F.lds + LDS_MISC);
    if (F.tid < 2) bst[F.tid] = 0u;
    __syncthreads();
    XcdBarrier bar = xcd_barrier_post((unsigned*)(ws + WS_CTL) + CW_BAR, bst);
    if (lo < 0) grid.sync();
#define IN(k) (lo <= (k) && (k) < hi)
#define BOTH(k) (IN(k) && IN((k) + 1))
#define GRID_BAR() xcd_barrier(bar)

    if (IN(0)) { p0_prologue(F, args); if (BOTH(0)) GRID_BAR(); }

    if (IN(1)) {
        {
            pg8::Gemm g{(const pg8::bf16_t*)(ws + WS_XN), (const pg8::bf16_t*)(ws + WS_WIN), MTOK, NQKV, DM}; pg8::StaticOrder S; S.init(MTOK, NQKV, F.G, (int)blockIdx.x);
            pg8::EpiQKV E{(pg8::bf16_t*)(ws + WS_QKV), args.in[6], args.in[7], args.in[8], args.in[9], args.in[13], (const float*)(ws + WS_ROPE), (const float*)(ws + WS_ROPE) + TP * 8};
            pg8::gemm_phase<pg8::EpiQKV, pg8::StaticOrder, true, true>(F.lds, g, S, E);
        }
        {
            pg8::Gemm g{(const pg8::bf16_t*)(ws + WS_XNMEM), (const pg8::bf16_t*)(ws + WS_WMEM), MMEM, 512, DM}; pg8::StaticOrder S; S.init(MMEM, 512, F.G, F.G - 1 - (int)blockIdx.x);
            pg8::EpiMemKV E{(pg8::bf16_t*)(ws + WS_MK), (pg8::bf16_t*)(ws + WS_MV), args.in[14]};
            pg8::gemm_phase<pg8::EpiMemKV, pg8::StaticOrder, true, true>(F.lds, g, S, E);
        }
        if (BOTH(1)) GRID_BAR();
    }

#if ATT_V2
    if (IN(2)) { att2_phase_a(F, args); if (BOTH(2)) GRID_BAR(); }
    if (IN(3)) { att2_phase_b(F, args); if (BOTH(3)) GRID_BAR(); }
#else
    if (IN(2)) { attn_phase(F, args); if (PROBE_MODE) { F.nostore = true; F.tm = (PROBE_MODE & 2) ? 0 : -1; F.what = PROBE_WHAT; attn_phase(F, args); F.nostore = false; F.tm = -1; F.what = 7; } if (!(ATT_A_MFMA && ATT_B_MFMA && ATT_M_MFMA)) attn_simple_phase(F, args); if (BOTH(2)) GRID_BAR(); }

    if (IN(3)) { if (BOTH(3)) GRID_BAR(); }
#endif

    if (IN(4)) {
        pg8::Gemm g{(const pg8::bf16_t*)(ws + WS_O), (const pg8::bf16_t*)(ws + WS_WOUT), MTOK, DM, DM}; pg8::StaticOrder S; S.init(MTOK, DM, F.G, (int)blockIdx.x);
        pg8::EpiX1 E{args.in[0], args.in[1], F.out, (pg8::bf16_t*)(ws + WS_X1B), (float*)(ws + WS_SSQF), (const float*)(ws + WS_SSQA)};
        pg8::gemm_phase<pg8::EpiX1, pg8::StaticOrder, true, true>(F.lds, g, S, E);
        if (BOTH(4)) GRID_BAR();
    }

    if (IN(5)) {
        pg8::Gemm g{(const pg8::bf16_t*)(ws + WS_X1B), (const pg8::bf16_t*)(ws + WS_W1), MTOK, FF, DM}; pg8::StaticOrder S; S.init(MTOK, FF, F.G, (int)blockIdx.x);
        pg8::EpiH E{(pg8::bf16_t*)(ws + WS_H), (const float*)(ws + WS_SSQF), args.ph_hi >> 8};
        pg8::gemm_phase<pg8::EpiH, pg8::StaticOrder, true, true>(F.lds, g, S, E);
        if (BOTH(5)) GRID_BAR();
    }

    if (IN(6)) {
        pg8::Gemm g{(const pg8::bf16_t*)(ws + WS_H), (const pg8::bf16_t*)(ws + WS_W2), MTOK, DM, FF}; pg8::StaticOrder S; S.init(MTOK, DM, F.G, (int)blockIdx.x);
        pg8::EpiOut E{F.out, (const pg8::bf16_t*)(ws + WS_X1B)};
        pg8::gemm_phase<pg8::EpiOut, pg8::StaticOrder, true, true>(F.lds, g, S, E);
    }
#undef IN
#undef BOTH
}

extern "C" void kernel_launch(void* const* d_in, const int* in_sizes, int n_in, void* d_out, int out_size, void* d_ws, size_t ws_size, hipStream_t stream) {
    static int grid = 0;
    if (grid == 0) {
        if (n_in != 22 || in_sizes[0] != TP * DM || in_sizes[1] != NBS * TS * DM || out_size != MTOK * DM || ws_size < WS_END) {
            fprintf(stderr, "kernel_launch: unexpected shapes / workspace (n_in %d, in0 %d, out %d, ws %zu); nothing launched\n", n_in, n_in > 0 ? in_sizes[0] : -1, out_size, ws_size); grid = -1; return; }
        int dev = 0, cus = 0, per_cu = 0;
        if (hipGetDevice(&dev) != hipSuccess || hipDeviceGetAttribute(&cus, hipDeviceAttributeMultiprocessorCount, dev) != hipSuccess) { grid = -1; return; }
        if (hipFuncSetAttribute((const void*)skel_fwd, hipFuncAttributeMaxDynamicSharedMemorySize, LDS_BYTES) != hipSuccess) { fprintf(stderr, "kernel_launch: hipFuncSetAttribute failed\n"); grid = -1; return; }
        if (hipOccupancyMaxActiveBlocksPerMultiprocessor(&per_cu, (const void*)skel_fwd, NWAVES * 64, LDS_BYTES) != hipSuccess || per_cu < 1) { fprintf(stderr, "kernel_launch: occupancy query says %d\n", per_cu); (void)hipGetLastError(); grid = -1; return; }
        grid = cus * per_cu;
    }
    if (grid < 0) return;
    if (hipMemsetAsync((char*)d_ws + WS_CTL, 0, CTL_ZERO_BYTES, stream) != hipSuccess) return;
    Args a{};
    for (int i = 0; i < 22; ++i) a.in[i] = (const float*)d_in[i];
    a.out = (float*)d_out; a.ws = (unsigned char*)d_ws;
    auto launch = [&](int lo, int hi) {
        if (lo > 0) (void)hipMemsetAsync((char*)d_ws + WS_CTL + (size_t)CW_BAR * 4, 0, (size_t)XCD_BAR_WORDS * 4, stream);
        a.ph_lo = lo; a.ph_hi = hi; void* kargs[] = {&a};
        hipError_t e = hipLaunchCooperativeKernel((const void*)skel_fwd, dim3(grid), dim3(NWAVES * 64), kargs, LDS_BYTES, stream);
        if (e != hipSuccess) fprintf(stderr, "kernel_launch: cooperative launch failed: %s (grid %d)\n", hipGetErrorString(e), grid);
    };
#if PROBE_SEQ == 0
    launch(0, NPH);
#elif PROBE_SEQ == 1
    launch(0, NPH); launch(0, 1);
#elif PROBE_SEQ == 2
    launch(0, NPH); launch(1, 2);
#elif PROBE_SEQ == 3
    launch(0, 4); (void)hipMemsetAsync((char*)d_ws + WS_SSQA, 0, (size_t)MTOK * 16, stream); launch(2, 4); launch(4, NPH);
#elif PROBE_SEQ == 4
    launch(0, 5); (void)hipMemsetAsync((char*)d_ws + WS_SSQF, 0, (size_t)MTOK * 4, stream); launch(4, 5); launch(5, NPH);
#elif PROBE_SEQ == 5
    launch(0, NPH); launch(5, 6);
#elif PROBE_SEQ == 7
    launch(0, NPH); launch(2, 3);
#elif PROBE_SEQ == 8
    launch(0, NPH); launch(2, 3 | 256);
#elif PROBE_SEQ == 9
    launch(0, NPH); launch(3, 4);
#elif PROBE_SEQ == 10
    launch(0, NPH); launch(3, 4 | 256);
#elif PROBE_SEQ == 11
    launch(0, NPH); launch(5, 6 | 256);
#elif PROBE_SEQ == 12
    launch(0, NPH); launch(5, 6 | 512);
#elif PROBE_SEQ == 6
    launch(0, 3); (void)hipMemsetAsync((char*)d_ws + WS_SSQA, 0, (size_t)MTOK * 16, stream); launch(2, 3); launch(3, NPH);
#endif
}
```

```cpp
#include <hip/hip_runtime.h>
#include <hip/hip_cooperative_groups.h>
#include <cstdio>
#include <cstdint>
namespace cg = cooperative_groups;

constexpr int DM = 1024, TP = 16384, TS = 8192, NBS = 4, MTOK = TP + NBS * TS;
constexpr int NQKV = 2560, NHEADS = 40, FF = 4096, NMEM = 256, NBATCH = 1 + NBS, MMEM = NBATCH * NMEM;
constexpr float RMS_EPS = 1e-6f;
constexpr float LOG2E = 1.4426950408889634f;
constexpr float QSCALE = 0.125f * LOG2E;

#ifndef ATT_A_MFMA
#define ATT_A_MFMA 1
#endif
#ifndef ATT_B_MFMA
#define ATT_B_MFMA 1
#endif
#ifndef ATT_M_MFMA
#define ATT_M_MFMA 1
#endif
#ifndef PROBE_MODE
#define PROBE_MODE 0
#endif
#ifndef PROBE_WHAT
#define PROBE_WHAT 4
#endif
#ifndef ATT_V2
#define ATT_V2 1
#endif
#ifndef PROBE_SEQ
#define PROBE_SEQ 0
#endif
#ifndef PROBE_T
#define PROBE_T 0
#endif
#ifndef PROBE_I
#define PROBE_I 4
#endif
#ifndef PROBE_J
#define PROBE_J 7
#endif
#ifndef PROBE_PHASE
#define PROBE_PHASE 3
#endif
#ifndef PROBE_PHASE
#define PROBE_PHASE 3
#endif
constexpr int RING_BYTES = 131072;
constexpr int LDS_BYTES = 147456, LDS_MISC = LDS_BYTES - 128;
constexpr int CW_BAR = 4096, CW_ARANK = 8192;
constexpr int LDS_BYTES_UNUSED = 0;


#if PROBE_T
#define PT_SLOTS_L(lds) ((volatile __attribute__((address_space(3))) long long*)((lds) + LDS_MISC + 32))
#define PT_ON_L(lds) (*(volatile __attribute__((address_space(3))) unsigned*)((lds) + LDS_MISC + 24))
#define PT_SUB_L(lds, i) do { if (threadIdx.x == 0 && blockIdx.x == 0 && PT_ON_L(lds)) PT_SLOTS_L(lds)[i] -= (long long)__builtin_readcyclecounter(); } while (0)
#define PT_ADD_L(lds, i) do { if (threadIdx.x == 0 && blockIdx.x == 0 && PT_ON_L(lds)) PT_SLOTS_L(lds)[i] += (long long)__builtin_readcyclecounter(); } while (0)
#else
#define PT_SUB_L(lds, i) do {} while (0)
#define PT_ADD_L(lds, i) do {} while (0)
#endif
#if PROBE_T == 2
#define PTK_SUB(F, i) PT_SUB_L((F).lds, i)
#define PTK_ADD(F, i) PT_ADD_L((F).lds, i)
#define PT_SUB(F, i) do {} while (0)
#define PT_ADD(F, i) do {} while (0)
#else
#define PTK_SUB(F, i) do {} while (0)
#define PTK_ADD(F, i) do {} while (0)
#define PT_SUB(F, i) PT_SUB_L((F).lds, i)
#define PT_ADD(F, i) PT_ADD_L((F).lds, i)
#endif
namespace pg8 {
#define PG8_LAS __attribute__((address_space(3)))
typedef unsigned short bf16_t;
typedef short bf16x8 __attribute__((ext_vector_type(8)));
typedef float f32x4 __attribute__((ext_vector_type(4)));
typedef unsigned u32x4 __attribute__((ext_vector_type(4)));
constexpr int BM = 256, BK = 64, HALF = 128, HTB = HALF * BK * 2  , STAGE_BYTES = 8 * HTB, NXCD = 8, WGM = 8;

__host__ __device__ __forceinline__ int lds_byte(int r, int c) { const int st = (r >> 4) * 2 + (c >> 5), rr = r & 15, cc = c & 31, ob = rr * 64 + cc * 2; return st * 1024 + (ob ^ (((ob >> 9) & 1) << 5)); }
__host__ __device__ __forceinline__ void stage_rc(int b, int& R, int& C) { const int st = b / 1024, sb = b % 1024, swz = sb ^ (((sb >> 9) & 1) << 5); R = (st >> 1) * 16 + swz / 64; C = (st & 1) * 32 + (swz % 64) / 2; }
__host__ __device__ __forceinline__ int perm32(int rho) { const int n = rho >> 4, i = rho & 15; return 8 * (i >> 2) + 4 * n + (i & 3); }

struct Unit { int pm, pn; };
struct Gemm { const bf16_t* A; const bf16_t* Bt; int M, N, K; };

struct StaticOrder {
    int nM, nN, nwg, G, c;
    __host__ __device__ void init(int M, int N, int G_, int c_) { nM = M / BM; nN = N / BM; nwg = nM * nN; G = G_; c = c_; }
    __host__ __device__ bool next(int i, Unit& u) const {
        const long L = (long)i * G + c; if (L >= nwg) return false;
        int wgid = (int)L; { const int q = nwg / NXCD, r = nwg % NXCD, xcd = wgid % NXCD, off = wgid / NXCD; wgid = (xcd < r ? xcd * (q + 1) : r * (q + 1) + (xcd - r) * q) + off; }
        const int nig = WGM * nN, gid = wgid / nig, fm = gid * WGM, gsz = (nM - fm) < WGM ? (nM - fm) : WGM;
        u.pm = fm + ((wgid % nig) % gsz); u.pn = (wgid % nig) / gsz; return true;
    }
    __device__ __forceinline__ void a_ready(const Unit&) const {}
    __device__ __forceinline__ void done(const Unit&) const {}
};

__device__ __forceinline__ unsigned cvt_pk_bf16(float lo, float hi) { unsigned r; asm volatile("v_cvt_pk_bf16_f32 %0, %1, %2" : "=v"(r) : "v"(lo), "v"(hi)); return r; }
typedef float f32x2 __attribute__((ext_vector_type(2)));
__device__ __forceinline__ float sum_xor16(float v) { const auto r = __builtin_amdgcn_permlane16_swap(__float_as_uint(v), __float_as_uint(v), false, false); return __uint_as_float(r[0]) + __uint_as_float(r[1]); }
__device__ __forceinline__ float sum_xor32(float v) { const auto r = __builtin_amdgcn_permlane32_swap(__float_as_uint(v), __float_as_uint(v), false, false); return __uint_as_float(r[0]) + __uint_as_float(r[1]); }
__device__ __forceinline__ float sq4(const f32x4 v) { return (v[0] * v[0] + v[1] * v[1]) + (v[2] * v[2] + v[3] * v[3]); }
__device__ __forceinline__ u32x4 pack8(const f32x4 a, const f32x4 b) { u32x4 w; w.x = cvt_pk_bf16(a[0], a[1]); w.y = cvt_pk_bf16(a[2], a[3]); w.z = cvt_pk_bf16(b[0], b[1]); w.w = cvt_pk_bf16(b[2], b[3]); return w; }

struct EpiQKV {
    static constexpr bool PERM = true, AFTER_DRAIN = false, KSCALE = false, PREP = false, PREFETCH = false; static constexpr int KS_T1 = -1, KS_T2 = -1;
    bf16_t* QKV;
    const float *gqa, *gka, *gqb, *gkb, *gqm;
    const float *rc, *rs;
    __device__ __forceinline__ void operator()(const f32x4 (&acc)[2][2][4][2], const Unit& u, int wr, int wc, int fr, int fq) const {
        const int hidx = u.pn * 4 + wc;
        const float* gain = nullptr; bool rope = false; float qs = 1.f;
        if (hidx < 6) { gain = gqa; rope = true; qs = QSCALE; } else if (hidx < 12) { gain = gka; rope = true; } else if (hidx < 18) { } else if (hidx < 24) { gain = gqb; qs = QSCALE; }
        else if (hidx < 30) { gain = gkb; } else if (hidx < 36) { } else { gain = gqm; qs = QSCALE; }
        const bool rl = rope && fq < 2;
        f32x4 g[2][2];
#pragma unroll
        for (int bj = 0; bj < 2; ++bj)
#pragma unroll
            for (int n = 0; n < 2; ++n) { const int d0 = (rl && bj == 0) ? (8 * n + 4 * fq) : (32 * bj + 8 * fq + 4 * n); g[bj][n] = gain ? *(const f32x4*)(gain + d0) : (f32x4){1.f, 1.f, 1.f, 1.f}; }
        bf16_t* base = QKV + (size_t)hidx * MTOK * 64 + 8 * fq;
#pragma unroll
        for (int ai = 0; ai < 2; ++ai)
#pragma unroll
            for (int m = 0; m < 4; ++m) {
                const int row = u.pm * BM + ai * HALF + wr * 64 + m * 16 + fr;
                f32x4 v[2][2];
#pragma unroll
                for (int bj = 0; bj < 2; ++bj)
#pragma unroll
                    for (int n = 0; n < 2; ++n) v[bj][n] = acc[ai][bj][m][n];
                if (gain) {
                    float ss = (sq4(v[0][0]) + sq4(v[0][1])) + (sq4(v[1][0]) + sq4(v[1][1]));
                    ss = sum_xor32(sum_xor16(ss));
                    const float r = rsqrtf(ss * (1.f / 64.f) + RMS_EPS) * qs;
#pragma unroll
                    for (int bj = 0; bj < 2; ++bj)
#pragma unroll
                        for (int n = 0; n < 2; ++n) v[bj][n] = v[bj][n] * r * g[bj][n];
                    if (rope) {
                        const int pos = row < TP ? row : ((row - TP) & (TS - 1));
                        const f32x4 c = *(const f32x4*)(rc + pos * 8 + 4 * (fq & 1)), s = *(const f32x4*)(rs + pos * 8 + 4 * (fq & 1));
                        if (fq < 2) { const f32x4 x1 = v[0][0], x2 = v[0][1]; v[0][0] = x1 * c - x2 * s; v[0][1] = x2 * c + x1 * s; }
                    }
                }
                bf16_t* rowp = base + (size_t)row * 64;
                __builtin_nontemporal_store(pack8(v[0][0], v[0][1]), (u32x4*)(rowp));
                __builtin_nontemporal_store(pack8(v[1][0], v[1][1]), (u32x4*)(rowp + 32));
            }
    }
};
struct EpiMemKV {
    static constexpr bool PERM = true, AFTER_DRAIN = false, KSCALE = false, PREP = false, PREFETCH = false; static constexpr int KS_T1 = -1, KS_T2 = -1;
    bf16_t* MK; bf16_t* MV; const float* gk;
    __device__ __forceinline__ void operator()(const f32x4 (&acc)[2][2][4][2], const Unit& u, int wr, int wc, int fr, int fq) const {
        const int hidx = u.pn * 4 + wc; const bool isk = hidx < 4; const int h = hidx & 3;
        f32x4 g[2][2];
#pragma unroll
        for (int bj = 0; bj < 2; ++bj)
#pragma unroll
            for (int n = 0; n < 2; ++n) g[bj][n] = isk ? *(const f32x4*)(gk + 32 * bj + 8 * fq + 4 * n) : (f32x4){1.f, 1.f, 1.f, 1.f};
        bf16_t* base = (isk ? MK : MV) + 8 * fq;
#pragma unroll
        for (int ai = 0; ai < 2; ++ai)
#pragma unroll
            for (int m = 0; m < 4; ++m) {
                const int row = u.pm * BM + ai * HALF + wr * 64 + m * 16 + fr;
                f32x4 v[2][2];
#pragma unroll
                for (int bj = 0; bj < 2; ++bj)
#pragma unroll
                    for (int n = 0; n < 2; ++n) v[bj][n] = acc[ai][bj][m][n];
                if (isk) {
                    float ss = (sq4(v[0][0]) + sq4(v[0][1])) + (sq4(v[1][0]) + sq4(v[1][1]));
                    ss = sum_xor32(sum_xor16(ss));
                    const float r = rsqrtf(ss * (1.f / 64.f) + RMS_EPS);
#pragma unroll
                    for (int bj = 0; bj < 2; ++bj)
#pragma unroll
                        for (int n = 0; n < 2; ++n) v[bj][n] = v[bj][n] * r * g[bj][n];
                }
                bf16_t* rowp = base + ((size_t)((row >> 8) * 4 + h) * NMEM + (row & 255)) * 64;
                *(u32x4*)(rowp) = pack8(v[0][0], v[0][1]);
                *(u32x4*)(rowp + 32) = pack8(v[1][0], v[1][1]);
            }
    }
};
struct EpiX1 {
    static constexpr bool PERM = true, AFTER_DRAIN = false, KSCALE = true, PREP = true, PREFETCH = false; static constexpr int KS_T1 = 6, KS_T2 = 12;
    const float* xp; const float* xs; float* out; bf16_t* x1b; float* ssq; const float* ssqa;
    static constexpr int TBL_OFF = 131072;
    __device__ __forceinline__ void prep(const Unit& u, PG8_LAS unsigned char* lds, int idx, int tid) const {
        if (tid < BM) { const f32x4* qp = (const f32x4*)(ssqa + (size_t)(u.pm * BM + tid) * 16); const f32x4 q0 = qp[0], q1 = qp[1], q2 = qp[2], q3 = qp[3];
            const float qa = (q0[0] + q0[1]) + (q0[2] + q0[3]) + (q1[0] + q1[1]), qb = (q1[2] + q1[3]) + (q2[0] + q2[1]) + (q2[2] + q2[3]), qm = (q3[0] + q3[1]) + (q3[2] + q3[3]);
            const float sa = rsqrtf(qa * (1.f / 384.f) + RMS_EPS), sb = rsqrtf(qb * (1.f / 384.f) + RMS_EPS), sm = rsqrtf(qm * (1.f / 256.f) + RMS_EPS);
            *(PG8_LAS f32x4*)(lds + TBL_OFF + (idx & 1) * 4096 + tid * 16) = (f32x4){sa / sb, sb / sm, sm, 0.f}; }
    }
    __device__ __forceinline__ void kscale(f32x4 (&acc)[2][2][4][2], int t, int wr, int fr, PG8_LAS unsigned char* lds, int idx) const {
        const PG8_LAS float* tb = (const PG8_LAS float*)(lds + TBL_OFF + (idx & 1) * 4096) + ((t == KS_T1) ? 0 : 1);
#pragma unroll
        for (int ai = 0; ai < 2; ++ai)
#pragma unroll
            for (int m = 0; m < 4; ++m) {
                const float f = tb[(ai * HALF + wr * 64 + m * 16 + fr) * 4];
#pragma unroll
                for (int bj = 0; bj < 2; ++bj)
#pragma unroll
                    for (int n = 0; n < 2; ++n) acc[ai][bj][m][n] = acc[ai][bj][m][n] * f;
            }
    }
    static constexpr int JUNK_OFF = 131072 + 8192;
    __device__ __forceinline__ void prefetch(const Unit& u, PG8_LAS unsigned char* lds, int tid) const {
        const int wid = tid >> 6;
#pragma unroll
        for (int i = 0; i < 4; ++i) { const int line = i * 512 + tid, row = u.pm * BM + (line >> 3);
            const float* src = (row < TP ? xp + (size_t)row * DM : xs + (size_t)(row - TP) * DM) + u.pn * BM + (line & 7) * 32;
            __builtin_amdgcn_global_load_lds((const unsigned*)src, (PG8_LAS unsigned*)(lds + JUNK_OFF + (wid & 3) * 256), 4, 0, 0); }
    }
    __device__ __forceinline__ void epi(const f32x4 (&acc)[2][2][4][2], const Unit& u, int wr, int wc, int fr, int fq, PG8_LAS unsigned char* lds, int idx) const {
        const PG8_LAS float* tb = (const PG8_LAS float*)(lds + TBL_OFF + (idx & 1) * 4096) + 2;
        const int col0 = u.pn * BM + wc * 32 + 8 * fq;
#pragma unroll
        for (int aim = 0; aim < 4; ++aim) {
            const int ai = aim >> 1, m0 = 2 * (aim & 1);
            f32x4 xr[2][2][2];
#pragma unroll
            for (int mm = 0; mm < 2; ++mm) { const int row = u.pm * BM + ai * HALF + wr * 64 + (m0 + mm) * 16 + fr;
                const float* xrow = (row < TP ? xp + (size_t)row * DM : xs + (size_t)(row - TP) * DM) + col0;
#pragma unroll
                for (int bj = 0; bj < 2; ++bj) { xr[mm][bj][0] = __builtin_nontemporal_load((const f32x4*)(xrow + bj * HALF)); xr[mm][bj][1] = __builtin_nontemporal_load((const f32x4*)(xrow + bj * HALF + 4)); } }
#pragma unroll
            for (int mm = 0; mm < 2; ++mm) {
                const int m = m0 + mm, row = u.pm * BM + ai * HALF + wr * 64 + m * 16 + fr;
                const float sm = tb[(ai * HALF + wr * 64 + m * 16 + fr) * 4];
                bf16_t* brow = x1b + (size_t)row * DM + col0;
                float ss = 0.f;
#pragma unroll
                for (int bj = 0; bj < 2; ++bj) {
                    const f32x4 v0 = acc[ai][bj][m][0] * sm + xr[mm][bj][0], v1 = acc[ai][bj][m][1] * sm + xr[mm][bj][1];
                    *(u32x4*)(brow + bj * HALF) = pack8(v0, v1);
                    ss += sq4(v0) + sq4(v1);
                }
                ss = sum_xor32(sum_xor16(ss));
                if (fq == 0) ssq[(size_t)row * 16 + u.pn * 4 + wc] = ss;
            }
            asm volatile("" ::: "memory");
        }
    }
};
struct EpiH {
    static constexpr bool PERM = true, AFTER_DRAIN = false, KSCALE = false, PREP = true, PREFETCH = false; static constexpr int KS_T1 = -1, KS_T2 = -1;
    bf16_t* H; const float* ssq; int mode;
    static constexpr int TBL_OFF = 131072;
    __device__ __forceinline__ void prep(const Unit& u, PG8_LAS unsigned char* lds, int idx, int tid) const {
        if (tid < BM) { const f32x4* qp = (const f32x4*)(ssq + (size_t)(u.pm * BM + tid) * 16); const f32x4 q0 = qp[0], q1 = qp[1], q2 = qp[2], q3 = qp[3];
            const float s = ((q0[0] + q0[1]) + (q0[2] + q0[3])) + ((q1[0] + q1[1]) + (q1[2] + q1[3])) + ((q2[0] + q2[1]) + (q2[2] + q2[3])) + ((q3[0] + q3[1]) + (q3[2] + q3[3]));
            *(PG8_LAS float*)(lds + TBL_OFF + (idx & 1) * 1024 + tid * 4) = rsqrtf(s * (1.f / DM) + RMS_EPS); }
    }
    __device__ __forceinline__ void epi(const f32x4 (&acc)[2][2][4][2], const Unit& u, int wr, int wc, int fr, int fq, PG8_LAS unsigned char* lds, int idx) const {
        if (mode == 2) return;
        const PG8_LAS float* tb = (const PG8_LAS float*)(lds + TBL_OFF + (idx & 1) * 1024);
        const int col0 = u.pn * BM + wc * 32 + 8 * fq;
#pragma unroll
        for (int ai = 0; ai < 2; ++ai)
#pragma unroll
            for (int m = 0; m < 4; ++m) {
                const int row = u.pm * BM + ai * HALF + wr * 64 + m * 16 + fr;
                const float r = tb[ai * HALF + wr * 64 + m * 16 + fr];
                bf16_t* hrow = H + (size_t)row * FF + col0;
#pragma unroll
                for (int bj = 0; bj < 2; ++bj) {
                    f32x4 v0 = acc[ai][bj][m][0] * r, v1 = acc[ai][bj][m][1] * r;
#pragma unroll
                    for (int e = 0; e < 4; ++e) { const float a = fmaxf(v0[e], 0.f), b = fmaxf(v1[e], 0.f); v0[e] = a * a; v1[e] = b * b; }
                    const u32x4 pk = pack8(v0, v1); if (mode == 0) *(u32x4*)(hrow + bj * HALF) = pk; else asm volatile("" :: "v"(pk));
                }
            }
    }
};
struct EpiOut {
    static constexpr bool PERM = true, AFTER_DRAIN = false, KSCALE = false, PREP = false, PREFETCH = false; static constexpr int KS_T1 = -1, KS_T2 = -1;
    float* out; const bf16_t* x1b;
    static constexpr int JUNK_OFF = 131072 + 8192;
    __device__ __forceinline__ void prefetch(const Unit& u, PG8_LAS unsigned char* lds, int tid) const {
        const int wid = tid >> 6;
#pragma unroll
        for (int i = 0; i < 2; ++i) { const int line = i * 512 + tid; const bf16_t* src = x1b + (size_t)(u.pm * BM + (line >> 2)) * DM + u.pn * BM + (line & 3) * 64;
            __builtin_amdgcn_global_load_lds((const unsigned*)src, (PG8_LAS unsigned*)(lds + JUNK_OFF + (wid & 3) * 256), 4, 0, 0); }
    }
    __device__ __forceinline__ void operator()(const f32x4 (&acc)[2][2][4][2], const Unit& u, int wr, int wc, int fr, int fq) const {
        const int col0 = u.pn * BM + wc * 32 + 8 * fq;
#pragma unroll
        for (int ai = 0; ai < 2; ++ai) {
            u32x4 rr[4][2];
#pragma unroll
            for (int m = 0; m < 4; ++m) { const bf16_t* brow = x1b + (size_t)(u.pm * BM + ai * HALF + wr * 64 + m * 16 + fr) * DM + col0;
#pragma unroll
                for (int bj = 0; bj < 2; ++bj) rr[m][bj] = *(const u32x4*)(brow + bj * HALF); }
#pragma unroll
            for (int m = 0; m < 4; ++m) {
                const int row = u.pm * BM + ai * HALF + wr * 64 + m * 16 + fr;
                float* orow = out + (size_t)row * DM + col0;
#pragma unroll
                for (int bj = 0; bj < 2; ++bj) {
                    const u32x4 r = rr[m][bj];
                    const f32x4 r0 = {__uint_as_float(r.x << 16), __uint_as_float(r.x & 0xffff0000u), __uint_as_float(r.y << 16), __uint_as_float(r.y & 0xffff0000u)};
                    const f32x4 r1 = {__uint_as_float(r.z << 16), __uint_as_float(r.z & 0xffff0000u), __uint_as_float(r.w << 16), __uint_as_float(r.w & 0xffff0000u)};
                    *(f32x4*)(orow + bj * HALF) = acc[ai][bj][m][0] + r0; *(f32x4*)(orow + bj * HALF + 4) = acc[ai][bj][m][1] + r1;
                }
            }
            asm volatile("" ::: "memory");
        }
    }
};

template <class Epi, class Sched, bool ALIGN_EPI = false, bool SP2 = false>
__device__ __forceinline__ void gemm_phase(PG8_LAS unsigned char* lds, const Gemm g, const Sched& S, const Epi& E) {
    const int tid = threadIdx.x, wid = __builtin_amdgcn_readfirstlane(tid >> 6), lane = tid & 63, wr = wid >> 2, wc = wid & 3, fr = lane & 15, fq = lane >> 4;
    const int K = g.K, nt = K / BK;
    unsigned voffA[2], voffB[2];
#pragma unroll
    for (int i = 0; i < 2; ++i) { int R, C; stage_rc(tid * 16 + i * 8192, R, C); const int Rb = Epi::PERM ? ((R & ~31) + perm32(R & 31)) : R;
        voffA[i] = (unsigned)(R * K + C) * 2u; voffB[i] = (unsigned)(Rb * K + C) * 2u; }
    const size_t kstep = (size_t)(BK * 2);
    const size_t hstep = (size_t)HALF * K * 2;
    const size_t tstep = 2 * hstep;
    const unsigned ldsw = (unsigned)wid * 1024u;
    const int aoff = lds_byte(wr * 64 + fr, fq * 8), boff = lds_byte(wc * 32 + fr, fq * 8);
#define PG8_SA(b, h) (((b) * 2 + (h)) * HTB)
#define PG8_SB(b, h) ((4 + (b) * 2 + (h)) * HTB)
#define PG8_STAGE(bufoff, gbase, voff) do { _Pragma("unroll") for (int _i = 0; _i < 2; ++_i) \
        __builtin_amdgcn_global_load_lds((const unsigned*)((const char*)(gbase) + (voff)[_i]), (PG8_LAS unsigned*)(lds + (bufoff) + ldsw + _i * 8192), 16, 0, 0); } while (0)
#define PG8_LDA(dst, b, h) do { _Pragma("unroll") for (int m = 0; m < 4; ++m) _Pragma("unroll") for (int k = 0; k < 2; ++k) dst[m][k] = *(const PG8_LAS bf16x8*)(lds + PG8_SA(b, h) + aoff + m * 2048 + k * 1024); } while (0)
#define PG8_LDB(dst, b, h) do { _Pragma("unroll") for (int n = 0; n < 2; ++n) _Pragma("unroll") for (int k = 0; k < 2; ++k) dst[n][k] = *(const PG8_LAS bf16x8*)(lds + PG8_SB(b, h) + boff + n * 2048 + k * 1024); } while (0)
#define PG8_MMA(ai, bj, At, Bt) do { __builtin_amdgcn_s_setprio(1); _Pragma("unroll") for (int m = 0; m < 4; ++m) _Pragma("unroll") for (int n = 0; n < 2; ++n) _Pragma("unroll") for (int k = 0; k < 2; ++k) \
        acc[ai][bj][m][n] = __builtin_amdgcn_mfma_f32_16x16x32_bf16(Bt[n][k], At[m][k], acc[ai][bj][m][n], 0, 0, 0); __builtin_amdgcn_s_setprio(0); } while (0)
#define PG8_WAIT_V(n) asm volatile("s_waitcnt vmcnt(" #n ")" ::: "memory")
#define PG8_WAIT_L(n) asm volatile("s_waitcnt lgkmcnt(" #n ")" ::: "memory")
#define PG8_BAR __builtin_amdgcn_s_barrier()
#define PG8_SCHED __builtin_amdgcn_sched_barrier(0)
    Unit cur, nxt; int ui = 0;
    if (!S.next(0, cur)) return;
    PT_SUB_L(lds, 5);
    f32x4 acc[2][2][4][2];
#pragma unroll
    for (int a = 0; a < 2; ++a)
#pragma unroll
        for (int b = 0; b < 2; ++b)
#pragma unroll
            for (int m = 0; m < 4; ++m)
#pragma unroll
                for (int n = 0; n < 2; ++n) acc[a][b][m][n] = (f32x4){0.f, 0.f, 0.f, 0.f};
    bf16x8 At[4][2], B0[2][2], B1[2][2];
    const char* cA = (const char*)g.A + (size_t)cur.pm * tstep; const char* cB = (const char*)g.Bt + (size_t)cur.pn * tstep;
    S.a_ready(cur);
    if constexpr (Epi::PREP) E.prep(cur, lds, 0, tid);
    if constexpr (SP2) {
        PG8_STAGE(PG8_SB(0, 0), cB, voffB); PG8_STAGE(PG8_SB(0, 1), cB + hstep, voffB); PG8_STAGE(PG8_SA(0, 0), cA, voffA); PG8_STAGE(PG8_SA(0, 1), cA + hstep, voffA);
        if (wr == 1) PG8_BAR;
        PG8_WAIT_V(2); PG8_BAR;
        PG8_STAGE(PG8_SB(1, 0), cB + kstep, voffB); PG8_STAGE(PG8_SA(1, 0), cA + kstep, voffA); PG8_STAGE(PG8_SB(1, 1), cB + hstep + kstep, voffB);
        PG8_WAIT_V(6); PG8_BAR;
    } else {
        PG8_STAGE(PG8_SB(0, 0), cB, voffB); PG8_STAGE(PG8_SA(0, 0), cA, voffA); PG8_STAGE(PG8_SB(0, 1), cB + hstep, voffB); PG8_STAGE(PG8_SA(0, 1), cA + hstep, voffA);
        if (wr == 1) PG8_BAR;
        PG8_WAIT_V(4); PG8_BAR;
        PG8_STAGE(PG8_SB(1, 0), cB + kstep, voffB); PG8_STAGE(PG8_SA(1, 0), cA + kstep, voffA); PG8_STAGE(PG8_SB(1, 1), cB + hstep + kstep, voffB);
        PG8_WAIT_V(6); PG8_BAR;
    }
    for (;;) {
        const bool has_next = S.next(ui + 1, nxt);
        const char* nA = has_next ? (const char*)g.A + (size_t)nxt.pm * tstep : cA; const char* nB = has_next ? (const char*)g.Bt + (size_t)nxt.pn * tstep : cB;
        for (int t = 0; t < nt; t += 2) {
            const bool last = (t == nt - 2);
            if constexpr (Epi::KSCALE) { if (t == Epi::KS_T1 || t == Epi::KS_T2) E.kscale(acc, t, wr, fr, lds, ui); }
            if constexpr (Epi::PREFETCH) { if (t == 4) E.prefetch(cur, lds, tid); }
            const char* a1 = cA + (size_t)(t + 1) * kstep;
            const char* a2 = last ? nA : cA + (size_t)(t + 2) * kstep; const char* b2 = last ? nB : cB + (size_t)(t + 2) * kstep;
            const char* a3 = a2 + kstep; const char* b3 = b2 + kstep;
            if (last && has_next) { S.a_ready(nxt); if constexpr (Epi::PREP) E.prep(nxt, lds, ui + 1, tid); }
            if constexpr (SP2) {
            PG8_LDB(B0, 0, 0); PG8_LDB(B1, 0, 1); PG8_SCHED; PG8_LDA(At, 0, 0); PG8_STAGE(PG8_SA(1, 1), a1 + hstep, voffA);
            PG8_WAIT_V(8); PG8_WAIT_L(0); PG8_BAR; PG8_MMA(0, 0, At, B0); PG8_MMA(0, 1, At, B1); PG8_BAR; PG8_SCHED;
            PG8_LDA(At, 0, 1); PG8_STAGE(PG8_SB(0, 0), b2, voffB); PG8_STAGE(PG8_SB(0, 1), b2 + hstep, voffB); PG8_STAGE(PG8_SA(0, 0), a2, voffA);
            PG8_WAIT_V(8); PG8_WAIT_L(0); PG8_BAR; PG8_MMA(1, 0, At, B0); PG8_MMA(1, 1, At, B1); PG8_BAR; PG8_SCHED;
            PG8_LDB(B0, 1, 0); PG8_LDB(B1, 1, 1); PG8_SCHED; PG8_LDA(At, 1, 0); PG8_STAGE(PG8_SA(0, 1), a2 + hstep, voffA);
            PG8_WAIT_V(8); PG8_WAIT_L(0); PG8_BAR; PG8_MMA(0, 0, At, B0); PG8_MMA(0, 1, At, B1); PG8_BAR; PG8_SCHED;
            PG8_LDA(At, 1, 1); PG8_STAGE(PG8_SB(1, 0), b3, voffB); PG8_STAGE(PG8_SB(1, 1), b3 + hstep, voffB); PG8_STAGE(PG8_SA(1, 0), a3, voffA);
            PG8_WAIT_V(8); PG8_WAIT_L(0); PG8_BAR; PG8_MMA(1, 0, At, B0); PG8_MMA(1, 1, At, B1); PG8_BAR; PG8_SCHED;
            } else {
            PG8_LDB(B0, 0, 0); PG8_SCHED; PG8_LDA(At, 0, 0); PG8_STAGE(PG8_SA(1, 1), a1 + hstep, voffA);
            PG8_WAIT_L(8); PG8_BAR; PG8_WAIT_L(0); PG8_MMA(0, 0, At, B0); PG8_BAR; PG8_SCHED;
            PG8_LDB(B1, 0, 1); PG8_STAGE(PG8_SB(0, 0), b2, voffB);
            PG8_BAR; PG8_WAIT_L(0); PG8_MMA(0, 1, At, B1); PG8_BAR;
            PG8_LDA(At, 0, 1); PG8_STAGE(PG8_SA(0, 0), a2, voffA);
            PG8_BAR; PG8_WAIT_L(0); PG8_MMA(1, 0, At, B0); PG8_BAR; PG8_SCHED;
            PG8_STAGE(PG8_SB(0, 1), b2 + hstep, voffB);
            PG8_WAIT_V(6); PG8_BAR; PG8_MMA(1, 1, At, B1); PG8_BAR;
            PG8_LDB(B0, 1, 0); PG8_SCHED; PG8_LDA(At, 1, 0); PG8_STAGE(PG8_SA(0, 1), a2 + hstep, voffA);
            PG8_WAIT_L(8); PG8_BAR; PG8_WAIT_L(0); PG8_MMA(0, 0, At, B0); PG8_BAR; PG8_SCHED;
            PG8_LDB(B1, 1, 1); PG8_STAGE(PG8_SB(1, 0), b3, voffB);
            PG8_BAR; PG8_WAIT_L(0); PG8_MMA(0, 1, At, B1); PG8_BAR;
            PG8_LDA(At, 1, 1); PG8_STAGE(PG8_SA(1, 0), a3, voffA);
            PG8_BAR; PG8_WAIT_L(0); PG8_MMA(1, 0, At, B0); PG8_BAR; PG8_SCHED;
            PG8_STAGE(PG8_SB(1, 1), b3 + hstep, voffB);
            PG8_WAIT_V(6); PG8_BAR; PG8_MMA(1, 1, At, B1); PG8_BAR;
            }
        }
        if constexpr (ALIGN_EPI) { if (wr == 0) PG8_BAR; }
        PT_SUB_L(lds, 4);
        if constexpr (!Epi::AFTER_DRAIN) { if constexpr (Epi::PREP) E.epi(acc, cur, wr, wc, fr, fq, lds, ui); else E(acc, cur, wr, wc, fr, fq); S.done(cur); }
        PT_ADD_L(lds, 4);
        if (!has_next) break;
#pragma unroll
        for (int a = 0; a < 2; ++a)
#pragma unroll
            for (int b = 0; b < 2; ++b)
#pragma unroll
                for (int m = 0; m < 4; ++m)
#pragma unroll
                    for (int n = 0; n < 2; ++n) acc[a][b][m][n] = (f32x4){0.f, 0.f, 0.f, 0.f};
        cur = nxt; cA = nA; cB = nB; ++ui;
        if constexpr (ALIGN_EPI) { if (wr == 1) PG8_BAR; }
    }
    PT_ADD_L(lds, 5);
    PG8_WAIT_V(0);
    if constexpr (!ALIGN_EPI) { if (wr == 0) PG8_BAR; }
    PG8_BAR;
    if constexpr (Epi::AFTER_DRAIN) { E.fused(acc, cur, wr, wc, fr, fq, lds, wid, lane); S.done(cur); }
#undef PG8_SA
#undef PG8_SB
#undef PG8_STAGE
#undef PG8_LDA
#undef PG8_LDB
#undef PG8_MMA
#undef PG8_WAIT_V
#undef PG8_WAIT_L
#undef PG8_BAR
#undef PG8_SCHED
}
}

constexpr int NWAVES = 8;
#ifndef MK_N_LAUNCHES
#define MK_N_LAUNCHES 1
#endif
constexpr int NPH = 7;
constexpr int N_LAUNCHES = MK_N_LAUNCHES;

constexpr size_t MiB = 1u << 20;
constexpr size_t WS_CTL = 0, CTL_ZERO_BYTES = 1 * MiB;
constexpr size_t WS_SSQF = 27 * MiB;
constexpr size_t WS_SSQA = 464 * MiB;
constexpr size_t WS_ROPE = 2 * MiB;
constexpr size_t WS_WIN = 3 * MiB, WS_WMEM = 8 * MiB, WS_WOUT = 9 * MiB, WS_W1 = 11 * MiB, WS_W2 = 19 * MiB;
constexpr size_t WS_XNMEM = 27 * MiB, WS_MK = 30 * MiB, WS_MV = 31 * MiB;
constexpr size_t WS_X1B = 32 * MiB;
constexpr size_t WS_XN = 128 * MiB, WS_O = 128 * MiB;
constexpr size_t WS_QKV = 224 * MiB;
constexpr size_t WS_H = 128 * MiB;
constexpr size_t WS_END = 512 * MiB;
static_assert(WS_QKV + (size_t)NHEADS * MTOK * 64 * 2 <= WS_END && WS_H + (size_t)MTOK * FF * 2 <= WS_END && WS_X1B + (size_t)MTOK * DM * 2 <= WS_XN && WS_XN + (size_t)MTOK * DM * 2 <= WS_QKV, "d_ws map");

#define LAS __attribute__((address_space(3)))
typedef unsigned short bf16;
typedef unsigned v4u __attribute__((ext_vector_type(4)));
typedef float f32x4 __attribute__((ext_vector_type(4)));
#define LDS_WAIT() asm volatile("s_waitcnt lgkmcnt(0)" ::: "memory")
__device__ __forceinline__ unsigned f2bf(float f) { unsigned u = __builtin_bit_cast(unsigned, f); return (u + 0x7fffu + ((u >> 16) & 1u)) >> 16; }
__device__ __forceinline__ unsigned pk2(float lo, float hi) { return f2bf(lo) | (f2bf(hi) << 16); }
__device__ __forceinline__ float bflo(unsigned w) { return __uint_as_float(w << 16); }
__device__ __forceinline__ float bfhi(unsigned w) { return __uint_as_float(w & 0xffff0000u); }
__device__ __forceinline__ float wave_sum(float v) {
#pragma unroll
    for (int o = 1; o < 64; o <<= 1) v += __shfl_xor(v, o);
    return v;
}

struct Frame {
    LAS unsigned char* lds;
    int tid, lane, wave, vcu, G, tm, what; bool nostore, pt_on;
    float* out; unsigned char* ws;
};
struct Args { const float* in[22]; float* out; unsigned char* ws; int ph_lo, ph_hi; };


namespace att {
typedef short bf16x8 __attribute__((ext_vector_type(8)));
typedef short s16x4 __attribute__((ext_vector_type(4)));
typedef short v4i16_t __attribute__((ext_vector_type(4)));
typedef float f32x16 __attribute__((ext_vector_type(16)));
typedef float f32x4 __attribute__((ext_vector_type(4)));
typedef unsigned u32x4 __attribute__((ext_vector_type(4)));
typedef float f32x2_t __attribute__((ext_vector_type(2))); typedef __bf16 bf16x2_t __attribute__((ext_vector_type(2)));
typedef __attribute__((address_space(3))) unsigned char* lptr;
__device__ __forceinline__ unsigned cvtpk(float lo, float hi) { f32x2_t v = {lo, hi}; bf16x2_t b = __builtin_convertvector(v, bf16x2_t); return __builtin_bit_cast(unsigned, b); }
__device__ __forceinline__ s16x4 vtr(lptr p) { return __builtin_bit_cast(s16x4, __builtin_amdgcn_ds_read_tr16_b64_v4i16((__attribute__((address_space(3))) v4i16_t*)p)); }
__device__ __forceinline__ int creg(int r) { return (r & 3) + 8 * (r >> 2); }
constexpr float NEG = -INFINITY;

constexpr int VDH = 2112, TILE_V = 4096, TILE_BYTES = TILE_V + 2 * VDH;
template <class Spec> __device__ __forceinline__ void load_tile(const Spec& S, int t, u32x4 (&kn)[4], u32x4 (&vn)[4], int lane) {
#pragma unroll
    for (int j = 0; j < 4; ++j) { const int row = 8 * j + (lane >> 3); kn[j] = *(const u32x4*)(S.krow(t, row) + 8 * (lane & 7)); vn[j] = *(const u32x4*)(S.vrow(t, row) + 8 * (lane & 7)); }
}
template <int NJ, class Spec> __device__ __forceinline__ void run_tiles(const Spec& S, const bf16x8 (&qr)[NJ][4], f32x16 (&o)[NJ][2], float (&lsum)[NJ], lptr tb, int lane) {
    const int r32 = lane & 31, hi = lane >> 5;
    const int NT = S.ntiles();
    const int loff = TILE_V + ((lane >> 4) & 1) * 32 + (lane & 3) * 8 + (4 * hi + ((lane & 15) >> 2)) * 64;
    const int wrow = lane >> 3, wc = lane & 7;
    const int vwoff = TILE_V + (wc >> 2) * VDH + wrow * 64 + (wc & 3) * 16;
    u32x4 kn[4], vn[4];
    load_tile(S, 0, kn, vn, lane);
    for (int t = 0; t < NT; ++t) {
#pragma unroll
        for (int j = 0; j < 4; ++j) { const int row = 8 * j + wrow;
            *(__attribute__((address_space(3))) u32x4*)(tb + row * 128 + ((wc ^ ((row >> 1) & 7)) * 16)) = kn[j];
            *(__attribute__((address_space(3))) u32x4*)(tb + vwoff + j * 512) = vn[j]; }
        if (t + 1 < NT) load_tile(S, t + 1, kn, vn, lane);
        bf16x8 kf[4];
#pragma unroll
        for (int d0 = 0; d0 < 4; ++d0) kf[d0] = *(__attribute__((address_space(3))) bf16x8*)(tb + r32 * 128 + (((2 * d0 + hi) ^ ((r32 >> 1) & 7)) * 16));
        bf16x8 vf[2][2];
#pragma unroll
        for (int dh = 0; dh < 2; ++dh)
#pragma unroll
            for (int ks = 0; ks < 2; ++ks) { const s16x4 l0 = vtr(tb + dh * VDH + ks * 1024 + loff), h0 = vtr(tb + dh * VDH + ks * 1024 + 512 + loff);
                vf[dh][ks] = (bf16x8){l0[0], l0[1], l0[2], l0[3], h0[0], h0[1], h0[2], h0[3]}; }
#pragma unroll
        for (int jb = 0; jb < NJ; ++jb) {
            if (NJ > 1 && !S.active(jb, t)) continue;
            f32x16 p = {};
#pragma unroll
            for (int d0 = 0; d0 < 4; ++d0) p = __builtin_amdgcn_mfma_f32_32x32x16_bf16(kf[d0], qr[jb][d0], p, 0, 0, 0);
            S.mask(jb, t, p, lane);
            float sacc = 0.f;
#pragma unroll
            for (int r = 0; r < 16; ++r) { p[r] = __builtin_amdgcn_exp2f(p[r]); sacc += p[r]; }
            lsum[jb] += sacc;
            u32x4 pw0, pw1;
            pw0[0] = cvtpk(p[0], p[1]); pw0[1] = cvtpk(p[2], p[3]); pw0[2] = cvtpk(p[4], p[5]); pw0[3] = cvtpk(p[6], p[7]);
            pw1[0] = cvtpk(p[8], p[9]); pw1[1] = cvtpk(p[10], p[11]); pw1[2] = cvtpk(p[12], p[13]); pw1[3] = cvtpk(p[14], p[15]);
#pragma unroll
            for (int dh = 0; dh < 2; ++dh) {
                o[jb][dh] = __builtin_amdgcn_mfma_f32_32x32x16_bf16(__builtin_bit_cast(bf16x8, pw0), vf[dh][0], o[jb][dh], 0, 0, 0);
                o[jb][dh] = __builtin_amdgcn_mfma_f32_32x32x16_bf16(__builtin_bit_cast(bf16x8, pw1), vf[dh][1], o[jb][dh], 0, 0, 0);
            }
        }
    }
}
__device__ __forceinline__ void load_q(bf16x8 (&qr)[4], const bf16* qrow, int lane) {
    const int hi = lane >> 5;
#pragma unroll
    for (int d0 = 0; d0 < 4; ++d0) qr[d0] = *(const bf16x8*)(qrow + 16 * d0 + 8 * hi);
}
template <class RowFn, class SsqFn> __device__ __forceinline__ void store_out(const f32x16 (&o)[2], float lsum, lptr wbuf, const RowFn& orow, const SsqFn& ssqp, int lane, bool nostore = false) {
    const int r32 = lane & 31, hi = lane >> 5;
    lsum += __shfl_xor(lsum, 32);
    __attribute__((address_space(3))) float* ls = (__attribute__((address_space(3))) float*)(wbuf + 4096);
    if (hi == 0) ls[r32] = lsum;
    __attribute__((address_space(3))) unsigned short* stg = (__attribute__((address_space(3))) unsigned short*)wbuf;
    float rl[16];
#pragma unroll
    for (int g = 0; g < 4; ++g) { const f32x4 lv = *(__attribute__((address_space(3))) f32x4*)(ls + 8 * g + 4 * hi);
#pragma unroll
        for (int j = 0; j < 4; ++j) rl[4 * g + j] = __builtin_amdgcn_rcpf(lv[j]); }
#pragma unroll
    for (int r = 0; r < 16; ++r) { const int q = creg(r) + 4 * hi;
#pragma unroll
        for (int dh = 0; dh < 2; ++dh) stg[q * 64 + dh * 32 + r32] = (unsigned short)f2bf(o[dh][r] * rl[r]); }
#pragma unroll
    for (int i = 0; i < 4; ++i) { const int row = i * 8 + (lane >> 3), ch = lane & 7; const u32x4 v = *(__attribute__((address_space(3))) u32x4*)(stg + row * 64 + ch * 8);
        float ss = 0.f;
#pragma unroll
        for (int e = 0; e < 4; ++e) { const float a = bflo(v[e]), b = bfhi(v[e]); ss += a * a + b * b; }
        ss += __shfl_xor(ss, 1); ss += __shfl_xor(ss, 2); ss += __shfl_xor(ss, 4);
        if (!nostore) { *(u32x4*)(orow(row) + ch * 8) = v; if (ch == 0) unsafeAtomicAdd(ssqp(row), ss); } }
}

struct SpecM { const bf16* K; const bf16* V; int tm;
    __device__ __forceinline__ int ntiles() const { return 8; }
    __device__ __forceinline__ const bf16* krow(int t, int i) const { return K + (32 * (t & tm) + i) * 64; }
    __device__ __forceinline__ const bf16* vrow(int t, int i) const { return V + (32 * (t & tm) + i) * 64; }
    __device__ __forceinline__ bool active(int, int) const { return true; }
    __device__ __forceinline__ void mask(int, int, f32x16&, int) const {}
};
struct SpecB { const bf16* K; const bf16* V;
    int nt, rk0, w0;
    int rlo, dr0;
    int cb;
    const __attribute__((address_space(3))) float* tb;
    int tm;
    __device__ __forceinline__ int ntiles() const { return nt; }
    __device__ __forceinline__ const bf16* krow(int t, int i) const { return K + ((rk0 + (t & tm)) * 64 + w0 + i) * 64; }
    __device__ __forceinline__ const bf16* vrow(int t, int i) const { return V + ((rk0 + (t & tm)) * 64 + w0 + i) * 64; }
    __device__ __forceinline__ bool active(int, int) const { return true; }
    __device__ __forceinline__ void mask(int, int t, f32x16& p, int lane) const {
        const int hi = lane >> 5, rk = rk0 + t; const bool rok = (unsigned)(rk - rlo) < 8u;
        int dr = rk + dr0; dr = dr < 0 ? 0 : (dr > 14 ? 14 : dr);
        const __attribute__((address_space(3))) float* tp = tb + dr * 64 + 4 * hi; const int cbh = rok ? cb + 4 * hi : -4096;
#pragma unroll
        for (int h8 = 0; h8 < 2; ++h8) {
            float bv[8];
#pragma unroll
            for (int r = 0; r < 8; ++r) bv[r] = tp[creg(8 * h8 + r)];
#pragma unroll
            for (int r = 0; r < 8; ++r) { const float sb = p[8 * h8 + r] + bv[r]; p[8 * h8 + r] = ((unsigned)(cbh + creg(8 * h8 + r)) < 16u) ? sb : NEG; }
            asm volatile("" ::: "memory");
        }
    }
};
struct SpecA { const bf16* K; const bf16* V;
    int kp0, qs, tstep, imask, ishift, nt, T, tm;
    __device__ __forceinline__ int ntiles() const { return nt; }
    __device__ __forceinline__ int kpos(int t, int i) const { int p = kp0 + (tstep * (t & tm) + (i & imask)) * qs + (i >> ishift); return p < 0 ? 0 : (p >= T ? T - 1 : p); }
    __device__ __forceinline__ const bf16* krow(int t, int i) const { return K + kpos(t, i) * 64; }
    __device__ __forceinline__ const bf16* vrow(int t, int i) const { return V + kpos(t, i) * 64; }
    __device__ __forceinline__ bool active(int, int) const { return true; }
    __device__ __forceinline__ void mask(int, int t, f32x16& p, int lane) const {
        const int r32 = lane & 31, hi = lane >> 5, cq = r32 >> ishift, iq = r32 & imask;
        const int lo = kp0 + tstep * t * qs, hip = lo + imask * qs + (31 >> ishift);
        if (t == 0 || t == nt - 1 || ishift == 4) {
            const int base = tstep * t - iq + 4 * hi;
            const int b0 = (cq == 0) ? base : -4096, b1 = (cq == (16 >> ishift) ? base : -4096);
#pragma unroll
            for (int r = 0; r < 16; ++r) { if ((unsigned)((r < 8 ? b0 : b1) + (creg(r) & imask)) > 128u) p[r] = NEG; } }
        if (lo < 0 || hip >= T) {
            const int kb = lo + 4 * hi * qs;
#pragma unroll
            for (int r = 0; r < 16; ++r) { const int kp = kb + (creg(r) & imask) * qs + (creg(r) >> ishift); if ((unsigned)kp >= (unsigned)T) p[r] = NEG; } }
    }
};
}
template <class CM, class KS>
__device__ __forceinline__ void p0_transpose_item(const float* W, int K, int N, bf16* WT, LAS float* scr, int item, int lane, CM cm, KS ks) {
    const int nblk = N / 32, kb = item / nblk, nb = item % nblk, k0 = 64 * kb, n0 = 32 * nb;
    const int sc = cm(n0 + (lane & 31));
#pragma unroll
    for (int i = 0; i < 32; ++i) { const int kk = 2 * i + (lane >> 5); scr[kk * 33 + (lane & 31)] = __builtin_nontemporal_load(W + (size_t)(k0 + kk) * N + sc) * ks(k0 + kk); }
    LDS_WAIT(); asm volatile("" ::: "memory");
    const int c = lane & 7;
#pragma unroll
    for (int j = 0; j < 4; ++j) { const int n = (lane >> 3) + 8 * j; const LAS float* s = scr + (8 * c) * 33 + n;
        v4u o; o.x = pk2(s[0 * 33], s[1 * 33]); o.y = pk2(s[2 * 33], s[3 * 33]); o.z = pk2(s[4 * 33], s[5 * 33]); o.w = pk2(s[6 * 33], s[7 * 33]);
        *(v4u*)(WT + (size_t)(n0 + n) * K + k0 + 8 * c) = o; }
    LDS_WAIT(); asm volatile("" ::: "memory");
}
struct CMapHead { int nrope;
    __device__ __forceinline__ int operator()(int c) const { const int pn = c >> 8, bj = (c >> 7) & 1, hh = (c >> 5) & 3, p5 = c & 31, hidx = 4 * pn + hh; int p = 32 * bj + p5;
        if (hidx < nrope && p < 16) p = (p & 3) + 8 * ((p >> 2) & 1) + 4 * (p >> 3); return 64 * hidx + p; } };
struct CMapId { __device__ __forceinline__ int operator()(int c) const { return c; } };
struct KSOne { __device__ __forceinline__ float operator()(int) const { return 1.f; } };
struct KSVec { const float* g; __device__ __forceinline__ float operator()(int k) const { return g[k]; } };
struct KSOut { const float *a, *b, *m; __device__ __forceinline__ float operator()(int k) const { return k < 384 ? a[k] : (k < 768 ? b[k - 384] : m[k - 768]); } };

template <int NR> __device__ __forceinline__ void rms_rows_to_bf16(const float* const (&xrow)[NR], const float* g, bf16* const (&orow)[NR], int lane) {
    f32x4 v[NR][4];
#pragma unroll
    for (int r = 0; r < NR; ++r) { const f32x4* xr = (const f32x4*)xrow[r] + lane;
#pragma unroll
        for (int j = 0; j < 4; ++j) v[r][j] = __builtin_nontemporal_load(xr + 64 * j); }
    const f32x4* gr = (const f32x4*)g + lane;
#pragma unroll
    for (int r = 0; r < NR; ++r) {
        float s = 0.f;
#pragma unroll
        for (int j = 0; j < 4; ++j) s += (v[r][j].x * v[r][j].x + v[r][j].y * v[r][j].y) + (v[r][j].z * v[r][j].z + v[r][j].w * v[r][j].w);
        const float rstd = rsqrtf(wave_sum(s) * (1.f / DM) + RMS_EPS);
        unsigned long long* o8 = (unsigned long long*)orow[r] + lane;
#pragma unroll
        for (int j = 0; j < 4; ++j) { const f32x4 gg = gr[64 * j]; o8[64 * j] = (unsigned long long)pk2(v[r][j].x * rstd * gg.x, v[r][j].y * rstd * gg.y) | ((unsigned long long)pk2(v[r][j].z * rstd * gg.z, v[r][j].w * rstd * gg.w) << 32); }
    }
}
__device__ __forceinline__ void p0_prologue(Frame& F, const Args& A) {
    LAS float* scr = (LAS float*)(F.lds + F.wave * 16384);
    const int gw = F.vcu * NWAVES + F.wave, NGW = F.G * NWAVES;
    unsigned char* ws = F.ws;
    constexpr int I_IN = (DM / 64) * (NQKV / 32), I_MEM = (DM / 64) * (512 / 32), I_OUT = (DM / 64) * (DM / 32), I_1 = (DM / 64) * (FF / 32), I_2 = (FF / 64) * (DM / 32);
    constexpr int NITEMS = I_IN + I_MEM + I_OUT + I_1 + I_2;
    PT_SUB(F, 0);
    for (int it = gw; it < NITEMS; it += NGW) {
        int r = it;
        if (r < I_IN) { p0_transpose_item(A.in[5], DM, NQKV, (bf16*)(ws + WS_WIN), scr, r, F.lane, CMapHead{12}, KSOne{}); continue; } r -= I_IN;
        if (r < I_MEM) { p0_transpose_item(A.in[12], DM, 512, (bf16*)(ws + WS_WMEM), scr, r, F.lane, CMapHead{0}, KSOne{}); continue; } r -= I_MEM;
        if (r < I_OUT) { p0_transpose_item(A.in[18], DM, DM, (bf16*)(ws + WS_WOUT), scr, r, F.lane, CMapId{}, KSOut{A.in[15], A.in[16], A.in[17]}); continue; } r -= I_OUT;
        if (r < I_1) { p0_transpose_item(A.in[20], DM, FF, (bf16*)(ws + WS_W1), scr, r, F.lane, CMapId{}, KSVec{A.in[19]}); continue; } r -= I_1;
        p0_transpose_item(A.in[21], FF, DM, (bf16*)(ws + WS_W2), scr, r, F.lane, CMapId{}, KSOne{});
    }
    PT_ADD(F, 0); PT_SUB(F, 1);
    for (int m4 = gw; m4 < (MTOK + MMEM) / 4; m4 += NGW) {
        const int m = 4 * m4; const float* xr[4]; bf16* orw[4]; const float* gn;
        if (m < MTOK) { const float* x0 = m < TP ? A.in[0] + (size_t)m * DM : A.in[1] + (size_t)(m - TP) * DM; bf16* o0 = (bf16*)(ws + WS_XN) + (size_t)m * DM; gn = A.in[4];
#pragma unroll
            for (int r = 0; r < 4; ++r) { xr[r] = x0 + (size_t)r * DM; orw[r] = o0 + (size_t)r * DM; } }
        else { const int r0 = m - MTOK; const float* x0 = r0 < NMEM ? A.in[2] + (size_t)r0 * DM : A.in[3] + (size_t)(r0 - NMEM) * DM; bf16* o0 = (bf16*)(ws + WS_XNMEM) + (size_t)r0 * DM; gn = A.in[11];
#pragma unroll
            for (int r = 0; r < 4; ++r) { xr[r] = x0 + (size_t)r * DM; orw[r] = o0 + (size_t)r * DM; } }
        rms_rows_to_bf16<4>(xr, gn, orw, F.lane);
    }
    PT_ADD(F, 1); PT_SUB(F, 2);
    float* rc = (float*)(ws + WS_ROPE); float* rs = rc + TP * 8;
    for (int i = (F.vcu * NWAVES * 64) + F.tid; i < TP * 8; i += F.G * NWAVES * 64) {
        const int pos = i >> 3, fi = i & 7;
        const float inv = exp2f(-(float)fi * 0.125f * 18.931568569324174f);
        const float ang = (float)pos * inv;
        const double rev = (double)ang * 0.15915494309189535; const float fr = (float)(rev - __builtin_rint(rev));
        rc[i] = __builtin_amdgcn_cosf(fr); rs[i] = __builtin_amdgcn_sinf(fr);
    }
    PT_ADD(F, 2);
}

template <int NR, class KF>
__device__ __forceinline__ void attn_item(const bf16* qrow, const bf16* Kb, const bf16* Vb, const KF& kf, bf16* orow, int lane) {
    float q[64];
#pragma unroll
    for (int c = 0; c < 8; ++c) { const v4u w = *(const v4u*)(qrow + 8 * c);
#pragma unroll
        for (int e = 0; e < 4; ++e) { q[8 * c + 2 * e] = bflo(w[e]); q[8 * c + 2 * e + 1] = bfhi(w[e]); } }
    float p[NR]; float lsum = 0.f;
#pragma unroll
    for (int r = 0; r < NR; ++r) {
        long ridx; float bias; const bool ok = kf(64 * r + lane, ridx, bias);
        const bf16* krow = Kb + ridx * 64; float s = 0.f;
#pragma unroll
        for (int c = 0; c < 8; ++c) { const v4u w = *(const v4u*)(krow + 8 * c);
#pragma unroll
            for (int e = 0; e < 4; ++e) s += q[8 * c + 2 * e] * bflo(w[e]) + q[8 * c + 2 * e + 1] * bfhi(w[e]); }
        p[r] = ok ? exp2f(s + bias) : 0.f; lsum += p[r];
    }
    lsum = wave_sum(lsum);
    float o = 0.f;
#pragma unroll
    for (int r = 0; r < NR; ++r) {
#pragma unroll 8
        for (int l = 0; l < 64; ++l) {
            long ridx; float bias; (void)kf(64 * r + l, ridx, bias);
            const float pj = __int_as_float(__builtin_amdgcn_readlane(__float_as_int(p[r]), l));
            o += pj * __uint_as_float((unsigned)Vb[ridx * 64 + lane] << 16);
        }
    }
    orow[lane] = (bf16)f2bf(o / lsum);
}
struct KeyA { long sb; int pos, T;
    __device__ __forceinline__ bool operator()(int j, long& ridx, float& bias) const { const int pat = j >= 258 ? 2 : (j >= 129 ? 1 : 0), idx = j - 129 * pat, dil = 1 << (2 * pat), kp = pos + (idx - 64) * dil;
        const bool ok = j < 387 && kp >= 0 && kp < T; ridx = sb + (ok ? kp : pos); bias = 0.f; return ok; } };
struct KeyB { long sb; int r, c, rs, cs; const float* rpb;
    __device__ __forceinline__ bool operator()(int j, long& ridx, float& bias) const { const int kr = (j >> 4) & 7, kc = j & 15; ridx = sb + (rs + kr) * 64 + cs + kc;
        bias = rpb[(rs + kr - r + 7) * 31 + (cs + kc - c + 15)] * LOG2E; return true; } };
struct KeyM { long b0;
    __device__ __forceinline__ bool operator()(int j, long& ridx, float& bias) const { ridx = b0 + (j & 255); bias = 0.f; return true; } };

__device__ __forceinline__ void attn_simple_phase(Frame& F, const Args& A) {
    const int gw = F.vcu * NWAVES + F.wave, NGW = F.G * NWAVES;
    const bf16* QKV = (const bf16*)(F.ws + WS_QKV); bf16* O = (bf16*)(F.ws + WS_O);
    const bf16* MK = (const bf16*)(F.ws + WS_MK); const bf16* MV = (const bf16*)(F.ws + WS_MV);
    for (int it = gw; it < MTOK * 16; it += NGW) {
        const int hh = it / MTOK, row = it - hh * MTOK;
        const int sbat = row < TP ? 0 : 1 + ((row - TP) >> 13);
        const long sb = row < TP ? 0 : TP + (long)(sbat - 1) * TS; const int T = row < TP ? TP : TS, pos = (int)(row - sb);
        if (hh < 6) {
            if (ATT_A_MFMA) continue;
            const int h = hh;
            attn_item<7>(QKV + ((size_t)(0 + h) * MTOK + row) * 64, QKV + (size_t)(6 + h) * MTOK * 64, QKV + (size_t)(12 + h) * MTOK * 64, KeyA{sb, pos, T}, O + (size_t)row * DM + h * 64, F.lane);
        } else if (hh < 12) {
            if (ATT_B_MFMA) continue;
            const int h = hh - 6, rows = T / 64, r = pos >> 6, c = pos & 63;
            int rs = r - 4; rs = rs < 0 ? 0 : (rs > rows - 8 ? rows - 8 : rs); int cs = c - 8; cs = cs < 0 ? 0 : (cs > 48 ? 48 : cs);
            attn_item<2>(QKV + ((size_t)(18 + h) * MTOK + row) * 64, QKV + (size_t)(24 + h) * MTOK * 64, QKV + (size_t)(30 + h) * MTOK * 64, KeyB{sb, r, c, rs, cs, A.in[10] + h * 15 * 31}, O + (size_t)row * DM + 384 + h * 64, F.lane);
        } else {
            if (ATT_M_MFMA) continue;
            const int h = hh - 12;
            attn_item<4>(QKV + ((size_t)(36 + h) * MTOK + row) * 64, MK, MV, KeyM{(long)(sbat * 4 + h) * NMEM}, O + (size_t)row * DM + 768 + h * 64, F.lane);
        }
    }
}
__device__ __forceinline__ void onorm_phase(Frame& F) {
    const int gw = F.vcu * NWAVES + F.wave, NGW = F.G * NWAVES;
    bf16* O = (bf16*)(F.ws + WS_O);
    for (int m = gw; m < MTOK; m += NGW) {
        v4u* p = (v4u*)(O + (size_t)m * DM) + 2 * F.lane; v4u w0 = p[0], w1 = p[1];
        float v[16];
#pragma unroll
        for (int e = 0; e < 4; ++e) { v[2 * e] = bflo(w0[e]); v[2 * e + 1] = bfhi(w0[e]); v[8 + 2 * e] = bflo(w1[e]); v[8 + 2 * e + 1] = bfhi(w1[e]); }
        float ss = 0.f;
#pragma unroll
        for (int e = 0; e < 16; ++e) ss += v[e] * v[e];
        const int grp = F.lane < 24 ? 0 : (F.lane < 48 ? 1 : 2);
        const float sa = wave_sum(grp == 0 ? ss : 0.f), sb = wave_sum(grp == 1 ? ss : 0.f), sm = wave_sum(grp == 2 ? ss : 0.f);
        const float r = grp == 0 ? rsqrtf(sa * (1.f / 384.f) + RMS_EPS) : (grp == 1 ? rsqrtf(sb * (1.f / 384.f) + RMS_EPS) : rsqrtf(sm * (1.f / 256.f) + RMS_EPS));
#pragma unroll
        for (int e = 0; e < 4; ++e) { w0[e] = pk2(v[2 * e] * r, v[2 * e + 1] * r); w1[e] = pk2(v[8 + 2 * e] * r, v[8 + 2 * e + 1] * r); }
        p[0] = w0; p[1] = w1;
    }
}

#define XB_TMO      128
#define XB_XCNT(j)  (256  + 64 * (j))
#define XB_XSUB(j)  (1280 + 64 * (j))
#define XB_XGEN(j)  (2304 + 64 * (j))
#define XB_TOP      3328
#define XB_TOPGEN   3392
#define XCD_BAR_WORDS 3456
#define XB_SPIN_CAP (1u << 18)

__device__ __forceinline__ unsigned xb_ld(unsigned* p)              { return __hip_atomic_load(p, __ATOMIC_RELAXED, __HIP_MEMORY_SCOPE_AGENT); }
__device__ __forceinline__ unsigned xb_add(unsigned* p, unsigned v) { return __hip_atomic_fetch_add(p, v, __ATOMIC_RELAXED, __HIP_MEMORY_SCOPE_AGENT); }
__device__ __forceinline__ unsigned xb_xcc_id() { return (unsigned)__builtin_amdgcn_s_getreg((3 << 11) | 20) & 0xFu; }
#define XB_SPIN(cond, bar) do { unsigned _sp = 0; while (cond) { __builtin_amdgcn_s_sleep(1); \
    if ((++_sp & 255u) == 0u) { if (xb_ld(&(bar)[XB_TMO])) break; if (_sp > XB_SPIN_CAP) { atomicAdd(&(bar)[XB_TMO], 1u); break; } } } } while (0)

struct XcdBarrier {
    unsigned* bar; unsigned x;
    volatile LAS unsigned* st;
};

__device__ __forceinline__ XcdBarrier xcd_barrier_post(unsigned* bar, volatile LAS unsigned* st) {
    XcdBarrier b; b.bar = bar; b.x = xb_xcc_id(); b.st = st;
    if (threadIdx.x == 0) (void)xb_add(&bar[XB_XCNT(b.x)], 1u);
    return b;
}
__device__ __forceinline__ void xcd_barrier_complete(unsigned* bar, unsigned x, unsigned& nloc, unsigned& nx) {
    const unsigned G = gridDim.x * gridDim.y * gridDim.z;
    unsigned sum, cnt, mine, sp = 0u;
    for (;;) {
        sum = 0u; cnt = 0u; mine = 0u;
#pragma unroll
        for (unsigned j = 0; j < 16; ++j) { const unsigned c = xb_ld(&bar[XB_XCNT(j)]); sum += c; cnt += (c > 0u) ? 1u : 0u; mine = (j == x) ? c : mine; }
        if (sum == G) break;
        __builtin_amdgcn_s_sleep(1);
        if ((++sp & 255u) == 0u) { if (xb_ld(&bar[XB_TMO])) break; if (sp > XB_SPIN_CAP) { atomicAdd(&bar[XB_TMO], 1u); break; } }
    }
    nloc = mine > 0u ? mine : 1u; nx = cnt > 0u ? cnt : 1u;
}

__device__ __forceinline__ void xcd_barrier(const XcdBarrier& b) {
    asm volatile("s_waitcnt vmcnt(0)" ::: "memory");
    __syncthreads();
    if (threadIdx.x == 0) {
        unsigned* bar = b.bar;
        __builtin_amdgcn_s_waitcnt(0);
        unsigned nloc = b.st[0], nx = b.st[1];
        if (nloc == 0u) { xcd_barrier_complete(bar, b.x, nloc, nx); b.st[0] = nloc; b.st[1] = nx; }
        const unsigned old = xb_add(&bar[XB_XSUB(b.x)], 1u);
        const unsigned gen = old / nloc;
        if (old + 1u == (gen + 1u) * nloc) {
            __builtin_amdgcn_fence(__ATOMIC_RELEASE, "agent");
            asm volatile("s_waitcnt vmcnt(0)" ::: "memory");
            const unsigned og = xb_add(&bar[XB_TOP], 1u);
            const unsigned tg = og / nx;
            if (og + 1u == (tg + 1u) * nx) xb_add(&bar[XB_TOPGEN], 1u);
            else XB_SPIN(xb_ld(&bar[XB_TOPGEN]) == tg, bar);
            __builtin_amdgcn_fence(__ATOMIC_ACQUIRE, "agent");
            xb_add(&bar[XB_XGEN(b.x)], 1u);
            asm volatile("s_waitcnt vmcnt(0)" ::: "memory");
        } else {
            XB_SPIN(xb_ld(&bar[XB_XGEN(b.x)]) == gen, bar);
            __builtin_amdgcn_fence(__ATOMIC_ACQUIRE, "agent");
            asm volatile("s_waitcnt vmcnt(0)" ::: "memory");
        }
    }
    __syncthreads();
}

constexpr int N_AUNITS = (MTOK / 256) * 6;
constexpr int N_BJOBS = (MTOK / 128) * 6 * 4;
constexpr int N_MJOBS = (MTOK / 32) * 4;
constexpr int LA_WSTRIDE = 8320, LA_ACC = 69632, LA_L = LA_ACC + 65536;
constexpr int LW_STRIDE = 12544, LW_TBL = 8448;

struct SeqInfo { long sb; int T; int bat; };
__device__ __forceinline__ SeqInfo seq_of(int row) { SeqInfo s; if (row < TP) { s.sb = 0; s.T = TP; s.bat = 0; } else { const int b = (row - TP) >> 13; s.sb = TP + (long)b * TS; s.T = TS; s.bat = 1 + b; } return s; }

__device__ __forceinline__ void m_job(Frame& F, int jm) {
    const int h = jm / (MTOK / 32), row0 = (jm - h * (MTOK / 32)) * 32; const SeqInfo si = seq_of(row0);
    const bf16* QKV = (const bf16*)(F.ws + WS_QKV);
    const int r32 = F.lane & 31;
    att::bf16x8 qr[1][4]; att::load_q(qr[0], QKV + ((size_t)(36 + h) * MTOK + row0 + r32) * 64, F.lane);
    att::SpecM S{(const bf16*)(F.ws + WS_MK) + (size_t)(si.bat * 4 + h) * NMEM * 64, (const bf16*)(F.ws + WS_MV) + (size_t)(si.bat * 4 + h) * NMEM * 64, F.tm};
    att::f32x16 o[1][2] = {}; float lsum[1] = {0.f};
    att::lptr wb = (att::lptr)(F.lds + F.wave * LW_STRIDE);
    att::run_tiles<1>(S, qr, o, lsum, wb, F.lane);
    bf16* O = (bf16*)(F.ws + WS_O) + (size_t)row0 * DM + 768 + 64 * h; float* SQ = (float*)(F.ws + WS_SSQA) + (size_t)row0 * 4 + 2;
    att::store_out(o[0], lsum[0], wb, [=](int q) { return O + (size_t)q * DM; }, [=](int q) { return SQ + (size_t)q * 4; }, F.lane, F.nostore);
}
__device__ __forceinline__ void b_job(Frame& F, const Args& A, int jb) {
    const int g = jb & 3, rest = jb >> 2, h = rest / (MTOK / 128), rp = rest - h * (MTOK / 128);
    int r0, rows; long sb;
    if (rp < TP / 128) { r0 = 2 * rp; rows = TP / 64; sb = 0; } else { const int q = rp - TP / 128, b = q / (TS / 128); r0 = 2 * (q - b * (TS / 128)); rows = TS / 64; sb = TP + (long)b * TS; }
    const int r32 = F.lane & 31;
    const int rq = r0 + (r32 >> 4), c = 16 * g + (r32 & 15);
    int rlo = rq - 4; rlo = rlo < 0 ? 0 : (rlo > rows - 8 ? rows - 8 : rlo);
    int cs = c - 8; cs = cs < 0 ? 0 : (cs > 48 ? 48 : cs);
    int rk0 = r0 - 4; rk0 = rk0 < 0 ? 0 : (rk0 > rows - 8 ? rows - 8 : rk0);
    int rk1 = r0 + 1 - 4; rk1 = rk1 < 0 ? 0 : (rk1 > rows - 8 ? rows - 8 : rk1);
    const int w0 = g == 0 ? 0 : (g == 1 ? 8 : (g == 2 ? 24 : 32));
    att::lptr wb = (att::lptr)(F.lds + F.wave * LW_STRIDE);
    __attribute__((address_space(3))) float* tbl = (__attribute__((address_space(3))) float*)(wb + LW_TBL);
    const float* rpb = A.in[10] + h * 465;
    if (F.lane < 31) {
#pragma unroll 5
        for (int dr = 0; dr < 15; ++dr) tbl[dr * 64 + 16 + F.lane] = rpb[dr * 31 + F.lane] * LOG2E; }
    asm volatile("" ::: "memory");
    const bf16* QKV = (const bf16*)(F.ws + WS_QKV);
    att::bf16x8 qr[1][4]; att::load_q(qr[0], QKV + ((size_t)(18 + h) * MTOK + sb + rq * 64 + c) * 64, F.lane);
    att::SpecB S{QKV + ((size_t)(24 + h) * MTOK + sb) * 64, QKV + ((size_t)(30 + h) * MTOK + sb) * 64, rk1 + 8 - rk0, rk0, w0, rlo, 7 - rq, w0 - cs, tbl + (31 + w0 - c), F.tm};
    att::f32x16 o[1][2] = {}; float lsum[1] = {0.f};
    att::run_tiles<1>(S, qr, o, lsum, wb, F.lane);
    bf16* O = (bf16*)(F.ws + WS_O) + (size_t)(sb + r0 * 64 + 16 * g) * DM + 384 + 64 * h; float* SQ = (float*)(F.ws + WS_SSQA) + (size_t)(sb + r0 * 64 + 16 * g) * 4 + 1;
    att::store_out(o[0], lsum[0], wb, [=](int q) { return O + (size_t)((q >> 4) * 64 + (q & 15)) * DM; }, [=](int q) { return SQ + (size_t)((q >> 4) * 64 + (q & 15)) * 4; }, F.lane, F.nostore);
}
template <class Spec, class QLoc> __device__ __forceinline__ void a_job(Frame& F, const Spec& S, const bf16* qrow, const QLoc& qloc) {
    att::bf16x8 qr[1][4]; att::load_q(qr[0], qrow, F.lane);
    att::f32x16 o1[1][2] = {}; float lsum1[1] = {0.f};
    att::run_tiles<1>(S, qr, o1, lsum1, (att::lptr)(F.lds + F.wave * LA_WSTRIDE), F.lane);
    const att::f32x16 (&o)[2] = o1[0]; const float lsum = lsum1[0];
    const int r32 = F.lane & 31, hi = F.lane >> 5;
    __attribute__((address_space(3))) float* acc = (__attribute__((address_space(3))) float*)(F.lds + LA_ACC);
    __attribute__((address_space(3))) float* ls = (__attribute__((address_space(3))) float*)(F.lds + LA_L);
#pragma unroll
    for (int r = 0; r < 16; ++r) { const int ql = qloc(att::creg(r) + 4 * hi);
#pragma unroll
        for (int dh = 0; dh < 2; ++dh) (void)__hip_atomic_fetch_add(acc + ql * 64 + dh * 32 + r32, o[dh][r], __ATOMIC_RELAXED, __HIP_MEMORY_SCOPE_WORKGROUP); }
    (void)__hip_atomic_fetch_add(ls + qloc(r32), lsum, __ATOMIC_RELAXED, __HIP_MEMORY_SCOPE_WORKGROUP);
}
__device__ __forceinline__ void a_unit(Frame& F, int ua) {
    const int h = ua / (MTOK / 256), row0 = (ua - h * (MTOK / 256)) * 256; const SeqInfo si = seq_of(row0);
    const int pq0 = (int)(row0 - si.sb), w = F.wave, r32 = F.lane & 31;
    { __attribute__((address_space(3))) att::f32x4* z = (__attribute__((address_space(3))) att::f32x4*)(F.lds + LA_ACC);
#pragma unroll
      for (int i = 0; i < 8; ++i) z[i * 512 + F.tid] = (att::f32x4){0.f, 0.f, 0.f, 0.f};
      if (F.tid < 64) z[4096 + F.tid] = (att::f32x4){0.f, 0.f, 0.f, 0.f}; }
    __syncthreads();
    const bf16* QKV = (const bf16*)(F.ws + WS_QKV);
    const bf16* Q = QKV + ((size_t)(0 + h) * MTOK + si.sb) * 64; const bf16* K = QKV + ((size_t)(6 + h) * MTOK + si.sb) * 64; const bf16* V = QKV + ((size_t)(12 + h) * MTOK + si.sb) * 64;
    for (int pat = 0; pat < 3; ++pat) {
        const int qs = pat == 0 ? 1 : (pat == 1 ? 4 : 16), qb = pat == 0 ? 32 * w : (pat == 1 ? 128 * (w & 1) + (w >> 1) : 2 * w);
        const int imask = pat == 2 ? 15 : 31, ishift = pat == 2 ? 4 : 5;
        att::SpecA S{K, V, pq0 + qb - 64 * qs, qs, pat == 2 ? 16 : 32, imask, ishift, pat == 2 ? 9 : 5, si.T, F.tm};
        a_job(F, S, Q + (size_t)(pq0 + qb + (r32 & imask) * qs + (r32 >> ishift)) * 64, [=](int q) { return qb + (q & imask) * qs + (q >> ishift); });
    }
    __syncthreads();
    {
        const int q = 32 * w + (F.lane >> 1), dh = F.lane & 1;
        const __attribute__((address_space(3))) att::f32x4* a = (const __attribute__((address_space(3))) att::f32x4*)(F.lds + LA_ACC + (q * 64 + dh * 32) * 4);
        const float rl = __builtin_amdgcn_rcpf(((const __attribute__((address_space(3))) float*)(F.lds + LA_L))[q]);
        bf16* op = (bf16*)(F.ws + WS_O) + (size_t)(row0 + q) * DM + 64 * h + 32 * dh;
        float ss = 0.f;
#pragma unroll
        for (int i = 0; i < 4; ++i) { const att::f32x4 x = a[2 * i], y = a[2 * i + 1]; v4u o; o.x = pk2(x[0] * rl, x[1] * rl); o.y = pk2(x[2] * rl, x[3] * rl); o.z = pk2(y[0] * rl, y[1] * rl); o.w = pk2(y[2] * rl, y[3] * rl);
#pragma unroll
            for (int e = 0; e < 4; ++e) { const float u0 = bflo(o[e]), u1 = bfhi(o[e]); ss += u0 * u0 + u1 * u1; }
            if (!F.nostore) *(v4u*)(op + 8 * i) = o; }
        ss += __shfl_xor(ss, 1);
        if (!F.nostore && dh == 0) unsafeAtomicAdd((float*)(F.ws + WS_SSQA) + (size_t)(row0 + q) * 4 + 0, ss);
    }
    __syncthreads();
}
__device__ __forceinline__ void attn_phase(Frame& F, const Args& A) {
    volatile LAS unsigned* ast = (volatile LAS unsigned*)(F.lds + LDS_MISC + 16);
    if (F.tid == 0) {
        unsigned* barw = (unsigned*)(F.ws + WS_CTL) + CW_BAR; const unsigned myx = xb_xcc_id();
        bool ok = (F.G == 256); unsigned chunk = 0, npop = 0;
        for (unsigned j = 0; j < 16; ++j) { const unsigned cnt = xb_ld(&barw[XB_XCNT(j)]); if (cnt) { ++npop; if (cnt != 32u) ok = false; if (j < myx) ++chunk; } }
        if (npop != 8u) ok = false;
        unsigned rank = 0;
        if (ok) rank = xb_add((unsigned*)(F.ws + WS_CTL) + CW_ARANK + 64 * myx, 1u);
        ast[0] = ok ? 1u : 0u; ast[1] = chunk; ast[2] = rank;
    }
    __syncthreads();
    const bool blocked = ast[0] != 0u;
    const int xcd = (int)ast[1], ci = (int)ast[2];
#if ATT_A_MFMA
    if (!(F.what & 1)) {} else if (blocked) { for (int k = ci; k < N_AUNITS / 8; k += 32) a_unit(F, xcd * (N_AUNITS / 8) + k); }
    else { for (int ua = blockIdx.x; ua < N_AUNITS; ua += F.G) a_unit(F, ua); }
#endif
    __syncthreads();
    if (blocked) {
        const int widx = ci * 8 + F.wave;
        for (int k = 0; k < 9; ++k) {
            int l;
            if (k < 6) l = k * 256 + widx; else { if (ci < 16) break; l = 1536 + (k - 6) * 128 + (widx - 128); }
            if (l < N_BJOBS / 8) {
#if ATT_B_MFMA
                if (F.what & 2) b_job(F, A, xcd * (N_BJOBS / 8) + l);
#endif
            } else {
#if ATT_M_MFMA
                if (F.what & 4) m_job(F, xcd * (N_MJOBS / 8) + (l - N_BJOBS / 8));
#endif
            }
        }
    } else {
        const int NJ = N_BJOBS + N_MJOBS;
        for (int j = blockIdx.x * 8 + F.wave; j < NJ; j += F.G * 8) {
            if (j < N_BJOBS) {
#if ATT_B_MFMA
                b_job(F, A, j);
#endif
            } else {
#if ATT_M_MFMA
                m_job(F, j - N_BJOBS);
#endif
            }
        }
    }
    __syncthreads();
}

namespace att2 {
using att::bf16x8; using att::s16x4; using att::f32x16; using att::f32x4; using att::u32x4; using att::lptr; using att::creg; using att::cvtpk; using att::vtr; using att::NEG;
constexpr int NS = 4, SLOT = 32768, TILE = 16384, TV = 8192, VDH64 = 4096;
constexpr int L_RING = 0, L_TBL = NS * SLOT, TBLB = 3840, L_LS = L_TBL + 2 * TBLB, L_END = L_LS + 8 * 128;
static_assert(L_END <= LDS_MISC, "attention LDS map");
#define ATT2_WAITBAR(N) asm volatile("s_waitcnt vmcnt(" #N ") lgkmcnt(0)\n\ts_barrier" ::: "memory")

struct TileSrc { const bf16* K; const bf16* V; int p0, qs, T, pm; };
__device__ __forceinline__ void dma_tile(LAS unsigned char* tile, const TileSrc& s, int w, int lane) {
    const bool inside = (s.p0 >= 0) && (s.p0 + 63 * s.qs < s.T);
    { const int row = 8 * w + (lane >> 3); int p = s.p0 + row * s.qs; if (!inside) p = p < 0 ? 0 : (p >= s.T ? s.T - 1 : p); p &= s.pm;
      __builtin_amdgcn_global_load_lds((const unsigned*)(s.K + (size_t)p * 64 + 8 * ((lane & 7) ^ ((row >> 1) & 7))), (LAS unsigned*)(tile + w * 1024), 16, 0, 0); }
    { const int row = 16 * (w & 3) + (lane >> 2); int p = s.p0 + row * s.qs; if (!inside) p = p < 0 ? 0 : (p >= s.T ? s.T - 1 : p); p &= s.pm;
      __builtin_amdgcn_global_load_lds((const unsigned*)(s.V + (size_t)p * 64 + 32 * (w >> 2) + 8 * (lane & 3)), (LAS unsigned*)(tile + TV + (w >> 2) * VDH64 + (w & 3) * 1024), 16, 0, 0); }
}
__device__ __forceinline__ f32x16 qk_sub(lptr tile, int roff, const bf16x8 (&qr)[4], int lane) {
    const int r32 = lane & 31, hi = lane >> 5, row = roff + r32;
    lptr kp = tile + row * 128; const int sw = (row >> 1) & 7;
    f32x16 p = {};
#pragma unroll
    for (int d0 = 0; d0 < 4; ++d0) { const bf16x8 kf = *(__attribute__((address_space(3))) bf16x8*)(kp + (((2 * d0 + hi) ^ sw) * 16)); p = __builtin_amdgcn_mfma_f32_32x32x16_bf16(kf, qr[d0], p, 0, 0, 0); }
    return p;
}
__device__ __forceinline__ void pv_sub(lptr tile, int roff, f32x16& p, f32x16 (&o)[2], float& lsum, int lane) {
    const int hi = lane >> 5;
    float sacc = 0.f;
#pragma unroll
    for (int r = 0; r < 16; ++r) { p[r] = __builtin_amdgcn_exp2f(p[r]); sacc += p[r]; }
    lsum += sacc;
    u32x4 pw0, pw1;
    pw0[0] = cvtpk(p[0], p[1]); pw0[1] = cvtpk(p[2], p[3]); pw0[2] = cvtpk(p[4], p[5]); pw0[3] = cvtpk(p[6], p[7]);
    pw1[0] = cvtpk(p[8], p[9]); pw1[1] = cvtpk(p[10], p[11]); pw1[2] = cvtpk(p[12], p[13]); pw1[3] = cvtpk(p[14], p[15]);
    lptr vp = tile + TV + (roff + 4 * hi + ((lane & 15) >> 2)) * 64 + ((lane >> 4) & 1) * 32 + (lane & 3) * 8;
#pragma unroll
    for (int dh = 0; dh < 2; ++dh) {
        const s16x4 l0 = vtr(vp + dh * VDH64), h0 = vtr(vp + dh * VDH64 + 512), l1 = vtr(vp + dh * VDH64 + 1024), h1 = vtr(vp + dh * VDH64 + 1536);
        const bf16x8 f0 = {l0[0], l0[1], l0[2], l0[3], h0[0], h0[1], h0[2], h0[3]}, f1 = {l1[0], l1[1], l1[2], l1[3], h1[0], h1[1], h1[2], h1[3]};
        o[dh] = __builtin_amdgcn_mfma_f32_32x32x16_bf16(__builtin_bit_cast(bf16x8, pw0), f0, o[dh], 0, 0, 0);
        o[dh] = __builtin_amdgcn_mfma_f32_32x32x16_bf16(__builtin_bit_cast(bf16x8, pw1), f1, o[dh], 0, 0, 0);
    }
}
__device__ __forceinline__ void mask_band(f32x16& p, int rel, int kr0, int L, int lane) {
    const int r32 = lane & 31, hi = lane >> 5;
    if (rel == 0 || rel == 4) { const int base = 32 * rel - r32 + 4 * hi;
#pragma unroll
        for (int r = 0; r < 16; ++r) { if ((unsigned)(base + creg(r)) > 128u) p[r] = NEG; } }
    if (kr0 < 0 || kr0 + 31 >= L) { const int kb = kr0 + 4 * hi;
#pragma unroll
        for (int r = 0; r < 16; ++r) { if ((unsigned)(kb + creg(r)) >= (unsigned)L) p[r] = NEG; } }
}
__device__ __forceinline__ void stage_rows(const f32x16 (&o)[2], float lsum, bool normalise, lptr scr, __attribute__((address_space(3))) float* ls, int lane) {
    const int r32 = lane & 31, hi = lane >> 5;
    lsum = pg8::sum_xor32(lsum);
    if (hi == 0) ls[r32] = lsum;
    __attribute__((address_space(3))) unsigned short* stg = (__attribute__((address_space(3))) unsigned short*)scr;
    float rl[16];
#pragma unroll
    for (int g = 0; g < 4; ++g) { const f32x4 lv = *(__attribute__((address_space(3))) f32x4*)(ls + 8 * g + 4 * hi);
#pragma unroll
        for (int j = 0; j < 4; ++j) rl[4 * g + j] = normalise ? __builtin_amdgcn_rcpf(lv[j]) : 1.f; }
#pragma unroll
    for (int r = 0; r < 16; r += 2) { const int q = creg(r) + 4 * hi;
#pragma unroll
        for (int dh = 0; dh < 2; ++dh) { const unsigned pk = cvtpk(o[dh][r] * rl[r], o[dh][r + 1] * rl[r + 1]);
            stg[q * 64 + dh * 32 + r32] = (unsigned short)pk; stg[(q + 1) * 64 + dh * 32 + r32] = (unsigned short)(pk >> 16); } }
}
template <class RowFn, class SsqFn> __device__ __forceinline__ void out_final(const f32x16 (&o)[2], float lsum, lptr scr, __attribute__((address_space(3))) float* ls, const RowFn& orow, const SsqFn& ssqp, int lane) {
    stage_rows(o, lsum, true, scr, ls, lane);
    __attribute__((address_space(3))) unsigned short* stg = (__attribute__((address_space(3))) unsigned short*)scr;
#pragma unroll
    for (int i = 0; i < 4; ++i) { const int row = i * 8 + (lane >> 3), ch = lane & 7; const u32x4 v = *(__attribute__((address_space(3))) u32x4*)(stg + row * 64 + ch * 8);
        float ss = 0.f;
#pragma unroll
        for (int e = 0; e < 4; ++e) { const float a = bflo(v[e]), b = bfhi(v[e]); ss += a * a + b * b; }
        ss += __shfl_xor(ss, 1); ss += __shfl_xor(ss, 2); ss += __shfl_xor(ss, 4);
        *(u32x4*)(orow(row) + ch * 8) = v; if (ch == 0) *ssqp(row) = ss; }
}
}

constexpr int N2_M = (MTOK / 512) * 4;
constexpr int N2_B = (MTOK / 256) * 3;
constexpr int N2_A = (MTOK / 512) * 6;
constexpr size_t WS_PART = WS_X1B;
constexpr size_t WS_PARTL = WS_PART + (size_t)2 * MTOK * 384 * 2;
static_assert(WS_PARTL + (size_t)2 * MTOK * 8 * 4 <= WS_XN, "partials fit the X1B region");

struct BandU { long sb; int T, qs, L, cls, s0; };
__device__ __forceinline__ BandU band_unit(int tt, int qs) {
    BandU u; int j, nt; if (tt < TP / 256) { u.sb = 0; u.T = TP; j = tt; nt = TP / 256; } else { const int q = tt - TP / 256, b = q / (TS / 256); u.sb = TP + (long)b * TS; u.T = TS; j = q - b * (TS / 256); nt = TS / 256; }
    const int nb = nt / qs; u.qs = qs; u.L = u.T / qs; u.cls = j / nb; u.s0 = 256 * (j - u.cls * nb); return u;
}
struct UD { int kind, idx, nst; att2::TileSrc x, y; int xb, xs, yb, ys, yrot; };
__device__ __forceinline__ UD make_ud(Frame& F, int kind, int idx) {
    UD d; d.kind = kind; d.idx = idx; d.nst = 0; d.xb = d.xs = d.yb = d.ys = d.yrot = 0; d.x = att2::TileSrc{nullptr, nullptr, 0, 1, 1, F.tm}; d.y = d.x;
    const bf16* QKV = (const bf16*)(F.ws + WS_QKV);
    if (kind >= 0 && kind <= 2) {
        const int h = idx / (MTOK / 512), tt = 2 * (idx - h * (MTOK / 512)), qs = kind == 0 ? 16 : (kind == 1 ? 4 : 1);
        const BandU ux = band_unit(tt, qs), uy = band_unit(tt + 1, qs);
        const bf16* Kh = QKV + (size_t)(6 + h) * MTOK * 64; const bf16* Vh = QKV + (size_t)(12 + h) * MTOK * 64;
        d.nst = 6; d.x = att2::TileSrc{Kh + ux.sb * 64, Vh + ux.sb * 64, 0, qs, ux.T, F.tm}; d.y = att2::TileSrc{Kh + uy.sb * 64, Vh + uy.sb * 64, 0, qs, uy.T, F.tm};
        d.xb = ux.cls + (ux.s0 - 64) * qs; d.xs = 64 * qs; d.yb = uy.cls + (uy.s0 - 64) * qs; d.ys = 64 * qs; d.yrot = 3;
    } else if (kind == 3) {
        const int hp = idx / (MTOK / 256), rq4 = idx - hp * (MTOK / 256);
        int r0, rows; long sb; int T;
        if (rq4 < TP / 256) { r0 = 4 * rq4; rows = TP / 64; sb = 0; T = TP; } else { const int q = rq4 - TP / 256, b = q / (TS / 256); r0 = 4 * (q - b * (TS / 256)); rows = TS / 64; sb = TP + (long)b * TS; T = TS; }
        int rk0 = r0 - 4; rk0 = rk0 < 0 ? 0 : (rk0 > rows - 8 ? rows - 8 : rk0);
        int rk1 = r0 + 3 - 4; rk1 = rk1 < 0 ? 0 : (rk1 > rows - 8 ? rows - 8 : rk1);
        d.nst = rk1 + 8 - rk0;
        d.x = att2::TileSrc{QKV + ((size_t)(24 + 2 * hp) * MTOK + sb) * 64, QKV + ((size_t)(30 + 2 * hp) * MTOK + sb) * 64, 0, 1, T, F.tm};
        d.y = att2::TileSrc{QKV + ((size_t)(25 + 2 * hp) * MTOK + sb) * 64, QKV + ((size_t)(31 + 2 * hp) * MTOK + sb) * 64, 0, 1, T, F.tm};
        d.xb = rk0 * 64; d.xs = 64; d.yb = rk0 * 64; d.ys = 64; d.yrot = 0;
    } else if (kind == 4) {
        const int h = idx / (MTOK / 512), row0 = (idx - h * (MTOK / 512)) * 512; const SeqInfo si = seq_of(row0);
        d.nst = 4; d.x = att2::TileSrc{(const bf16*)(F.ws + WS_MK) + (size_t)(si.bat * 4 + h) * NMEM * 64, (const bf16*)(F.ws + WS_MV) + (size_t)(si.bat * 4 + h) * NMEM * 64, 0, 1, NMEM, F.tm}; d.y = d.x;
        d.xb = 0; d.xs = 64; d.yb = 0; d.ys = 64; d.yrot = 0;
    }
    return d;
}
__device__ __forceinline__ void ud_issue(Frame& F, UD& d, int s, int gstep) {
    LAS unsigned char* sl = F.lds + att2::L_RING + (gstep & (att2::NS - 1)) * att2::SLOT;
    int sy = s + d.yrot; sy = sy >= 6 ? sy - 6 : sy; if (d.yrot == 0) sy = s;
    d.x.p0 = d.xb + d.xs * s; d.y.p0 = d.yb + d.ys * sy;
    att2::dma_tile(sl, d.x, F.wave, F.lane); att2::dma_tile(sl + att2::TILE, d.y, F.wave, F.lane);
}
__device__ __forceinline__ void ud_load_q(Frame& F, const UD& d, att::bf16x8 (&qa)[4], att::bf16x8 (&qb)[4]) {
    const int w = F.wave, lane = F.lane, r32 = lane & 31;
    const bf16* QKV = (const bf16*)(F.ws + WS_QKV);
    const bf16* pa = QKV; const bf16* pb = QKV;
    if (d.kind >= 0 && d.kind <= 2) {
        const int h = d.idx / (MTOK / 512), tt = 2 * (d.idx - h * (MTOK / 512)), qs = d.kind == 0 ? 16 : (d.kind == 1 ? 4 : 1);
        const BandU ux = band_unit(tt, qs), uy = band_unit(tt + 1, qs);
        const bf16* Qh = QKV + (size_t)(0 + h) * MTOK * 64;
        pa = Qh + (size_t)(ux.sb + ux.cls + (ux.s0 + 32 * w + r32) * qs) * 64; pb = Qh + (size_t)(uy.sb + uy.cls + (uy.s0 + 32 * w + r32) * qs) * 64;
    } else if (d.kind == 3) {
        const int hp = d.idx / (MTOK / 256), rq4 = d.idx - hp * (MTOK / 256);
        int r0; long sb;
        if (rq4 < TP / 256) { r0 = 4 * rq4; sb = 0; } else { const int q = rq4 - TP / 256, b = q / (TS / 256); r0 = 4 * (q - b * (TS / 256)); sb = TP + (long)b * TS; }
        const int hd = w >> 2, g = w & 3, h = 2 * hp + hd, rq = r0 + (r32 >> 4), c = 16 * g + (r32 & 15);
        pa = QKV + ((size_t)(18 + h) * MTOK + sb + rq * 64 + c) * 64; pb = pa + (size_t)128 * 64;
    } else if (d.kind == 4) {
        const int h = d.idx / (MTOK / 512), row0 = (d.idx - h * (MTOK / 512)) * 512;
        pa = QKV + ((size_t)(36 + h) * MTOK + row0 + 32 * w + r32) * 64; pb = pa + (size_t)256 * 64;
    }
    att::load_q(qa, pa, lane); att::load_q(qb, pb, lane);
}
#define ATT3_STEP_BEGIN() do { if (s == 0) PT_ADD(F, 5); PT_SUB(F, 0); const int ahead_ = gi - gs - 1; \
        if (ahead_ >= 2) { ATT2_WAITBAR(8); } else if (ahead_ == 1) { ATT2_WAITBAR(4); } else { ATT2_WAITBAR(0); } \
        { const int t_ = s + 3; if (t_ < d.nst) { ud_issue(F, d, t_, gi); ++gi; } else if (dn.kind >= 0 && t_ - d.nst < 3) { ud_issue(F, dn, t_ - d.nst, gi); ++gi; } } PT_ADD(F, 0); PT_SUB(F, 1); } while (0)
#define ATT3_UNIT_END() asm volatile("s_waitcnt lgkmcnt(0)\n\ts_barrier" ::: "memory")

__device__ __forceinline__ void att3_body_M(Frame& F, UD& d, UD& dn, int& gs, int& gi, att::bf16x8 (&qr)[4], att::bf16x8 (&qnb)[4]) {
    const int h = d.idx / (MTOK / 512), row0 = (d.idx - h * (MTOK / 512)) * 512;
    const int w = F.wave, lane = F.lane;
    att::f32x16 o[2] = {}, o2[2] = {}; float lsum = 0.f, lsum2 = 0.f;
#pragma unroll 1
    for (int s = 0; s < 4; ++s) {
        ATT3_STEP_BEGIN();
        att::lptr tile = (att::lptr)(F.lds + att2::L_RING + (gs & (att2::NS - 1)) * att2::SLOT);
#pragma unroll
        for (int hf = 0; hf < 2; ++hf) {
            att::f32x16 pa = att2::qk_sub(tile, 32 * hf, qr, lane), pb = att2::qk_sub(tile, 32 * hf, qnb, lane);
            att2::pv_sub(tile, 32 * hf, pa, o, lsum, lane); att2::pv_sub(tile, 32 * hf, pb, o2, lsum2, lane);
            asm volatile("" ::: "memory");
        }
        ++gs; PT_ADD(F, 1);
    }
    ud_load_q(F, dn, qr, qnb);
    PT_SUB(F, 2); ATT3_UNIT_END();
    att::lptr scr = (att::lptr)(F.lds + att2::L_RING + ((gs - 1) & (att2::NS - 1)) * att2::SLOT + w * 4096);
    __attribute__((address_space(3))) float* ls = (__attribute__((address_space(3))) float*)(F.lds + att2::L_LS + w * 128);
    { bf16* O = (bf16*)(F.ws + WS_O) + (size_t)(row0 + 32 * w) * DM + 768 + 64 * h; float* SQ = (float*)(F.ws + WS_SSQA) + (size_t)(row0 + 32 * w) * 16 + 12 + h;
      att2::out_final(o, lsum, scr, ls, [=](int q) { return O + (size_t)q * DM; }, [=](int q) { return SQ + (size_t)q * 16; }, lane); }
    { bf16* O = (bf16*)(F.ws + WS_O) + (size_t)(row0 + 256 + 32 * w) * DM + 768 + 64 * h; float* SQ = (float*)(F.ws + WS_SSQA) + (size_t)(row0 + 256 + 32 * w) * 16 + 12 + h;
      att2::out_final(o2, lsum2, scr, ls, [=](int q) { return O + (size_t)q * DM; }, [=](int q) { return SQ + (size_t)q * 16; }, lane); }
    PT_ADD(F, 2);
}
__device__ __forceinline__ void att3_body_B(Frame& F, const Args& A, UD& d, UD& dn, int& gs, int& gi, att::bf16x8 (&qr)[4], att::bf16x8 (&qnb)[4]) {
    const int hp = d.idx / (MTOK / 256), rq4 = d.idx - hp * (MTOK / 256);
    int r0, rows; long sb;
    if (rq4 < TP / 256) { r0 = 4 * rq4; rows = TP / 64; sb = 0; } else { const int q = rq4 - TP / 256, b = q / (TS / 256); r0 = 4 * (q - b * (TS / 256)); rows = TS / 64; sb = TP + (long)b * TS; }
    const int w = F.wave, lane = F.lane, r32 = lane & 31, hi = lane >> 5;
    const int hd = w >> 2, g = w & 3, h = 2 * hp + hd;
    const int c = 16 * g + (r32 & 15);
    int cs = c - 8; cs = cs < 0 ? 0 : (cs > 48 ? 48 : cs);
    const int rk0 = d.xb >> 6;
    const int w0 = g == 0 ? 0 : (g == 1 ? 8 : (g == 2 ? 24 : 32));
    { const int th = F.tid >> 8, tl = F.tid & 255;
      __attribute__((address_space(3))) float* tbl = (__attribute__((address_space(3))) float*)(F.lds + att2::L_TBL + th * att2::TBLB);
      const float* rpb = A.in[10] + (2 * hp + th) * 465;
      for (int idx = tl; idx < 465; idx += 256) { const int dr = idx / 31, dl = idx - dr * 31; tbl[dr * 64 + 16 + dl] = rpb[idx] * LOG2E; } }
    att::f32x16 o[2] = {}, o2[2] = {}; float lsum = 0.f, lsum2 = 0.f;
    const __attribute__((address_space(3))) float* tb = (const __attribute__((address_space(3))) float*)(F.lds + att2::L_TBL + hd * att2::TBLB) + (31 + w0 - c) + 4 * hi;
    const int cb = w0 - cs + 4 * hi, nst = d.nst;
    const int rq0 = r0 + (r32 >> 4), rq1 = rq0 + 2;
    int rlo0 = rq0 - 4; rlo0 = rlo0 < 0 ? 0 : (rlo0 > rows - 8 ? rows - 8 : rlo0);
    int rlo1 = rq1 - 4; rlo1 = rlo1 < 0 ? 0 : (rlo1 > rows - 8 ? rows - 8 : rlo1);
    int b0lo = r0 - 4; b0lo = b0lo < 0 ? 0 : (b0lo > rows - 8 ? rows - 8 : b0lo); int b0hi = r0 + 1 - 4; b0hi = (b0hi < 0 ? 0 : (b0hi > rows - 8 ? rows - 8 : b0hi)) + 7;
    int b1lo = r0 + 2 - 4; b1lo = b1lo < 0 ? 0 : (b1lo > rows - 8 ? rows - 8 : b1lo); int b1hi = r0 + 3 - 4; b1hi = (b1hi < 0 ? 0 : (b1hi > rows - 8 ? rows - 8 : b1hi)) + 7;
#pragma unroll 1
    for (int s = 0; s < nst; ++s) {
        ATT3_STEP_BEGIN();
        att::lptr tile = (att::lptr)(F.lds + att2::L_RING + (gs & (att2::NS - 1)) * att2::SLOT + hd * att2::TILE);
        const int rk = rk0 + s;
        if (rk >= b0lo && rk <= b0hi) {
            att::f32x16 p = att2::qk_sub(tile, w0, qr, lane);
            const bool rok = (unsigned)(rk - rlo0) < 8u; int dr = rk + 7 - rq0; dr = dr < 0 ? 0 : (dr > 14 ? 14 : dr);
            const __attribute__((address_space(3))) float* tp = tb + dr * 64; const int cbh = rok ? cb : -4096;
#pragma unroll
            for (int r = 0; r < 16; ++r) { const float sbv = p[r] + tp[att::creg(r)]; p[r] = ((unsigned)(cbh + att::creg(r)) < 16u) ? sbv : att::NEG; }
            att2::pv_sub(tile, w0, p, o, lsum, lane);
        }
        if (rk >= b1lo && rk <= b1hi) {
            att::f32x16 p = att2::qk_sub(tile, w0, qnb, lane);
            const bool rok = (unsigned)(rk - rlo1) < 8u; int dr = rk + 7 - rq1; dr = dr < 0 ? 0 : (dr > 14 ? 14 : dr);
            const __attribute__((address_space(3))) float* tp = tb + dr * 64; const int cbh = rok ? cb : -4096;
#pragma unroll
            for (int r = 0; r < 16; ++r) { const float sbv = p[r] + tp[att::creg(r)]; p[r] = ((unsigned)(cbh + att::creg(r)) < 16u) ? sbv : att::NEG; }
            att2::pv_sub(tile, w0, p, o2, lsum2, lane);
        }
        ++gs; PT_ADD(F, 1);
    }
    ud_load_q(F, dn, qr, qnb);
    PT_SUB(F, 2); ATT3_UNIT_END();
    att::lptr scr = (att::lptr)(F.lds + att2::L_RING + ((gs - 1) & (att2::NS - 1)) * att2::SLOT + w * 4096);
    __attribute__((address_space(3))) float* ls = (__attribute__((address_space(3))) float*)(F.lds + att2::L_LS + w * 128);
    { bf16* O = (bf16*)(F.ws + WS_O) + (size_t)(sb + r0 * 64 + 16 * g) * DM + 384 + 64 * h; float* SQ = (float*)(F.ws + WS_SSQA) + (size_t)(sb + r0 * 64 + 16 * g) * 16 + 6 + h;
      att2::out_final(o, lsum, scr, ls, [=](int q) { return O + (size_t)((q >> 4) * 64 + (q & 15)) * DM; }, [=](int q) { return SQ + (size_t)((q >> 4) * 64 + (q & 15)) * 16; }, lane); }
    { bf16* O = (bf16*)(F.ws + WS_O) + (size_t)(sb + (r0 + 2) * 64 + 16 * g) * DM + 384 + 64 * h; float* SQ = (float*)(F.ws + WS_SSQA) + (size_t)(sb + (r0 + 2) * 64 + 16 * g) * 16 + 6 + h;
      att2::out_final(o2, lsum2, scr, ls, [=](int q) { return O + (size_t)((q >> 4) * 64 + (q & 15)) * DM; }, [=](int q) { return SQ + (size_t)((q >> 4) * 64 + (q & 15)) * 16; }, lane); }
    PT_ADD(F, 2);
}
__device__ __forceinline__ void att3_body_A(Frame& F, UD& d, UD& dn, int& gs, int& gi, att::bf16x8 (&qx)[4], att::bf16x8 (&qy)[4]) {
    const int pat = d.kind, ud = d.idx;
    const int h = ud / (MTOK / 512), tt = 2 * (ud - h * (MTOK / 512)), qs = pat == 0 ? 16 : (pat == 1 ? 4 : 1);
    const BandU ux = band_unit(tt, qs), uy = band_unit(tt + 1, qs);
    const int w = F.wave, lane = F.lane, r32 = lane & 31;
    const bf16* Qh = (const bf16*)(F.ws + WS_QKV) + (size_t)(0 + h) * MTOK * 64;
    att::f32x16 ox[2] = {}, oy[2] = {}; float lx = 0.f, ly = 0.f;
#pragma unroll 1
    for (int s = 0; s < 6; ++s) {
        ATT3_STEP_BEGIN();
        att::lptr tX = (att::lptr)(F.lds + att2::L_RING + (gs & (att2::NS - 1)) * att2::SLOT), tY = tX + att2::TILE;
        const int sy = (s + 3) % 6;
#pragma unroll
        for (int hf = 0; hf < 2; ++hf) {
            const int gx = 2 * s + hf, gy = 2 * sy + hf;
            const bool ax = (unsigned)(gx - w) <= 4u, ay = (unsigned)(gy - w) <= 4u;
            att::f32x16 pxx, pyy;
            if (ax) pxx = att2::qk_sub(tX, 32 * hf, qx, lane);
            if (ay) pyy = att2::qk_sub(tY, 32 * hf, qy, lane);
            if (ax) { att2::mask_band(pxx, gx - w, ux.s0 - 64 + 32 * gx, ux.L, lane); att2::pv_sub(tX, 32 * hf, pxx, ox, lx, lane); }
            if (ay) { att2::mask_band(pyy, gy - w, uy.s0 - 64 + 32 * gy, uy.L, lane); att2::pv_sub(tY, 32 * hf, pyy, oy, ly, lane); }
        }
        ++gs; PT_ADD(F, 1);
    }
    ud_load_q(F, dn, qx, qy);
    bf16* PB = (bf16*)(F.ws + WS_PART); float* PL = (float*)(F.ws + WS_PARTL);
    int lane_o = F.lane; asm volatile("" : "+v"(lane_o));
    att::u32x4 pa[4], pb[4]; float pl[4];
#define ATT3_LOAD_PART(side_) do { const BandU& u_ = (side_) ? uy : ux; const long t0_ = u_.sb + u_.cls + (long)(u_.s0 + 32 * w); \
        _Pragma("unroll") for (int i = 0; i < 4; ++i) { const int row = i * 8 + (lane_o >> 3), ch = lane_o & 7; const long tok = t0_ + row; \
            pa[i] = *(const att::u32x4*)(PB + ((size_t)tok) * 384 + 64 * h + ch * 8); pb[i] = *(const att::u32x4*)(PB + ((size_t)MTOK + tok) * 384 + 64 * h + ch * 8); \
            pl[i] = PL[(size_t)tok * 8 + h] + PL[((size_t)MTOK + tok) * 8 + h]; } } while (0)
    if (pat == 2) ATT3_LOAD_PART(0);
    PT_SUB(F, 2); ATT3_UNIT_END();
    att::lptr scr = (att::lptr)(F.lds + att2::L_RING + ((gs - 1) & (att2::NS - 1)) * att2::SLOT + w * 4096);
    __attribute__((address_space(3))) unsigned short* stg = (__attribute__((address_space(3))) unsigned short*)scr;
    __attribute__((address_space(3))) float* ls = (__attribute__((address_space(3))) float*)(F.lds + att2::L_LS + w * 128);
#pragma unroll
    for (int side = 0; side < 2; ++side) {
        const BandU& u = side ? uy : ux;
        const long tok0 = u.sb + u.cls + (long)(u.s0 + 32 * w) * qs;
        att2::stage_rows(side ? oy : ox, side ? ly : lx, false, scr, ls, lane);
        if (pat < 2) {
#pragma unroll
            for (int i = 0; i < 4; ++i) { const int row = i * 8 + (lane_o >> 3), ch = lane_o & 7; const att::u32x4 v = *(__attribute__((address_space(3))) att::u32x4*)(stg + row * 64 + ch * 8);
                *(att::u32x4*)(PB + ((size_t)pat * MTOK + tok0 + (long)row * qs) * 384 + 64 * h + ch * 8) = v; }
            if (lane_o < 32) PL[((size_t)pat * MTOK + tok0 + (long)lane_o * qs) * 8 + h] = ls[lane_o];
        } else {
            att::u32x4 a4[4], b4[4]; float l4[4];
#pragma unroll
            for (int i = 0; i < 4; ++i) { a4[i] = pa[i]; b4[i] = pb[i]; l4[i] = pl[i]; }
            if (side == 0) ATT3_LOAD_PART(1);
#pragma unroll
            for (int i = 0; i < 4; ++i) { const int row = i * 8 + (lane_o >> 3), ch = lane_o & 7; const long tok = tok0 + row;
                const att::u32x4 v = *(__attribute__((address_space(3))) att::u32x4*)(stg + row * 64 + ch * 8);
                const att::u32x4 a = a4[i], b = b4[i];
                const float rl = __builtin_amdgcn_rcpf(ls[row] + l4[i]);
                att::u32x4 ov; float ss = 0.f;
#pragma unroll
                for (int e = 0; e < 4; ++e) { const float x0 = (bflo(v[e]) + bflo(a[e]) + bflo(b[e])) * rl, x1 = (bfhi(v[e]) + bfhi(a[e]) + bfhi(b[e])) * rl; ov[e] = pk2(x0, x1);
                    const float y0 = bflo(ov[e]), y1 = bfhi(ov[e]); ss += y0 * y0 + y1 * y1; }
                ss += __shfl_xor(ss, 1); ss += __shfl_xor(ss, 2); ss += __shfl_xor(ss, 4);
                *(att::u32x4*)((bf16*)(F.ws + WS_O) + (size_t)tok * DM + 64 * h + ch * 8) = ov;
                if (ch == 0) ((float*)(F.ws + WS_SSQA))[(size_t)tok * 16 + h] = ss; }
        }
    }
#undef ATT3_LOAD_PART
    PT_ADD(F, 2);
}
template <class ListFn> __device__ __forceinline__ void att3_run(Frame& F, const Args& A, const ListFn& unit_of) {
    PT_SUB(F, 3);
    int gs = 0, gi = 0, k, i;
    unit_of(0, k, i); UD d = make_ud(F, k, i);
    if (d.kind < 0) return;
    for (int s = 0; s < 3; ++s) { ud_issue(F, d, s, gi); ++gi; }
    att::bf16x8 qa[4], qb[4]; ud_load_q(F, d, qa, qb);
    for (int j = 0; d.kind >= 0; ++j) {
        PT_SUB(F, 4); unit_of(j + 1, k, i); UD dn = make_ud(F, k, i); PT_ADD(F, 4); PT_SUB(F, 5);
        const int kslot_ = d.kind; PTK_SUB(F, kslot_);
        if (d.kind <= 2) att3_body_A(F, d, dn, gs, gi, qa, qb); else if (d.kind == 3) att3_body_B(F, A, d, dn, gs, gi, qa, qb); else att3_body_M(F, d, dn, gs, gi, qa, qb);
        PTK_ADD(F, kslot_);
        d = dn;
    }
    ATT2_WAITBAR(0);
    PT_ADD(F, 3);
}
__device__ __forceinline__ void att2_phase_a(Frame& F, const Args& A) {
    const int NU = 2 * N2_A + N2_B, G = F.G;
    const bool blk = (G == 256); const int per = NU / 8, xcd = blockIdx.x & 7, ci = blockIdx.x >> 3, bx = blockIdx.x;
    att3_run(F, A, [=](int j, int& kind, int& idx) {
        const int jj = blk ? ci + 32 * j : bx + G * j; const bool ok = blk ? (jj < per) : (jj < NU);
        const int u = blk ? xcd * per + jj : jj, i = u / 3, k = u - 3 * i;
        kind = !ok ? -1 : (k == 0 ? 0 : (k == 1 ? 1 : 3)); idx = i; });
}
__device__ __forceinline__ void att2_phase_b(Frame& F, const Args& A) {
    const int NU = N2_A + N2_M, G = F.G;
    const bool blk = (G == 256); const int per = NU / 8, xcd = blockIdx.x & 7, ci = blockIdx.x >> 3, bx = blockIdx.x;
    att3_run(F, A, [=](int j, int& kind, int& idx) {
        const int jj = blk ? ci + 32 * j : bx + G * j; const bool ok = blk ? (jj < per) : (jj < NU);
        const int u = blk ? xcd * per + jj : jj, gq = u / 5, k = u - 5 * gq;
        kind = !ok ? -1 : (k < 3 ? 2 : 4); idx = k < 3 ? 3 * gq + k : 2 * gq + (k - 3); });
}
__global__ void __launch_bounds__(NWAVES * 64, 2) skel_fwd(Args args) {
    extern __shared__ __attribute__((aligned(16))) unsigned char lds[];
    cg::grid_group grid = cg::this_grid();
    Frame F;
    F.lds = (LAS unsigned char*)lds;
    F.tid = threadIdx.x; F.lane = F.tid & 63; F.wave = __builtin_amdgcn_readfirstlane(F.tid >> 6);
    F.G = gridDim.x; { const int bx = blockIdx.x; F.vcu = (F.G % 8 == 0) ? (bx % 8) * (F.G / 8) + bx / 8 : bx; }
    F.out = args.out; F.ws = args.ws; F.tm = -1; F.nostore = false; F.what = 7; F.pt_on = false;
    unsigned char* ws = args.ws;
    const int lo = args.ph_lo, hi = args.ph_hi & 255; if (args.ph_hi >> 8) F.tm = 63;
    volatile LAS unsigned* bst = (volatile LAS unsigned*)(F.lds + LDS_MISC);
    if (F.tid < 2) bst[F.tid] = 0u;
    if (F.tid >= 8 && F.tid < 24) ((volatile LAS unsigned*)(F.lds + LDS_MISC))[F.tid] = 0u;
    __syncthreads();
    XcdBarrier bar = xcd_barrier_post((unsigned*)(ws + WS_CTL) + CW_BAR, bst);
    if (lo < 0) grid.sync();
#define IN(k) (lo <= (k) && (k) < hi)
#define BOTH(k) (IN(k) && IN((k) + 1))
#define GRID_BAR() xcd_barrier(bar)
#if PROBE_T
#define PT_PHASE(k) do { if (F.tid == 0) PT_ON_L(F.lds) = ((k) == PROBE_PHASE) ? 1u : 0u; } while (0)
#else
#define PT_PHASE(k) do {} while (0)
#endif

    if (IN(0)) { PT_PHASE(0); p0_prologue(F, args); PT_PHASE(-1); if (BOTH(0)) GRID_BAR(); }

    if (IN(1)) {
        PT_PHASE(1);
        {
            pg8::Gemm g{(const pg8::bf16_t*)(ws + WS_XN), (const pg8::bf16_t*)(ws + WS_WIN), MTOK, NQKV, DM}; pg8::StaticOrder S; S.init(MTOK, NQKV, F.G, (int)blockIdx.x);
            pg8::EpiQKV E{(pg8::bf16_t*)(ws + WS_QKV), args.in[6], args.in[7], args.in[8], args.in[9], args.in[13], (const float*)(ws + WS_ROPE), (const float*)(ws + WS_ROPE) + TP * 8};
            pg8::gemm_phase<pg8::EpiQKV, pg8::StaticOrder, true, true>(F.lds, g, S, E);
        }
        {
            pg8::Gemm g{(const pg8::bf16_t*)(ws + WS_XNMEM), (const pg8::bf16_t*)(ws + WS_WMEM), MMEM, 512, DM}; pg8::StaticOrder S; S.init(MMEM, 512, F.G, F.G - 1 - (int)blockIdx.x);
            pg8::EpiMemKV E{(pg8::bf16_t*)(ws + WS_MK), (pg8::bf16_t*)(ws + WS_MV), args.in[14]};
            pg8::gemm_phase<pg8::EpiMemKV, pg8::StaticOrder, true, true>(F.lds, g, S, E);
        }
        PT_PHASE(-1);
        if (BOTH(1)) GRID_BAR();
    }

#if ATT_V2
    if (IN(2)) { PT_PHASE(2); att2_phase_a(F, args); PT_PHASE(-1); if (BOTH(2)) GRID_BAR(); }
    if (IN(3)) { PT_PHASE(3); att2_phase_b(F, args); PT_PHASE(-1); if (BOTH(3)) GRID_BAR(); }
#else
    if (IN(2)) { attn_phase(F, args); if (PROBE_MODE) { F.nostore = true; F.tm = (PROBE_MODE & 2) ? 0 : -1; F.what = PROBE_WHAT; attn_phase(F, args); F.nostore = false; F.tm = -1; F.what = 7; } if (!(ATT_A_MFMA && ATT_B_MFMA && ATT_M_MFMA)) attn_simple_phase(F, args); if (BOTH(2)) GRID_BAR(); }

    if (IN(3)) { if (BOTH(3)) GRID_BAR(); }
#endif

    if (IN(4)) {
        pg8::Gemm g{(const pg8::bf16_t*)(ws + WS_O), (const pg8::bf16_t*)(ws + WS_WOUT), MTOK, DM, DM}; pg8::StaticOrder S; S.init(MTOK, DM, F.G, (int)blockIdx.x);
        pg8::EpiX1 E{args.in[0], args.in[1], F.out, (pg8::bf16_t*)(ws + WS_X1B), (float*)(ws + WS_SSQF), (const float*)(ws + WS_SSQA)};
        PT_PHASE(4); pg8::gemm_phase<pg8::EpiX1, pg8::StaticOrder, true, true>(F.lds, g, S, E); PT_PHASE(-1);
        if (BOTH(4)) GRID_BAR();
    }

    if (IN(5)) {
        pg8::Gemm g{(const pg8::bf16_t*)(ws + WS_X1B), (const pg8::bf16_t*)(ws + WS_W1), MTOK, FF, DM}; pg8::StaticOrder S; S.init(MTOK, FF, F.G, (int)blockIdx.x);
        pg8::EpiH E{(pg8::bf16_t*)(ws + WS_H), (const float*)(ws + WS_SSQF), args.ph_hi >> 8};
        PT_PHASE(5); pg8::gemm_phase<pg8::EpiH, pg8::StaticOrder, true, true>(F.lds, g, S, E); PT_PHASE(-1);
        if (BOTH(5)) GRID_BAR();
    }

    if (IN(6)) {
        pg8::Gemm g{(const pg8::bf16_t*)(ws + WS_H), (const pg8::bf16_t*)(ws + WS_W2), MTOK, DM, FF}; pg8::StaticOrder S; S.init(MTOK, DM, F.G, (int)blockIdx.x);
        pg8::EpiOut E{F.out, (const pg8::bf16_t*)(ws + WS_X1B)};
        PT_PHASE(6); pg8::gemm_phase<pg8::EpiOut, pg8::StaticOrder, true, true>(F.lds, g, S, E); PT_PHASE(-1);
    }
#if PROBE_T
    __syncthreads();
    if (blockIdx.x == 0 && F.tid == 0) { F.out[0] = (float)(PT_SLOTS_L(F.lds)[PROBE_I] >> 15) * 16.384f; F.out[1] = (float)PT_SLOTS_L(F.lds)[PROBE_J] * (1.0f / 2000.0f); }
#endif
#undef IN
#undef BOTH
}

extern "C" void kernel_launch(void* const* d_in, const int* in_sizes, int n_in, void* d_out, int out_size, void* d_ws, size_t ws_size, hipStream_t stream) {
    static int grid = 0;
    if (grid == 0) {
        if (n_in != 22 || in_sizes[0] != TP * DM || in_sizes[1] != NBS * TS * DM || out_size != MTOK * DM || ws_size < WS_END) {
            fprintf(stderr, "kernel_launch: unexpected shapes / workspace (n_in %d, in0 %d, out %d, ws %zu); nothing launched\n", n_in, n_in > 0 ? in_sizes[0] : -1, out_size, ws_size); grid = -1; return; }
        int dev = 0, cus = 0, per_cu = 0;
        if (hipGetDevice(&dev) != hipSuccess || hipDeviceGetAttribute(&cus, hipDeviceAttributeMultiprocessorCount, dev) != hipSuccess) { grid = -1; return; }
        if (hipFuncSetAttribute((const void*)skel_fwd, hipFuncAttributeMaxDynamicSharedMemorySize, LDS_BYTES) != hipSuccess) { fprintf(stderr, "kernel_launch: hipFuncSetAttribute failed\n"); grid = -1; return; }
        if (hipOccupancyMaxActiveBlocksPerMultiprocessor(&per_cu, (const void*)skel_fwd, NWAVES * 64, LDS_BYTES) != hipSuccess || per_cu < 1) { fprintf(stderr, "kernel_launch: occupancy query says %d\n", per_cu); (void)hipGetLastError(); grid = -1; return; }
        grid = cus * per_cu;
    }
    if (grid < 0) return;
    if (hipMemsetAsync((char*)d_ws + WS_CTL, 0, CTL_ZERO_BYTES, stream) != hipSuccess) return;
    Args a{};
    for (int i = 0; i < 22; ++i) a.in[i] = (const float*)d_in[i];
    a.out = (float*)d_out; a.ws = (unsigned char*)d_ws;
    auto launch = [&](int lo, int hi) {
        if (lo > 0) (void)hipMemsetAsync((char*)d_ws + WS_CTL + (size_t)CW_BAR * 4, 0, (size_t)XCD_BAR_WORDS * 4, stream);
        a.ph_lo = lo; a.ph_hi = hi; void* kargs[] = {&a};
        hipError_t e = hipLaunchCooperativeKernel((const void*)skel_fwd, dim3(grid), dim3(NWAVES * 64), kargs, LDS_BYTES, stream);
        if (e != hipSuccess) fprintf(stderr, "kernel_launch: cooperative launch failed: %s (grid %d)\n", hipGetErrorString(e), grid);
    };
#if PROBE_SEQ == 0
    launch(0, NPH);
#elif PROBE_SEQ == 1
    launch(0, NPH); launch(0, 1);
#elif PROBE_SEQ == 2
    launch(0, NPH); launch(1, 2);
#elif PROBE_SEQ == 3
    launch(0, 4); (void)hipMemsetAsync((char*)d_ws + WS_SSQA, 0, (size_t)MTOK * 16, stream); launch(2, 4); launch(4, NPH);
#elif PROBE_SEQ == 4
    launch(0, 5); (void)hipMemsetAsync((char*)d_ws + WS_SSQF, 0, (size_t)MTOK * 4, stream); launch(4, 5); launch(5, NPH);
#elif PROBE_SEQ == 5
    launch(0, NPH); launch(5, 6);
#elif PROBE_SEQ == 7
    launch(0, NPH); launch(2, 3);
#elif PROBE_SEQ == 8
    launch(0, NPH); launch(2, 3 | 256);
#elif PROBE_SEQ == 9
    launch(0, NPH); launch(3, 4);
#elif PROBE_SEQ == 10
    launch(0, NPH); launch(3, 4 | 256);
#elif PROBE_SEQ == 11
    launch(0, NPH); launch(5, 6 | 256);
#elif PROBE_SEQ == 12
    launch(0, NPH); launch(5, 6 | 512);
#elif PROBE_SEQ == 13
    launch(0, NPH); launch(0, 1 | 256);
#elif PROBE_SEQ == 6
    launch(0, 3); (void)hipMemsetAsync((char*)d_ws + WS_SSQA, 0, (size_t)MTOK * 16, stream); launch(2, 3); launch(3, NPH);
#endif
}
```

```cpp
#include <hip/hip_runtime.h>
#include <hip/hip_cooperative_groups.h>
#include <cstdio>
#include <cstdint>
namespace cg = cooperative_groups;

constexpr int DM = 1024, TP = 16384, TS = 8192, NBS = 4, MTOK = TP + NBS * TS;
constexpr int NQKV = 2560, NHEADS = 40, FF = 4096, NMEM = 256, NBATCH = 1 + NBS, MMEM = NBATCH * NMEM;
constexpr float RMS_EPS = 1e-6f;
constexpr float LOG2E = 1.4426950408889634f;
constexpr float QSCALE = 0.125f * LOG2E;

#ifndef PROBE_SEQ
#define PROBE_SEQ 0
#endif
#ifndef PROBE_T
#define PROBE_T 0
#endif
#ifndef PROBE_I
#define PROBE_I 6
#endif
#ifndef PROBE_J
#define PROBE_J 7
#endif
#ifndef PROBE_PHASE
#define PROBE_PHASE 3
#endif
#ifndef PROBE_PHASE
#define PROBE_PHASE 3
#endif
constexpr int RING_BYTES = 131072;
constexpr int LDS_BYTES = 147456, LDS_MISC = LDS_BYTES - 128;
constexpr int CW_BAR = 4096, CW_ARANK = 8192;
constexpr int LDS_BYTES_UNUSED = 0;


#if PROBE_T
#define PT_SLOTS_L(lds) ((volatile __attribute__((address_space(3))) long long*)((lds) + LDS_MISC + 32))
#define PT_ON_L(lds) (*(volatile __attribute__((address_space(3))) unsigned*)((lds) + LDS_MISC + 24))
#define PT_SUB_L(lds, i) do { if (threadIdx.x == 0 && blockIdx.x == 0 && PT_ON_L(lds)) PT_SLOTS_L(lds)[i] -= (long long)__builtin_readcyclecounter(); } while (0)
#define PT_ADD_L(lds, i) do { if (threadIdx.x == 0 && blockIdx.x == 0 && PT_ON_L(lds)) PT_SLOTS_L(lds)[i] += (long long)__builtin_readcyclecounter(); } while (0)
#else
#define PT_SUB_L(lds, i) do {} while (0)
#define PT_ADD_L(lds, i) do {} while (0)
#endif
#if PROBE_T == 2
#define PTK_SUB(F, i) PT_SUB_L((F).lds, i)
#define PTK_ADD(F, i) PT_ADD_L((F).lds, i)
#define PT_SUB(F, i) do {} while (0)
#define PT_ADD(F, i) do {} while (0)
#else
#define PTK_SUB(F, i) do {} while (0)
#define PTK_ADD(F, i) do {} while (0)
#define PT_SUB(F, i) PT_SUB_L((F).lds, i)
#define PT_ADD(F, i) PT_ADD_L((F).lds, i)
#endif
namespace pg8 {
#define PG8_LAS __attribute__((address_space(3)))
typedef unsigned short bf16_t;
typedef short bf16x8 __attribute__((ext_vector_type(8)));
typedef float f32x4 __attribute__((ext_vector_type(4)));
typedef unsigned u32x4 __attribute__((ext_vector_type(4)));
constexpr int BM = 256, BK = 64, HALF = 128, HTB = HALF * BK * 2  , STAGE_BYTES = 8 * HTB, NXCD = 8, WGM = 8;

__host__ __device__ __forceinline__ int lds_byte(int r, int c) { const int st = (r >> 4) * 2 + (c >> 5), rr = r & 15, cc = c & 31, ob = rr * 64 + cc * 2; return st * 1024 + (ob ^ (((ob >> 9) & 1) << 5)); }
__host__ __device__ __forceinline__ void stage_rc(int b, int& R, int& C) { const int st = b / 1024, sb = b % 1024, swz = sb ^ (((sb >> 9) & 1) << 5); R = (st >> 1) * 16 + swz / 64; C = (st & 1) * 32 + (swz % 64) / 2; }
__host__ __device__ __forceinline__ int perm32(int rho) { const int n = rho >> 4, i = rho & 15; return 8 * (i >> 2) + 4 * n + (i & 3); }

struct Unit { int pm, pn; };
struct Gemm { const bf16_t* A; const bf16_t* Bt; int M, N, K; };

struct StaticOrder {
    int nM, nN, nwg, G, c;
    __host__ __device__ void init(int M, int N, int G_, int c_) { nM = M / BM; nN = N / BM; nwg = nM * nN; G = G_; c = c_; }
    __host__ __device__ bool next(int i, Unit& u) const {
        const long L = (long)i * G + c; if (L >= nwg) return false;
        int wgid = (int)L; { const int q = nwg / NXCD, r = nwg % NXCD, xcd = wgid % NXCD, off = wgid / NXCD; wgid = (xcd < r ? xcd * (q + 1) : r * (q + 1) + (xcd - r) * q) + off; }
        const int nig = WGM * nN, gid = wgid / nig, fm = gid * WGM, gsz = (nM - fm) < WGM ? (nM - fm) : WGM;
        u.pm = fm + ((wgid % nig) % gsz); u.pn = (wgid % nig) / gsz; return true;
    }
    __device__ __forceinline__ void a_ready(const Unit&) const {}
    __device__ __forceinline__ void done(const Unit&) const {}
};

__device__ __forceinline__ unsigned cvt_pk_bf16(float lo, float hi) { unsigned r; asm volatile("v_cvt_pk_bf16_f32 %0, %1, %2" : "=v"(r) : "v"(lo), "v"(hi)); return r; }
typedef float f32x2 __attribute__((ext_vector_type(2)));
__device__ __forceinline__ float sum_xor16(float v) { const auto r = __builtin_amdgcn_permlane16_swap(__float_as_uint(v), __float_as_uint(v), false, false); return __uint_as_float(r[0]) + __uint_as_float(r[1]); }
__device__ __forceinline__ float sum_xor32(float v) { const auto r = __builtin_amdgcn_permlane32_swap(__float_as_uint(v), __float_as_uint(v), false, false); return __uint_as_float(r[0]) + __uint_as_float(r[1]); }
__device__ __forceinline__ float sq4(const f32x4 v) { return (v[0] * v[0] + v[1] * v[1]) + (v[2] * v[2] + v[3] * v[3]); }
__device__ __forceinline__ u32x4 pack8(const f32x4 a, const f32x4 b) { u32x4 w; w.x = cvt_pk_bf16(a[0], a[1]); w.y = cvt_pk_bf16(a[2], a[3]); w.z = cvt_pk_bf16(b[0], b[1]); w.w = cvt_pk_bf16(b[2], b[3]); return w; }

struct EpiQKV {
    static constexpr bool PERM = true, AFTER_DRAIN = false, KSCALE = false, PREP = false, PREFETCH = false; static constexpr int KS_T1 = -1, KS_T2 = -1;
    bf16_t* QKV;
    const float *gqa, *gka, *gqb, *gkb, *gqm;
    const float *rc, *rs;
    __device__ __forceinline__ void operator()(const f32x4 (&acc)[2][2][4][2], const Unit& u, int wr, int wc, int fr, int fq) const {
        const int hidx = u.pn * 4 + wc;
        const float* gain = nullptr; bool rope = false; float qs = 1.f;
        if (hidx < 6) { gain = gqa; rope = true; qs = QSCALE; } else if (hidx < 12) { gain = gka; rope = true; } else if (hidx < 18) { } else if (hidx < 24) { gain = gqb; qs = QSCALE; }
        else if (hidx < 30) { gain = gkb; } else if (hidx < 36) { } else { gain = gqm; qs = QSCALE; }
        const bool rl = rope && fq < 2;
        f32x4 g[2][2];
#pragma unroll
        for (int bj = 0; bj < 2; ++bj)
#pragma unroll
            for (int n = 0; n < 2; ++n) { const int d0 = (rl && bj == 0) ? (8 * n + 4 * fq) : (32 * bj + 8 * fq + 4 * n); g[bj][n] = gain ? *(const f32x4*)(gain + d0) : (f32x4){1.f, 1.f, 1.f, 1.f}; }
        bf16_t* base = QKV + (size_t)hidx * MTOK * 64 + 8 * fq;
#pragma unroll
        for (int ai = 0; ai < 2; ++ai)
#pragma unroll
            for (int m = 0; m < 4; ++m) {
                const int row = u.pm * BM + ai * HALF + wr * 64 + m * 16 + fr;
                f32x4 v[2][2];
#pragma unroll
                for (int bj = 0; bj < 2; ++bj)
#pragma unroll
                    for (int n = 0; n < 2; ++n) v[bj][n] = acc[ai][bj][m][n];
                if (gain) {
                    float ss = (sq4(v[0][0]) + sq4(v[0][1])) + (sq4(v[1][0]) + sq4(v[1][1]));
                    ss = sum_xor32(sum_xor16(ss));
                    const float r = rsqrtf(ss * (1.f / 64.f) + RMS_EPS) * qs;
#pragma unroll
                    for (int bj = 0; bj < 2; ++bj)
#pragma unroll
                        for (int n = 0; n < 2; ++n) v[bj][n] = v[bj][n] * r * g[bj][n];
                    if (rope) {
                        const int pos = row < TP ? row : ((row - TP) & (TS - 1));
                        const f32x4 c = *(const f32x4*)(rc + pos * 8 + 4 * (fq & 1)), s = *(const f32x4*)(rs + pos * 8 + 4 * (fq & 1));
                        if (fq < 2) { const f32x4 x1 = v[0][0], x2 = v[0][1]; v[0][0] = x1 * c - x2 * s; v[0][1] = x2 * c + x1 * s; }
                    }
                }
                bf16_t* rowp = base + (size_t)row * 64;
                __builtin_nontemporal_store(pack8(v[0][0], v[0][1]), (u32x4*)(rowp));
                __builtin_nontemporal_store(pack8(v[1][0], v[1][1]), (u32x4*)(rowp + 32));
            }
    }
};
struct EpiMemKV {
    static constexpr bool PERM = true, AFTER_DRAIN = false, KSCALE = false, PREP = false, PREFETCH = false; static constexpr int KS_T1 = -1, KS_T2 = -1;
    bf16_t* MK; bf16_t* MV; const float* gk;
    __device__ __forceinline__ void operator()(const f32x4 (&acc)[2][2][4][2], const Unit& u, int wr, int wc, int fr, int fq) const {
        const int hidx = u.pn * 4 + wc; const bool isk = hidx < 4; const int h = hidx & 3;
        f32x4 g[2][2];
#pragma unroll
        for (int bj = 0; bj < 2; ++bj)
#pragma unroll
            for (int n = 0; n < 2; ++n) g[bj][n] = isk ? *(const f32x4*)(gk + 32 * bj + 8 * fq + 4 * n) : (f32x4){1.f, 1.f, 1.f, 1.f};
        bf16_t* base = (isk ? MK : MV) + 8 * fq;
#pragma unroll
        for (int ai = 0; ai < 2; ++ai)
#pragma unroll
            for (int m = 0; m < 4; ++m) {
                const int row = u.pm * BM + ai * HALF + wr * 64 + m * 16 + fr;
                f32x4 v[2][2];
#pragma unroll
                for (int bj = 0; bj < 2; ++bj)
#pragma unroll
                    for (int n = 0; n < 2; ++n) v[bj][n] = acc[ai][bj][m][n];
                if (isk) {
                    float ss = (sq4(v[0][0]) + sq4(v[0][1])) + (sq4(v[1][0]) + sq4(v[1][1]));
                    ss = sum_xor32(sum_xor16(ss));
                    const float r = rsqrtf(ss * (1.f / 64.f) + RMS_EPS);
#pragma unroll
                    for (int bj = 0; bj < 2; ++bj)
#pragma unroll
                        for (int n = 0; n < 2; ++n) v[bj][n] = v[bj][n] * r * g[bj][n];
                }
                bf16_t* rowp = base + ((size_t)((row >> 8) * 4 + h) * NMEM + (row & 255)) * 64;
                *(u32x4*)(rowp) = pack8(v[0][0], v[0][1]);
                *(u32x4*)(rowp + 32) = pack8(v[1][0], v[1][1]);
            }
    }
};
struct EpiX1 {
    static constexpr bool PERM = true, AFTER_DRAIN = false, KSCALE = true, PREP = true, PREFETCH = false; static constexpr int KS_T1 = 6, KS_T2 = 12;
    const float* xp; const float* xs; float* out; bf16_t* x1b; float* ssq; const float* ssqa;
    static constexpr int TBL_OFF = 131072;
    __device__ __forceinline__ void prep(const Unit& u, PG8_LAS unsigned char* lds, int idx, int tid) const {
        if (tid < BM) { const f32x4* qp = (const f32x4*)(ssqa + (size_t)(u.pm * BM + tid) * 16); const f32x4 q0 = qp[0], q1 = qp[1], q2 = qp[2], q3 = qp[3];
            const float qa = (q0[0] + q0[1]) + (q0[2] + q0[3]) + (q1[0] + q1[1]), qb = (q1[2] + q1[3]) + (q2[0] + q2[1]) + (q2[2] + q2[3]), qm = (q3[0] + q3[1]) + (q3[2] + q3[3]);
            const float sa = rsqrtf(qa * (1.f / 384.f) + RMS_EPS), sb = rsqrtf(qb * (1.f / 384.f) + RMS_EPS), sm = rsqrtf(qm * (1.f / 256.f) + RMS_EPS);
            *(PG8_LAS f32x4*)(lds + TBL_OFF + (idx & 1) * 4096 + tid * 16) = (f32x4){sa / sb, sb / sm, sm, 0.f}; }
    }
    __device__ __forceinline__ void kscale(f32x4 (&acc)[2][2][4][2], int t, int wr, int fr, PG8_LAS unsigned char* lds, int idx) const {
        const PG8_LAS float* tb = (const PG8_LAS float*)(lds + TBL_OFF + (idx & 1) * 4096) + ((t == KS_T1) ? 0 : 1);
#pragma unroll
        for (int ai = 0; ai < 2; ++ai)
#pragma unroll
            for (int m = 0; m < 4; ++m) {
                const float f = tb[(ai * HALF + wr * 64 + m * 16 + fr) * 4];
#pragma unroll
                for (int bj = 0; bj < 2; ++bj)
#pragma unroll
                    for (int n = 0; n < 2; ++n) acc[ai][bj][m][n] = acc[ai][bj][m][n] * f;
            }
    }
    static constexpr int JUNK_OFF = 131072 + 8192;
    __device__ __forceinline__ void prefetch(const Unit& u, PG8_LAS unsigned char* lds, int tid) const {
        const int wid = tid >> 6;
#pragma unroll
        for (int i = 0; i < 4; ++i) { const int line = i * 512 + tid, row = u.pm * BM + (line >> 3);
            const float* src = (row < TP ? xp + (size_t)row * DM : xs + (size_t)(row - TP) * DM) + u.pn * BM + (line & 7) * 32;
            __builtin_amdgcn_global_load_lds((const unsigned*)src, (PG8_LAS unsigned*)(lds + JUNK_OFF + (wid & 3) * 256), 4, 0, 0); }
    }
    __device__ __forceinline__ void epi(const f32x4 (&acc)[2][2][4][2], const Unit& u, int wr, int wc, int fr, int fq, PG8_LAS unsigned char* lds, int idx) const {
        const PG8_LAS float* tb = (const PG8_LAS float*)(lds + TBL_OFF + (idx & 1) * 4096) + 2;
        const int col0 = u.pn * BM + wc * 32 + 8 * fq;
#pragma unroll
        for (int aim = 0; aim < 4; ++aim) {
            const int ai = aim >> 1, m0 = 2 * (aim & 1);
            f32x4 xr[2][2][2];
#pragma unroll
            for (int mm = 0; mm < 2; ++mm) { const int row = u.pm * BM + ai * HALF + wr * 64 + (m0 + mm) * 16 + fr;
                const float* xrow = (row < TP ? xp + (size_t)row * DM : xs + (size_t)(row - TP) * DM) + col0;
#pragma unroll
                for (int bj = 0; bj < 2; ++bj) { xr[mm][bj][0] = __builtin_nontemporal_load((const f32x4*)(xrow + bj * HALF)); xr[mm][bj][1] = __builtin_nontemporal_load((const f32x4*)(xrow + bj * HALF + 4)); } }
#pragma unroll
            for (int mm = 0; mm < 2; ++mm) {
                const int m = m0 + mm, row = u.pm * BM + ai * HALF + wr * 64 + m * 16 + fr;
                const float sm = tb[(ai * HALF + wr * 64 + m * 16 + fr) * 4];
                bf16_t* brow = x1b + (size_t)row * DM + col0;
                float ss = 0.f;
#pragma unroll
                for (int bj = 0; bj < 2; ++bj) {
                    const f32x4 v0 = acc[ai][bj][m][0] * sm + xr[mm][bj][0], v1 = acc[ai][bj][m][1] * sm + xr[mm][bj][1];
                    *(u32x4*)(brow + bj * HALF) = pack8(v0, v1);
                    ss += sq4(v0) + sq4(v1);
                }
                ss = sum_xor32(sum_xor16(ss));
                if (fq == 0) ssq[(size_t)row * 16 + u.pn * 4 + wc] = ss;
            }
            asm volatile("" ::: "memory");
        }
    }
};
struct EpiH {
    static constexpr bool PERM = true, AFTER_DRAIN = false, KSCALE = false, PREP = true, PREFETCH = false; static constexpr int KS_T1 = -1, KS_T2 = -1;
    bf16_t* H; const float* ssq; int mode;
    static constexpr int TBL_OFF = 131072;
    __device__ __forceinline__ void prep(const Unit& u, PG8_LAS unsigned char* lds, int idx, int tid) const {
        if (tid < BM) { const f32x4* qp = (const f32x4*)(ssq + (size_t)(u.pm * BM + tid) * 16); const f32x4 q0 = qp[0], q1 = qp[1], q2 = qp[2], q3 = qp[3];
            const float s = ((q0[0] + q0[1]) + (q0[2] + q0[3])) + ((q1[0] + q1[1]) + (q1[2] + q1[3])) + ((q2[0] + q2[1]) + (q2[2] + q2[3])) + ((q3[0] + q3[1]) + (q3[2] + q3[3]));
            *(PG8_LAS float*)(lds + TBL_OFF + (idx & 1) * 1024 + tid * 4) = rsqrtf(s * (1.f / DM) + RMS_EPS); }
    }
    __device__ __forceinline__ void epi(const f32x4 (&acc)[2][2][4][2], const Unit& u, int wr, int wc, int fr, int fq, PG8_LAS unsigned char* lds, int idx) const {
        if (mode == 2) return;
        const PG8_LAS float* tb = (const PG8_LAS float*)(lds + TBL_OFF + (idx & 1) * 1024);
        const int col0 = u.pn * BM + wc * 32 + 8 * fq;
#pragma unroll
        for (int ai = 0; ai < 2; ++ai)
#pragma unroll
            for (int m = 0; m < 4; ++m) {
                const int row = u.pm * BM + ai * HALF + wr * 64 + m * 16 + fr;
                const float r = tb[ai * HALF + wr * 64 + m * 16 + fr];
                bf16_t* hrow = H + (size_t)row * FF + col0;
#pragma unroll
                for (int bj = 0; bj < 2; ++bj) {
                    f32x4 v0 = acc[ai][bj][m][0] * r, v1 = acc[ai][bj][m][1] * r;
#pragma unroll
                    for (int e = 0; e < 4; ++e) { const float a = fmaxf(v0[e], 0.f), b = fmaxf(v1[e], 0.f); v0[e] = a * a; v1[e] = b * b; }
                    const u32x4 pk = pack8(v0, v1); if (mode == 0) *(u32x4*)(hrow + bj * HALF) = pk; else asm volatile("" :: "v"(pk));
                }
            }
    }
};
struct EpiOut {
    static constexpr bool PERM = true, AFTER_DRAIN = false, KSCALE = false, PREP = false, PREFETCH = false; static constexpr int KS_T1 = -1, KS_T2 = -1;
    float* out; const bf16_t* x1b;
    static constexpr int JUNK_OFF = 131072 + 8192;
    __device__ __forceinline__ void prefetch(const Unit& u, PG8_LAS unsigned char* lds, int tid) const {
        const int wid = tid >> 6;
#pragma unroll
        for (int i = 0; i < 2; ++i) { const int line = i * 512 + tid; const bf16_t* src = x1b + (size_t)(u.pm * BM + (line >> 2)) * DM + u.pn * BM + (line & 3) * 64;
            __builtin_amdgcn_global_load_lds((const unsigned*)src, (PG8_LAS unsigned*)(lds + JUNK_OFF + (wid & 3) * 256), 4, 0, 0); }
    }
    __device__ __forceinline__ void operator()(const f32x4 (&acc)[2][2][4][2], const Unit& u, int wr, int wc, int fr, int fq) const {
        const int col0 = u.pn * BM + wc * 32 + 8 * fq;
#pragma unroll
        for (int ai = 0; ai < 2; ++ai) {
            u32x4 rr[4][2];
#pragma unroll
            for (int m = 0; m < 4; ++m) { const bf16_t* brow = x1b + (size_t)(u.pm * BM + ai * HALF + wr * 64 + m * 16 + fr) * DM + col0;
#pragma unroll
                for (int bj = 0; bj < 2; ++bj) rr[m][bj] = *(const u32x4*)(brow + bj * HALF); }
#pragma unroll
            for (int m = 0; m < 4; ++m) {
                const int row = u.pm * BM + ai * HALF + wr * 64 + m * 16 + fr;
                float* orow = out + (size_t)row * DM + col0;
#pragma unroll
                for (int bj = 0; bj < 2; ++bj) {
                    const u32x4 r = rr[m][bj];
                    const f32x4 r0 = {__uint_as_float(r.x << 16), __uint_as_float(r.x & 0xffff0000u), __uint_as_float(r.y << 16), __uint_as_float(r.y & 0xffff0000u)};
                    const f32x4 r1 = {__uint_as_float(r.z << 16), __uint_as_float(r.z & 0xffff0000u), __uint_as_float(r.w << 16), __uint_as_float(r.w & 0xffff0000u)};
                    *(f32x4*)(orow + bj * HALF) = acc[ai][bj][m][0] + r0; *(f32x4*)(orow + bj * HALF + 4) = acc[ai][bj][m][1] + r1;
                }
            }
            asm volatile("" ::: "memory");
        }
    }
};

template <class Epi, class Sched, bool ALIGN_EPI = false, bool SP2 = false>
__device__ __forceinline__ void gemm_phase(PG8_LAS unsigned char* lds, const Gemm g, const Sched& S, const Epi& E) {
    const int tid = threadIdx.x, wid = __builtin_amdgcn_readfirstlane(tid >> 6), lane = tid & 63, wr = wid >> 2, wc = wid & 3, fr = lane & 15, fq = lane >> 4;
    const int K = g.K, nt = K / BK;
    unsigned voffA[2], voffB[2];
#pragma unroll
    for (int i = 0; i < 2; ++i) { int R, C; stage_rc(tid * 16 + i * 8192, R, C); const int Rb = Epi::PERM ? ((R & ~31) + perm32(R & 31)) : R;
        voffA[i] = (unsigned)(R * K + C) * 2u; voffB[i] = (unsigned)(Rb * K + C) * 2u; }
    const size_t kstep = (size_t)(BK * 2);
    const size_t hstep = (size_t)HALF * K * 2;
    const size_t tstep = 2 * hstep;
    const unsigned ldsw = (unsigned)wid * 1024u;
    const int aoff = lds_byte(wr * 64 + fr, fq * 8), boff = lds_byte(wc * 32 + fr, fq * 8);
#define PG8_SA(b, h) (((b) * 2 + (h)) * HTB)
#define PG8_SB(b, h) ((4 + (b) * 2 + (h)) * HTB)
#define PG8_STAGE(bufoff, gbase, voff) do { _Pragma("unroll") for (int _i = 0; _i < 2; ++_i) \
        __builtin_amdgcn_global_load_lds((const unsigned*)((const char*)(gbase) + (voff)[_i]), (PG8_LAS unsigned*)(lds + (bufoff) + ldsw + _i * 8192), 16, 0, 0); } while (0)
#define PG8_LDA(dst, b, h) do { _Pragma("unroll") for (int m = 0; m < 4; ++m) _Pragma("unroll") for (int k = 0; k < 2; ++k) dst[m][k] = *(const PG8_LAS bf16x8*)(lds + PG8_SA(b, h) + aoff + m * 2048 + k * 1024); } while (0)
#define PG8_LDB(dst, b, h) do { _Pragma("unroll") for (int n = 0; n < 2; ++n) _Pragma("unroll") for (int k = 0; k < 2; ++k) dst[n][k] = *(const PG8_LAS bf16x8*)(lds + PG8_SB(b, h) + boff + n * 2048 + k * 1024); } while (0)
#define PG8_MMA(ai, bj, At, Bt) do { __builtin_amdgcn_s_setprio(1); _Pragma("unroll") for (int m = 0; m < 4; ++m) _Pragma("unroll") for (int n = 0; n < 2; ++n) _Pragma("unroll") for (int k = 0; k < 2; ++k) \
        acc[ai][bj][m][n] = __builtin_amdgcn_mfma_f32_16x16x32_bf16(Bt[n][k], At[m][k], acc[ai][bj][m][n], 0, 0, 0); __builtin_amdgcn_s_setprio(0); } while (0)
#define PG8_WAIT_V(n) asm volatile("s_waitcnt vmcnt(" #n ")" ::: "memory")
#define PG8_WAIT_L(n) asm volatile("s_waitcnt lgkmcnt(" #n ")" ::: "memory")
#define PG8_BAR __builtin_amdgcn_s_barrier()
#define PG8_SCHED __builtin_amdgcn_sched_barrier(0)
    Unit cur, nxt; int ui = 0;
    if (!S.next(0, cur)) return;
    PT_SUB_L(lds, 5);
    f32x4 acc[2][2][4][2];
#pragma unroll
    for (int a = 0; a < 2; ++a)
#pragma unroll
        for (int b = 0; b < 2; ++b)
#pragma unroll
            for (int m = 0; m < 4; ++m)
#pragma unroll
                for (int n = 0; n < 2; ++n) acc[a][b][m][n] = (f32x4){0.f, 0.f, 0.f, 0.f};
    bf16x8 At[4][2], B0[2][2], B1[2][2];
    const char* cA = (const char*)g.A + (size_t)cur.pm * tstep; const char* cB = (const char*)g.Bt + (size_t)cur.pn * tstep;
    S.a_ready(cur);
    if constexpr (Epi::PREP) E.prep(cur, lds, 0, tid);
    if constexpr (SP2) {
        PG8_STAGE(PG8_SB(0, 0), cB, voffB); PG8_STAGE(PG8_SB(0, 1), cB + hstep, voffB); PG8_STAGE(PG8_SA(0, 0), cA, voffA); PG8_STAGE(PG8_SA(0, 1), cA + hstep, voffA);
        if (wr == 1) PG8_BAR;
        PG8_WAIT_V(2); PG8_BAR;
        PG8_STAGE(PG8_SB(1, 0), cB + kstep, voffB); PG8_STAGE(PG8_SA(1, 0), cA + kstep, voffA); PG8_STAGE(PG8_SB(1, 1), cB + hstep + kstep, voffB);
        PG8_WAIT_V(6); PG8_BAR;
    } else {
        PG8_STAGE(PG8_SB(0, 0), cB, voffB); PG8_STAGE(PG8_SA(0, 0), cA, voffA); PG8_STAGE(PG8_SB(0, 1), cB + hstep, voffB); PG8_STAGE(PG8_SA(0, 1), cA + hstep, voffA);
        if (wr == 1) PG8_BAR;
        PG8_WAIT_V(4); PG8_BAR;
        PG8_STAGE(PG8_SB(1, 0), cB + kstep, voffB); PG8_STAGE(PG8_SA(1, 0), cA + kstep, voffA); PG8_STAGE(PG8_SB(1, 1), cB + hstep + kstep, voffB);
        PG8_WAIT_V(6); PG8_BAR;
    }
    for (;;) {
        const bool has_next = S.next(ui + 1, nxt);
        const char* nA = has_next ? (const char*)g.A + (size_t)nxt.pm * tstep : cA; const char* nB = has_next ? (const char*)g.Bt + (size_t)nxt.pn * tstep : cB;
        for (int t = 0; t < nt; t += 2) {
            const bool last = (t == nt - 2);
            if constexpr (Epi::KSCALE) { if (t == Epi::KS_T1 || t == Epi::KS_T2) E.kscale(acc, t, wr, fr, lds, ui); }
            if constexpr (Epi::PREFETCH) { if (t == 4) E.prefetch(cur, lds, tid); }
            const char* a1 = cA + (size_t)(t + 1) * kstep;
            const char* a2 = last ? nA : cA + (size_t)(t + 2) * kstep; const char* b2 = last ? nB : cB + (size_t)(t + 2) * kstep;
            const char* a3 = a2 + kstep; const char* b3 = b2 + kstep;
            if (last && has_next) { S.a_ready(nxt); if constexpr (Epi::PREP) E.prep(nxt, lds, ui + 1, tid); }
            if constexpr (SP2) {
            PG8_LDB(B0, 0, 0); PG8_LDB(B1, 0, 1); PG8_SCHED; PG8_LDA(At, 0, 0); PG8_STAGE(PG8_SA(1, 1), a1 + hstep, voffA);
            PG8_WAIT_V(8); PG8_WAIT_L(0); PG8_BAR; PG8_MMA(0, 0, At, B0); PG8_MMA(0, 1, At, B1); PG8_BAR; PG8_SCHED;
            PG8_LDA(At, 0, 1); PG8_STAGE(PG8_SB(0, 0), b2, voffB); PG8_STAGE(PG8_SB(0, 1), b2 + hstep, voffB); PG8_STAGE(PG8_SA(0, 0), a2, voffA);
            PG8_WAIT_V(8); PG8_WAIT_L(0); PG8_BAR; PG8_MMA(1, 0, At, B0); PG8_MMA(1, 1, At, B1); PG8_BAR; PG8_SCHED;
            PG8_LDB(B0, 1, 0); PG8_LDB(B1, 1, 1); PG8_SCHED; PG8_LDA(At, 1, 0); PG8_STAGE(PG8_SA(0, 1), a2 + hstep, voffA);
            PG8_WAIT_V(8); PG8_WAIT_L(0); PG8_BAR; PG8_MMA(0, 0, At, B0); PG8_MMA(0, 1, At, B1); PG8_BAR; PG8_SCHED;
            PG8_LDA(At, 1, 1); PG8_STAGE(PG8_SB(1, 0), b3, voffB); PG8_STAGE(PG8_SB(1, 1), b3 + hstep, voffB); PG8_STAGE(PG8_SA(1, 0), a3, voffA);
            PG8_WAIT_V(8); PG8_WAIT_L(0); PG8_BAR; PG8_MMA(1, 0, At, B0); PG8_MMA(1, 1, At, B1); PG8_BAR; PG8_SCHED;
            } else {
            PG8_LDB(B0, 0, 0); PG8_SCHED; PG8_LDA(At, 0, 0); PG8_STAGE(PG8_SA(1, 1), a1 + hstep, voffA);
            PG8_WAIT_L(8); PG8_BAR; PG8_WAIT_L(0); PG8_MMA(0, 0, At, B0); PG8_BAR; PG8_SCHED;
            PG8_LDB(B1, 0, 1); PG8_STAGE(PG8_SB(0, 0), b2, voffB);
            PG8_BAR; PG8_WAIT_L(0); PG8_MMA(0, 1, At, B1); PG8_BAR;
            PG8_LDA(At, 0, 1); PG8_STAGE(PG8_SA(0, 0), a2, voffA);
            PG8_BAR; PG8_WAIT_L(0); PG8_MMA(1, 0, At, B0); PG8_BAR; PG8_SCHED;
            PG8_STAGE(PG8_SB(0, 1), b2 + hstep, voffB);
            PG8_WAIT_V(6); PG8_BAR; PG8_MMA(1, 1, At, B1); PG8_BAR;
            PG8_LDB(B0, 1, 0); PG8_SCHED; PG8_LDA(At, 1, 0); PG8_STAGE(PG8_SA(0, 1), a2 + hstep, voffA);
            PG8_WAIT_L(8); PG8_BAR; PG8_WAIT_L(0); PG8_MMA(0, 0, At, B0); PG8_BAR; PG8_SCHED;
            PG8_LDB(B1, 1, 1); PG8_STAGE(PG8_SB(1, 0), b3, voffB);
            PG8_BAR; PG8_WAIT_L(0); PG8_MMA(0, 1, At, B1); PG8_BAR;
            PG8_LDA(At, 1, 1); PG8_STAGE(PG8_SA(1, 0), a3, voffA);
            PG8_BAR; PG8_WAIT_L(0); PG8_MMA(1, 0, At, B0); PG8_BAR; PG8_SCHED;
            PG8_STAGE(PG8_SB(1, 1), b3 + hstep, voffB);
            PG8_WAIT_V(6); PG8_BAR; PG8_MMA(1, 1, At, B1); PG8_BAR;
            }
        }
        if constexpr (ALIGN_EPI) { if (wr == 0) PG8_BAR; }
        PT_SUB_L(lds, 4);
        if constexpr (!Epi::AFTER_DRAIN) { if constexpr (Epi::PREP) E.epi(acc, cur, wr, wc, fr, fq, lds, ui); else E(acc, cur, wr, wc, fr, fq); S.done(cur); }
        PT_ADD_L(lds, 4);
        if (!has_next) break;
#pragma unroll
        for (int a = 0; a < 2; ++a)
#pragma unroll
            for (int b = 0; b < 2; ++b)
#pragma unroll
                for (int m = 0; m < 4; ++m)
#pragma unroll
                    for (int n = 0; n < 2; ++n) acc[a][b][m][n] = (f32x4){0.f, 0.f, 0.f, 0.f};
        cur = nxt; cA = nA; cB = nB; ++ui;
        if constexpr (ALIGN_EPI) { if (wr == 1) PG8_BAR; }
    }
    PT_ADD_L(lds, 5);
    PG8_WAIT_V(0);
    if constexpr (!ALIGN_EPI) { if (wr == 0) PG8_BAR; }
    PG8_BAR;
    if constexpr (Epi::AFTER_DRAIN) { E.fused(acc, cur, wr, wc, fr, fq, lds, wid, lane); S.done(cur); }
#undef PG8_SA
#undef PG8_SB
#undef PG8_STAGE
#undef PG8_LDA
#undef PG8_LDB
#undef PG8_MMA
#undef PG8_WAIT_V
#undef PG8_WAIT_L
#undef PG8_BAR
#undef PG8_SCHED
}
}

constexpr int NWAVES = 8;
#ifndef MK_N_LAUNCHES
#define MK_N_LAUNCHES 1
#endif
constexpr int NPH = 7;
constexpr int N_LAUNCHES = MK_N_LAUNCHES;

constexpr size_t MiB = 1u << 20;
constexpr size_t WS_CTL = 0, CTL_ZERO_BYTES = 1 * MiB;
constexpr size_t WS_SSQF = 27 * MiB;
constexpr size_t WS_SSQA = 464 * MiB;
constexpr size_t WS_ROPE = 2 * MiB;
constexpr size_t WS_WIN = 3 * MiB, WS_WMEM = 8 * MiB, WS_WOUT = 9 * MiB, WS_W1 = 11 * MiB, WS_W2 = 19 * MiB;
constexpr size_t WS_XNMEM = 27 * MiB, WS_MK = 30 * MiB, WS_MV = 31 * MiB;
constexpr size_t WS_X1B = 32 * MiB;
constexpr size_t WS_XN = 128 * MiB, WS_O = 128 * MiB;
constexpr size_t WS_QKV = 224 * MiB;
constexpr size_t WS_H = 128 * MiB;
constexpr size_t WS_END = 512 * MiB;
static_assert(WS_QKV + (size_t)NHEADS * MTOK * 64 * 2 <= WS_END && WS_H + (size_t)MTOK * FF * 2 <= WS_END && WS_X1B + (size_t)MTOK * DM * 2 <= WS_XN && WS_XN + (size_t)MTOK * DM * 2 <= WS_QKV, "d_ws map");

#define LAS __attribute__((address_space(3)))
typedef unsigned short bf16;
typedef unsigned v4u __attribute__((ext_vector_type(4)));
typedef float f32x4 __attribute__((ext_vector_type(4)));
#define LDS_WAIT() asm volatile("s_waitcnt lgkmcnt(0)" ::: "memory")
__device__ __forceinline__ unsigned f2bf(float f) { unsigned u = __builtin_bit_cast(unsigned, f); return (u + 0x7fffu + ((u >> 16) & 1u)) >> 16; }
__device__ __forceinline__ unsigned pk2(float lo, float hi) { return f2bf(lo) | (f2bf(hi) << 16); }
__device__ __forceinline__ float bflo(unsigned w) { return __uint_as_float(w << 16); }
__device__ __forceinline__ float bfhi(unsigned w) { return __uint_as_float(w & 0xffff0000u); }
__device__ __forceinline__ float wave_sum(float v) {
#pragma unroll
    for (int o = 1; o < 64; o <<= 1) v += __shfl_xor(v, o);
    return v;
}

struct Frame {
    LAS unsigned char* lds;
    int tid, lane, wave, vcu, G, tm;
    float* out; unsigned char* ws;
};
struct Args { const float* in[22]; float* out; unsigned char* ws; int ph_lo, ph_hi; };


namespace att {
typedef short bf16x8 __attribute__((ext_vector_type(8)));
typedef short s16x4 __attribute__((ext_vector_type(4)));
typedef short v4i16_t __attribute__((ext_vector_type(4)));
typedef float f32x16 __attribute__((ext_vector_type(16)));
typedef float f32x4 __attribute__((ext_vector_type(4)));
typedef unsigned u32x4 __attribute__((ext_vector_type(4)));
typedef float f32x2_t __attribute__((ext_vector_type(2))); typedef __bf16 bf16x2_t __attribute__((ext_vector_type(2)));
typedef __attribute__((address_space(3))) unsigned char* lptr;
__device__ __forceinline__ unsigned cvtpk(float lo, float hi) { f32x2_t v = {lo, hi}; bf16x2_t b = __builtin_convertvector(v, bf16x2_t); return __builtin_bit_cast(unsigned, b); }
__device__ __forceinline__ s16x4 vtr(lptr p) { return __builtin_bit_cast(s16x4, __builtin_amdgcn_ds_read_tr16_b64_v4i16((__attribute__((address_space(3))) v4i16_t*)p)); }
__device__ __forceinline__ int creg(int r) { return (r & 3) + 8 * (r >> 2); }
constexpr float NEG = -INFINITY;

__device__ __forceinline__ void load_q(bf16x8 (&qr)[4], const bf16* qrow, int lane) {
    const int hi = lane >> 5;
#pragma unroll
    for (int d0 = 0; d0 < 4; ++d0) qr[d0] = *(const bf16x8*)(qrow + 16 * d0 + 8 * hi);
}
}
template <class CM, class KS>
__device__ __forceinline__ void p0_transpose_item(const float* W, int K, int N, bf16* WT, LAS float* scr, int item, int lane, CM cm, KS ks) {
    const int nblk = N / 32, kb = item / nblk, nb = item % nblk, k0 = 64 * kb, n0 = 32 * nb;
    const int sc = cm(n0 + (lane & 31));
#pragma unroll
    for (int i = 0; i < 32; ++i) { const int kk = 2 * i + (lane >> 5); scr[kk * 33 + (lane & 31)] = __builtin_nontemporal_load(W + (size_t)(k0 + kk) * N + sc) * ks(k0 + kk); }
    LDS_WAIT(); asm volatile("" ::: "memory");
    const int c = lane & 7;
#pragma unroll
    for (int j = 0; j < 4; ++j) { const int n = (lane >> 3) + 8 * j; const LAS float* s = scr + (8 * c) * 33 + n;
        v4u o; o.x = pk2(s[0 * 33], s[1 * 33]); o.y = pk2(s[2 * 33], s[3 * 33]); o.z = pk2(s[4 * 33], s[5 * 33]); o.w = pk2(s[6 * 33], s[7 * 33]);
        *(v4u*)(WT + (size_t)(n0 + n) * K + k0 + 8 * c) = o; }
    LDS_WAIT(); asm volatile("" ::: "memory");
}
struct CMapHead { int nrope;
    __device__ __forceinline__ int operator()(int c) const { const int pn = c >> 8, bj = (c >> 7) & 1, hh = (c >> 5) & 3, p5 = c & 31, hidx = 4 * pn + hh; int p = 32 * bj + p5;
        if (hidx < nrope && p < 16) p = (p & 3) + 8 * ((p >> 2) & 1) + 4 * (p >> 3); return 64 * hidx + p; } };
struct CMapId { __device__ __forceinline__ int operator()(int c) const { return c; } };
struct KSOne { __device__ __forceinline__ float operator()(int) const { return 1.f; } };
struct KSVec { const float* g; __device__ __forceinline__ float operator()(int k) const { return g[k]; } };
struct KSOut { const float *a, *b, *m; __device__ __forceinline__ float operator()(int k) const { return k < 384 ? a[k] : (k < 768 ? b[k - 384] : m[k - 768]); } };

template <int NR> __device__ __forceinline__ void rms_rows_to_bf16(const float* const (&xrow)[NR], const float* g, bf16* const (&orow)[NR], int lane) {
    f32x4 v[NR][4];
#pragma unroll
    for (int r = 0; r < NR; ++r) { const f32x4* xr = (const f32x4*)xrow[r] + lane;
#pragma unroll
        for (int j = 0; j < 4; ++j) v[r][j] = __builtin_nontemporal_load(xr + 64 * j); }
    const f32x4* gr = (const f32x4*)g + lane;
#pragma unroll
    for (int r = 0; r < NR; ++r) {
        float s = 0.f;
#pragma unroll
        for (int j = 0; j < 4; ++j) s += (v[r][j].x * v[r][j].x + v[r][j].y * v[r][j].y) + (v[r][j].z * v[r][j].z + v[r][j].w * v[r][j].w);
        const float rstd = rsqrtf(wave_sum(s) * (1.f / DM) + RMS_EPS);
        unsigned long long* o8 = (unsigned long long*)orow[r] + lane;
#pragma unroll
        for (int j = 0; j < 4; ++j) { const f32x4 gg = gr[64 * j]; o8[64 * j] = (unsigned long long)pk2(v[r][j].x * rstd * gg.x, v[r][j].y * rstd * gg.y) | ((unsigned long long)pk2(v[r][j].z * rstd * gg.z, v[r][j].w * rstd * gg.w) << 32); }
    }
}
__device__ __forceinline__ void p0_prologue(Frame& F, const Args& A) {
    LAS float* scr = (LAS float*)(F.lds + F.wave * 16384);
    const int gw = F.vcu * NWAVES + F.wave, NGW = F.G * NWAVES;
    unsigned char* ws = F.ws;
    constexpr int I_IN = (DM / 64) * (NQKV / 32), I_MEM = (DM / 64) * (512 / 32), I_OUT = (DM / 64) * (DM / 32), I_1 = (DM / 64) * (FF / 32), I_2 = (FF / 64) * (DM / 32);
    constexpr int NITEMS = I_IN + I_MEM + I_OUT + I_1 + I_2;
    PT_SUB(F, 0);
    for (int it = gw; it < NITEMS; it += NGW) {
        int r = it;
        if (r < I_IN) { p0_transpose_item(A.in[5], DM, NQKV, (bf16*)(ws + WS_WIN), scr, r, F.lane, CMapHead{12}, KSOne{}); continue; } r -= I_IN;
        if (r < I_MEM) { p0_transpose_item(A.in[12], DM, 512, (bf16*)(ws + WS_WMEM), scr, r, F.lane, CMapHead{0}, KSOne{}); continue; } r -= I_MEM;
        if (r < I_OUT) { p0_transpose_item(A.in[18], DM, DM, (bf16*)(ws + WS_WOUT), scr, r, F.lane, CMapId{}, KSOut{A.in[15], A.in[16], A.in[17]}); continue; } r -= I_OUT;
        if (r < I_1) { p0_transpose_item(A.in[20], DM, FF, (bf16*)(ws + WS_W1), scr, r, F.lane, CMapId{}, KSVec{A.in[19]}); continue; } r -= I_1;
        p0_transpose_item(A.in[21], FF, DM, (bf16*)(ws + WS_W2), scr, r, F.lane, CMapId{}, KSOne{});
    }
    PT_ADD(F, 0); PT_SUB(F, 1);
    for (int m4 = gw; m4 < (MTOK + MMEM) / 4; m4 += NGW) {
        const int m = 4 * m4; const float* xr[4]; bf16* orw[4]; const float* gn;
        if (m < MTOK) { const float* x0 = m < TP ? A.in[0] + (size_t)m * DM : A.in[1] + (size_t)(m - TP) * DM; bf16* o0 = (bf16*)(ws + WS_XN) + (size_t)m * DM; gn = A.in[4];
#pragma unroll
            for (int r = 0; r < 4; ++r) { xr[r] = x0 + (size_t)r * DM; orw[r] = o0 + (size_t)r * DM; } }
        else { const int r0 = m - MTOK; const float* x0 = r0 < NMEM ? A.in[2] + (size_t)r0 * DM : A.in[3] + (size_t)(r0 - NMEM) * DM; bf16* o0 = (bf16*)(ws + WS_XNMEM) + (size_t)r0 * DM; gn = A.in[11];
#pragma unroll
            for (int r = 0; r < 4; ++r) { xr[r] = x0 + (size_t)r * DM; orw[r] = o0 + (size_t)r * DM; } }
        rms_rows_to_bf16<4>(xr, gn, orw, F.lane);
    }
    PT_ADD(F, 1); PT_SUB(F, 2);
    float* rc = (float*)(ws + WS_ROPE); float* rs = rc + TP * 8;
    for (int i = (F.vcu * NWAVES * 64) + F.tid; i < TP * 8; i += F.G * NWAVES * 64) {
        const int pos = i >> 3, fi = i & 7;
        const float inv = exp2f(-(float)fi * 0.125f * 18.931568569324174f);
        const float ang = (float)pos * inv;
        const double rev = (double)ang * 0.15915494309189535; const float fr = (float)(rev - __builtin_rint(rev));
        rc[i] = __builtin_amdgcn_cosf(fr); rs[i] = __builtin_amdgcn_sinf(fr);
    }
    PT_ADD(F, 2);
}

#define XB_TMO      128
#define XB_XCNT(j)  (256  + 64 * (j))
#define XB_XSUB(j)  (1280 + 64 * (j))
#define XB_XGEN(j)  (2304 + 64 * (j))
#define XB_TOP      3328
#define XB_TOPGEN   3392
#define XCD_BAR_WORDS 3456
#define XB_SPIN_CAP (1u << 18)

__device__ __forceinline__ unsigned xb_ld(unsigned* p)              { return __hip_atomic_load(p, __ATOMIC_RELAXED, __HIP_MEMORY_SCOPE_AGENT); }
__device__ __forceinline__ unsigned xb_add(unsigned* p, unsigned v) { return __hip_atomic_fetch_add(p, v, __ATOMIC_RELAXED, __HIP_MEMORY_SCOPE_AGENT); }
__device__ __forceinline__ unsigned xb_xcc_id() { return (unsigned)__builtin_amdgcn_s_getreg((3 << 11) | 20) & 0xFu; }
#define XB_SPIN(cond, bar) do { unsigned _sp = 0; while (cond) { __builtin_amdgcn_s_sleep(1); \
    if ((++_sp & 255u) == 0u) { if (xb_ld(&(bar)[XB_TMO])) break; if (_sp > XB_SPIN_CAP) { atomicAdd(&(bar)[XB_TMO], 1u); break; } } } } while (0)

struct XcdBarrier {
    unsigned* bar; unsigned x;
    volatile LAS unsigned* st;
};

__device__ __forceinline__ XcdBarrier xcd_barrier_post(unsigned* bar, volatile LAS unsigned* st) {
    XcdBarrier b; b.bar = bar; b.x = xb_xcc_id(); b.st = st;
    if (threadIdx.x == 0) (void)xb_add(&bar[XB_XCNT(b.x)], 1u);
    return b;
}
__device__ __forceinline__ void xcd_barrier_complete(unsigned* bar, unsigned x, unsigned& nloc, unsigned& nx) {
    const unsigned G = gridDim.x * gridDim.y * gridDim.z;
    unsigned sum, cnt, mine, sp = 0u;
    for (;;) {
        sum = 0u; cnt = 0u; mine = 0u;
#pragma unroll
        for (unsigned j = 0; j < 16; ++j) { const unsigned c = xb_ld(&bar[XB_XCNT(j)]); sum += c; cnt += (c > 0u) ? 1u : 0u; mine = (j == x) ? c : mine; }
        if (sum == G) break;
        __builtin_amdgcn_s_sleep(1);
        if ((++sp & 255u) == 0u) { if (xb_ld(&bar[XB_TMO])) break; if (sp > XB_SPIN_CAP) { atomicAdd(&bar[XB_TMO], 1u); break; } }
    }
    nloc = mine > 0u ? mine : 1u; nx = cnt > 0u ? cnt : 1u;
}

__device__ __forceinline__ void xcd_barrier(const XcdBarrier& b) {
    asm volatile("s_waitcnt vmcnt(0)" ::: "memory");
    __syncthreads();
    if (threadIdx.x == 0) {
        unsigned* bar = b.bar;
        __builtin_amdgcn_s_waitcnt(0);
        unsigned nloc = b.st[0], nx = b.st[1];
        if (nloc == 0u) { xcd_barrier_complete(bar, b.x, nloc, nx); b.st[0] = nloc; b.st[1] = nx; }
        const unsigned old = xb_add(&bar[XB_XSUB(b.x)], 1u);
        const unsigned gen = old / nloc;
        if (old + 1u == (gen + 1u) * nloc) {
            __builtin_amdgcn_fence(__ATOMIC_RELEASE, "agent");
            asm volatile("s_waitcnt vmcnt(0)" ::: "memory");
            const unsigned og = xb_add(&bar[XB_TOP], 1u);
            const unsigned tg = og / nx;
            if (og + 1u == (tg + 1u) * nx) xb_add(&bar[XB_TOPGEN], 1u);
            else XB_SPIN(xb_ld(&bar[XB_TOPGEN]) == tg, bar);
            __builtin_amdgcn_fence(__ATOMIC_ACQUIRE, "agent");
            xb_add(&bar[XB_XGEN(b.x)], 1u);
            asm volatile("s_waitcnt vmcnt(0)" ::: "memory");
        } else {
            XB_SPIN(xb_ld(&bar[XB_XGEN(b.x)]) == gen, bar);
            __builtin_amdgcn_fence(__ATOMIC_ACQUIRE, "agent");
            asm volatile("s_waitcnt vmcnt(0)" ::: "memory");
        }
    }
    __syncthreads();
}

struct SeqInfo { long sb; int T; int bat; };
__device__ __forceinline__ SeqInfo seq_of(int row) { SeqInfo s; if (row < TP) { s.sb = 0; s.T = TP; s.bat = 0; } else { const int b = (row - TP) >> 13; s.sb = TP + (long)b * TS; s.T = TS; s.bat = 1 + b; } return s; }


namespace att2 {
using att::bf16x8; using att::s16x4; using att::f32x16; using att::f32x4; using att::u32x4; using att::lptr; using att::creg; using att::cvtpk; using att::vtr; using att::NEG;
constexpr int NS = 4, SLOT = 32768, TILE = 16384, TV = 8192, VDH64 = 4096;
constexpr int L_RING = 0, L_TBL = NS * SLOT, TBLB = 3840, L_LS = L_TBL + 2 * TBLB, L_END = L_LS + 8 * 128;
static_assert(L_END <= LDS_MISC, "attention LDS map");
#define ATT2_WAITBAR(N) asm volatile("s_waitcnt vmcnt(" #N ") lgkmcnt(0)\n\ts_barrier" ::: "memory")

struct TileSrc { const bf16* K; const bf16* V; int p0, qs, T, pm; };
__device__ __forceinline__ void dma_tile(LAS unsigned char* tile, const TileSrc& s, int w, int lane) {
    const bool inside = (s.p0 >= 0) && (s.p0 + 63 * s.qs < s.T);
    { const int row = 8 * w + (lane >> 3); int p = s.p0 + row * s.qs; if (!inside) p = p < 0 ? 0 : (p >= s.T ? s.T - 1 : p); p &= s.pm;
      __builtin_amdgcn_global_load_lds((const unsigned*)(s.K + (size_t)p * 64 + 8 * ((lane & 7) ^ ((row >> 1) & 7))), (LAS unsigned*)(tile + w * 1024), 16, 0, 0); }
    { const int row = 16 * (w & 3) + (lane >> 2); int p = s.p0 + row * s.qs; if (!inside) p = p < 0 ? 0 : (p >= s.T ? s.T - 1 : p); p &= s.pm;
      __builtin_amdgcn_global_load_lds((const unsigned*)(s.V + (size_t)p * 64 + 32 * (w >> 2) + 8 * (lane & 3)), (LAS unsigned*)(tile + TV + (w >> 2) * VDH64 + (w & 3) * 1024), 16, 0, 0); }
}
__device__ __forceinline__ f32x16 qk_sub(lptr tile, int roff, const bf16x8 (&qr)[4], int lane) {
    const int r32 = lane & 31, hi = lane >> 5, row = roff + r32;
    lptr kp = tile + row * 128; const int sw = (row >> 1) & 7;
    f32x16 p = {};
#pragma unroll
    for (int d0 = 0; d0 < 4; ++d0) { const bf16x8 kf = *(__attribute__((address_space(3))) bf16x8*)(kp + (((2 * d0 + hi) ^ sw) * 16)); p = __builtin_amdgcn_mfma_f32_32x32x16_bf16(kf, qr[d0], p, 0, 0, 0); }
    return p;
}
__device__ __forceinline__ void pv_sub(lptr tile, int roff, f32x16& p, f32x16 (&o)[2], float& lsum, int lane) {
    const int hi = lane >> 5;
    float sacc = 0.f;
#pragma unroll
    for (int r = 0; r < 16; ++r) { p[r] = __builtin_amdgcn_exp2f(p[r]); sacc += p[r]; }
    lsum += sacc;
    u32x4 pw0, pw1;
    pw0[0] = cvtpk(p[0], p[1]); pw0[1] = cvtpk(p[2], p[3]); pw0[2] = cvtpk(p[4], p[5]); pw0[3] = cvtpk(p[6], p[7]);
    pw1[0] = cvtpk(p[8], p[9]); pw1[1] = cvtpk(p[10], p[11]); pw1[2] = cvtpk(p[12], p[13]); pw1[3] = cvtpk(p[14], p[15]);
    lptr vp = tile + TV + (roff + 4 * hi + ((lane & 15) >> 2)) * 64 + ((lane >> 4) & 1) * 32 + (lane & 3) * 8;
#pragma unroll
    for (int dh = 0; dh < 2; ++dh) {
        const s16x4 l0 = vtr(vp + dh * VDH64), h0 = vtr(vp + dh * VDH64 + 512), l1 = vtr(vp + dh * VDH64 + 1024), h1 = vtr(vp + dh * VDH64 + 1536);
        const bf16x8 f0 = {l0[0], l0[1], l0[2], l0[3], h0[0], h0[1], h0[2], h0[3]}, f1 = {l1[0], l1[1], l1[2], l1[3], h1[0], h1[1], h1[2], h1[3]};
        o[dh] = __builtin_amdgcn_mfma_f32_32x32x16_bf16(__builtin_bit_cast(bf16x8, pw0), f0, o[dh], 0, 0, 0);
        o[dh] = __builtin_amdgcn_mfma_f32_32x32x16_bf16(__builtin_bit_cast(bf16x8, pw1), f1, o[dh], 0, 0, 0);
    }
}
__device__ __forceinline__ void mask_band(f32x16& p, int rel, int kr0, int L, int lane) {
    const int r32 = lane & 31, hi = lane >> 5;
    if (rel == 0 || rel == 4) { const int base = 32 * rel - r32 + 4 * hi;
#pragma unroll
        for (int r = 0; r < 16; ++r) { if ((unsigned)(base + creg(r)) > 128u) p[r] = NEG; } }
    if (kr0 < 0 || kr0 + 31 >= L) { const int kb = kr0 + 4 * hi;
#pragma unroll
        for (int r = 0; r < 16; ++r) { if ((unsigned)(kb + creg(r)) >= (unsigned)L) p[r] = NEG; } }
}
__device__ __forceinline__ void stage_rows(const f32x16 (&o)[2], float lsum, bool normalise, lptr scr, __attribute__((address_space(3))) float* ls, int lane) {
    const int r32 = lane & 31, hi = lane >> 5;
    lsum = pg8::sum_xor32(lsum);
    if (hi == 0) ls[r32] = lsum;
    __attribute__((address_space(3))) unsigned short* stg = (__attribute__((address_space(3))) unsigned short*)scr;
    float rl[16];
#pragma unroll
    for (int g = 0; g < 4; ++g) { const f32x4 lv = *(__attribute__((address_space(3))) f32x4*)(ls + 8 * g + 4 * hi);
#pragma unroll
        for (int j = 0; j < 4; ++j) rl[4 * g + j] = normalise ? __builtin_amdgcn_rcpf(lv[j]) : 1.f; }
#pragma unroll
    for (int r = 0; r < 16; r += 2) { const int q = creg(r) + 4 * hi;
#pragma unroll
        for (int dh = 0; dh < 2; ++dh) { const unsigned pk = cvtpk(o[dh][r] * rl[r], o[dh][r + 1] * rl[r + 1]);
            stg[q * 64 + dh * 32 + r32] = (unsigned short)pk; stg[(q + 1) * 64 + dh * 32 + r32] = (unsigned short)(pk >> 16); } }
}
template <class RowFn, class SsqFn> __device__ __forceinline__ void out_final(const f32x16 (&o)[2], float lsum, lptr scr, __attribute__((address_space(3))) float* ls, const RowFn& orow, const SsqFn& ssqp, int lane) {
    stage_rows(o, lsum, true, scr, ls, lane);
    __attribute__((address_space(3))) unsigned short* stg = (__attribute__((address_space(3))) unsigned short*)scr;
#pragma unroll
    for (int i = 0; i < 4; ++i) { const int row = i * 8 + (lane >> 3), ch = lane & 7; const u32x4 v = *(__attribute__((address_space(3))) u32x4*)(stg + row * 64 + ch * 8);
        float ss = 0.f;
#pragma unroll
        for (int e = 0; e < 4; ++e) { const float a = bflo(v[e]), b = bfhi(v[e]); ss += a * a + b * b; }
        ss += __shfl_xor(ss, 1); ss += __shfl_xor(ss, 2); ss += __shfl_xor(ss, 4);
        *(u32x4*)(orow(row) + ch * 8) = v; if (ch == 0) *ssqp(row) = ss; }
}
}

constexpr int N2_M = (MTOK / 512) * 4;
constexpr int N2_B = (MTOK / 256) * 3;
constexpr int N2_A = (MTOK / 512) * 6;
constexpr size_t WS_PART = WS_X1B;
constexpr size_t WS_PARTL = WS_PART + (size_t)2 * MTOK * 384 * 2;
static_assert(WS_PARTL + (size_t)2 * MTOK * 8 * 4 <= WS_XN, "partials fit the X1B region");

struct BandU { long sb; int T, qs, L, cls, s0; };
__device__ __forceinline__ BandU band_unit(int tt, int qs) {
    BandU u; int j, nt; if (tt < TP / 256) { u.sb = 0; u.T = TP; j = tt; nt = TP / 256; } else { const int q = tt - TP / 256, b = q / (TS / 256); u.sb = TP + (long)b * TS; u.T = TS; j = q - b * (TS / 256); nt = TS / 256; }
    const int nb = nt / qs; u.qs = qs; u.L = u.T / qs; u.cls = j / nb; u.s0 = 256 * (j - u.cls * nb); return u;
}
struct UD { int kind, idx, nst; att2::TileSrc x, y; int xb, xs, yb, ys, yrot; };
__device__ __forceinline__ UD make_ud(Frame& F, int kind, int idx) {
    UD d; d.kind = kind; d.idx = idx; d.nst = 0; d.xb = d.xs = d.yb = d.ys = d.yrot = 0; d.x = att2::TileSrc{nullptr, nullptr, 0, 1, 1, F.tm}; d.y = d.x;
    const bf16* QKV = (const bf16*)(F.ws + WS_QKV);
    if (kind >= 0 && kind <= 2) {
        const int h = idx / (MTOK / 512), tt = 2 * (idx - h * (MTOK / 512)), qs = kind == 0 ? 16 : (kind == 1 ? 4 : 1);
        const BandU ux = band_unit(tt, qs), uy = band_unit(tt + 1, qs);
        const bf16* Kh = QKV + (size_t)(6 + h) * MTOK * 64; const bf16* Vh = QKV + (size_t)(12 + h) * MTOK * 64;
        d.nst = 6; d.x = att2::TileSrc{Kh + ux.sb * 64, Vh + ux.sb * 64, 0, qs, ux.T, F.tm}; d.y = att2::TileSrc{Kh + uy.sb * 64, Vh + uy.sb * 64, 0, qs, uy.T, F.tm};
        d.xb = ux.cls + (ux.s0 - 64) * qs; d.xs = 64 * qs; d.yb = uy.cls + (uy.s0 - 64) * qs; d.ys = 64 * qs; d.yrot = 3;
    } else if (kind == 3) {
        const int hp = idx / (MTOK / 256), rq4 = idx - hp * (MTOK / 256);
        int r0, rows; long sb; int T;
        if (rq4 < TP / 256) { r0 = 4 * rq4; rows = TP / 64; sb = 0; T = TP; } else { const int q = rq4 - TP / 256, b = q / (TS / 256); r0 = 4 * (q - b * (TS / 256)); rows = TS / 64; sb = TP + (long)b * TS; T = TS; }
        int rk0 = r0 - 4; rk0 = rk0 < 0 ? 0 : (rk0 > rows - 8 ? rows - 8 : rk0);
        int rk1 = r0 + 3 - 4; rk1 = rk1 < 0 ? 0 : (rk1 > rows - 8 ? rows - 8 : rk1);
        d.nst = rk1 + 8 - rk0;
        d.x = att2::TileSrc{QKV + ((size_t)(24 + 2 * hp) * MTOK + sb) * 64, QKV + ((size_t)(30 + 2 * hp) * MTOK + sb) * 64, 0, 1, T, F.tm};
        d.y = att2::TileSrc{QKV + ((size_t)(25 + 2 * hp) * MTOK + sb) * 64, QKV + ((size_t)(31 + 2 * hp) * MTOK + sb) * 64, 0, 1, T, F.tm};
        d.xb = rk0 * 64; d.xs = 64; d.yb = rk0 * 64; d.ys = 64; d.yrot = 0;
    } else if (kind == 4) {
        const int h = idx / (MTOK / 512), row0 = (idx - h * (MTOK / 512)) * 512; const SeqInfo si = seq_of(row0);
        d.nst = 4; d.x = att2::TileSrc{(const bf16*)(F.ws + WS_MK) + (size_t)(si.bat * 4 + h) * NMEM * 64, (const bf16*)(F.ws + WS_MV) + (size_t)(si.bat * 4 + h) * NMEM * 64, 0, 1, NMEM, F.tm}; d.y = d.x;
        d.xb = 0; d.xs = 64; d.yb = 0; d.ys = 64; d.yrot = 0;
    }
    return d;
}
__device__ __forceinline__ void ud_issue(Frame& F, UD& d, int s, int gstep) {
    LAS unsigned char* sl = F.lds + att2::L_RING + (gstep & (att2::NS - 1)) * att2::SLOT;
    int sy = s + d.yrot; sy = sy >= 6 ? sy - 6 : sy; if (d.yrot == 0) sy = s;
    d.x.p0 = d.xb + d.xs * s; d.y.p0 = d.yb + d.ys * sy;
    att2::dma_tile(sl, d.x, F.wave, F.lane); att2::dma_tile(sl + att2::TILE, d.y, F.wave, F.lane);
}
__device__ __forceinline__ void ud_load_q(Frame& F, const UD& d, att::bf16x8 (&qa)[4], att::bf16x8 (&qb)[4]) {
    const int w = F.wave, lane = F.lane, r32 = lane & 31;
    const bf16* QKV = (const bf16*)(F.ws + WS_QKV);
    const bf16* pa = QKV; const bf16* pb = QKV;
    if (d.kind >= 0 && d.kind <= 2) {
        const int h = d.idx / (MTOK / 512), tt = 2 * (d.idx - h * (MTOK / 512)), qs = d.kind == 0 ? 16 : (d.kind == 1 ? 4 : 1);
        const BandU ux = band_unit(tt, qs), uy = band_unit(tt + 1, qs);
        const bf16* Qh = QKV + (size_t)(0 + h) * MTOK * 64;
        pa = Qh + (size_t)(ux.sb + ux.cls + (ux.s0 + 32 * w + r32) * qs) * 64; pb = Qh + (size_t)(uy.sb + uy.cls + (uy.s0 + 32 * w + r32) * qs) * 64;
    } else if (d.kind == 3) {
        const int hp = d.idx / (MTOK / 256), rq4 = d.idx - hp * (MTOK / 256);
        int r0; long sb;
        if (rq4 < TP / 256) { r0 = 4 * rq4; sb = 0; } else { const int q = rq4 - TP / 256, b = q / (TS / 256); r0 = 4 * (q - b * (TS / 256)); sb = TP + (long)b * TS; }
        const int hd = w >> 2, g = w & 3, h = 2 * hp + hd, rq = r0 + (r32 >> 4), c = 16 * g + (r32 & 15);
        pa = QKV + ((size_t)(18 + h) * MTOK + sb + rq * 64 + c) * 64; pb = pa + (size_t)128 * 64;
    } else if (d.kind == 4) {
        const int h = d.idx / (MTOK / 512), row0 = (d.idx - h * (MTOK / 512)) * 512;
        pa = QKV + ((size_t)(36 + h) * MTOK + row0 + 32 * w + r32) * 64; pb = pa + (size_t)256 * 64;
    }
    att::load_q(qa, pa, lane); att::load_q(qb, pb, lane);
}
#define ATT3_STEP_BEGIN() do { if (s == 0) PT_ADD(F, 5); PT_SUB(F, 0); const int ahead_ = gi - gs - 1; \
        if (ahead_ >= 2) { ATT2_WAITBAR(8); } else if (ahead_ == 1) { ATT2_WAITBAR(4); } else { ATT2_WAITBAR(0); } \
        { const int t_ = s + 3; if (t_ < d.nst) { ud_issue(F, d, t_, gi); ++gi; } else if (dn.kind >= 0 && t_ - d.nst < 3) { ud_issue(F, dn, t_ - d.nst, gi); ++gi; } } PT_ADD(F, 0); PT_SUB(F, 1); } while (0)
#define ATT3_UNIT_END() asm volatile("s_waitcnt lgkmcnt(0)\n\ts_barrier" ::: "memory")

__device__ __forceinline__ void att3_body_M(Frame& F, UD& d, UD& dn, int& gs, int& gi, att::bf16x8 (&qr)[4], att::bf16x8 (&qnb)[4]) {
    const int h = d.idx / (MTOK / 512), row0 = (d.idx - h * (MTOK / 512)) * 512;
    const int w = F.wave, lane = F.lane;
    att::f32x16 o[2] = {}, o2[2] = {}; float lsum = 0.f, lsum2 = 0.f;
#pragma unroll 1
    for (int s = 0; s < 4; ++s) {
        ATT3_STEP_BEGIN();
        att::lptr tile = (att::lptr)(F.lds + att2::L_RING + (gs & (att2::NS - 1)) * att2::SLOT);
#pragma unroll
        for (int hf = 0; hf < 2; ++hf) {
            att::f32x16 pa = att2::qk_sub(tile, 32 * hf, qr, lane), pb = att2::qk_sub(tile, 32 * hf, qnb, lane);
            att2::pv_sub(tile, 32 * hf, pa, o, lsum, lane); att2::pv_sub(tile, 32 * hf, pb, o2, lsum2, lane);
            asm volatile("" ::: "memory");
        }
        ++gs; PT_ADD(F, 1);
    }
    ud_load_q(F, dn, qr, qnb);
    PT_SUB(F, 2); ATT3_UNIT_END();
    att::lptr scr = (att::lptr)(F.lds + att2::L_RING + ((gs - 1) & (att2::NS - 1)) * att2::SLOT + w * 4096);
    __attribute__((address_space(3))) float* ls = (__attribute__((address_space(3))) float*)(F.lds + att2::L_LS + w * 128);
    { bf16* O = (bf16*)(F.ws + WS_O) + (size_t)(row0 + 32 * w) * DM + 768 + 64 * h; float* SQ = (float*)(F.ws + WS_SSQA) + (size_t)(row0 + 32 * w) * 16 + 12 + h;
      att2::out_final(o, lsum, scr, ls, [=](int q) { return O + (size_t)q * DM; }, [=](int q) { return SQ + (size_t)q * 16; }, lane); }
    { bf16* O = (bf16*)(F.ws + WS_O) + (size_t)(row0 + 256 + 32 * w) * DM + 768 + 64 * h; float* SQ = (float*)(F.ws + WS_SSQA) + (size_t)(row0 + 256 + 32 * w) * 16 + 12 + h;
      att2::out_final(o2, lsum2, scr, ls, [=](int q) { return O + (size_t)q * DM; }, [=](int q) { return SQ + (size_t)q * 16; }, lane); }
    PT_ADD(F, 2);
}
__device__ __forceinline__ void att3_body_B(Frame& F, const Args& A, UD& d, UD& dn, int& gs, int& gi, att::bf16x8 (&qr)[4], att::bf16x8 (&qnb)[4]) {
    const int hp = d.idx / (MTOK / 256), rq4 = d.idx - hp * (MTOK / 256);
    int r0, rows; long sb;
    if (rq4 < TP / 256) { r0 = 4 * rq4; rows = TP / 64; sb = 0; } else { const int q = rq4 - TP / 256, b = q / (TS / 256); r0 = 4 * (q - b * (TS / 256)); rows = TS / 64; sb = TP + (long)b * TS; }
    const int w = F.wave, lane = F.lane, r32 = lane & 31, hi = lane >> 5;
    const int hd = w >> 2, g = w & 3, h = 2 * hp + hd;
    const int c = 16 * g + (r32 & 15);
    int cs = c - 8; cs = cs < 0 ? 0 : (cs > 48 ? 48 : cs);
    const int rk0 = d.xb >> 6;
    const int w0 = g == 0 ? 0 : (g == 1 ? 8 : (g == 2 ? 24 : 32));
    { const int th = F.tid >> 8, tl = F.tid & 255;
      __attribute__((address_space(3))) float* tbl = (__attribute__((address_space(3))) float*)(F.lds + att2::L_TBL + th * att2::TBLB);
      const float* rpb = A.in[10] + (2 * hp + th) * 465;
      for (int idx = tl; idx < 465; idx += 256) { const int dr = idx / 31, dl = idx - dr * 31; tbl[dr * 64 + 16 + dl] = rpb[idx] * LOG2E; } }
    att::f32x16 o[2] = {}, o2[2] = {}; float lsum = 0.f, lsum2 = 0.f;
    const __attribute__((address_space(3))) float* tb = (const __attribute__((address_space(3))) float*)(F.lds + att2::L_TBL + hd * att2::TBLB) + (31 + w0 - c) + 4 * hi;
    const int cb = w0 - cs + 4 * hi, nst = d.nst;
    const int rq0 = r0 + (r32 >> 4), rq1 = rq0 + 2;
    int rlo0 = rq0 - 4; rlo0 = rlo0 < 0 ? 0 : (rlo0 > rows - 8 ? rows - 8 : rlo0);
    int rlo1 = rq1 - 4; rlo1 = rlo1 < 0 ? 0 : (rlo1 > rows - 8 ? rows - 8 : rlo1);
    int b0lo = r0 - 4; b0lo = b0lo < 0 ? 0 : (b0lo > rows - 8 ? rows - 8 : b0lo); int b0hi = r0 + 1 - 4; b0hi = (b0hi < 0 ? 0 : (b0hi > rows - 8 ? rows - 8 : b0hi)) + 7;
    int b1lo = r0 + 2 - 4; b1lo = b1lo < 0 ? 0 : (b1lo > rows - 8 ? rows - 8 : b1lo); int b1hi = r0 + 3 - 4; b1hi = (b1hi < 0 ? 0 : (b1hi > rows - 8 ? rows - 8 : b1hi)) + 7;
#pragma unroll 1
    for (int s = 0; s < nst; ++s) {
        ATT3_STEP_BEGIN();
        att::lptr tile = (att::lptr)(F.lds + att2::L_RING + (gs & (att2::NS - 1)) * att2::SLOT + hd * att2::TILE);
        const int rk = rk0 + s;
        if (rk >= b0lo && rk <= b0hi) {
            att::f32x16 p = att2::qk_sub(tile, w0, qr, lane);
            const bool rok = (unsigned)(rk - rlo0) < 8u; int dr = rk + 7 - rq0; dr = dr < 0 ? 0 : (dr > 14 ? 14 : dr);
            const __attribute__((address_space(3))) float* tp = tb + dr * 64; const int cbh = rok ? cb : -4096;
#pragma unroll
            for (int r = 0; r < 16; ++r) { const float sbv = p[r] + tp[att::creg(r)]; p[r] = ((unsigned)(cbh + att::creg(r)) < 16u) ? sbv : att::NEG; }
            att2::pv_sub(tile, w0, p, o, lsum, lane);
        }
        if (rk >= b1lo && rk <= b1hi) {
            att::f32x16 p = att2::qk_sub(tile, w0, qnb, lane);
            const bool rok = (unsigned)(rk - rlo1) < 8u; int dr = rk + 7 - rq1; dr = dr < 0 ? 0 : (dr > 14 ? 14 : dr);
            const __attribute__((address_space(3))) float* tp = tb + dr * 64; const int cbh = rok ? cb : -4096;
#pragma unroll
            for (int r = 0; r < 16; ++r) { const float sbv = p[r] + tp[att::creg(r)]; p[r] = ((unsigned)(cbh + att::creg(r)) < 16u) ? sbv : att::NEG; }
            att2::pv_sub(tile, w0, p, o2, lsum2, lane);
        }
        ++gs; PT_ADD(F, 1);
    }
    ud_load_q(F, dn, qr, qnb);
    PT_SUB(F, 2); ATT3_UNIT_END();
    att::lptr scr = (att::lptr)(F.lds + att2::L_RING + ((gs - 1) & (att2::NS - 1)) * att2::SLOT + w * 4096);
    __attribute__((address_space(3))) float* ls = (__attribute__((address_space(3))) float*)(F.lds + att2::L_LS + w * 128);
    { bf16* O = (bf16*)(F.ws + WS_O) + (size_t)(sb + r0 * 64 + 16 * g) * DM + 384 + 64 * h; float* SQ = (float*)(F.ws + WS_SSQA) + (size_t)(sb + r0 * 64 + 16 * g) * 16 + 6 + h;
      att2::out_final(o, lsum, scr, ls, [=](int q) { return O + (size_t)((q >> 4) * 64 + (q & 15)) * DM; }, [=](int q) { return SQ + (size_t)((q >> 4) * 64 + (q & 15)) * 16; }, lane); }
    { bf16* O = (bf16*)(F.ws + WS_O) + (size_t)(sb + (r0 + 2) * 64 + 16 * g) * DM + 384 + 64 * h; float* SQ = (float*)(F.ws + WS_SSQA) + (size_t)(sb + (r0 + 2) * 64 + 16 * g) * 16 + 6 + h;
      att2::out_final(o2, lsum2, scr, ls, [=](int q) { return O + (size_t)((q >> 4) * 64 + (q & 15)) * DM; }, [=](int q) { return SQ + (size_t)((q >> 4) * 64 + (q & 15)) * 16; }, lane); }
    PT_ADD(F, 2);
}
__device__ __forceinline__ void att3_body_A(Frame& F, UD& d, UD& dn, int& gs, int& gi, att::bf16x8 (&qx)[4], att::bf16x8 (&qy)[4]) {
    const int pat = d.kind, ud = d.idx;
    const int h = ud / (MTOK / 512), tt = 2 * (ud - h * (MTOK / 512)), qs = pat == 0 ? 16 : (pat == 1 ? 4 : 1);
    const BandU ux = band_unit(tt, qs), uy = band_unit(tt + 1, qs);
    const int w = F.wave, lane = F.lane, r32 = lane & 31;
    const bf16* Qh = (const bf16*)(F.ws + WS_QKV) + (size_t)(0 + h) * MTOK * 64;
    att::f32x16 ox[2] = {}, oy[2] = {}; float lx = 0.f, ly = 0.f;
#pragma unroll 1
    for (int s = 0; s < 6; ++s) {
        ATT3_STEP_BEGIN();
        att::lptr tX = (att::lptr)(F.lds + att2::L_RING + (gs & (att2::NS - 1)) * att2::SLOT), tY = tX + att2::TILE;
        const int sy = (s + 3) % 6;
#pragma unroll
        for (int hf = 0; hf < 2; ++hf) {
            const int gx = 2 * s + hf, gy = 2 * sy + hf;
            const bool ax = (unsigned)(gx - w) <= 4u, ay = (unsigned)(gy - w) <= 4u;
            att::f32x16 pxx, pyy;
            if (ax) pxx = att2::qk_sub(tX, 32 * hf, qx, lane);
            if (ay) pyy = att2::qk_sub(tY, 32 * hf, qy, lane);
            if (ax) { att2::mask_band(pxx, gx - w, ux.s0 - 64 + 32 * gx, ux.L, lane); att2::pv_sub(tX, 32 * hf, pxx, ox, lx, lane); }
            if (ay) { att2::mask_band(pyy, gy - w, uy.s0 - 64 + 32 * gy, uy.L, lane); att2::pv_sub(tY, 32 * hf, pyy, oy, ly, lane); }
        }
        ++gs; PT_ADD(F, 1);
    }
    ud_load_q(F, dn, qx, qy);
    bf16* PB = (bf16*)(F.ws + WS_PART); float* PL = (float*)(F.ws + WS_PARTL);
    int lane_o = F.lane; asm volatile("" : "+v"(lane_o));
    att::u32x4 pa[4], pb[4]; float pl[4];
#define ATT3_LOAD_PART(side_) do { const BandU& u_ = (side_) ? uy : ux; const long t0_ = u_.sb + u_.cls + (long)(u_.s0 + 32 * w); \
        _Pragma("unroll") for (int i = 0; i < 4; ++i) { const int row = i * 8 + (lane_o >> 3), ch = lane_o & 7; const long tok = t0_ + row; \
            pa[i] = *(const att::u32x4*)(PB + ((size_t)tok) * 384 + 64 * h + ch * 8); pb[i] = *(const att::u32x4*)(PB + ((size_t)MTOK + tok) * 384 + 64 * h + ch * 8); \
            pl[i] = PL[(size_t)tok * 8 + h] + PL[((size_t)MTOK + tok) * 8 + h]; } } while (0)
    if (pat == 2) ATT3_LOAD_PART(0);
    PT_SUB(F, 2); ATT3_UNIT_END();
    att::lptr scr = (att::lptr)(F.lds + att2::L_RING + ((gs - 1) & (att2::NS - 1)) * att2::SLOT + w * 4096);
    __attribute__((address_space(3))) unsigned short* stg = (__attribute__((address_space(3))) unsigned short*)scr;
    __attribute__((address_space(3))) float* ls = (__attribute__((address_space(3))) float*)(F.lds + att2::L_LS + w * 128);
#pragma unroll
    for (int side = 0; side < 2; ++side) {
        const BandU& u = side ? uy : ux;
        const long tok0 = u.sb + u.cls + (long)(u.s0 + 32 * w) * qs;
        att2::stage_rows(side ? oy : ox, side ? ly : lx, false, scr, ls, lane);
        if (pat < 2) {
#pragma unroll
            for (int i = 0; i < 4; ++i) { const int row = i * 8 + (lane_o >> 3), ch = lane_o & 7; const att::u32x4 v = *(__attribute__((address_space(3))) att::u32x4*)(stg + row * 64 + ch * 8);
                *(att::u32x4*)(PB + ((size_t)pat * MTOK + tok0 + (long)row * qs) * 384 + 64 * h + ch * 8) = v; }
            if (lane_o < 32) PL[((size_t)pat * MTOK + tok0 + (long)lane_o * qs) * 8 + h] = ls[lane_o];
        } else {
            att::u32x4 a4[4], b4[4]; float l4[4];
#pragma unroll
            for (int i = 0; i < 4; ++i) { a4[i] = pa[i]; b4[i] = pb[i]; l4[i] = pl[i]; }
            if (side == 0) ATT3_LOAD_PART(1);
#pragma unroll
            for (int i = 0; i < 4; ++i) { const int row = i * 8 + (lane_o >> 3), ch = lane_o & 7; const long tok = tok0 + row;
                const att::u32x4 v = *(__attribute__((address_space(3))) att::u32x4*)(stg + row * 64 + ch * 8);
                const att::u32x4 a = a4[i], b = b4[i];
                const float rl = __builtin_amdgcn_rcpf(ls[row] + l4[i]);
                att::u32x4 ov; float ss = 0.f;
#pragma unroll
                for (int e = 0; e < 4; ++e) { const float x0 = (bflo(v[e]) + bflo(a[e]) + bflo(b[e])) * rl, x1 = (bfhi(v[e]) + bfhi(a[e]) + bfhi(b[e])) * rl; ov[e] = pk2(x0, x1);
                    const float y0 = bflo(ov[e]), y1 = bfhi(ov[e]); ss += y0 * y0 + y1 * y1; }
                ss += __shfl_xor(ss, 1); ss += __shfl_xor(ss, 2); ss += __shfl_xor(ss, 4);
                *(att::u32x4*)((bf16*)(F.ws + WS_O) + (size_t)tok * DM + 64 * h + ch * 8) = ov;
                if (ch == 0) ((float*)(F.ws + WS_SSQA))[(size_t)tok * 16 + h] = ss; }
        }
    }
#undef ATT3_LOAD_PART
    PT_ADD(F, 2);
}
template <class ListFn> __device__ __forceinline__ void att3_run(Frame& F, const Args& A, const ListFn& unit_of) {
    PT_SUB(F, 3);
    int gs = 0, gi = 0, k, i;
    unit_of(0, k, i); UD d = make_ud(F, k, i);
    if (d.kind < 0) return;
    for (int s = 0; s < 3; ++s) { ud_issue(F, d, s, gi); ++gi; }
    att::bf16x8 qa[4], qb[4]; ud_load_q(F, d, qa, qb);
    for (int j = 0; d.kind >= 0; ++j) {
        PT_SUB(F, 4); unit_of(j + 1, k, i); UD dn = make_ud(F, k, i); PT_ADD(F, 4); PT_SUB(F, 5);
        const int kslot_ = d.kind; PTK_SUB(F, kslot_);
        if (d.kind <= 2) att3_body_A(F, d, dn, gs, gi, qa, qb); else if (d.kind == 3) att3_body_B(F, A, d, dn, gs, gi, qa, qb); else att3_body_M(F, d, dn, gs, gi, qa, qb);
        PTK_ADD(F, kslot_);
        d = dn;
    }
    ATT2_WAITBAR(0);
    PT_ADD(F, 3);
}
__device__ __forceinline__ void att2_phase_a(Frame& F, const Args& A) {
    const int NU = 2 * N2_A + N2_B, G = F.G;
    const bool blk = (G == 256); const int per = NU / 8, xcd = blockIdx.x & 7, ci = blockIdx.x >> 3, bx = blockIdx.x;
    att3_run(F, A, [=](int j, int& kind, int& idx) {
        const int jj = blk ? ci + 32 * j : bx + G * j; const bool ok = blk ? (jj < per) : (jj < NU);
        const int u = blk ? xcd * per + jj : jj, i = u / 3, k = u - 3 * i;
        kind = !ok ? -1 : (k == 0 ? 0 : (k == 1 ? 1 : 3)); idx = i; });
}
__device__ __forceinline__ void att2_phase_b(Frame& F, const Args& A) {
    const int NU = N2_A + N2_M, G = F.G;
    const bool blk = (G == 256); const int per = NU / 8, xcd = blockIdx.x & 7, ci = blockIdx.x >> 3, bx = blockIdx.x;
    att3_run(F, A, [=](int j, int& kind, int& idx) {
        const int jj = blk ? ci + 32 * j : bx + G * j; const bool ok = blk ? (jj < per) : (jj < NU);
        const int u = blk ? xcd * per + jj : jj, gq = u / 5, k = u - 5 * gq;
        kind = !ok ? -1 : (k < 3 ? 2 : 4); idx = k < 3 ? 3 * gq + k : 2 * gq + (k - 3); });
}
__global__ void __launch_bounds__(NWAVES * 64, 2) skel_fwd(Args args) {
    extern __shared__ __attribute__((aligned(16))) unsigned char lds[];
    cg::grid_group grid = cg::this_grid();
    Frame F;
    F.lds = (LAS unsigned char*)lds;
    F.tid = threadIdx.x; F.lane = F.tid & 63; F.wave = __builtin_amdgcn_readfirstlane(F.tid >> 6);
    F.G = gridDim.x; { const int bx = blockIdx.x; F.vcu = (F.G % 8 == 0) ? (bx % 8) * (F.G / 8) + bx / 8 : bx; }
    F.out = args.out; F.ws = args.ws; F.tm = -1;
    unsigned char* ws = args.ws;
    const int lo = args.ph_lo, hi = args.ph_hi & 255; if (args.ph_hi >> 8) F.tm = 63;
    volatile LAS unsigned* bst = (volatile LAS unsigned*)(F.lds + LDS_MISC);
    if (F.tid < 2) bst[F.tid] = 0u;
    if (F.tid >= 8 && F.tid < 24) ((volatile LAS unsigned*)(F.lds + LDS_MISC))[F.tid] = 0u;
    __syncthreads();
    XcdBarrier bar = xcd_barrier_post((unsigned*)(ws + WS_CTL) + CW_BAR, bst);
    if (lo < 0) grid.sync();
#define IN(k) (lo <= (k) && (k) < hi)
#define BOTH(k) (IN(k) && IN((k) + 1))
#define GRID_BAR() xcd_barrier(bar)
#if PROBE_T == 3
#define PT_STAMP(k) do { if (F.tid == 0 && blockIdx.x == 0) PT_SLOTS_L(F.lds)[k] = (long long)__builtin_amdgcn_s_memrealtime(); } while (0)
#else
#define PT_STAMP(k) do {} while (0)
#endif
#if PROBE_T
#define PT_PHASE(k) do { if (F.tid == 0) PT_ON_L(F.lds) = ((k) == PROBE_PHASE) ? 1u : 0u; } while (0)
#else
#define PT_PHASE(k) do {} while (0)
#endif

    PT_STAMP(0);
    if (IN(0)) { PT_PHASE(0); p0_prologue(F, args); PT_PHASE(-1); if (BOTH(0)) GRID_BAR(); }
    PT_STAMP(1);

    if (IN(1)) {
        PT_PHASE(1);
        {
            pg8::Gemm g{(const pg8::bf16_t*)(ws + WS_XN), (const pg8::bf16_t*)(ws + WS_WIN), MTOK, NQKV, DM}; pg8::StaticOrder S; S.init(MTOK, NQKV, F.G, (int)blockIdx.x);
            pg8::EpiQKV E{(pg8::bf16_t*)(ws + WS_QKV), args.in[6], args.in[7], args.in[8], args.in[9], args.in[13], (const float*)(ws + WS_ROPE), (const float*)(ws + WS_ROPE) + TP * 8};
            pg8::gemm_phase<pg8::EpiQKV, pg8::StaticOrder, true, true>(F.lds, g, S, E);
        }
        {
            pg8::Gemm g{(const pg8::bf16_t*)(ws + WS_XNMEM), (const pg8::bf16_t*)(ws + WS_WMEM), MMEM, 512, DM}; pg8::StaticOrder S; S.init(MMEM, 512, F.G, F.G - 1 - (int)blockIdx.x);
            pg8::EpiMemKV E{(pg8::bf16_t*)(ws + WS_MK), (pg8::bf16_t*)(ws + WS_MV), args.in[14]};
            pg8::gemm_phase<pg8::EpiMemKV, pg8::StaticOrder, true, true>(F.lds, g, S, E);
        }
        PT_PHASE(-1);
        if (BOTH(1)) GRID_BAR();
    }
    PT_STAMP(2);

    if (IN(2)) { PT_PHASE(2); att2_phase_a(F, args); PT_PHASE(-1); if (BOTH(2)) GRID_BAR(); }
    PT_STAMP(3);
    if (IN(3)) { PT_PHASE(3); att2_phase_b(F, args); PT_PHASE(-1); if (BOTH(3)) GRID_BAR(); }
    PT_STAMP(4);

    if (IN(4)) {
        pg8::Gemm g{(const pg8::bf16_t*)(ws + WS_O), (const pg8::bf16_t*)(ws + WS_WOUT), MTOK, DM, DM}; pg8::StaticOrder S; S.init(MTOK, DM, F.G, (int)blockIdx.x);
        pg8::EpiX1 E{args.in[0], args.in[1], F.out, (pg8::bf16_t*)(ws + WS_X1B), (float*)(ws + WS_SSQF), (const float*)(ws + WS_SSQA)};
        PT_PHASE(4); pg8::gemm_phase<pg8::EpiX1, pg8::StaticOrder, true, true>(F.lds, g, S, E); PT_PHASE(-1);
        if (BOTH(4)) GRID_BAR();
    }
    PT_STAMP(5);

    if (IN(5)) {
        pg8::Gemm g{(const pg8::bf16_t*)(ws + WS_X1B), (const pg8::bf16_t*)(ws + WS_W1), MTOK, FF, DM}; pg8::StaticOrder S; S.init(MTOK, FF, F.G, (int)blockIdx.x);
        pg8::EpiH E{(pg8::bf16_t*)(ws + WS_H), (const float*)(ws + WS_SSQF), args.ph_hi >> 8};
        PT_PHASE(5); pg8::gemm_phase<pg8::EpiH, pg8::StaticOrder, true, true>(F.lds, g, S, E); PT_PHASE(-1);
        if (BOTH(5)) GRID_BAR();
    }
    PT_STAMP(6);

    if (IN(6)) {
        pg8::Gemm g{(const pg8::bf16_t*)(ws + WS_H), (const pg8::bf16_t*)(ws + WS_W2), MTOK, DM, FF}; pg8::StaticOrder S; S.init(MTOK, DM, F.G, (int)blockIdx.x);
        pg8::EpiOut E{F.out, (const pg8::bf16_t*)(ws + WS_X1B)};
        PT_PHASE(6); pg8::gemm_phase<pg8::EpiOut, pg8::StaticOrder, true, true>(F.lds, g, S, E); PT_PHASE(-1);
    }
#if PROBE_T == 3
    PT_STAMP(7);
    __syncthreads();
    if (blockIdx.x == 0 && F.tid == 0) { F.out[0] = (float)(PT_SLOTS_L(F.lds)[PROBE_I + 1] - PT_SLOTS_L(F.lds)[PROBE_I]) * 0.01f; F.out[1] = 0.f; }
#elif PROBE_T
    __syncthreads();
    if (blockIdx.x == 0 && F.tid == 0) { F.out[0] = (float)(PT_SLOTS_L(F.lds)[PROBE_I] >> 15) * 16.384f; F.out[1] = (float)PT_SLOTS_L(F.lds)[PROBE_J] * (1.0f / 2000.0f); }
#endif
#undef IN
#undef BOTH
}

extern "C" void kernel_launch(void* const* d_in, const int* in_sizes, int n_in, void* d_out, int out_size, void* d_ws, size_t ws_size, hipStream_t stream) {
    static int grid = 0;
    if (grid == 0) {
        if (n_in != 22 || in_sizes[0] != TP * DM || in_sizes[1] != NBS * TS * DM || out_size != MTOK * DM || ws_size < WS_END) {
            fprintf(stderr, "kernel_launch: unexpected shapes / workspace (n_in %d, in0 %d, out %d, ws %zu); nothing launched\n", n_in, n_in > 0 ? in_sizes[0] : -1, out_size, ws_size); grid = -1; return; }
        int dev = 0, cus = 0, per_cu = 0;
        if (hipGetDevice(&dev) != hipSuccess || hipDeviceGetAttribute(&cus, hipDeviceAttributeMultiprocessorCount, dev) != hipSuccess) { grid = -1; return; }
        if (hipFuncSetAttribute((const void*)skel_fwd, hipFuncAttributeMaxDynamicSharedMemorySize, LDS_BYTES) != hipSuccess) { fprintf(stderr, "kernel_launch: hipFuncSetAttribute failed\n"); grid = -1; return; }
        if (hipOccupancyMaxActiveBlocksPerMultiprocessor(&per_cu, (const void*)skel_fwd, NWAVES * 64, LDS_BYTES) != hipSuccess || per_cu < 1) { fprintf(stderr, "kernel_launch: occupancy query says %d\n", per_cu); (void)hipGetLastError(); grid = -1; return; }
        grid = cus * per_cu;
    }
    if (grid < 0) return;
    if (hipMemsetAsync((char*)d_ws + WS_CTL, 0, CTL_ZERO_BYTES, stream) != hipSuccess) return;
    Args a{};
    for (int i = 0; i < 22; ++i) a.in[i] = (const float*)d_in[i];
    a.out = (float*)d_out; a.ws = (unsigned char*)d_ws;
    auto launch = [&](int lo, int hi) {
        if (lo > 0) (void)hipMemsetAsync((char*)d_ws + WS_CTL + (size_t)CW_BAR * 4, 0, (size_t)XCD_BAR_WORDS * 4, stream);
        a.ph_lo = lo; a.ph_hi = hi; void* kargs[] = {&a};
        hipError_t e = hipLaunchCooperativeKernel((const void*)skel_fwd, dim3(grid), dim3(NWAVES * 64), kargs, LDS_BYTES, stream);
        if (e != hipSuccess) fprintf(stderr, "kernel_launch: cooperative launch failed: %s (grid %d)\n", hipGetErrorString(e), grid);
    };
#if PROBE_SEQ == 0
    launch(0, NPH);
#elif PROBE_SEQ == 1
    launch(0, NPH); launch(0, 1);
#elif PROBE_SEQ == 2
    launch(0, NPH); launch(1, 2);
#elif PROBE_SEQ == 3
    launch(0, 4); (void)hipMemsetAsync((char*)d_ws + WS_SSQA, 0, (size_t)MTOK * 16, stream); launch(2, 4); launch(4, NPH);
#elif PROBE_SEQ == 4
    launch(0, 5); (void)hipMemsetAsync((char*)d_ws + WS_SSQF, 0, (size_t)MTOK * 4, stream); launch(4, 5); launch(5, NPH);
#elif PROBE_SEQ == 5
    launch(0, NPH); launch(5, 6);
#elif PROBE_SEQ == 7
    launch(0, NPH); launch(2, 3);
#elif PROBE_SEQ == 8
    launch(0, NPH); launch(2, 3 | 256);
#elif PROBE_SEQ == 9
    launch(0, NPH); launch(3, 4);
#elif PROBE_SEQ == 10
    launch(0, NPH); launch(3, 4 | 256);
#elif PROBE_SEQ == 11
    launch(0, NPH); launch(5, 6 | 256);
#elif PROBE_SEQ == 12
    launch(0, NPH); launch(5, 6 | 512);
#elif PROBE_SEQ == 13
    launch(0, NPH); launch(0, 1 | 256);
#elif PROBE_SEQ == 6
    launch(0, 3); (void)hipMemsetAsync((char*)d_ws + WS_SSQA, 0, (size_t)MTOK * 16, stream); launch(2, 3); launch(3, NPH);
#endif
}
```

```cpp
#include <hip/hip_runtime.h>
#include <hip/hip_cooperative_groups.h>
#include <cstdio>
#include <cstdint>
namespace cg = cooperative_groups;

constexpr int DM = 1024, TP = 16384, TS = 8192, NBS = 4, MTOK = TP + NBS * TS;
constexpr int NQKV = 2560, NHEADS = 40, FF = 4096, NMEM = 256, NBATCH = 1 + NBS, MMEM = NBATCH * NMEM;
constexpr float RMS_EPS = 1e-6f;
constexpr float LOG2E = 1.4426950408889634f;
constexpr float QSCALE = 0.125f * LOG2E;

#ifndef PROBE_SEQ
#define PROBE_SEQ 0
#endif
#ifndef PROBE_T
#define PROBE_T 0
#endif
#ifndef PROBE_I
#define PROBE_I 6
#endif
#ifndef PROBE_J
#define PROBE_J 7
#endif
#ifndef PROBE_PHASE
#define PROBE_PHASE 3
#endif
#ifndef PROBE_PHASE
#define PROBE_PHASE 3
#endif
constexpr int RING_BYTES = 131072;
constexpr int LDS_BYTES = 147456, LDS_MISC = LDS_BYTES - 128;
constexpr int CW_BAR = 4096, CW_ARANK = 8192;
constexpr int LDS_BYTES_UNUSED = 0;


#if PROBE_T
#define PT_SLOTS_L(lds) ((volatile __attribute__((address_space(3))) long long*)((lds) + LDS_MISC + 32))
#define PT_ON_L(lds) (*(volatile __attribute__((address_space(3))) unsigned*)((lds) + LDS_MISC + 24))
#define PT_SUB_L(lds, i) do { if (threadIdx.x == 0 && blockIdx.x == 0 && PT_ON_L(lds)) PT_SLOTS_L(lds)[i] -= (long long)__builtin_readcyclecounter(); } while (0)
#define PT_ADD_L(lds, i) do { if (threadIdx.x == 0 && blockIdx.x == 0 && PT_ON_L(lds)) PT_SLOTS_L(lds)[i] += (long long)__builtin_readcyclecounter(); } while (0)
#else
#define PT_SUB_L(lds, i) do {} while (0)
#define PT_ADD_L(lds, i) do {} while (0)
#endif
#if PROBE_T == 2
#define PTK_SUB(F, i) PT_SUB_L((F).lds, i)
#define PTK_ADD(F, i) PT_ADD_L((F).lds, i)
#define PT_SUB(F, i) do {} while (0)
#define PT_ADD(F, i) do {} while (0)
#else
#define PTK_SUB(F, i) do {} while (0)
#define PTK_ADD(F, i) do {} while (0)
#define PT_SUB(F, i) PT_SUB_L((F).lds, i)
#define PT_ADD(F, i) PT_ADD_L((F).lds, i)
#endif
namespace pg8 {
#define PG8_LAS __attribute__((address_space(3)))
typedef unsigned short bf16_t;
typedef short bf16x8 __attribute__((ext_vector_type(8)));
typedef float f32x4 __attribute__((ext_vector_type(4)));
typedef unsigned u32x4 __attribute__((ext_vector_type(4)));
constexpr int BM = 256, BK = 64, HALF = 128, HTB = HALF * BK * 2  , STAGE_BYTES = 8 * HTB, NXCD = 8, WGM = 8;

__host__ __device__ __forceinline__ int lds_byte(int r, int c) { const int st = (r >> 4) * 2 + (c >> 5), rr = r & 15, cc = c & 31, ob = rr * 64 + cc * 2; return st * 1024 + (ob ^ (((ob >> 9) & 1) << 5)); }
__host__ __device__ __forceinline__ void stage_rc(int b, int& R, int& C) { const int st = b / 1024, sb = b % 1024, swz = sb ^ (((sb >> 9) & 1) << 5); R = (st >> 1) * 16 + swz / 64; C = (st & 1) * 32 + (swz % 64) / 2; }
__host__ __device__ __forceinline__ int perm32(int rho) { const int n = rho >> 4, i = rho & 15; return 8 * (i >> 2) + 4 * n + (i & 3); }

struct Unit { int pm, pn; };
struct Gemm { const bf16_t* A; const bf16_t* Bt; int M, N, K; };

struct StaticOrder {
    int nM, nN, nwg, G, c;
    __host__ __device__ void init(int M, int N, int G_, int c_) { nM = M / BM; nN = N / BM; nwg = nM * nN; G = G_; c = c_; }
    __host__ __device__ bool next(int i, Unit& u) const {
        const long L = (long)i * G + c; if (L >= nwg) return false;
        int wgid = (int)L; { const int q = nwg / NXCD, r = nwg % NXCD, xcd = wgid % NXCD, off = wgid / NXCD; wgid = (xcd < r ? xcd * (q + 1) : r * (q + 1) + (xcd - r) * q) + off; }
        const int nig = WGM * nN, gid = wgid / nig, fm = gid * WGM, gsz = (nM - fm) < WGM ? (nM - fm) : WGM;
        u.pm = fm + ((wgid % nig) % gsz); u.pn = (wgid % nig) / gsz; return true;
    }
    __device__ __forceinline__ void a_ready(const Unit&) const {}
    __device__ __forceinline__ void done(const Unit&) const {}
};

__device__ __forceinline__ unsigned cvt_pk_bf16(float lo, float hi) { unsigned r; asm volatile("v_cvt_pk_bf16_f32 %0, %1, %2" : "=v"(r) : "v"(lo), "v"(hi)); return r; }
typedef float f32x2 __attribute__((ext_vector_type(2)));
__device__ __forceinline__ float sum_xor16(float v) { const auto r = __builtin_amdgcn_permlane16_swap(__float_as_uint(v), __float_as_uint(v), false, false); return __uint_as_float(r[0]) + __uint_as_float(r[1]); }
__device__ __forceinline__ float sum_xor32(float v) { const auto r = __builtin_amdgcn_permlane32_swap(__float_as_uint(v), __float_as_uint(v), false, false); return __uint_as_float(r[0]) + __uint_as_float(r[1]); }
__device__ __forceinline__ float sq4(const f32x4 v) { return (v[0] * v[0] + v[1] * v[1]) + (v[2] * v[2] + v[3] * v[3]); }
__device__ __forceinline__ u32x4 pack8(const f32x4 a, const f32x4 b) { u32x4 w; w.x = cvt_pk_bf16(a[0], a[1]); w.y = cvt_pk_bf16(a[2], a[3]); w.z = cvt_pk_bf16(b[0], b[1]); w.w = cvt_pk_bf16(b[2], b[3]); return w; }

struct EpiQKV {
    static constexpr bool PERM = true, AFTER_DRAIN = false, KSCALE = false, PREP = false, PREFETCH = false; static constexpr int KS_T1 = -1, KS_T2 = -1;
    bf16_t* QKV;
    const float *gqa, *gka, *gqb, *gkb, *gqm;
    const float *rc, *rs;
    __device__ __forceinline__ void operator()(const f32x4 (&acc)[2][2][4][2], const Unit& u, int wr, int wc, int fr, int fq) const {
        const int hidx = u.pn * 4 + wc;
        const float* gain = nullptr; bool rope = false; float qs = 1.f;
        if (hidx < 6) { gain = gqa; rope = true; qs = QSCALE; } else if (hidx < 12) { gain = gka; rope = true; } else if (hidx < 18) { } else if (hidx < 24) { gain = gqb; qs = QSCALE; }
        else if (hidx < 30) { gain = gkb; } else if (hidx < 36) { } else { gain = gqm; qs = QSCALE; }
        const bool rl = rope && fq < 2;
        f32x4 g[2][2];
#pragma unroll
        for (int bj = 0; bj < 2; ++bj)
#pragma unroll
            for (int n = 0; n < 2; ++n) { const int d0 = (rl && bj == 0) ? (8 * n + 4 * fq) : (32 * bj + 8 * fq + 4 * n); g[bj][n] = gain ? *(const f32x4*)(gain + d0) : (f32x4){1.f, 1.f, 1.f, 1.f}; }
        bf16_t* base = QKV + (size_t)hidx * MTOK * 64 + 8 * fq;
#pragma unroll
        for (int ai = 0; ai < 2; ++ai)
#pragma unroll
            for (int m = 0; m < 4; ++m) {
                const int row = u.pm * BM + ai * HALF + wr * 64 + m * 16 + fr;
                f32x4 v[2][2];
#pragma unroll
                for (int bj = 0; bj < 2; ++bj)
#pragma unroll
                    for (int n = 0; n < 2; ++n) v[bj][n] = acc[ai][bj][m][n];
                if (gain) {
                    float ss = (sq4(v[0][0]) + sq4(v[0][1])) + (sq4(v[1][0]) + sq4(v[1][1]));
                    ss = sum_xor32(sum_xor16(ss));
                    const float r = rsqrtf(ss * (1.f / 64.f) + RMS_EPS) * qs;
#pragma unroll
                    for (int bj = 0; bj < 2; ++bj)
#pragma unroll
                        for (int n = 0; n < 2; ++n) v[bj][n] = v[bj][n] * r * g[bj][n];
                    if (rope) {
                        const int pos = row < TP ? row : ((row - TP) & (TS - 1));
                        const f32x4 c = *(const f32x4*)(rc + pos * 8 + 4 * (fq & 1)), s = *(const f32x4*)(rs + pos * 8 + 4 * (fq & 1));
                        if (fq < 2) { const f32x4 x1 = v[0][0], x2 = v[0][1]; v[0][0] = x1 * c - x2 * s; v[0][1] = x2 * c + x1 * s; }
                    }
                }
                bf16_t* rowp = base + (size_t)row * 64;
                __builtin_nontemporal_store(pack8(v[0][0], v[0][1]), (u32x4*)(rowp));
                __builtin_nontemporal_store(pack8(v[1][0], v[1][1]), (u32x4*)(rowp + 32));
            }
    }
};
struct EpiMemKV {
    static constexpr bool PERM = true, AFTER_DRAIN = false, KSCALE = false, PREP = false, PREFETCH = false; static constexpr int KS_T1 = -1, KS_T2 = -1;
    bf16_t* MK; bf16_t* MV; const float* gk;
    __device__ __forceinline__ void operator()(const f32x4 (&acc)[2][2][4][2], const Unit& u, int wr, int wc, int fr, int fq) const {
        const int hidx = u.pn * 4 + wc; const bool isk = hidx < 4; const int h = hidx & 3;
        f32x4 g[2][2];
#pragma unroll
        for (int bj = 0; bj < 2; ++bj)
#pragma unroll
            for (int n = 0; n < 2; ++n) g[bj][n] = isk ? *(const f32x4*)(gk + 32 * bj + 8 * fq + 4 * n) : (f32x4){1.f, 1.f, 1.f, 1.f};
        bf16_t* base = (isk ? MK : MV) + 8 * fq;
#pragma unroll
        for (int ai = 0; ai < 2; ++ai)
#pragma unroll
            for (int m = 0; m < 4; ++m) {
                const int row = u.pm * BM + ai * HALF + wr * 64 + m * 16 + fr;
                f32x4 v[2][2];
#pragma unroll
                for (int bj = 0; bj < 2; ++bj)
#pragma unroll
                    for (int n = 0; n < 2; ++n) v[bj][n] = acc[ai][bj][m][n];
                if (isk) {
                    float ss = (sq4(v[0][0]) + sq4(v[0][1])) + (sq4(v[1][0]) + sq4(v[1][1]));
                    ss = sum_xor32(sum_xor16(ss));
                    const float r = rsqrtf(ss * (1.f / 64.f) + RMS_EPS);
#pragma unroll
                    for (int bj = 0; bj < 2; ++bj)
#pragma unroll
                        for (int n = 0; n < 2; ++n) v[bj][n] = v[bj][n] * r * g[bj][n];
                }
                bf16_t* rowp = base + ((size_t)((row >> 8) * 4 + h) * NMEM + (row & 255)) * 64;
                *(u32x4*)(rowp) = pack8(v[0][0], v[0][1]);
                *(u32x4*)(rowp + 32) = pack8(v[1][0], v[1][1]);
            }
    }
};
struct EpiX1 {
    static constexpr bool PERM = true, AFTER_DRAIN = false, KSCALE = true, PREP = true, PREFETCH = false; static constexpr int KS_T1 = 6, KS_T2 = 12;
    const bf16_t* xn; const float* irstd; const float* gin; bf16_t* x1b; float* ssq; const float* ssqa;
    static constexpr int TBL_OFF = 131072, GTBL_OFF = 131072 + 8192;
    __device__ __forceinline__ void prep(const Unit& u, PG8_LAS unsigned char* lds, int idx, int tid) const {
        if (tid < BM) { const f32x4* qp = (const f32x4*)(ssqa + (size_t)(u.pm * BM + tid) * 16); const f32x4 q0 = qp[0], q1 = qp[1], q2 = qp[2], q3 = qp[3];
            const float qa = (q0[0] + q0[1]) + (q0[2] + q0[3]) + (q1[0] + q1[1]), qb = (q1[2] + q1[3]) + (q2[0] + q2[1]) + (q2[2] + q2[3]), qm = (q3[0] + q3[1]) + (q3[2] + q3[3]);
            const float sa = rsqrtf(qa * (1.f / 384.f) + RMS_EPS), sb = rsqrtf(qb * (1.f / 384.f) + RMS_EPS), sm = rsqrtf(qm * (1.f / 256.f) + RMS_EPS);
            *(PG8_LAS f32x4*)(lds + TBL_OFF + (idx & 1) * 4096 + tid * 16) = (f32x4){sa / sb, sb / sm, sm, irstd[u.pm * BM + tid]}; }
        else { const int c = tid - BM; *(PG8_LAS float*)(lds + GTBL_OFF + (idx & 1) * 1024 + c * 4) = 1.0f / gin[u.pn * BM + c]; }
    }
    __device__ __forceinline__ void kscale(f32x4 (&acc)[2][2][4][2], int t, int wr, int fr, PG8_LAS unsigned char* lds, int idx) const {
        const PG8_LAS float* tb = (const PG8_LAS float*)(lds + TBL_OFF + (idx & 1) * 4096) + ((t == KS_T1) ? 0 : 1);
#pragma unroll
        for (int ai = 0; ai < 2; ++ai)
#pragma unroll
            for (int m = 0; m < 4; ++m) {
                const float f = tb[(ai * HALF + wr * 64 + m * 16 + fr) * 4];
#pragma unroll
                for (int bj = 0; bj < 2; ++bj)
#pragma unroll
                    for (int n = 0; n < 2; ++n) acc[ai][bj][m][n] = acc[ai][bj][m][n] * f;
            }
    }
    __device__ __forceinline__ void epi(const f32x4 (&acc)[2][2][4][2], const Unit& u, int wr, int wc, int fr, int fq, PG8_LAS unsigned char* lds, int idx) const {
        const PG8_LAS float* tb = (const PG8_LAS float*)(lds + TBL_OFF + (idx & 1) * 4096);
        const PG8_LAS f32x4* gt = (const PG8_LAS f32x4*)(lds + GTBL_OFF + (idx & 1) * 1024 + (wc * 32 + 8 * fq) * 4);
        f32x4 ig[2][2];
#pragma unroll
        for (int bj = 0; bj < 2; ++bj) { ig[bj][0] = gt[bj * 32]; ig[bj][1] = gt[bj * 32 + 1]; }
        const int col0 = u.pn * BM + wc * 32 + 8 * fq;
#pragma unroll
        for (int ai = 0; ai < 2; ++ai) {
            u32x4 xr[4][2];
#pragma unroll
            for (int m = 0; m < 4; ++m) { const bf16_t* xrow = xn + (size_t)(u.pm * BM + ai * HALF + wr * 64 + m * 16 + fr) * DM + col0;
#pragma unroll
                for (int bj = 0; bj < 2; ++bj) xr[m][bj] = __builtin_nontemporal_load((const u32x4*)(xrow + bj * HALF)); }
#pragma unroll
            for (int m = 0; m < 4; ++m) {
                const int rl = ai * HALF + wr * 64 + m * 16 + fr, row = u.pm * BM + rl;
                const float sm = tb[rl * 4 + 2], ir = tb[rl * 4 + 3];
                bf16_t* brow = x1b + (size_t)row * DM + col0;
                float ss = 0.f;
#pragma unroll
                for (int bj = 0; bj < 2; ++bj) {
                    const u32x4 r = xr[m][bj];
                    const f32x4 r0 = {__uint_as_float(r.x << 16), __uint_as_float(r.x & 0xffff0000u), __uint_as_float(r.y << 16), __uint_as_float(r.y & 0xffff0000u)};
                    const f32x4 r1 = {__uint_as_float(r.z << 16), __uint_as_float(r.z & 0xffff0000u), __uint_as_float(r.w << 16), __uint_as_float(r.w & 0xffff0000u)};
                    const f32x4 v0 = acc[ai][bj][m][0] * sm + r0 * ig[bj][0] * ir, v1 = acc[ai][bj][m][1] * sm + r1 * ig[bj][1] * ir;
                    *(u32x4*)(brow + bj * HALF) = pack8(v0, v1);
                    ss += sq4(v0) + sq4(v1);
                }
                ss = sum_xor32(sum_xor16(ss));
                if (fq == 0) ssq[(size_t)row * 16 + u.pn * 4 + wc] = ss;
            }
            asm volatile("" ::: "memory");
        }
    }
};
struct EpiH {
    static constexpr bool PERM = true, AFTER_DRAIN = false, KSCALE = false, PREP = true, PREFETCH = false; static constexpr int KS_T1 = -1, KS_T2 = -1;
    bf16_t* H; const float* ssq; int mode;
    static constexpr int TBL_OFF = 131072;
    __device__ __forceinline__ void prep(const Unit& u, PG8_LAS unsigned char* lds, int idx, int tid) const {
        if (tid < BM) { const f32x4* qp = (const f32x4*)(ssq + (size_t)(u.pm * BM + tid) * 16); const f32x4 q0 = qp[0], q1 = qp[1], q2 = qp[2], q3 = qp[3];
            const float s = ((q0[0] + q0[1]) + (q0[2] + q0[3])) + ((q1[0] + q1[1]) + (q1[2] + q1[3])) + ((q2[0] + q2[1]) + (q2[2] + q2[3])) + ((q3[0] + q3[1]) + (q3[2] + q3[3]));
            *(PG8_LAS float*)(lds + TBL_OFF + (idx & 1) * 1024 + tid * 4) = rsqrtf(s * (1.f / DM) + RMS_EPS); }
    }
    __device__ __forceinline__ void epi(const f32x4 (&acc)[2][2][4][2], const Unit& u, int wr, int wc, int fr, int fq, PG8_LAS unsigned char* lds, int idx) const {
        if (mode == 2) return;
        const PG8_LAS float* tb = (const PG8_LAS float*)(lds + TBL_OFF + (idx & 1) * 1024);
        const int col0 = u.pn * BM + wc * 32 + 8 * fq;
#pragma unroll
        for (int ai = 0; ai < 2; ++ai)
#pragma unroll
            for (int m = 0; m < 4; ++m) {
                const int row = u.pm * BM + ai * HALF + wr * 64 + m * 16 + fr;
                const float r = tb[ai * HALF + wr * 64 + m * 16 + fr];
                bf16_t* hrow = H + (size_t)row * FF + col0;
#pragma unroll
                for (int bj = 0; bj < 2; ++bj) {
                    f32x4 v0 = acc[ai][bj][m][0] * r, v1 = acc[ai][bj][m][1] * r;
#pragma unroll
                    for (int e = 0; e < 4; ++e) { const float a = fmaxf(v0[e], 0.f), b = fmaxf(v1[e], 0.f); v0[e] = a * a; v1[e] = b * b; }
                    const u32x4 pk = pack8(v0, v1); if (mode == 0) *(u32x4*)(hrow + bj * HALF) = pk; else asm volatile("" :: "v"(pk));
                }
            }
    }
};
struct EpiOut {
    static constexpr bool PERM = true, AFTER_DRAIN = false, KSCALE = false, PREP = false, PREFETCH = false; static constexpr int KS_T1 = -1, KS_T2 = -1;
    float* out; const bf16_t* x1b;
    static constexpr int JUNK_OFF = 131072 + 8192;
    __device__ __forceinline__ void prefetch(const Unit& u, PG8_LAS unsigned char* lds, int tid) const {
        const int wid = tid >> 6;
#pragma unroll
        for (int i = 0; i < 2; ++i) { const int line = i * 512 + tid; const bf16_t* src = x1b + (size_t)(u.pm * BM + (line >> 2)) * DM + u.pn * BM + (line & 3) * 64;
            __builtin_amdgcn_global_load_lds((const unsigned*)src, (PG8_LAS unsigned*)(lds + JUNK_OFF + (wid & 3) * 256), 4, 0, 0); }
    }
    __device__ __forceinline__ void operator()(const f32x4 (&acc)[2][2][4][2], const Unit& u, int wr, int wc, int fr, int fq) const {
        const int col0 = u.pn * BM + wc * 32 + 8 * fq;
#pragma unroll
        for (int ai = 0; ai < 2; ++ai) {
            u32x4 rr[4][2];
#pragma unroll
            for (int m = 0; m < 4; ++m) { const bf16_t* brow = x1b + (size_t)(u.pm * BM + ai * HALF + wr * 64 + m * 16 + fr) * DM + col0;
#pragma unroll
                for (int bj = 0; bj < 2; ++bj) rr[m][bj] = *(const u32x4*)(brow + bj * HALF); }
#pragma unroll
            for (int m = 0; m < 4; ++m) {
                const int row = u.pm * BM + ai * HALF + wr * 64 + m * 16 + fr;
                float* orow = out + (size_t)row * DM + col0;
#pragma unroll
                for (int bj = 0; bj < 2; ++bj) {
                    const u32x4 r = rr[m][bj];
                    const f32x4 r0 = {__uint_as_float(r.x << 16), __uint_as_float(r.x & 0xffff0000u), __uint_as_float(r.y << 16), __uint_as_float(r.y & 0xffff0000u)};
                    const f32x4 r1 = {__uint_as_float(r.z << 16), __uint_as_float(r.z & 0xffff0000u), __uint_as_float(r.w << 16), __uint_as_float(r.w & 0xffff0000u)};
                    *(f32x4*)(orow + bj * HALF) = acc[ai][bj][m][0] + r0; *(f32x4*)(orow + bj * HALF + 4) = acc[ai][bj][m][1] + r1;
                }
            }
            asm volatile("" ::: "memory");
        }
    }
};

template <class Epi, class Sched, bool ALIGN_EPI = false, bool SP2 = false>
__device__ __forceinline__ void gemm_phase(PG8_LAS unsigned char* lds, const Gemm g, const Sched& S, const Epi& E) {
    const int tid = threadIdx.x, wid = __builtin_amdgcn_readfirstlane(tid >> 6), lane = tid & 63, wr = wid >> 2, wc = wid & 3, fr = lane & 15, fq = lane >> 4;
    const int K = g.K, nt = K / BK;
    unsigned voffA[2], voffB[2];
#pragma unroll
    for (int i = 0; i < 2; ++i) { int R, C; stage_rc(tid * 16 + i * 8192, R, C); const int Rb = Epi::PERM ? ((R & ~31) + perm32(R & 31)) : R;
        voffA[i] = (unsigned)(R * K + C) * 2u; voffB[i] = (unsigned)(Rb * K + C) * 2u; }
    const size_t kstep = (size_t)(BK * 2);
    const size_t hstep = (size_t)HALF * K * 2;
    const size_t tstep = 2 * hstep;
    const unsigned ldsw = (unsigned)wid * 1024u;
    const int aoff = lds_byte(wr * 64 + fr, fq * 8), boff = lds_byte(wc * 32 + fr, fq * 8);
#define PG8_SA(b, h) (((b) * 2 + (h)) * HTB)
#define PG8_SB(b, h) ((4 + (b) * 2 + (h)) * HTB)
#define PG8_STAGE(bufoff, gbase, voff) do { _Pragma("unroll") for (int _i = 0; _i < 2; ++_i) \
        __builtin_amdgcn_global_load_lds((const unsigned*)((const char*)(gbase) + (voff)[_i]), (PG8_LAS unsigned*)(lds + (bufoff) + ldsw + _i * 8192), 16, 0, 0); } while (0)
#define PG8_LDA(dst, b, h) do { _Pragma("unroll") for (int m = 0; m < 4; ++m) _Pragma("unroll") for (int k = 0; k < 2; ++k) dst[m][k] = *(const PG8_LAS bf16x8*)(lds + PG8_SA(b, h) + aoff + m * 2048 + k * 1024); } while (0)
#define PG8_LDB(dst, b, h) do { _Pragma("unroll") for (int n = 0; n < 2; ++n) _Pragma("unroll") for (int k = 0; k < 2; ++k) dst[n][k] = *(const PG8_LAS bf16x8*)(lds + PG8_SB(b, h) + boff + n * 2048 + k * 1024); } while (0)
#define PG8_MMA(ai, bj, At, Bt) do { __builtin_amdgcn_s_setprio(1); _Pragma("unroll") for (int m = 0; m < 4; ++m) _Pragma("unroll") for (int n = 0; n < 2; ++n) _Pragma("unroll") for (int k = 0; k < 2; ++k) \
        acc[ai][bj][m][n] = __builtin_amdgcn_mfma_f32_16x16x32_bf16(Bt[n][k], At[m][k], acc[ai][bj][m][n], 0, 0, 0); __builtin_amdgcn_s_setprio(0); } while (0)
#define PG8_WAIT_V(n) asm volatile("s_waitcnt vmcnt(" #n ")" ::: "memory")
#define PG8_WAIT_L(n) asm volatile("s_waitcnt lgkmcnt(" #n ")" ::: "memory")
#define PG8_BAR __builtin_amdgcn_s_barrier()
#define PG8_SCHED __builtin_amdgcn_sched_barrier(0)
    Unit cur, nxt; int ui = 0;
    if (!S.next(0, cur)) return;
    PT_SUB_L(lds, 5);
    f32x4 acc[2][2][4][2];
#pragma unroll
    for (int a = 0; a < 2; ++a)
#pragma unroll
        for (int b = 0; b < 2; ++b)
#pragma unroll
            for (int m = 0; m < 4; ++m)
#pragma unroll
                for (int n = 0; n < 2; ++n) acc[a][b][m][n] = (f32x4){0.f, 0.f, 0.f, 0.f};
    bf16x8 At[4][2], B0[2][2], B1[2][2];
    const char* cA = (const char*)g.A + (size_t)cur.pm * tstep; const char* cB = (const char*)g.Bt + (size_t)cur.pn * tstep;
    S.a_ready(cur);
    if constexpr (Epi::PREP) E.prep(cur, lds, 0, tid);
    if constexpr (SP2) {
        PG8_STAGE(PG8_SB(0, 0), cB, voffB); PG8_STAGE(PG8_SB(0, 1), cB + hstep, voffB); PG8_STAGE(PG8_SA(0, 0), cA, voffA); PG8_STAGE(PG8_SA(0, 1), cA + hstep, voffA);
        if (wr == 1) PG8_BAR;
        PG8_WAIT_V(2); PG8_BAR;
        PG8_STAGE(PG8_SB(1, 0), cB + kstep, voffB); PG8_STAGE(PG8_SA(1, 0), cA + kstep, voffA); PG8_STAGE(PG8_SB(1, 1), cB + hstep + kstep, voffB);
        PG8_WAIT_V(6); PG8_BAR;
    } else {
        PG8_STAGE(PG8_SB(0, 0), cB, voffB); PG8_STAGE(PG8_SA(0, 0), cA, voffA); PG8_STAGE(PG8_SB(0, 1), cB + hstep, voffB); PG8_STAGE(PG8_SA(0, 1), cA + hstep, voffA);
        if (wr == 1) PG8_BAR;
        PG8_WAIT_V(4); PG8_BAR;
        PG8_STAGE(PG8_SB(1, 0), cB + kstep, voffB); PG8_STAGE(PG8_SA(1, 0), cA + kstep, voffA); PG8_STAGE(PG8_SB(1, 1), cB + hstep + kstep, voffB);
        PG8_WAIT_V(6); PG8_BAR;
    }
    for (;;) {
        const bool has_next = S.next(ui + 1, nxt);
        const char* nA = has_next ? (const char*)g.A + (size_t)nxt.pm * tstep : cA; const char* nB = has_next ? (const char*)g.Bt + (size_t)nxt.pn * tstep : cB;
        for (int t = 0; t < nt; t += 2) {
            const bool last = (t == nt - 2);
            if constexpr (Epi::KSCALE) { if (t == Epi::KS_T1 || t == Epi::KS_T2) E.kscale(acc, t, wr, fr, lds, ui); }
            if constexpr (Epi::PREFETCH) { if (t == 4) E.prefetch(cur, lds, tid); }
            const char* a1 = cA + (size_t)(t + 1) * kstep;
            const char* a2 = last ? nA : cA + (size_t)(t + 2) * kstep; const char* b2 = last ? nB : cB + (size_t)(t + 2) * kstep;
            const char* a3 = a2 + kstep; const char* b3 = b2 + kstep;
            if (last && has_next) { S.a_ready(nxt); if constexpr (Epi::PREP) E.prep(nxt, lds, ui + 1, tid); }
            if constexpr (SP2) {
            PG8_LDB(B0, 0, 0); PG8_LDB(B1, 0, 1); PG8_SCHED; PG8_LDA(At, 0, 0); PG8_STAGE(PG8_SA(1, 1), a1 + hstep, voffA);
            PG8_WAIT_V(8); PG8_WAIT_L(0); PG8_BAR; PG8_MMA(0, 0, At, B0); PG8_MMA(0, 1, At, B1); PG8_BAR; PG8_SCHED;
            PG8_LDA(At, 0, 1); PG8_STAGE(PG8_SB(0, 0), b2, voffB); PG8_STAGE(PG8_SB(0, 1), b2 + hstep, voffB); PG8_STAGE(PG8_SA(0, 0), a2, voffA);
            PG8_WAIT_V(8); PG8_WAIT_L(0); PG8_BAR; PG8_MMA(1, 0, At, B0); PG8_MMA(1, 1, At, B1); PG8_BAR; PG8_SCHED;
            PG8_LDB(B0, 1, 0); PG8_LDB(B1, 1, 1); PG8_SCHED; PG8_LDA(At, 1, 0); PG8_STAGE(PG8_SA(0, 1), a2 + hstep, voffA);
            PG8_WAIT_V(8); PG8_WAIT_L(0); PG8_BAR; PG8_MMA(0, 0, At, B0); PG8_MMA(0, 1, At, B1); PG8_BAR; PG8_SCHED;
            PG8_LDA(At, 1, 1); PG8_STAGE(PG8_SB(1, 0), b3, voffB); PG8_STAGE(PG8_SB(1, 1), b3 + hstep, voffB); PG8_STAGE(PG8_SA(1, 0), a3, voffA);
            PG8_WAIT_V(8); PG8_WAIT_L(0); PG8_BAR; PG8_MMA(1, 0, At, B0); PG8_MMA(1, 1, At, B1); PG8_BAR; PG8_SCHED;
            } else {
            PG8_LDB(B0, 0, 0); PG8_SCHED; PG8_LDA(At, 0, 0); PG8_STAGE(PG8_SA(1, 1), a1 + hstep, voffA);
            PG8_WAIT_L(8); PG8_BAR; PG8_WAIT_L(0); PG8_MMA(0, 0, At, B0); PG8_BAR; PG8_SCHED;
            PG8_LDB(B1, 0, 1); PG8_STAGE(PG8_SB(0, 0), b2, voffB);
            PG8_BAR; PG8_WAIT_L(0); PG8_MMA(0, 1, At, B1); PG8_BAR;
            PG8_LDA(At, 0, 1); PG8_STAGE(PG8_SA(0, 0), a2, voffA);
            PG8_BAR; PG8_WAIT_L(0); PG8_MMA(1, 0, At, B0); PG8_BAR; PG8_SCHED;
            PG8_STAGE(PG8_SB(0, 1), b2 + hstep, voffB);
            PG8_WAIT_V(6); PG8_BAR; PG8_MMA(1, 1, At, B1); PG8_BAR;
            PG8_LDB(B0, 1, 0); PG8_SCHED; PG8_LDA(At, 1, 0); PG8_STAGE(PG8_SA(0, 1), a2 + hstep, voffA);
            PG8_WAIT_L(8); PG8_BAR; PG8_WAIT_L(0); PG8_MMA(0, 0, At, B0); PG8_BAR; PG8_SCHED;
            PG8_LDB(B1, 1, 1); PG8_STAGE(PG8_SB(1, 0), b3, voffB);
            PG8_BAR; PG8_WAIT_L(0); PG8_MMA(0, 1, At, B1); PG8_BAR;
            PG8_LDA(At, 1, 1); PG8_STAGE(PG8_SA(1, 0), a3, voffA);
            PG8_BAR; PG8_WAIT_L(0); PG8_MMA(1, 0, At, B0); PG8_BAR; PG8_SCHED;
            PG8_STAGE(PG8_SB(1, 1), b3 + hstep, voffB);
            PG8_WAIT_V(6); PG8_BAR; PG8_MMA(1, 1, At, B1); PG8_BAR;
            }
        }
        if constexpr (ALIGN_EPI) { if (wr == 0) PG8_BAR; }
        PT_SUB_L(lds, 4);
        if constexpr (!Epi::AFTER_DRAIN) { if constexpr (Epi::PREP) E.epi(acc, cur, wr, wc, fr, fq, lds, ui); else E(acc, cur, wr, wc, fr, fq); S.done(cur); }
        PT_ADD_L(lds, 4);
        if (!has_next) break;
#pragma unroll
        for (int a = 0; a < 2; ++a)
#pragma unroll
            for (int b = 0; b < 2; ++b)
#pragma unroll
                for (int m = 0; m < 4; ++m)
#pragma unroll
                    for (int n = 0; n < 2; ++n) acc[a][b][m][n] = (f32x4){0.f, 0.f, 0.f, 0.f};
        cur = nxt; cA = nA; cB = nB; ++ui;
        if constexpr (ALIGN_EPI) { if (wr == 1) PG8_BAR; }
    }
    PT_ADD_L(lds, 5);
    PG8_WAIT_V(0);
    if constexpr (!ALIGN_EPI) { if (wr == 0) PG8_BAR; }
    PG8_BAR;
    if constexpr (Epi::AFTER_DRAIN) { E.fused(acc, cur, wr, wc, fr, fq, lds, wid, lane); S.done(cur); }
#undef PG8_SA
#undef PG8_SB
#undef PG8_STAGE
#undef PG8_LDA
#undef PG8_LDB
#undef PG8_MMA
#undef PG8_WAIT_V
#undef PG8_WAIT_L
#undef PG8_BAR
#undef PG8_SCHED
}
}

constexpr int NWAVES = 8;
#ifndef MK_N_LAUNCHES
#define MK_N_LAUNCHES 1
#endif
constexpr int NPH = 7;
constexpr int N_LAUNCHES = MK_N_LAUNCHES;

constexpr size_t MiB = 1u << 20;
constexpr size_t WS_CTL = 0, CTL_ZERO_BYTES = 1 * MiB;
constexpr size_t WS_SSQF = 27 * MiB;
constexpr size_t WS_SSQA = 464 * MiB;
constexpr size_t WS_ROPE = 2 * MiB;
constexpr size_t WS_WIN = 3 * MiB, WS_WMEM = 8 * MiB, WS_WOUT = 9 * MiB, WS_W1 = 11 * MiB, WS_W2 = 19 * MiB;
constexpr size_t WS_XNMEM = 27 * MiB, WS_MK = 30 * MiB, WS_MV = 31 * MiB;
constexpr size_t WS_X1B = 32 * MiB;
constexpr size_t WS_XN = 128 * MiB;
constexpr size_t WS_IRSTD = 467 * MiB;
constexpr size_t WS_QKV = 224 * MiB;
constexpr size_t WS_H = 128 * MiB;
constexpr size_t WS_END = 512 * MiB;
static_assert(WS_QKV + (size_t)NHEADS * MTOK * 64 * 2 <= WS_END && WS_H + (size_t)MTOK * FF * 2 <= WS_END && WS_X1B + (size_t)MTOK * DM * 2 <= WS_XN && WS_XN + (size_t)MTOK * DM * 2 <= WS_QKV, "d_ws map");

#define LAS __attribute__((address_space(3)))
typedef unsigned short bf16;
typedef unsigned v4u __attribute__((ext_vector_type(4)));
typedef float f32x4 __attribute__((ext_vector_type(4)));
#define LDS_WAIT() asm volatile("s_waitcnt lgkmcnt(0)" ::: "memory")
__device__ __forceinline__ unsigned f2bf(float f) { unsigned u = __builtin_bit_cast(unsigned, f); return (u + 0x7fffu + ((u >> 16) & 1u)) >> 16; }
__device__ __forceinline__ unsigned pk2(float lo, float hi) { return f2bf(lo) | (f2bf(hi) << 16); }
__device__ __forceinline__ float bflo(unsigned w) { return __uint_as_float(w << 16); }
__device__ __forceinline__ float bfhi(unsigned w) { return __uint_as_float(w & 0xffff0000u); }
__device__ __forceinline__ float wave_sum(float v) {
#pragma unroll
    for (int o = 1; o < 64; o <<= 1) v += __shfl_xor(v, o);
    return v;
}

struct Frame {
    LAS unsigned char* lds;
    int tid, lane, wave, vcu, G, tm;
    float* out; unsigned char* ws;
};
struct Args { const float* in[22]; float* out; unsigned char* ws; int ph_lo, ph_hi; };


namespace att {
typedef short bf16x8 __attribute__((ext_vector_type(8)));
typedef short s16x4 __attribute__((ext_vector_type(4)));
typedef short v4i16_t __attribute__((ext_vector_type(4)));
typedef float f32x16 __attribute__((ext_vector_type(16)));
typedef float f32x4 __attribute__((ext_vector_type(4)));
typedef unsigned u32x4 __attribute__((ext_vector_type(4)));
typedef float f32x2_t __attribute__((ext_vector_type(2))); typedef __bf16 bf16x2_t __attribute__((ext_vector_type(2)));
typedef __attribute__((address_space(3))) unsigned char* lptr;
__device__ __forceinline__ unsigned cvtpk(float lo, float hi) { f32x2_t v = {lo, hi}; bf16x2_t b = __builtin_convertvector(v, bf16x2_t); return __builtin_bit_cast(unsigned, b); }
__device__ __forceinline__ s16x4 vtr(lptr p) { return __builtin_bit_cast(s16x4, __builtin_amdgcn_ds_read_tr16_b64_v4i16((__attribute__((address_space(3))) v4i16_t*)p)); }
__device__ __forceinline__ int creg(int r) { return (r & 3) + 8 * (r >> 2); }
constexpr float NEG = -INFINITY;

__device__ __forceinline__ void load_q(bf16x8 (&qr)[4], const bf16* qrow, int lane) {
    const int hi = lane >> 5;
#pragma unroll
    for (int d0 = 0; d0 < 4; ++d0) qr[d0] = *(const bf16x8*)(qrow + 16 * d0 + 8 * hi);
}
}
template <class CM, class KS>
__device__ __forceinline__ void p0_transpose_item(const float* W, int K, int N, bf16* WT, LAS float* scr, int item, int lane, CM cm, KS ks) {
    const int nblk = N / 32, kb = item / nblk, nb = item % nblk, k0 = 64 * kb, n0 = 32 * nb;
    const int sc = cm(n0 + (lane & 31));
#pragma unroll
    for (int i = 0; i < 32; ++i) { const int kk = 2 * i + (lane >> 5); scr[kk * 33 + (lane & 31)] = __builtin_nontemporal_load(W + (size_t)(k0 + kk) * N + sc) * ks(k0 + kk); }
    LDS_WAIT(); asm volatile("" ::: "memory");
    const int c = lane & 7;
#pragma unroll
    for (int j = 0; j < 4; ++j) { const int n = (lane >> 3) + 8 * j; const LAS float* s = scr + (8 * c) * 33 + n;
        v4u o; o.x = pk2(s[0 * 33], s[1 * 33]); o.y = pk2(s[2 * 33], s[3 * 33]); o.z = pk2(s[4 * 33], s[5 * 33]); o.w = pk2(s[6 * 33], s[7 * 33]);
        *(v4u*)(WT + (size_t)(n0 + n) * K + k0 + 8 * c) = o; }
    LDS_WAIT(); asm volatile("" ::: "memory");
}
struct CMapHead { int nrope;
    __device__ __forceinline__ int operator()(int c) const { const int pn = c >> 8, bj = (c >> 7) & 1, hh = (c >> 5) & 3, p5 = c & 31, hidx = 4 * pn + hh; int p = 32 * bj + p5;
        if (hidx < nrope && p < 16) p = (p & 3) + 8 * ((p >> 2) & 1) + 4 * (p >> 3); return 64 * hidx + p; } };
struct CMapId { __device__ __forceinline__ int operator()(int c) const { return c; } };
struct KSOne { __device__ __forceinline__ float operator()(int) const { return 1.f; } };
struct KSVec { const float* g; __device__ __forceinline__ float operator()(int k) const { return g[k]; } };
struct KSOut { const float *a, *b, *m; __device__ __forceinline__ float operator()(int k) const { return k < 384 ? a[k] : (k < 768 ? b[k - 384] : m[k - 768]); } };

template <int NR> __device__ __forceinline__ void rms_rows_to_bf16(const float* const (&xrow)[NR], const float* g, bf16* const (&orow)[NR], float* irstd, int lane) {
    f32x4 v[NR][4];
#pragma unroll
    for (int r = 0; r < NR; ++r) { const f32x4* xr = (const f32x4*)xrow[r] + lane;
#pragma unroll
        for (int j = 0; j < 4; ++j) v[r][j] = __builtin_nontemporal_load(xr + 64 * j); }
    const f32x4* gr = (const f32x4*)g + lane;
#pragma unroll
    for (int r = 0; r < NR; ++r) {
        float s = 0.f;
#pragma unroll
        for (int j = 0; j < 4; ++j) s += (v[r][j].x * v[r][j].x + v[r][j].y * v[r][j].y) + (v[r][j].z * v[r][j].z + v[r][j].w * v[r][j].w);
        const float ms = wave_sum(s) * (1.f / DM) + RMS_EPS; const float rstd = rsqrtf(ms);
        if (irstd && lane == 0) irstd[r] = sqrtf(ms);
        unsigned long long* o8 = (unsigned long long*)orow[r] + lane;
#pragma unroll
        for (int j = 0; j < 4; ++j) { const f32x4 gg = gr[64 * j]; o8[64 * j] = (unsigned long long)pk2(v[r][j].x * rstd * gg.x, v[r][j].y * rstd * gg.y) | ((unsigned long long)pk2(v[r][j].z * rstd * gg.z, v[r][j].w * rstd * gg.w) << 32); }
    }
}
__device__ __forceinline__ void p0_prologue(Frame& F, const Args& A) {
    LAS float* scr = (LAS float*)(F.lds + F.wave * 16384);
    const int gw = F.vcu * NWAVES + F.wave, NGW = F.G * NWAVES;
    unsigned char* ws = F.ws;
    constexpr int I_IN = (DM / 64) * (NQKV / 32), I_MEM = (DM / 64) * (512 / 32), I_OUT = (DM / 64) * (DM / 32), I_1 = (DM / 64) * (FF / 32), I_2 = (FF / 64) * (DM / 32);
    constexpr int NITEMS = I_IN + I_MEM + I_OUT + I_1 + I_2;
    PT_SUB(F, 0);
    for (int it = gw; it < NITEMS; it += NGW) {
        int r = it;
        if (r < I_IN) { p0_transpose_item(A.in[5], DM, NQKV, (bf16*)(ws + WS_WIN), scr, r, F.lane, CMapHead{12}, KSOne{}); continue; } r -= I_IN;
        if (r < I_MEM) { p0_transpose_item(A.in[12], DM, 512, (bf16*)(ws + WS_WMEM), scr, r, F.lane, CMapHead{0}, KSOne{}); continue; } r -= I_MEM;
        if (r < I_OUT) { p0_transpose_item(A.in[18], DM, DM, (bf16*)(ws + WS_WOUT), scr, r, F.lane, CMapId{}, KSOut{A.in[15], A.in[16], A.in[17]}); continue; } r -= I_OUT;
        if (r < I_1) { p0_transpose_item(A.in[20], DM, FF, (bf16*)(ws + WS_W1), scr, r, F.lane, CMapId{}, KSVec{A.in[19]}); continue; } r -= I_1;
        p0_transpose_item(A.in[21], FF, DM, (bf16*)(ws + WS_W2), scr, r, F.lane, CMapId{}, KSOne{});
    }
    PT_ADD(F, 0); PT_SUB(F, 1);
    for (int m4 = gw; m4 < (MTOK + MMEM) / 4; m4 += NGW) {
        const int m = 4 * m4; const float* xr[4]; bf16* orw[4]; const float* gn; float* irs = nullptr;
        if (m < MTOK) { const float* x0 = m < TP ? A.in[0] + (size_t)m * DM : A.in[1] + (size_t)(m - TP) * DM; bf16* o0 = (bf16*)(ws + WS_XN) + (size_t)m * DM; gn = A.in[4]; irs = (float*)(ws + WS_IRSTD) + m;
#pragma unroll
            for (int r = 0; r < 4; ++r) { xr[r] = x0 + (size_t)r * DM; orw[r] = o0 + (size_t)r * DM; } }
        else { const int r0 = m - MTOK; const float* x0 = r0 < NMEM ? A.in[2] + (size_t)r0 * DM : A.in[3] + (size_t)(r0 - NMEM) * DM; bf16* o0 = (bf16*)(ws + WS_XNMEM) + (size_t)r0 * DM; gn = A.in[11];
#pragma unroll
            for (int r = 0; r < 4; ++r) { xr[r] = x0 + (size_t)r * DM; orw[r] = o0 + (size_t)r * DM; } }
        rms_rows_to_bf16<4>(xr, gn, orw, irs, F.lane);
    }
    PT_ADD(F, 1); PT_SUB(F, 2);
    float* rc = (float*)(ws + WS_ROPE); float* rs = rc + TP * 8;
    for (int i = (F.vcu * NWAVES * 64) + F.tid; i < TP * 8; i += F.G * NWAVES * 64) {
        const int pos = i >> 3, fi = i & 7;
        const float inv = exp2f(-(float)fi * 0.125f * 18.931568569324174f);
        const float ang = (float)pos * inv;
        const double rev = (double)ang * 0.15915494309189535; const float fr = (float)(rev - __builtin_rint(rev));
        rc[i] = __builtin_amdgcn_cosf(fr); rs[i] = __builtin_amdgcn_sinf(fr);
    }
    PT_ADD(F, 2);
}

#define XB_TMO      128
#define XB_XCNT(j)  (256  + 64 * (j))
#define XB_XSUB(j)  (1280 + 64 * (j))
#define XB_XGEN(j)  (2304 + 64 * (j))
#define XB_TOP      3328
#define XB_TOPGEN   3392
#define XCD_BAR_WORDS 3456
#define XB_SPIN_CAP (1u << 18)

__device__ __forceinline__ unsigned xb_ld(unsigned* p)              { return __hip_atomic_load(p, __ATOMIC_RELAXED, __HIP_MEMORY_SCOPE_AGENT); }
__device__ __forceinline__ unsigned xb_add(unsigned* p, unsigned v) { return __hip_atomic_fetch_add(p, v, __ATOMIC_RELAXED, __HIP_MEMORY_SCOPE_AGENT); }
__device__ __forceinline__ unsigned xb_xcc_id() { return (unsigned)__builtin_amdgcn_s_getreg((3 << 11) | 20) & 0xFu; }
#define XB_SPIN(cond, bar) do { unsigned _sp = 0; while (cond) { __builtin_amdgcn_s_sleep(1); \
    if ((++_sp & 255u) == 0u) { if (xb_ld(&(bar)[XB_TMO])) break; if (_sp > XB_SPIN_CAP) { atomicAdd(&(bar)[XB_TMO], 1u); break; } } } } while (0)

struct XcdBarrier {
    unsigned* bar; unsigned x;
    volatile LAS unsigned* st;
};

__device__ __forceinline__ XcdBarrier xcd_barrier_post(unsigned* bar, volatile LAS unsigned* st) {
    XcdBarrier b; b.bar = bar; b.x = xb_xcc_id(); b.st = st;
    if (threadIdx.x == 0) (void)xb_add(&bar[XB_XCNT(b.x)], 1u);
    return b;
}
__device__ __forceinline__ void xcd_barrier_complete(unsigned* bar, unsigned x, unsigned& nloc, unsigned& nx) {
    const unsigned G = gridDim.x * gridDim.y * gridDim.z;
    unsigned sum, cnt, mine, sp = 0u;
    for (;;) {
        sum = 0u; cnt = 0u; mine = 0u;
#pragma unroll
        for (unsigned j = 0; j < 16; ++j) { const unsigned c = xb_ld(&bar[XB_XCNT(j)]); sum += c; cnt += (c > 0u) ? 1u : 0u; mine = (j == x) ? c : mine; }
        if (sum == G) break;
        __builtin_amdgcn_s_sleep(1);
        if ((++sp & 255u) == 0u) { if (xb_ld(&bar[XB_TMO])) break; if (sp > XB_SPIN_CAP) { atomicAdd(&bar[XB_TMO], 1u); break; } }
    }
    nloc = mine > 0u ? mine : 1u; nx = cnt > 0u ? cnt : 1u;
}

__device__ __forceinline__ void xcd_barrier(const XcdBarrier& b) {
    asm volatile("s_waitcnt vmcnt(0)" ::: "memory");
    __syncthreads();
    if (threadIdx.x == 0) {
        unsigned* bar = b.bar;
        __builtin_amdgcn_s_waitcnt(0);
        unsigned nloc = b.st[0], nx = b.st[1];
        if (nloc == 0u) { xcd_barrier_complete(bar, b.x, nloc, nx); b.st[0] = nloc; b.st[1] = nx; }
        const unsigned old = xb_add(&bar[XB_XSUB(b.x)], 1u);
        const unsigned gen = old / nloc;
        if (old + 1u == (gen + 1u) * nloc) {
            __builtin_amdgcn_fence(__ATOMIC_RELEASE, "agent");
            asm volatile("s_waitcnt vmcnt(0)" ::: "memory");
            const unsigned og = xb_add(&bar[XB_TOP], 1u);
            const unsigned tg = og / nx;
            if (og + 1u == (tg + 1u) * nx) xb_add(&bar[XB_TOPGEN], 1u);
            else XB_SPIN(xb_ld(&bar[XB_TOPGEN]) == tg, bar);
            __builtin_amdgcn_fence(__ATOMIC_ACQUIRE, "agent");
            xb_add(&bar[XB_XGEN(b.x)], 1u);
            asm volatile("s_waitcnt vmcnt(0)" ::: "memory");
        } else {
            XB_SPIN(xb_ld(&bar[XB_XGEN(b.x)]) == gen, bar);
            __builtin_amdgcn_fence(__ATOMIC_ACQUIRE, "agent");
            asm volatile("s_waitcnt vmcnt(0)" ::: "memory");
        }
    }
    __syncthreads();
}

struct SeqInfo { long sb; int T; int bat; };
__device__ __forceinline__ SeqInfo seq_of(int row) { SeqInfo s; if (row < TP) { s.sb = 0; s.T = TP; s.bat = 0; } else { const int b = (row - TP) >> 13; s.sb = TP + (long)b * TS; s.T = TS; s.bat = 1 + b; } return s; }


namespace att2 {
using att::bf16x8; using att::s16x4; using att::f32x16; using att::f32x4; using att::u32x4; using att::lptr; using att::creg; using att::cvtpk; using att::vtr; using att::NEG;
constexpr int NS = 4, SLOT = 32768, TILE = 16384, TV = 8192, VDH64 = 4096;
constexpr int L_RING = 0, L_TBL = NS * SLOT, TBLB = 3840, L_LS = L_TBL + 2 * TBLB, L_END = L_LS + 8 * 128;
static_assert(L_END <= LDS_MISC, "attention LDS map");
#define ATT2_WAITBAR(N) asm volatile("s_waitcnt vmcnt(" #N ") lgkmcnt(0)\n\ts_barrier" ::: "memory")

struct TileSrc { const bf16* K; const bf16* V; int p0, qs, T, pm; };
__device__ __forceinline__ void dma_tile(LAS unsigned char* tile, const TileSrc& s, int w, int lane) {
    const bool inside = (s.p0 >= 0) && (s.p0 + 63 * s.qs < s.T);
    { const int row = 8 * w + (lane >> 3); int p = s.p0 + row * s.qs; if (!inside) p = p < 0 ? 0 : (p >= s.T ? s.T - 1 : p); p &= s.pm;
      __builtin_amdgcn_global_load_lds((const unsigned*)(s.K + (size_t)p * 64 + 8 * ((lane & 7) ^ ((row >> 1) & 7))), (LAS unsigned*)(tile + w * 1024), 16, 0, 0); }
    { const int row = 16 * (w & 3) + (lane >> 2); int p = s.p0 + row * s.qs; if (!inside) p = p < 0 ? 0 : (p >= s.T ? s.T - 1 : p); p &= s.pm;
      __builtin_amdgcn_global_load_lds((const unsigned*)(s.V + (size_t)p * 64 + 32 * (w >> 2) + 8 * (lane & 3)), (LAS unsigned*)(tile + TV + (w >> 2) * VDH64 + (w & 3) * 1024), 16, 0, 0); }
}
__device__ __forceinline__ f32x16 qk_sub(lptr tile, int roff, const bf16x8 (&qr)[4], int lane) {
    const int r32 = lane & 31, hi = lane >> 5, row = roff + r32;
    lptr kp = tile + row * 128; const int sw = (row >> 1) & 7;
    f32x16 p = {};
#pragma unroll
    for (int d0 = 0; d0 < 4; ++d0) { const bf16x8 kf = *(__attribute__((address_space(3))) bf16x8*)(kp + (((2 * d0 + hi) ^ sw) * 16)); p = __builtin_amdgcn_mfma_f32_32x32x16_bf16(kf, qr[d0], p, 0, 0, 0); }
    return p;
}
__device__ __forceinline__ void pv_sub(lptr tile, int roff, f32x16& p, f32x16 (&o)[2], float& lsum, int lane) {
    const int hi = lane >> 5;
    float sacc = 0.f;
#pragma unroll
    for (int r = 0; r < 16; ++r) { p[r] = __builtin_amdgcn_exp2f(p[r]); sacc += p[r]; }
    lsum += sacc;
    u32x4 pw0, pw1;
    pw0[0] = cvtpk(p[0], p[1]); pw0[1] = cvtpk(p[2], p[3]); pw0[2] = cvtpk(p[4], p[5]); pw0[3] = cvtpk(p[6], p[7]);
    pw1[0] = cvtpk(p[8], p[9]); pw1[1] = cvtpk(p[10], p[11]); pw1[2] = cvtpk(p[12], p[13]); pw1[3] = cvtpk(p[14], p[15]);
    lptr vp = tile + TV + (roff + 4 * hi + ((lane & 15) >> 2)) * 64 + ((lane >> 4) & 1) * 32 + (lane & 3) * 8;
#pragma unroll
    for (int dh = 0; dh < 2; ++dh) {
        const s16x4 l0 = vtr(vp + dh * VDH64), h0 = vtr(vp + dh * VDH64 + 512), l1 = vtr(vp + dh * VDH64 + 1024), h1 = vtr(vp + dh * VDH64 + 1536);
        const bf16x8 f0 = {l0[0], l0[1], l0[2], l0[3], h0[0], h0[1], h0[2], h0[3]}, f1 = {l1[0], l1[1], l1[2], l1[3], h1[0], h1[1], h1[2], h1[3]};
        o[dh] = __builtin_amdgcn_mfma_f32_32x32x16_bf16(__builtin_bit_cast(bf16x8, pw0), f0, o[dh], 0, 0, 0);
        o[dh] = __builtin_amdgcn_mfma_f32_32x32x16_bf16(__builtin_bit_cast(bf16x8, pw1), f1, o[dh], 0, 0, 0);
    }
}
__device__ __forceinline__ void mask_band(f32x16& p, int rel, int kr0, int L, int lane) {
    const int r32 = lane & 31, hi = lane >> 5;
    if (rel == 0 || rel == 4) { const int base = 32 * rel - r32 + 4 * hi;
#pragma unroll
        for (int r = 0; r < 16; ++r) { if ((unsigned)(base + creg(r)) > 128u) p[r] = NEG; } }
    if (kr0 < 0 || kr0 + 31 >= L) { const int kb = kr0 + 4 * hi;
#pragma unroll
        for (int r = 0; r < 16; ++r) { if ((unsigned)(kb + creg(r)) >= (unsigned)L) p[r] = NEG; } }
}
__device__ __forceinline__ void stage_rows(const f32x16 (&o)[2], float lsum, bool normalise, lptr scr, __attribute__((address_space(3))) float* ls, int lane) {
    const int r32 = lane & 31, hi = lane >> 5;
    lsum = pg8::sum_xor32(lsum);
    if (hi == 0) ls[r32] = lsum;
    __attribute__((address_space(3))) unsigned short* stg = (__attribute__((address_space(3))) unsigned short*)scr;
    float rl[16];
#pragma unroll
    for (int g = 0; g < 4; ++g) { const f32x4 lv = *(__attribute__((address_space(3))) f32x4*)(ls + 8 * g + 4 * hi);
#pragma unroll
        for (int j = 0; j < 4; ++j) rl[4 * g + j] = normalise ? __builtin_amdgcn_rcpf(lv[j]) : 1.f; }
#pragma unroll
    for (int r = 0; r < 16; r += 2) { const int q = creg(r) + 4 * hi;
#pragma unroll
        for (int dh = 0; dh < 2; ++dh) { const unsigned pk = cvtpk(o[dh][r] * rl[r], o[dh][r + 1] * rl[r + 1]);
            stg[q * 64 + dh * 32 + r32] = (unsigned short)pk; stg[(q + 1) * 64 + dh * 32 + r32] = (unsigned short)(pk >> 16); } }
}
template <class RowFn, class SsqFn> __device__ __forceinline__ void out_final(const f32x16 (&o)[2], float lsum, lptr scr, __attribute__((address_space(3))) float* ls, const RowFn& orow, const SsqFn& ssqp, int lane) {
    stage_rows(o, lsum, true, scr, ls, lane);
    __attribute__((address_space(3))) unsigned short* stg = (__attribute__((address_space(3))) unsigned short*)scr;
#pragma unroll
    for (int i = 0; i < 4; ++i) { const int row = i * 8 + (lane >> 3), ch = lane & 7; const u32x4 v = *(__attribute__((address_space(3))) u32x4*)(stg + row * 64 + ch * 8);
        float ss = 0.f;
#pragma unroll
        for (int e = 0; e < 4; ++e) { const float a = bflo(v[e]), b = bfhi(v[e]); ss += a * a + b * b; }
        ss += __shfl_xor(ss, 1); ss += __shfl_xor(ss, 2); ss += __shfl_xor(ss, 4);
        *(u32x4*)(orow(row) + ch * 8) = v; if (ch == 0) *ssqp(row) = ss; }
}
}

constexpr int N2_M = (MTOK / 512) * 4;
constexpr int N2_B = (MTOK / 256) * 3;
constexpr int N2_A = (MTOK / 512) * 6;
constexpr size_t WS_PART = WS_X1B;
constexpr size_t WS_PARTL = WS_PART + (size_t)2 * MTOK * 384 * 2;
static_assert(WS_PARTL + (size_t)2 * MTOK * 8 * 4 <= WS_XN, "partials fit the X1B region");

struct BandU { long sb; int T, qs, L, cls, s0; };
__device__ __forceinline__ BandU band_unit(int tt, int qs) {
    BandU u; int j, nt; if (tt < TP / 256) { u.sb = 0; u.T = TP; j = tt; nt = TP / 256; } else { const int q = tt - TP / 256, b = q / (TS / 256); u.sb = TP + (long)b * TS; u.T = TS; j = q - b * (TS / 256); nt = TS / 256; }
    const int nb = nt / qs; u.qs = qs; u.L = u.T / qs; u.cls = j / nb; u.s0 = 256 * (j - u.cls * nb); return u;
}
struct UD { int kind, idx, nst; att2::TileSrc x, y; int xb, xs, yb, ys, yrot; };
__device__ __forceinline__ UD make_ud(Frame& F, int kind, int idx) {
    UD d; d.kind = kind; d.idx = idx; d.nst = 0; d.xb = d.xs = d.yb = d.ys = d.yrot = 0; d.x = att2::TileSrc{nullptr, nullptr, 0, 1, 1, F.tm}; d.y = d.x;
    const bf16* QKV = (const bf16*)(F.ws + WS_QKV);
    if (kind >= 0 && kind <= 2) {
        const int h = idx / (MTOK / 512), tt = 2 * (idx - h * (MTOK / 512)), qs = kind == 0 ? 16 : (kind == 1 ? 4 : 1);
        const BandU ux = band_unit(tt, qs), uy = band_unit(tt + 1, qs);
        const bf16* Kh = QKV + (size_t)(6 + h) * MTOK * 64; const bf16* Vh = QKV + (size_t)(12 + h) * MTOK * 64;
        d.nst = 6; d.x = att2::TileSrc{Kh + ux.sb * 64, Vh + ux.sb * 64, 0, qs, ux.T, F.tm}; d.y = att2::TileSrc{Kh + uy.sb * 64, Vh + uy.sb * 64, 0, qs, uy.T, F.tm};
        d.xb = ux.cls + (ux.s0 - 64) * qs; d.xs = 64 * qs; d.yb = uy.cls + (uy.s0 - 64) * qs; d.ys = 64 * qs; d.yrot = 3;
    } else if (kind == 3) {
        const int hp = idx / (MTOK / 256), rq4 = idx - hp * (MTOK / 256);
        int r0, rows; long sb; int T;
        if (rq4 < TP / 256) { r0 = 4 * rq4; rows = TP / 64; sb = 0; T = TP; } else { const int q = rq4 - TP / 256, b = q / (TS / 256); r0 = 4 * (q - b * (TS / 256)); rows = TS / 64; sb = TP + (long)b * TS; T = TS; }
        int rk0 = r0 - 4; rk0 = rk0 < 0 ? 0 : (rk0 > rows - 8 ? rows - 8 : rk0);
        int rk1 = r0 + 3 - 4; rk1 = rk1 < 0 ? 0 : (rk1 > rows - 8 ? rows - 8 : rk1);
        d.nst = rk1 + 8 - rk0;
        d.x = att2::TileSrc{QKV + ((size_t)(24 + 2 * hp) * MTOK + sb) * 64, QKV + ((size_t)(30 + 2 * hp) * MTOK + sb) * 64, 0, 1, T, F.tm};
        d.y = att2::TileSrc{QKV + ((size_t)(25 + 2 * hp) * MTOK + sb) * 64, QKV + ((size_t)(31 + 2 * hp) * MTOK + sb) * 64, 0, 1, T, F.tm};
        d.xb = rk0 * 64; d.xs = 64; d.yb = rk0 * 64; d.ys = 64; d.yrot = 0;
    } else if (kind == 4) {
        const int h = idx / (MTOK / 512), row0 = (idx - h * (MTOK / 512)) * 512; const SeqInfo si = seq_of(row0);
        d.nst = 4; d.x = att2::TileSrc{(const bf16*)(F.ws + WS_MK) + (size_t)(si.bat * 4 + h) * NMEM * 64, (const bf16*)(F.ws + WS_MV) + (size_t)(si.bat * 4 + h) * NMEM * 64, 0, 1, NMEM, F.tm}; d.y = d.x;
        d.xb = 0; d.xs = 64; d.yb = 0; d.ys = 64; d.yrot = 0;
    }
    return d;
}
__device__ __forceinline__ void ud_issue(Frame& F, UD& d, int s, int gstep) {
    LAS unsigned char* sl = F.lds + att2::L_RING + (gstep & (att2::NS - 1)) * att2::SLOT;
    int sy = s + d.yrot; sy = sy >= 6 ? sy - 6 : sy; if (d.yrot == 0) sy = s;
    d.x.p0 = d.xb + d.xs * s; d.y.p0 = d.yb + d.ys * sy;
    att2::dma_tile(sl, d.x, F.wave, F.lane); att2::dma_tile(sl + att2::TILE, d.y, F.wave, F.lane);
}
__device__ __forceinline__ void ud_load_q(Frame& F, const UD& d, att::bf16x8 (&qa)[4], att::bf16x8 (&qb)[4]) {
    const int w = F.wave, lane = F.lane, r32 = lane & 31;
    const bf16* QKV = (const bf16*)(F.ws + WS_QKV);
    const bf16* pa = QKV; const bf16* pb = QKV;
    if (d.kind >= 0 && d.kind <= 2) {
        const int h = d.idx / (MTOK / 512), tt = 2 * (d.idx - h * (MTOK / 512)), qs = d.kind == 0 ? 16 : (d.kind == 1 ? 4 : 1);
        const BandU ux = band_unit(tt, qs), uy = band_unit(tt + 1, qs);
        const bf16* Qh = QKV + (size_t)(0 + h) * MTOK * 64;
        pa = Qh + (size_t)(ux.sb + ux.cls + (ux.s0 + 32 * w + r32) * qs) * 64; pb = Qh + (size_t)(uy.sb + uy.cls + (uy.s0 + 32 * w + r32) * qs) * 64;
    } else if (d.kind == 3) {
        const int hp = d.idx / (MTOK / 256), rq4 = d.idx - hp * (MTOK / 256);
        int r0; long sb;
        if (rq4 < TP / 256) { r0 = 4 * rq4; sb = 0; } else { const int q = rq4 - TP / 256, b = q / (TS / 256); r0 = 4 * (q - b * (TS / 256)); sb = TP + (long)b * TS; }
        const int hd = w >> 2, g = w & 3, h = 2 * hp + hd, rq = r0 + (r32 >> 4), c = 16 * g + (r32 & 15);
        pa = QKV + ((size_t)(18 + h) * MTOK + sb + rq * 64 + c) * 64; pb = pa + (size_t)128 * 64;
    } else if (d.kind == 4) {
        const int h = d.idx / (MTOK / 512), row0 = (d.idx - h * (MTOK / 512)) * 512;
        pa = QKV + ((size_t)(36 + h) * MTOK + row0 + 32 * w + r32) * 64; pb = pa + (size_t)256 * 64;
    }
    att::load_q(qa, pa, lane); att::load_q(qb, pb, lane);
}
#define ATT3_STEP_BEGIN() do { if (s == 0) PT_ADD(F, 5); PT_SUB(F, 0); const int ahead_ = gi - gs - 1; \
        if (ahead_ >= 2) { ATT2_WAITBAR(8); } else if (ahead_ == 1) { ATT2_WAITBAR(4); } else { ATT2_WAITBAR(0); } \
        { const int t_ = s + 3; if (t_ < d.nst) { ud_issue(F, d, t_, gi); ++gi; } else if (dn.kind >= 0 && t_ - d.nst < 3) { ud_issue(F, dn, t_ - d.nst, gi); ++gi; } } PT_ADD(F, 0); PT_SUB(F, 1); } while (0)
#define ATT3_UNIT_END() asm volatile("s_waitcnt lgkmcnt(0)\n\ts_barrier" ::: "memory")

__device__ __forceinline__ void att3_body_M(Frame& F, UD& d, UD& dn, int& gs, int& gi, att::bf16x8 (&qr)[4], att::bf16x8 (&qnb)[4]) {
    const int h = d.idx / (MTOK / 512), row0 = (d.idx - h * (MTOK / 512)) * 512;
    const int w = F.wave, lane = F.lane;
    att::f32x16 o[2] = {}, o2[2] = {}; float lsum = 0.f, lsum2 = 0.f;
#pragma unroll 1
    for (int s = 0; s < 4; ++s) {
        ATT3_STEP_BEGIN();
        att::lptr tile = (att::lptr)(F.lds + att2::L_RING + (gs & (att2::NS - 1)) * att2::SLOT);
#pragma unroll
        for (int hf = 0; hf < 2; ++hf) {
            att::f32x16 pa = att2::qk_sub(tile, 32 * hf, qr, lane), pb = att2::qk_sub(tile, 32 * hf, qnb, lane);
            att2::pv_sub(tile, 32 * hf, pa, o, lsum, lane); att2::pv_sub(tile, 32 * hf, pb, o2, lsum2, lane);
            asm volatile("" ::: "memory");
        }
        ++gs; PT_ADD(F, 1);
    }
    ud_load_q(F, dn, qr, qnb);
    PT_SUB(F, 2); ATT3_UNIT_END();
    att::lptr scr = (att::lptr)(F.lds + att2::L_RING + ((gs - 1) & (att2::NS - 1)) * att2::SLOT + w * 4096);
    __attribute__((address_space(3))) float* ls = (__attribute__((address_space(3))) float*)(F.lds + att2::L_LS + w * 128);
    { bf16* O = (bf16*)F.out + (size_t)(row0 + 32 * w) * DM + 768 + 64 * h; float* SQ = (float*)(F.ws + WS_SSQA) + (size_t)(row0 + 32 * w) * 16 + 12 + h;
      att2::out_final(o, lsum, scr, ls, [=](int q) { return O + (size_t)q * DM; }, [=](int q) { return SQ + (size_t)q * 16; }, lane); }
    { bf16* O = (bf16*)F.out + (size_t)(row0 + 256 + 32 * w) * DM + 768 + 64 * h; float* SQ = (float*)(F.ws + WS_SSQA) + (size_t)(row0 + 256 + 32 * w) * 16 + 12 + h;
      att2::out_final(o2, lsum2, scr, ls, [=](int q) { return O + (size_t)q * DM; }, [=](int q) { return SQ + (size_t)q * 16; }, lane); }
    PT_ADD(F, 2);
}
__device__ __forceinline__ void att3_body_B(Frame& F, const Args& A, UD& d, UD& dn, int& gs, int& gi, att::bf16x8 (&qr)[4], att::bf16x8 (&qnb)[4]) {
    const int hp = d.idx / (MTOK / 256), rq4 = d.idx - hp * (MTOK / 256);
    int r0, rows; long sb;
    if (rq4 < TP / 256) { r0 = 4 * rq4; rows = TP / 64; sb = 0; } else { const int q = rq4 - TP / 256, b = q / (TS / 256); r0 = 4 * (q - b * (TS / 256)); rows = TS / 64; sb = TP + (long)b * TS; }
    const int w = F.wave, lane = F.lane, r32 = lane & 31, hi = lane >> 5;
    const int hd = w >> 2, g = w & 3, h = 2 * hp + hd;
    const int c = 16 * g + (r32 & 15);
    int cs = c - 8; cs = cs < 0 ? 0 : (cs > 48 ? 48 : cs);
    const int rk0 = d.xb >> 6;
    const int w0 = g == 0 ? 0 : (g == 1 ? 8 : (g == 2 ? 24 : 32));
    { const int th = F.tid >> 8, tl = F.tid & 255;
      __attribute__((address_space(3))) float* tbl = (__attribute__((address_space(3))) float*)(F.lds + att2::L_TBL + th * att2::TBLB);
      const float* rpb = A.in[10] + (2 * hp + th) * 465;
      for (int idx = tl; idx < 465; idx += 256) { const int dr = idx / 31, dl = idx - dr * 31; tbl[dr * 64 + 16 + dl] = rpb[idx] * LOG2E; } }
    att::f32x16 o[2] = {}, o2[2] = {}; float lsum = 0.f, lsum2 = 0.f;
    const __attribute__((address_space(3))) float* tb = (const __attribute__((address_space(3))) float*)(F.lds + att2::L_TBL + hd * att2::TBLB) + (31 + w0 - c) + 4 * hi;
    const int cb = w0 - cs + 4 * hi, nst = d.nst;
    const int rq0 = r0 + (r32 >> 4), rq1 = rq0 + 2;
    int rlo0 = rq0 - 4; rlo0 = rlo0 < 0 ? 0 : (rlo0 > rows - 8 ? rows - 8 : rlo0);
    int rlo1 = rq1 - 4; rlo1 = rlo1 < 0 ? 0 : (rlo1 > rows - 8 ? rows - 8 : rlo1);
    int b0lo = r0 - 4; b0lo = b0lo < 0 ? 0 : (b0lo > rows - 8 ? rows - 8 : b0lo); int b0hi = r0 + 1 - 4; b0hi = (b0hi < 0 ? 0 : (b0hi > rows - 8 ? rows - 8 : b0hi)) + 7;
    int b1lo = r0 + 2 - 4; b1lo = b1lo < 0 ? 0 : (b1lo > rows - 8 ? rows - 8 : b1lo); int b1hi = r0 + 3 - 4; b1hi = (b1hi < 0 ? 0 : (b1hi > rows - 8 ? rows - 8 : b1hi)) + 7;
#pragma unroll 1
    for (int s = 0; s < nst; ++s) {
        ATT3_STEP_BEGIN();
        att::lptr tile = (att::lptr)(F.lds + att2::L_RING + (gs & (att2::NS - 1)) * att2::SLOT + hd * att2::TILE);
        const int rk = rk0 + s;
        if (rk >= b0lo && rk <= b0hi) {
            att::f32x16 p = att2::qk_sub(tile, w0, qr, lane);
            const bool rok = (unsigned)(rk - rlo0) < 8u; int dr = rk + 7 - rq0; dr = dr < 0 ? 0 : (dr > 14 ? 14 : dr);
            const __attribute__((address_space(3))) float* tp = tb + dr * 64; const int cbh = rok ? cb : -4096;
#pragma unroll
            for (int r = 0; r < 16; ++r) { const float sbv = p[r] + tp[att::creg(r)]; p[r] = ((unsigned)(cbh + att::creg(r)) < 16u) ? sbv : att::NEG; }
            att2::pv_sub(tile, w0, p, o, lsum, lane);
        }
        if (rk >= b1lo && rk <= b1hi) {
            att::f32x16 p = att2::qk_sub(tile, w0, qnb, lane);
            const bool rok = (unsigned)(rk - rlo1) < 8u; int dr = rk + 7 - rq1; dr = dr < 0 ? 0 : (dr > 14 ? 14 : dr);
            const __attribute__((address_space(3))) float* tp = tb + dr * 64; const int cbh = rok ? cb : -4096;
#pragma unroll
            for (int r = 0; r < 16; ++r) { const float sbv = p[r] + tp[att::creg(r)]; p[r] = ((unsigned)(cbh + att::creg(r)) < 16u) ? sbv : att::NEG; }
            att2::pv_sub(tile, w0, p, o2, lsum2, lane);
        }
        ++gs; PT_ADD(F, 1);
    }
    ud_load_q(F, dn, qr, qnb);
    PT_SUB(F, 2); ATT3_UNIT_END();
    att::lptr scr = (att::lptr)(F.lds + att2::L_RING + ((gs - 1) & (att2::NS - 1)) * att2::SLOT + w * 4096);
    __attribute__((address_space(3))) float* ls = (__attribute__((address_space(3))) float*)(F.lds + att2::L_LS + w * 128);
    { bf16* O = (bf16*)F.out + (size_t)(sb + r0 * 64 + 16 * g) * DM + 384 + 64 * h; float* SQ = (float*)(F.ws + WS_SSQA) + (size_t)(sb + r0 * 64 + 16 * g) * 16 + 6 + h;
      att2::out_final(o, lsum, scr, ls, [=](int q) { return O + (size_t)((q >> 4) * 64 + (q & 15)) * DM; }, [=](int q) { return SQ + (size_t)((q >> 4) * 64 + (q & 15)) * 16; }, lane); }
    { bf16* O = (bf16*)F.out + (size_t)(sb + (r0 + 2) * 64 + 16 * g) * DM + 384 + 64 * h; float* SQ = (float*)(F.ws + WS_SSQA) + (size_t)(sb + (r0 + 2) * 64 + 16 * g) * 16 + 6 + h;
      att2::out_final(o2, lsum2, scr, ls, [=](int q) { return O + (size_t)((q >> 4) * 64 + (q & 15)) * DM; }, [=](int q) { return SQ + (size_t)((q >> 4) * 64 + (q & 15)) * 16; }, lane); }
    PT_ADD(F, 2);
}
__device__ __forceinline__ void att3_body_A(Frame& F, UD& d, UD& dn, int& gs, int& gi, att::bf16x8 (&qx)[4], att::bf16x8 (&qy)[4]) {
    const int pat = d.kind, ud = d.idx;
    const int h = ud / (MTOK / 512), tt = 2 * (ud - h * (MTOK / 512)), qs = pat == 0 ? 16 : (pat == 1 ? 4 : 1);
    const BandU ux = band_unit(tt, qs), uy = band_unit(tt + 1, qs);
    const int w = F.wave, lane = F.lane, r32 = lane & 31;
    const bf16* Qh = (const bf16*)(F.ws + WS_QKV) + (size_t)(0 + h) * MTOK * 64;
    att::f32x16 ox[2] = {}, oy[2] = {}; float lx = 0.f, ly = 0.f;
#pragma unroll 1
    for (int s = 0; s < 6; ++s) {
        ATT3_STEP_BEGIN();
        att::lptr tX = (att::lptr)(F.lds + att2::L_RING + (gs & (att2::NS - 1)) * att2::SLOT), tY = tX + att2::TILE;
        const int sy = (s + 3) % 6;
#pragma unroll
        for (int hf = 0; hf < 2; ++hf) {
            const int gx = 2 * s + hf, gy = 2 * sy + hf;
            const bool ax = (unsigned)(gx - w) <= 4u, ay = (unsigned)(gy - w) <= 4u;
            att::f32x16 pxx, pyy;
            if (ax) pxx = att2::qk_sub(tX, 32 * hf, qx, lane);
            if (ay) pyy = att2::qk_sub(tY, 32 * hf, qy, lane);
            if (ax) { att2::mask_band(pxx, gx - w, ux.s0 - 64 + 32 * gx, ux.L, lane); att2::pv_sub(tX, 32 * hf, pxx, ox, lx, lane); }
            if (ay) { att2::mask_band(pyy, gy - w, uy.s0 - 64 + 32 * gy, uy.L, lane); att2::pv_sub(tY, 32 * hf, pyy, oy, ly, lane); }
        }
        ++gs; PT_ADD(F, 1);
    }
    ud_load_q(F, dn, qx, qy);
    bf16* PB = (bf16*)(F.ws + WS_PART); float* PL = (float*)(F.ws + WS_PARTL);
    int lane_o = F.lane; asm volatile("" : "+v"(lane_o));
    att::u32x4 pa[4], pb[4]; float pl[4];
#define ATT3_LOAD_PART(side_) do { const BandU& u_ = (side_) ? uy : ux; const long t0_ = u_.sb + u_.cls + (long)(u_.s0 + 32 * w); \
        _Pragma("unroll") for (int i = 0; i < 4; ++i) { const int row = i * 8 + (lane_o >> 3), ch = lane_o & 7; const long tok = t0_ + row; \
            pa[i] = *(const att::u32x4*)(PB + ((size_t)tok) * 384 + 64 * h + ch * 8); pb[i] = *(const att::u32x4*)(PB + ((size_t)MTOK + tok) * 384 + 64 * h + ch * 8); \
            pl[i] = PL[(size_t)tok * 8 + h] + PL[((size_t)MTOK + tok) * 8 + h]; } } while (0)
    if (pat == 2) ATT3_LOAD_PART(0);
    PT_SUB(F, 2); ATT3_UNIT_END();
    att::lptr scr = (att::lptr)(F.lds + att2::L_RING + ((gs - 1) & (att2::NS - 1)) * att2::SLOT + w * 4096);
    __attribute__((address_space(3))) unsigned short* stg = (__attribute__((address_space(3))) unsigned short*)scr;
    __attribute__((address_space(3))) float* ls = (__attribute__((address_space(3))) float*)(F.lds + att2::L_LS + w * 128);
#pragma unroll
    for (int side = 0; side < 2; ++side) {
        const BandU& u = side ? uy : ux;
        const long tok0 = u.sb + u.cls + (long)(u.s0 + 32 * w) * qs;
        att2::stage_rows(side ? oy : ox, side ? ly : lx, false, scr, ls, lane);
        if (pat < 2) {
#pragma unroll
            for (int i = 0; i < 4; ++i) { const int row = i * 8 + (lane_o >> 3), ch = lane_o & 7; const att::u32x4 v = *(__attribute__((address_space(3))) att::u32x4*)(stg + row * 64 + ch * 8);
                *(att::u32x4*)(PB + ((size_t)pat * MTOK + tok0 + (long)row * qs) * 384 + 64 * h + ch * 8) = v; }
            if (lane_o < 32) PL[((size_t)pat * MTOK + tok0 + (long)lane_o * qs) * 8 + h] = ls[lane_o];
        } else {
            att::u32x4 a4[4], b4[4]; float l4[4];
#pragma unroll
            for (int i = 0; i < 4; ++i) { a4[i] = pa[i]; b4[i] = pb[i]; l4[i] = pl[i]; }
            if (side == 0) ATT3_LOAD_PART(1);
#pragma unroll
            for (int i = 0; i < 4; ++i) { const int row = i * 8 + (lane_o >> 3), ch = lane_o & 7; const long tok = tok0 + row;
                const att::u32x4 v = *(__attribute__((address_space(3))) att::u32x4*)(stg + row * 64 + ch * 8);
                const att::u32x4 a = a4[i], b = b4[i];
                const float rl = __builtin_amdgcn_rcpf(ls[row] + l4[i]);
                att::u32x4 ov; float ss = 0.f;
#pragma unroll
                for (int e = 0; e < 4; ++e) { const float x0 = (bflo(v[e]) + bflo(a[e]) + bflo(b[e])) * rl, x1 = (bfhi(v[e]) + bfhi(a[e]) + bfhi(b[e])) * rl; ov[e] = pk2(x0, x1);
                    const float y0 = bflo(ov[e]), y1 = bfhi(ov[e]); ss += y0 * y0 + y1 * y1; }
                ss += __shfl_xor(ss, 1); ss += __shfl_xor(ss, 2); ss += __shfl_xor(ss, 4);
                *(att::u32x4*)((bf16*)F.out + (size_t)tok * DM + 64 * h + ch * 8) = ov;
                if (ch == 0) ((float*)(F.ws + WS_SSQA))[(size_t)tok * 16 + h] = ss; }
        }
    }
#undef ATT3_LOAD_PART
    PT_ADD(F, 2);
}
template <class ListFn> __device__ __forceinline__ void att3_run(Frame& F, const Args& A, const ListFn& unit_of) {
    PT_SUB(F, 3);
    int gs = 0, gi = 0, k, i;
    unit_of(0, k, i); UD d = make_ud(F, k, i);
    if (d.kind < 0) return;
    for (int s = 0; s < 3; ++s) { ud_issue(F, d, s, gi); ++gi; }
    att::bf16x8 qa[4], qb[4]; ud_load_q(F, d, qa, qb);
    for (int j = 0; d.kind >= 0; ++j) {
        PT_SUB(F, 4); unit_of(j + 1, k, i); UD dn = make_ud(F, k, i); PT_ADD(F, 4); PT_SUB(F, 5);
        const int kslot_ = d.kind; PTK_SUB(F, kslot_);
        if (d.kind <= 2) att3_body_A(F, d, dn, gs, gi, qa, qb); else if (d.kind == 3) att3_body_B(F, A, d, dn, gs, gi, qa, qb); else att3_body_M(F, d, dn, gs, gi, qa, qb);
        PTK_ADD(F, kslot_);
        d = dn;
    }
    ATT2_WAITBAR(0);
    PT_ADD(F, 3);
}
__device__ __forceinline__ void att2_phase_a(Frame& F, const Args& A) {
    const int NU = 2 * N2_A + N2_B, G = F.G;
    const bool blk = (G == 256); const int per = NU / 8, xcd = blockIdx.x & 7, ci = blockIdx.x >> 3, bx = blockIdx.x;
    att3_run(F, A, [=](int j, int& kind, int& idx) {
        const int jj = blk ? ci + 32 * j : bx + G * j; const bool ok = blk ? (jj < per) : (jj < NU);
        const int u = blk ? xcd * per + jj : jj, i = u / 3, k = u - 3 * i;
        kind = !ok ? -1 : (k == 0 ? 0 : (k == 1 ? 1 : 3)); idx = i; });
}
__device__ __forceinline__ void att2_phase_b(Frame& F, const Args& A) {
    const int NU = N2_A + N2_M, G = F.G;
    const bool blk = (G == 256); const int per = NU / 8, xcd = blockIdx.x & 7, ci = blockIdx.x >> 3, bx = blockIdx.x;
    att3_run(F, A, [=](int j, int& kind, int& idx) {
        const int jj = blk ? ci + 32 * j : bx + G * j; const bool ok = blk ? (jj < per) : (jj < NU);
        const int u = blk ? xcd * per + jj : jj, gq = u / 5, k = u - 5 * gq;
        kind = !ok ? -1 : (k < 3 ? 2 : 4); idx = k < 3 ? 3 * gq + k : 2 * gq + (k - 3); });
}
__global__ void __launch_bounds__(NWAVES * 64, 2) skel_fwd(Args args) {
    extern __shared__ __attribute__((aligned(16))) unsigned char lds[];
    cg::grid_group grid = cg::this_grid();
    Frame F;
    F.lds = (LAS unsigned char*)lds;
    F.tid = threadIdx.x; F.lane = F.tid & 63; F.wave = __builtin_amdgcn_readfirstlane(F.tid >> 6);
    F.G = gridDim.x; { const int bx = blockIdx.x; F.vcu = (F.G % 8 == 0) ? (bx % 8) * (F.G / 8) + bx / 8 : bx; }
    F.out = args.out; F.ws = args.ws; F.tm = -1;
    unsigned char* ws = args.ws;
    const int lo = args.ph_lo, hi = args.ph_hi & 255; if (args.ph_hi >> 8) F.tm = 63;
    volatile LAS unsigned* bst = (volatile LAS unsigned*)(F.lds + LDS_MISC);
    if (F.tid < 2) bst[F.tid] = 0u;
    if (F.tid >= 8 && F.tid < 24) ((volatile LAS unsigned*)(F.lds + LDS_MISC))[F.tid] = 0u;
    __syncthreads();
    XcdBarrier bar = xcd_barrier_post((unsigned*)(ws + WS_CTL) + CW_BAR, bst);
    if (lo < 0) grid.sync();
#define IN(k) (lo <= (k) && (k) < hi)
#define BOTH(k) (IN(k) && IN((k) + 1))
#define GRID_BAR() xcd_barrier(bar)
#if PROBE_T == 3
#define PT_STAMP(k) do { if (F.tid == 0 && blockIdx.x == 0) PT_SLOTS_L(F.lds)[k] = (long long)__builtin_amdgcn_s_memrealtime(); } while (0)
#else
#define PT_STAMP(k) do {} while (0)
#endif
#if PROBE_T
#define PT_PHASE(k) do { if (F.tid == 0) PT_ON_L(F.lds) = ((k) == PROBE_PHASE) ? 1u : 0u; } while (0)
#else
#define PT_PHASE(k) do {} while (0)
#endif

    PT_STAMP(0);
    if (IN(0)) { PT_PHASE(0); p0_prologue(F, args); PT_PHASE(-1); if (BOTH(0)) GRID_BAR(); }
    PT_STAMP(1);

    if (IN(1)) {
        PT_PHASE(1);
        {
            pg8::Gemm g{(const pg8::bf16_t*)(ws + WS_XN), (const pg8::bf16_t*)(ws + WS_WIN), MTOK, NQKV, DM}; pg8::StaticOrder S; S.init(MTOK, NQKV, F.G, (int)blockIdx.x);
            pg8::EpiQKV E{(pg8::bf16_t*)(ws + WS_QKV), args.in[6], args.in[7], args.in[8], args.in[9], args.in[13], (const float*)(ws + WS_ROPE), (const float*)(ws + WS_ROPE) + TP * 8};
            pg8::gemm_phase<pg8::EpiQKV, pg8::StaticOrder, true, true>(F.lds, g, S, E);
        }
        {
            pg8::Gemm g{(const pg8::bf16_t*)(ws + WS_XNMEM), (const pg8::bf16_t*)(ws + WS_WMEM), MMEM, 512, DM}; pg8::StaticOrder S; S.init(MMEM, 512, F.G, F.G - 1 - (int)blockIdx.x);
            pg8::EpiMemKV E{(pg8::bf16_t*)(ws + WS_MK), (pg8::bf16_t*)(ws + WS_MV), args.in[14]};
            pg8::gemm_phase<pg8::EpiMemKV, pg8::StaticOrder, true, true>(F.lds, g, S, E);
        }
        PT_PHASE(-1);
        if (BOTH(1)) GRID_BAR();
    }
    PT_STAMP(2);

    if (IN(2)) { PT_PHASE(2); att2_phase_a(F, args); PT_PHASE(-1); if (BOTH(2)) GRID_BAR(); }
    PT_STAMP(3);
    if (IN(3)) { PT_PHASE(3); att2_phase_b(F, args); PT_PHASE(-1); if (BOTH(3)) GRID_BAR(); }
    PT_STAMP(4);

    if (IN(4)) {
        pg8::Gemm g{(const pg8::bf16_t*)F.out, (const pg8::bf16_t*)(ws + WS_WOUT), MTOK, DM, DM};   pg8::StaticOrder S; S.init(MTOK, DM, F.G, (int)blockIdx.x);
        pg8::EpiX1 E{(const pg8::bf16_t*)(ws + WS_XN), (const float*)(ws + WS_IRSTD), args.in[4], (pg8::bf16_t*)(ws + WS_X1B), (float*)(ws + WS_SSQF), (const float*)(ws + WS_SSQA)};
        PT_PHASE(4); pg8::gemm_phase<pg8::EpiX1, pg8::StaticOrder, true, true>(F.lds, g, S, E); PT_PHASE(-1);
        if (BOTH(4)) GRID_BAR();
    }
    PT_STAMP(5);

    if (IN(5)) {
        pg8::Gemm g{(const pg8::bf16_t*)(ws + WS_X1B), (const pg8::bf16_t*)(ws + WS_W1), MTOK, FF, DM}; pg8::StaticOrder S; S.init(MTOK, FF, F.G, (int)blockIdx.x);
        pg8::EpiH E{(pg8::bf16_t*)(ws + WS_H), (const float*)(ws + WS_SSQF), args.ph_hi >> 8};
        PT_PHASE(5); pg8::gemm_phase<pg8::EpiH, pg8::StaticOrder, true, true>(F.lds, g, S, E); PT_PHASE(-1);
        if (BOTH(5)) GRID_BAR();
    }
    PT_STAMP(6);

    if (IN(6)) {
        pg8::Gemm g{(const pg8::bf16_t*)(ws + WS_H), (const pg8::bf16_t*)(ws + WS_W2), MTOK, DM, FF}; pg8::StaticOrder S; S.init(MTOK, DM, F.G, (int)blockIdx.x);
        pg8::EpiOut E{F.out, (const pg8::bf16_t*)(ws + WS_X1B)};
        PT_PHASE(6); pg8::gemm_phase<pg8::EpiOut, pg8::StaticOrder, true, true>(F.lds, g, S, E); PT_PHASE(-1);
    }
#if PROBE_T == 3
    PT_STAMP(7);
    __syncthreads();
    if (blockIdx.x == 0 && F.tid == 0) { F.out[0] = (float)(PT_SLOTS_L(F.lds)[PROBE_I + 1] - PT_SLOTS_L(F.lds)[PROBE_I]) * 0.01f; F.out[1] = 0.f; }
#elif PROBE_T
    __syncthreads();
    if (blockIdx.x == 0 && F.tid == 0) { F.out[0] = (float)(PT_SLOTS_L(F.lds)[PROBE_I] >> 15) * 16.384f; F.out[1] = (float)PT_SLOTS_L(F.lds)[PROBE_J] * (1.0f / 2000.0f); }
#endif
#undef IN
#undef BOTH
}

extern "C" void kernel_launch(void* const* d_in, const int* in_sizes, int n_in, void* d_out, int out_size, void* d_ws, size_t ws_size, hipStream_t stream) {
    static int grid = 0;
    if (grid == 0) {
        if (n_in != 22 || in_sizes[0] != TP * DM || in_sizes[1] != NBS * TS * DM || out_size != MTOK * DM || ws_size < WS_END) {
            fprintf(stderr, "kernel_launch: unexpected shapes / workspace (n_in %d, in0 %d, out %d, ws %zu); nothing launched\n", n_in, n_in > 0 ? in_sizes[0] : -1, out_size, ws_size); grid = -1; return; }
        int dev = 0, cus = 0, per_cu = 0;
        if (hipGetDevice(&dev) != hipSuccess || hipDeviceGetAttribute(&cus, hipDeviceAttributeMultiprocessorCount, dev) != hipSuccess) { grid = -1; return; }
        if (hipFuncSetAttribute((const void*)skel_fwd, hipFuncAttributeMaxDynamicSharedMemorySize, LDS_BYTES) != hipSuccess) { fprintf(stderr, "kernel_launch: hipFuncSetAttribute failed\n"); grid = -1; return; }
        if (hipOccupancyMaxActiveBlocksPerMultiprocessor(&per_cu, (const void*)skel_fwd, NWAVES * 64, LDS_BYTES) != hipSuccess || per_cu < 1) { fprintf(stderr, "kernel_launch: occupancy query says %d\n", per_cu); (void)hipGetLastError(); grid = -1; return; }
        grid = cus * per_cu;
    }
    if (grid < 0) return;
    if (hipMemsetAsync((char*)d_ws + WS_CTL, 0, CTL_ZERO_BYTES, stream) != hipSuccess) return;
    Args a{};
    for (int i = 0; i < 22; ++i) a.in[i] = (const float*)d_in[i];
    a.out = (float*)d_out; a.ws = (unsigned char*)d_ws;
    auto launch = [&](int lo, int hi) {
        if (lo > 0) (void)hipMemsetAsync((char*)d_ws + WS_CTL + (size_t)CW_BAR * 4, 0, (size_t)XCD_BAR_WORDS * 4, stream);
        a.ph_lo = lo; a.ph_hi = hi; void* kargs[] = {&a};
        hipError_t e = hipLaunchCooperativeKernel((const void*)skel_fwd, dim3(grid), dim3(NWAVES * 64), kargs, LDS_BYTES, stream);
        if (e != hipSuccess) fprintf(stderr, "kernel_launch: cooperative launch failed: %s (grid %d)\n", hipGetErrorString(e), grid);
    };
#if PROBE_SEQ == 0
    launch(0, NPH);
#elif PROBE_SEQ == 1
    launch(0, NPH); launch(0, 1);
#elif PROBE_SEQ == 2
    launch(0, NPH); launch(1, 2);
#elif PROBE_SEQ == 3
    launch(0, 4); (void)hipMemsetAsync((char*)d_ws + WS_SSQA, 0, (size_t)MTOK * 16, stream); launch(2, 4); launch(4, NPH);
#elif PROBE_SEQ == 4
    launch(0, 5); (void)hipMemsetAsync((char*)d_ws + WS_SSQF, 0, (size_t)MTOK * 4, stream); launch(4, 5); launch(5, NPH);
#elif PROBE_SEQ == 5
    launch(0, NPH); launch(5, 6);
#elif PROBE_SEQ == 7
    launch(0, NPH); launch(2, 3);
#elif PROBE_SEQ == 8
    launch(0, NPH); launch(2, 3 | 256);
#elif PROBE_SEQ == 9
    launch(0, NPH); launch(3, 4);
#elif PROBE_SEQ == 10
    launch(0, NPH); launch(3, 4 | 256);
#elif PROBE_SEQ == 11
    launch(0, NPH); launch(5, 6 | 256);
#elif PROBE_SEQ == 12
    launch(0, NPH); launch(5, 6 | 512);
#elif PROBE_SEQ == 13
    launch(0, NPH); launch(0, 1 | 256);
#elif PROBE_SEQ == 6
    launch(0, 3); (void)hipMemsetAsync((char*)d_ws + WS_SSQA, 0, (size_t)MTOK * 16, stream); launch(2, 3); launch(3, NPH);
#endif
}
```

```cpp
#include <hip/hip_runtime.h>
#include <hip/hip_cooperative_groups.h>
#include <cstdio>
#include <cstdint>
namespace cg = cooperative_groups;

constexpr int DM = 1024, TP = 16384, TS = 8192, NBS = 4, MTOK = TP + NBS * TS;
constexpr int NQKV = 2560, NHEADS = 40, FF = 4096, NMEM = 256, NBATCH = 1 + NBS, MMEM = NBATCH * NMEM;
constexpr float RMS_EPS = 1e-6f;
constexpr float LOG2E = 1.4426950408889634f;
constexpr float QSCALE = 0.125f * LOG2E;

#ifndef PROBE_SEQ
#define PROBE_SEQ 0
#endif
#ifndef PROBE_T
#define PROBE_T 0
#endif
#ifndef PROBE_I
#define PROBE_I 6
#endif
#ifndef PROBE_J
#define PROBE_J 7
#endif
#ifndef PROBE_PHASE
#define PROBE_PHASE 3
#endif
#ifndef PROBE_PHASE
#define PROBE_PHASE 3
#endif
#ifndef SPEC_ROLES
#define SPEC_ROLES 0
#endif
constexpr int RING_BYTES = 131072;
constexpr int LDS_BYTES = 147456, LDS_MISC = LDS_BYTES - 128;
constexpr int CW_BAR = 4096, CW_ARANK = 8192, CW_READY = 16384;
constexpr int LDS_BYTES_UNUSED = 0;


#if PROBE_T
#define PT_SLOTS_L(lds) ((volatile __attribute__((address_space(3))) long long*)((lds) + LDS_MISC + 32))
#define PT_ON_L(lds) (*(volatile __attribute__((address_space(3))) unsigned*)((lds) + LDS_MISC + 24))
#define PT_SUB_L(lds, i) do { if (threadIdx.x == 0 && blockIdx.x == 0 && PT_ON_L(lds)) PT_SLOTS_L(lds)[i] -= (long long)__builtin_readcyclecounter(); } while (0)
#define PT_ADD_L(lds, i) do { if (threadIdx.x == 0 && blockIdx.x == 0 && PT_ON_L(lds)) PT_SLOTS_L(lds)[i] += (long long)__builtin_readcyclecounter(); } while (0)
#else
#define PT_SUB_L(lds, i) do {} while (0)
#define PT_ADD_L(lds, i) do {} while (0)
#endif
#if PROBE_T == 2
#define PTK_SUB(F, i) PT_SUB_L((F).lds, i)
#define PTK_ADD(F, i) PT_ADD_L((F).lds, i)
#define PT_SUB(F, i) do {} while (0)
#define PT_ADD(F, i) do {} while (0)
#else
#define PTK_SUB(F, i) do {} while (0)
#define PTK_ADD(F, i) do {} while (0)
#define PT_SUB(F, i) PT_SUB_L((F).lds, i)
#define PT_ADD(F, i) PT_ADD_L((F).lds, i)
#endif
namespace pg8 {
#define PG8_LAS __attribute__((address_space(3)))
typedef unsigned short bf16_t;
typedef short bf16x8 __attribute__((ext_vector_type(8)));
typedef float f32x4 __attribute__((ext_vector_type(4)));
typedef unsigned u32x4 __attribute__((ext_vector_type(4)));
constexpr int BM = 256, BK = 64, HALF = 128, HTB = HALF * BK * 2  , STAGE_BYTES = 8 * HTB, NXCD = 8, WGM = 8;

__host__ __device__ __forceinline__ int lds_byte(int r, int c) { const int st = (r >> 4) * 2 + (c >> 5), rr = r & 15, cc = c & 31, ob = rr * 64 + cc * 2; return st * 1024 + (ob ^ (((ob >> 9) & 1) << 5)); }
__host__ __device__ __forceinline__ void stage_rc(int b, int& R, int& C) { const int st = b / 1024, sb = b % 1024, swz = sb ^ (((sb >> 9) & 1) << 5); R = (st >> 1) * 16 + swz / 64; C = (st & 1) * 32 + (swz % 64) / 2; }
__host__ __device__ __forceinline__ int perm32(int rho) { const int n = rho >> 4, i = rho & 15; return 8 * (i >> 2) + 4 * n + (i & 3); }

struct Unit { int pm, pn; };
struct Gemm { const bf16_t* A; const bf16_t* Bt; int M, N, K; };

struct StaticOrder {
    int nM, nN, nwg, G, c;
    __host__ __device__ void init(int M, int N, int G_, int c_) { nM = M / BM; nN = N / BM; nwg = nM * nN; G = G_; c = c_; }
    __host__ __device__ bool next(int i, Unit& u) const {
        const long L = (long)i * G + c; if (L >= nwg) return false;
        int wgid = (int)L; { const int q = nwg / NXCD, r = nwg % NXCD, xcd = wgid % NXCD, off = wgid / NXCD; wgid = (xcd < r ? xcd * (q + 1) : r * (q + 1) + (xcd - r) * q) + off; }
        const int nig = WGM * nN, gid = wgid / nig, fm = gid * WGM, gsz = (nM - fm) < WGM ? (nM - fm) : WGM;
        u.pm = fm + ((wgid % nig) % gsz); u.pn = (wgid % nig) / gsz; return true;
    }
    __device__ __forceinline__ void a_ready(const Unit&) const {}
    __device__ __forceinline__ void done(const Unit&) const {}
};

constexpr int NCV = 8;
struct SpecOrder {
    int nM, nN, nwg, G, c, x, j; bool spec; unsigned* ready; mutable int have;
    __device__ void init(int M, int N, int G_, int c_, bool spec_, unsigned* ready_) { nM = M / BM; nN = N / BM; nwg = nM * nN; G = G_; c = c_; spec = spec_; x = c_ & 7; j = c_ >> 3; ready = ready_; have = 0; }
    __device__ __forceinline__ bool next(int i, Unit& u) const {
        int wgid;
        if (spec) { const int off = (j >= NCV) ? (i < 2 ? (32 - NCV) * i + (j - NCV) : 2 * (32 - NCV) + 32 * (i - 2) + j) : 2 * (32 - NCV) + 32 * i + j; if (off >= nwg / NXCD) return false; wgid = x * (nwg / NXCD) + off; }
        else { const long L = (long)i * G + c; if (L >= nwg) return false;
            wgid = (int)L; { const int q = nwg / NXCD, r = nwg % NXCD, xcd = wgid % NXCD, off = wgid / NXCD; wgid = (xcd < r ? xcd * (q + 1) : r * (q + 1) + (xcd - r) * q) + off; } }
        const int nig = WGM * nN, gid = wgid / nig, fm = gid * WGM, gsz = (nM - fm) < WGM ? (nM - fm) : WGM;
        u.pm = fm + ((wgid % nig) % gsz); u.pn = (wgid % nig) / gsz; return true;
    }
    __device__ __forceinline__ void a_ready(const Unit& u) const {
        if (!spec) return;
        const int ch = u.pm / 24, grp = (u.pm - 24 * ch) >> 3;
        if (grp <= have) return;
        if (threadIdx.x < 64) {
            const unsigned long long t0 = __builtin_amdgcn_s_memrealtime();
            while ((unsigned)__builtin_amdgcn_readfirstlane(__hip_atomic_load(ready + 64 * (2 * ch + grp - 1), __ATOMIC_RELAXED, __HIP_MEMORY_SCOPE_AGENT)) < (unsigned)NCV) {
                if (__builtin_amdgcn_s_memrealtime() - t0 > 2000000ull) break;
                __builtin_amdgcn_s_sleep(2); }
            __builtin_amdgcn_fence(__ATOMIC_ACQUIRE, "agent");
            asm volatile("s_waitcnt vmcnt(0)" ::: "memory");
        }
        asm volatile("" ::: "memory"); __builtin_amdgcn_s_barrier(); asm volatile("" ::: "memory");
        have = grp;
    }
    __device__ __forceinline__ void done(const Unit&) const {}
};
struct ListOrder {
    int nN, n, first, stride;
    __device__ __forceinline__ bool next(int i, Unit& u) const { const long L = (long)first + (long)i * stride; if (L >= n) return false; u.pm = (int)L / nN; u.pn = (int)L % nN; return true; }
    __device__ __forceinline__ void a_ready(const Unit&) const {}
    __device__ __forceinline__ void done(const Unit&) const {}
};

__device__ __forceinline__ unsigned cvt_pk_bf16(float lo, float hi) { unsigned r; asm volatile("v_cvt_pk_bf16_f32 %0, %1, %2" : "=v"(r) : "v"(lo), "v"(hi)); return r; }
typedef float f32x2 __attribute__((ext_vector_type(2)));
__device__ __forceinline__ float sum_xor16(float v) { const auto r = __builtin_amdgcn_permlane16_swap(__float_as_uint(v), __float_as_uint(v), false, false); return __uint_as_float(r[0]) + __uint_as_float(r[1]); }
__device__ __forceinline__ float sum_xor32(float v) { const auto r = __builtin_amdgcn_permlane32_swap(__float_as_uint(v), __float_as_uint(v), false, false); return __uint_as_float(r[0]) + __uint_as_float(r[1]); }
__device__ __forceinline__ float sq4(const f32x4 v) { return (v[0] * v[0] + v[1] * v[1]) + (v[2] * v[2] + v[3] * v[3]); }
__device__ __forceinline__ u32x4 pack8(const f32x4 a, const f32x4 b) { u32x4 w; w.x = cvt_pk_bf16(a[0], a[1]); w.y = cvt_pk_bf16(a[2], a[3]); w.z = cvt_pk_bf16(b[0], b[1]); w.w = cvt_pk_bf16(b[2], b[3]); return w; }

struct EpiQKV {
    static constexpr bool PERM = true, AFTER_DRAIN = false, KSCALE = false, PREP = false, PREFETCH = false; static constexpr int KS_T1 = -1, KS_T2 = -1;
    bf16_t* QKV;
    const float *gqa, *gka, *gqb, *gkb, *gqm;
    const float *rc, *rs;
    __device__ __forceinline__ void operator()(const f32x4 (&acc)[2][2][4][2], const Unit& u, int wr, int wc, int fr, int fq) const {
        const int hidx = u.pn * 4 + wc;
        const float* gain = nullptr; bool rope = false; float qs = 1.f;
        if (hidx < 6) { gain = gqa; rope = true; qs = QSCALE; } else if (hidx < 12) { gain = gka; rope = true; } else if (hidx < 18) { } else if (hidx < 24) { gain = gqb; qs = QSCALE; }
        else if (hidx < 30) { gain = gkb; } else if (hidx < 36) { } else { gain = gqm; qs = QSCALE; }
        const bool rl = rope && fq < 2;
        f32x4 g[2][2];
#pragma unroll
        for (int bj = 0; bj < 2; ++bj)
#pragma unroll
            for (int n = 0; n < 2; ++n) { const int d0 = (rl && bj == 0) ? (8 * n + 4 * fq) : (32 * bj + 8 * fq + 4 * n); g[bj][n] = gain ? *(const f32x4*)(gain + d0) : (f32x4){1.f, 1.f, 1.f, 1.f}; }
        bf16_t* base = QKV + (size_t)hidx * MTOK * 64 + 8 * fq;
#pragma unroll
        for (int ai = 0; ai < 2; ++ai)
#pragma unroll
            for (int m = 0; m < 4; ++m) {
                const int row = u.pm * BM + ai * HALF + wr * 64 + m * 16 + fr;
                f32x4 v[2][2];
#pragma unroll
                for (int bj = 0; bj < 2; ++bj)
#pragma unroll
                    for (int n = 0; n < 2; ++n) v[bj][n] = acc[ai][bj][m][n];
                if (gain) {
                    float ss = (sq4(v[0][0]) + sq4(v[0][1])) + (sq4(v[1][0]) + sq4(v[1][1]));
                    ss = sum_xor32(sum_xor16(ss));
                    const float r = rsqrtf(ss * (1.f / 64.f) + RMS_EPS) * qs;
#pragma unroll
                    for (int bj = 0; bj < 2; ++bj)
#pragma unroll
                        for (int n = 0; n < 2; ++n) v[bj][n] = v[bj][n] * r * g[bj][n];
                    if (rope) {
                        const int pos = row < TP ? row : ((row - TP) & (TS - 1));
                        const f32x4 c = *(const f32x4*)(rc + pos * 8 + 4 * (fq & 1)), s = *(const f32x4*)(rs + pos * 8 + 4 * (fq & 1));
                        if (fq < 2) { const f32x4 x1 = v[0][0], x2 = v[0][1]; v[0][0] = x1 * c - x2 * s; v[0][1] = x2 * c + x1 * s; }
                    }
                }
                bf16_t* rowp = base + (size_t)row * 64;
                __builtin_nontemporal_store(pack8(v[0][0], v[0][1]), (u32x4*)(rowp));
                __builtin_nontemporal_store(pack8(v[1][0], v[1][1]), (u32x4*)(rowp + 32));
            }
    }
};
struct EpiMemKV {
    static constexpr bool PERM = true, AFTER_DRAIN = false, KSCALE = false, PREP = false, PREFETCH = false; static constexpr int KS_T1 = -1, KS_T2 = -1;
    bf16_t* MK; bf16_t* MV; const float* gk;
    __device__ __forceinline__ void operator()(const f32x4 (&acc)[2][2][4][2], const Unit& u, int wr, int wc, int fr, int fq) const {
        const int hidx = u.pn * 4 + wc; const bool isk = hidx < 4; const int h = hidx & 3;
        f32x4 g[2][2];
#pragma unroll
        for (int bj = 0; bj < 2; ++bj)
#pragma unroll
            for (int n = 0; n < 2; ++n) g[bj][n] = isk ? *(const f32x4*)(gk + 32 * bj + 8 * fq + 4 * n) : (f32x4){1.f, 1.f, 1.f, 1.f};
        bf16_t* base = (isk ? MK : MV) + 8 * fq;
#pragma unroll
        for (int ai = 0; ai < 2; ++ai)
#pragma unroll
            for (int m = 0; m < 4; ++m) {
                const int row = u.pm * BM + ai * HALF + wr * 64 + m * 16 + fr;
                f32x4 v[2][2];
#pragma unroll
                for (int bj = 0; bj < 2; ++bj)
#pragma unroll
                    for (int n = 0; n < 2; ++n) v[bj][n] = acc[ai][bj][m][n];
                if (isk) {
                    float ss = (sq4(v[0][0]) + sq4(v[0][1])) + (sq4(v[1][0]) + sq4(v[1][1]));
                    ss = sum_xor32(sum_xor16(ss));
                    const float r = rsqrtf(ss * (1.f / 64.f) + RMS_EPS);
#pragma unroll
                    for (int bj = 0; bj < 2; ++bj)
#pragma unroll
                        for (int n = 0; n < 2; ++n) v[bj][n] = v[bj][n] * r * g[bj][n];
                }
                bf16_t* rowp = base + ((size_t)((row >> 8) * 4 + h) * NMEM + (row & 255)) * 64;
                *(u32x4*)(rowp) = pack8(v[0][0], v[0][1]);
                *(u32x4*)(rowp + 32) = pack8(v[1][0], v[1][1]);
            }
    }
};
struct EpiX1 {
    static constexpr bool PERM = true, AFTER_DRAIN = false, KSCALE = true, PREP = true, PREFETCH = false; static constexpr int KS_T1 = 6, KS_T2 = 12;
    const bf16_t* xn; const float* irstd; const float* gin; bf16_t* x1b; float* ssq; const float* ssqa;
    static constexpr int TBL_OFF = 131072, GTBL_OFF = 131072 + 8192;
    __device__ __forceinline__ void prep(const Unit& u, PG8_LAS unsigned char* lds, int idx, int tid) const {
        if (tid < BM) { const f32x4* qp = (const f32x4*)(ssqa + (size_t)(u.pm * BM + tid) * 16); const f32x4 q0 = qp[0], q1 = qp[1], q2 = qp[2], q3 = qp[3];
            const float qa = (q0[0] + q0[1]) + (q0[2] + q0[3]) + (q1[0] + q1[1]), qb = (q1[2] + q1[3]) + (q2[0] + q2[1]) + (q2[2] + q2[3]), qm = (q3[0] + q3[1]) + (q3[2] + q3[3]);
            const float sa = rsqrtf(qa * (1.f / 384.f) + RMS_EPS), sb = rsqrtf(qb * (1.f / 384.f) + RMS_EPS), sm = rsqrtf(qm * (1.f / 256.f) + RMS_EPS);
            *(PG8_LAS f32x4*)(lds + TBL_OFF + (idx & 1) * 4096 + tid * 16) = (f32x4){sa / sb, sb / sm, sm, irstd[u.pm * BM + tid]}; }
        else { const int c = tid - BM; *(PG8_LAS float*)(lds + GTBL_OFF + (idx & 1) * 1024 + c * 4) = 1.0f / gin[u.pn * BM + c]; }
    }
    __device__ __forceinline__ void kscale(f32x4 (&acc)[2][2][4][2], int t, int wr, int fr, PG8_LAS unsigned char* lds, int idx) const {
        const PG8_LAS float* tb = (const PG8_LAS float*)(lds + TBL_OFF + (idx & 1) * 4096) + ((t == KS_T1) ? 0 : 1);
#pragma unroll
        for (int ai = 0; ai < 2; ++ai)
#pragma unroll
            for (int m = 0; m < 4; ++m) {
                const float f = tb[(ai * HALF + wr * 64 + m * 16 + fr) * 4];
#pragma unroll
                for (int bj = 0; bj < 2; ++bj)
#pragma unroll
                    for (int n = 0; n < 2; ++n) acc[ai][bj][m][n] = acc[ai][bj][m][n] * f;
            }
    }
    __device__ __forceinline__ void epi(const f32x4 (&acc)[2][2][4][2], const Unit& u, int wr, int wc, int fr, int fq, PG8_LAS unsigned char* lds, int idx) const {
        const PG8_LAS float* tb = (const PG8_LAS float*)(lds + TBL_OFF + (idx & 1) * 4096);
        const PG8_LAS f32x4* gt = (const PG8_LAS f32x4*)(lds + GTBL_OFF + (idx & 1) * 1024 + (wc * 32 + 8 * fq) * 4);
        f32x4 ig[2][2];
#pragma unroll
        for (int bj = 0; bj < 2; ++bj) { ig[bj][0] = gt[bj * 32]; ig[bj][1] = gt[bj * 32 + 1]; }
        const int col0 = u.pn * BM + wc * 32 + 8 * fq;
#pragma unroll
        for (int ai = 0; ai < 2; ++ai) {
            u32x4 xr[4][2];
#pragma unroll
            for (int m = 0; m < 4; ++m) { const bf16_t* xrow = xn + (size_t)(u.pm * BM + ai * HALF + wr * 64 + m * 16 + fr) * DM + col0;
#pragma unroll
                for (int bj = 0; bj < 2; ++bj) xr[m][bj] = __builtin_nontemporal_load((const u32x4*)(xrow + bj * HALF)); }
#pragma unroll
            for (int m = 0; m < 4; ++m) {
                const int rl = ai * HALF + wr * 64 + m * 16 + fr, row = u.pm * BM + rl;
                const float sm = tb[rl * 4 + 2], ir = tb[rl * 4 + 3];
                bf16_t* brow = x1b + (size_t)row * DM + col0;
                float ss = 0.f;
#pragma unroll
                for (int bj = 0; bj < 2; ++bj) {
                    const u32x4 r = xr[m][bj];
                    const f32x4 r0 = {__uint_as_float(r.x << 16), __uint_as_float(r.x & 0xffff0000u), __uint_as_float(r.y << 16), __uint_as_float(r.y & 0xffff0000u)};
                    const f32x4 r1 = {__uint_as_float(r.z << 16), __uint_as_float(r.z & 0xffff0000u), __uint_as_float(r.w << 16), __uint_as_float(r.w & 0xffff0000u)};
                    const f32x4 v0 = acc[ai][bj][m][0] * sm + r0 * ig[bj][0] * ir, v1 = acc[ai][bj][m][1] * sm + r1 * ig[bj][1] * ir;
                    *(u32x4*)(brow + bj * HALF) = pack8(v0, v1);
                    ss += sq4(v0) + sq4(v1);
                }
                ss = sum_xor32(sum_xor16(ss));
                if (fq == 0) ssq[(size_t)row * 16 + u.pn * 4 + wc] = ss;
            }
            asm volatile("" ::: "memory");
        }
    }
};
struct EpiH {
    static constexpr bool PERM = true, AFTER_DRAIN = false, KSCALE = false, PREP = true, PREFETCH = false; static constexpr int KS_T1 = -1, KS_T2 = -1;
    bf16_t* H; const float* ssq; int mode;
    static constexpr int TBL_OFF = 131072;
    __device__ __forceinline__ void prep(const Unit& u, PG8_LAS unsigned char* lds, int idx, int tid) const {
        if (tid < BM) { const f32x4* qp = (const f32x4*)(ssq + (size_t)(u.pm * BM + tid) * 16); const f32x4 q0 = qp[0], q1 = qp[1], q2 = qp[2], q3 = qp[3];
            const float s = ((q0[0] + q0[1]) + (q0[2] + q0[3])) + ((q1[0] + q1[1]) + (q1[2] + q1[3])) + ((q2[0] + q2[1]) + (q2[2] + q2[3])) + ((q3[0] + q3[1]) + (q3[2] + q3[3]));
            *(PG8_LAS float*)(lds + TBL_OFF + (idx & 1) * 1024 + tid * 4) = rsqrtf(s * (1.f / DM) + RMS_EPS); }
    }
    __device__ __forceinline__ void epi(const f32x4 (&acc)[2][2][4][2], const Unit& u, int wr, int wc, int fr, int fq, PG8_LAS unsigned char* lds, int idx) const {
        if (mode == 2) return;
        const PG8_LAS float* tb = (const PG8_LAS float*)(lds + TBL_OFF + (idx & 1) * 1024);
        const int col0 = u.pn * BM + wc * 32 + 8 * fq;
#pragma unroll
        for (int ai = 0; ai < 2; ++ai)
#pragma unroll
            for (int m = 0; m < 4; ++m) {
                const int row = u.pm * BM + ai * HALF + wr * 64 + m * 16 + fr;
                const float r = tb[ai * HALF + wr * 64 + m * 16 + fr];
                bf16_t* hrow = H + (size_t)row * FF + col0;
#pragma unroll
                for (int bj = 0; bj < 2; ++bj) {
                    f32x4 v0 = acc[ai][bj][m][0] * r, v1 = acc[ai][bj][m][1] * r;
#pragma unroll
                    for (int e = 0; e < 4; ++e) { const float a = fmaxf(v0[e], 0.f), b = fmaxf(v1[e], 0.f); v0[e] = a * a; v1[e] = b * b; }
                    const u32x4 pk = pack8(v0, v1); if (mode == 0) *(u32x4*)(hrow + bj * HALF) = pk; else asm volatile("" :: "v"(pk));
                }
            }
    }
};
struct EpiOut {
    static constexpr bool PERM = true, AFTER_DRAIN = false, KSCALE = false, PREP = false, PREFETCH = false; static constexpr int KS_T1 = -1, KS_T2 = -1;
    float* out; const bf16_t* x1b;
    static constexpr int JUNK_OFF = 131072 + 8192;
    __device__ __forceinline__ void prefetch(const Unit& u, PG8_LAS unsigned char* lds, int tid) const {
        const int wid = tid >> 6;
#pragma unroll
        for (int i = 0; i < 2; ++i) { const int line = i * 512 + tid; const bf16_t* src = x1b + (size_t)(u.pm * BM + (line >> 2)) * DM + u.pn * BM + (line & 3) * 64;
            __builtin_amdgcn_global_load_lds((const unsigned*)src, (PG8_LAS unsigned*)(lds + JUNK_OFF + (wid & 3) * 256), 4, 0, 0); }
    }
    __device__ __forceinline__ void operator()(const f32x4 (&acc)[2][2][4][2], const Unit& u, int wr, int wc, int fr, int fq) const {
        const int col0 = u.pn * BM + wc * 32 + 8 * fq;
#pragma unroll
        for (int ai = 0; ai < 2; ++ai) {
            u32x4 rr[4][2];
#pragma unroll
            for (int m = 0; m < 4; ++m) { const bf16_t* brow = x1b + (size_t)(u.pm * BM + ai * HALF + wr * 64 + m * 16 + fr) * DM + col0;
#pragma unroll
                for (int bj = 0; bj < 2; ++bj) rr[m][bj] = *(const u32x4*)(brow + bj * HALF); }
#pragma unroll
            for (int m = 0; m < 4; ++m) {
                const int row = u.pm * BM + ai * HALF + wr * 64 + m * 16 + fr;
                float* orow = out + (size_t)row * DM + col0;
#pragma unroll
                for (int bj = 0; bj < 2; ++bj) {
                    const u32x4 r = rr[m][bj];
                    const f32x4 r0 = {__uint_as_float(r.x << 16), __uint_as_float(r.x & 0xffff0000u), __uint_as_float(r.y << 16), __uint_as_float(r.y & 0xffff0000u)};
                    const f32x4 r1 = {__uint_as_float(r.z << 16), __uint_as_float(r.z & 0xffff0000u), __uint_as_float(r.w << 16), __uint_as_float(r.w & 0xffff0000u)};
                    *(f32x4*)(orow + bj * HALF) = acc[ai][bj][m][0] + r0; *(f32x4*)(orow + bj * HALF + 4) = acc[ai][bj][m][1] + r1;
                }
            }
            asm volatile("" ::: "memory");
        }
    }
};

template <class Epi, class Sched, bool ALIGN_EPI = false, bool SP2 = false>
__device__ __forceinline__ void gemm_phase(PG8_LAS unsigned char* lds, const Gemm g, const Sched& S, const Epi& E) {
    const int tid = threadIdx.x, wid = __builtin_amdgcn_readfirstlane(tid >> 6), lane = tid & 63, wr = wid >> 2, wc = wid & 3, fr = lane & 15, fq = lane >> 4;
    const int K = g.K, nt = K / BK;
    unsigned voffA[2], voffB[2];
#pragma unroll
    for (int i = 0; i < 2; ++i) { int R, C; stage_rc(tid * 16 + i * 8192, R, C); const int Rb = Epi::PERM ? ((R & ~31) + perm32(R & 31)) : R;
        voffA[i] = (unsigned)(R * K + C) * 2u; voffB[i] = (unsigned)(Rb * K + C) * 2u; }
    const size_t kstep = (size_t)(BK * 2);
    const size_t hstep = (size_t)HALF * K * 2;
    const size_t tstep = 2 * hstep;
    const unsigned ldsw = (unsigned)wid * 1024u;
    const int aoff = lds_byte(wr * 64 + fr, fq * 8), boff = lds_byte(wc * 32 + fr, fq * 8);
#define PG8_SA(b, h) (((b) * 2 + (h)) * HTB)
#define PG8_SB(b, h) ((4 + (b) * 2 + (h)) * HTB)
#define PG8_STAGE(bufoff, gbase, voff) do { _Pragma("unroll") for (int _i = 0; _i < 2; ++_i) \
        __builtin_amdgcn_global_load_lds((const unsigned*)((const char*)(gbase) + (voff)[_i]), (PG8_LAS unsigned*)(lds + (bufoff) + ldsw + _i * 8192), 16, 0, 0); } while (0)
#define PG8_LDA(dst, b, h) do { _Pragma("unroll") for (int m = 0; m < 4; ++m) _Pragma("unroll") for (int k = 0; k < 2; ++k) dst[m][k] = *(const PG8_LAS bf16x8*)(lds + PG8_SA(b, h) + aoff + m * 2048 + k * 1024); } while (0)
#define PG8_LDB(dst, b, h) do { _Pragma("unroll") for (int n = 0; n < 2; ++n) _Pragma("unroll") for (int k = 0; k < 2; ++k) dst[n][k] = *(const PG8_LAS bf16x8*)(lds + PG8_SB(b, h) + boff + n * 2048 + k * 1024); } while (0)
#define PG8_MMA(ai, bj, At, Bt) do { __builtin_amdgcn_s_setprio(1); _Pragma("unroll") for (int m = 0; m < 4; ++m) _Pragma("unroll") for (int n = 0; n < 2; ++n) _Pragma("unroll") for (int k = 0; k < 2; ++k) \
        acc[ai][bj][m][n] = __builtin_amdgcn_mfma_f32_16x16x32_bf16(Bt[n][k], At[m][k], acc[ai][bj][m][n], 0, 0, 0); __builtin_amdgcn_s_setprio(0); } while (0)
#define PG8_WAIT_V(n) asm volatile("s_waitcnt vmcnt(" #n ")" ::: "memory")
#define PG8_WAIT_L(n) asm volatile("s_waitcnt lgkmcnt(" #n ")" ::: "memory")
#define PG8_BAR __builtin_amdgcn_s_barrier()
#define PG8_SCHED __builtin_amdgcn_sched_barrier(0)
    Unit cur, nxt; int ui = 0;
    if (!S.next(0, cur)) return;
    PT_SUB_L(lds, 5);
    f32x4 acc[2][2][4][2];
#pragma unroll
    for (int a = 0; a < 2; ++a)
#pragma unroll
        for (int b = 0; b < 2; ++b)
#pragma unroll
            for (int m = 0; m < 4; ++m)
#pragma unroll
                for (int n = 0; n < 2; ++n) acc[a][b][m][n] = (f32x4){0.f, 0.f, 0.f, 0.f};
    bf16x8 At[4][2], B0[2][2], B1[2][2];
    const char* cA = (const char*)g.A + (size_t)cur.pm * tstep; const char* cB = (const char*)g.Bt + (size_t)cur.pn * tstep;
    S.a_ready(cur);
    if constexpr (Epi::PREP) E.prep(cur, lds, 0, tid);
    if constexpr (SP2) {
        PG8_STAGE(PG8_SB(0, 0), cB, voffB); PG8_STAGE(PG8_SB(0, 1), cB + hstep, voffB); PG8_STAGE(PG8_SA(0, 0), cA, voffA); PG8_STAGE(PG8_SA(0, 1), cA + hstep, voffA);
        if (wr == 1) PG8_BAR;
        PG8_WAIT_V(2); PG8_BAR;
        PG8_STAGE(PG8_SB(1, 0), cB + kstep, voffB); PG8_STAGE(PG8_SA(1, 0), cA + kstep, voffA); PG8_STAGE(PG8_SB(1, 1), cB + hstep + kstep, voffB);
        PG8_WAIT_V(6); PG8_BAR;
    } else {
        PG8_STAGE(PG8_SB(0, 0), cB, voffB); PG8_STAGE(PG8_SA(0, 0), cA, voffA); PG8_STAGE(PG8_SB(0, 1), cB + hstep, voffB); PG8_STAGE(PG8_SA(0, 1), cA + hstep, voffA);
        if (wr == 1) PG8_BAR;
        PG8_WAIT_V(4); PG8_BAR;
        PG8_STAGE(PG8_SB(1, 0), cB + kstep, voffB); PG8_STAGE(PG8_SA(1, 0), cA + kstep, voffA); PG8_STAGE(PG8_SB(1, 1), cB + hstep + kstep, voffB);
        PG8_WAIT_V(6); PG8_BAR;
    }
    for (;;) {
        const bool has_next = S.next(ui + 1, nxt);
        const char* nA = has_next ? (const char*)g.A + (size_t)nxt.pm * tstep : cA; const char* nB = has_next ? (const char*)g.Bt + (size_t)nxt.pn * tstep : cB;
        for (int t = 0; t < nt; t += 2) {
            const bool last = (t == nt - 2);
            if constexpr (Epi::KSCALE) { if (t == Epi::KS_T1 || t == Epi::KS_T2) E.kscale(acc, t, wr, fr, lds, ui); }
            if constexpr (Epi::PREFETCH) { if (t == 4) E.prefetch(cur, lds, tid); }
            const char* a1 = cA + (size_t)(t + 1) * kstep;
            const char* a2 = last ? nA : cA + (size_t)(t + 2) * kstep; const char* b2 = last ? nB : cB + (size_t)(t + 2) * kstep;
            const char* a3 = a2 + kstep; const char* b3 = b2 + kstep;
            if (last && has_next) { S.a_ready(nxt); if constexpr (Epi::PREP) E.prep(nxt, lds, ui + 1, tid); }
            if constexpr (SP2) {
            PG8_LDB(B0, 0, 0); PG8_LDB(B1, 0, 1); PG8_SCHED; PG8_LDA(At, 0, 0); PG8_STAGE(PG8_SA(1, 1), a1 + hstep, voffA);
            PG8_WAIT_V(8); PG8_WAIT_L(0); PG8_BAR; PG8_MMA(0, 0, At, B0); PG8_MMA(0, 1, At, B1); PG8_BAR; PG8_SCHED;
            PG8_LDA(At, 0, 1); PG8_STAGE(PG8_SB(0, 0), b2, voffB); PG8_STAGE(PG8_SB(0, 1), b2 + hstep, voffB); PG8_STAGE(PG8_SA(0, 0), a2, voffA);
            PG8_WAIT_V(8); PG8_WAIT_L(0); PG8_BAR; PG8_MMA(1, 0, At, B0); PG8_MMA(1, 1, At, B1); PG8_BAR; PG8_SCHED;
            PG8_LDB(B0, 1, 0); PG8_LDB(B1, 1, 1); PG8_SCHED; PG8_LDA(At, 1, 0); PG8_STAGE(PG8_SA(0, 1), a2 + hstep, voffA);
            PG8_WAIT_V(8); PG8_WAIT_L(0); PG8_BAR; PG8_MMA(0, 0, At, B0); PG8_MMA(0, 1, At, B1); PG8_BAR; PG8_SCHED;
            PG8_LDA(At, 1, 1); PG8_STAGE(PG8_SB(1, 0), b3, voffB); PG8_STAGE(PG8_SB(1, 1), b3 + hstep, voffB); PG8_STAGE(PG8_SA(1, 0), a3, voffA);
            PG8_WAIT_V(8); PG8_WAIT_L(0); PG8_BAR; PG8_MMA(1, 0, At, B0); PG8_MMA(1, 1, At, B1); PG8_BAR; PG8_SCHED;
            } else {
            PG8_LDB(B0, 0, 0); PG8_SCHED; PG8_LDA(At, 0, 0); PG8_STAGE(PG8_SA(1, 1), a1 + hstep, voffA);
            PG8_WAIT_L(8); PG8_BAR; PG8_WAIT_L(0); PG8_MMA(0, 0, At, B0); PG8_BAR; PG8_SCHED;
            PG8_LDB(B1, 0, 1); PG8_STAGE(PG8_SB(0, 0), b2, voffB);
            PG8_BAR; PG8_WAIT_L(0); PG8_MMA(0, 1, At, B1); PG8_BAR;
            PG8_LDA(At, 0, 1); PG8_STAGE(PG8_SA(0, 0), a2, voffA);
            PG8_BAR; PG8_WAIT_L(0); PG8_MMA(1, 0, At, B0); PG8_BAR; PG8_SCHED;
            PG8_STAGE(PG8_SB(0, 1), b2 + hstep, voffB);
            PG8_WAIT_V(6); PG8_BAR; PG8_MMA(1, 1, At, B1); PG8_BAR;
            PG8_LDB(B0, 1, 0); PG8_SCHED; PG8_LDA(At, 1, 0); PG8_STAGE(PG8_SA(0, 1), a2 + hstep, voffA);
            PG8_WAIT_L(8); PG8_BAR; PG8_WAIT_L(0); PG8_MMA(0, 0, At, B0); PG8_BAR; PG8_SCHED;
            PG8_LDB(B1, 1, 1); PG8_STAGE(PG8_SB(1, 0), b3, voffB);
            PG8_BAR; PG8_WAIT_L(0); PG8_MMA(0, 1, At, B1); PG8_BAR;
            PG8_LDA(At, 1, 1); PG8_STAGE(PG8_SA(1, 0), a3, voffA);
            PG8_BAR; PG8_WAIT_L(0); PG8_MMA(1, 0, At, B0); PG8_BAR; PG8_SCHED;
            PG8_STAGE(PG8_SB(1, 1), b3 + hstep, voffB);
            PG8_WAIT_V(6); PG8_BAR; PG8_MMA(1, 1, At, B1); PG8_BAR;
            }
        }
        if constexpr (ALIGN_EPI) { if (wr == 0) PG8_BAR; }
        PT_SUB_L(lds, 4);
        if constexpr (!Epi::AFTER_DRAIN) { if constexpr (Epi::PREP) E.epi(acc, cur, wr, wc, fr, fq, lds, ui); else E(acc, cur, wr, wc, fr, fq); S.done(cur); }
        PT_ADD_L(lds, 4);
        if (!has_next) break;
#pragma unroll
        for (int a = 0; a < 2; ++a)
#pragma unroll
            for (int b = 0; b < 2; ++b)
#pragma unroll
                for (int m = 0; m < 4; ++m)
#pragma unroll
                    for (int n = 0; n < 2; ++n) acc[a][b][m][n] = (f32x4){0.f, 0.f, 0.f, 0.f};
        cur = nxt; cA = nA; cB = nB; ++ui;
        if constexpr (ALIGN_EPI) { if (wr == 1) PG8_BAR; }
    }
    PT_ADD_L(lds, 5);
    PG8_WAIT_V(0);
    if constexpr (!ALIGN_EPI) { if (wr == 0) PG8_BAR; }
    PG8_BAR;
    if constexpr (Epi::AFTER_DRAIN) { E.fused(acc, cur, wr, wc, fr, fq, lds, wid, lane); S.done(cur); }
#undef PG8_SA
#undef PG8_SB
#undef PG8_STAGE
#undef PG8_LDA
#undef PG8_LDB
#undef PG8_MMA
#undef PG8_WAIT_V
#undef PG8_WAIT_L
#undef PG8_BAR
#undef PG8_SCHED
}
}

constexpr int NWAVES = 8;
#ifndef MK_N_LAUNCHES
#define MK_N_LAUNCHES 1
#endif
constexpr int NPH = 7;
constexpr int N_LAUNCHES = MK_N_LAUNCHES;

constexpr size_t MiB = 1u << 20;
constexpr size_t WS_CTL = 0, CTL_ZERO_BYTES = 1 * MiB;
constexpr size_t WS_SSQF = 27 * MiB;
constexpr size_t WS_SSQA = 464 * MiB;
constexpr size_t WS_ROPE = 2 * MiB;
constexpr size_t WS_WIN = 3 * MiB, WS_WMEM = 8 * MiB, WS_WOUT = 9 * MiB, WS_W1 = 11 * MiB, WS_W2 = 19 * MiB;
constexpr size_t WS_XNMEM = 27 * MiB, WS_MK = 30 * MiB, WS_MV = 31 * MiB;
constexpr size_t WS_X1B = 32 * MiB;
constexpr size_t WS_XN = 128 * MiB;
constexpr size_t WS_IRSTD = 467 * MiB;
constexpr size_t WS_QKV = 224 * MiB;
constexpr size_t WS_H = 128 * MiB;
constexpr size_t WS_END = 512 * MiB;
static_assert(WS_QKV + (size_t)NHEADS * MTOK * 64 * 2 <= WS_END && WS_H + (size_t)MTOK * FF * 2 <= WS_END && WS_X1B + (size_t)MTOK * DM * 2 <= WS_XN && WS_XN + (size_t)MTOK * DM * 2 <= WS_QKV, "d_ws map");

#define LAS __attribute__((address_space(3)))
typedef unsigned short bf16;
typedef unsigned v4u __attribute__((ext_vector_type(4)));
typedef float f32x4 __attribute__((ext_vector_type(4)));
#define LDS_WAIT() asm volatile("s_waitcnt lgkmcnt(0)" ::: "memory")
__device__ __forceinline__ unsigned f2bf(float f) { unsigned u = __builtin_bit_cast(unsigned, f); return (u + 0x7fffu + ((u >> 16) & 1u)) >> 16; }
__device__ __forceinline__ unsigned pk2(float lo, float hi) { return f2bf(lo) | (f2bf(hi) << 16); }
__device__ __forceinline__ float bflo(unsigned w) { return __uint_as_float(w << 16); }
__device__ __forceinline__ float bfhi(unsigned w) { return __uint_as_float(w & 0xffff0000u); }
__device__ __forceinline__ float wave_sum(float v) {
#pragma unroll
    for (int o = 1; o < 64; o <<= 1) v += __shfl_xor(v, o);
    return v;
}

struct Frame {
    LAS unsigned char* lds;
    int tid, lane, wave, vcu, G, tm;
    float* out; unsigned char* ws;
};
struct Args { const float* in[22]; float* out; unsigned char* ws; int ph_lo, ph_hi; };


namespace att {
typedef short bf16x8 __attribute__((ext_vector_type(8)));
typedef short s16x4 __attribute__((ext_vector_type(4)));
typedef short v4i16_t __attribute__((ext_vector_type(4)));
typedef float f32x16 __attribute__((ext_vector_type(16)));
typedef float f32x4 __attribute__((ext_vector_type(4)));
typedef unsigned u32x4 __attribute__((ext_vector_type(4)));
typedef float f32x2_t __attribute__((ext_vector_type(2))); typedef __bf16 bf16x2_t __attribute__((ext_vector_type(2)));
typedef __attribute__((address_space(3))) unsigned char* lptr;
__device__ __forceinline__ unsigned cvtpk(float lo, float hi) { f32x2_t v = {lo, hi}; bf16x2_t b = __builtin_convertvector(v, bf16x2_t); return __builtin_bit_cast(unsigned, b); }
__device__ __forceinline__ s16x4 vtr(lptr p) { return __builtin_bit_cast(s16x4, __builtin_amdgcn_ds_read_tr16_b64_v4i16((__attribute__((address_space(3))) v4i16_t*)p)); }
__device__ __forceinline__ int creg(int r) { return (r & 3) + 8 * (r >> 2); }
constexpr float NEG = -INFINITY;

__device__ __forceinline__ void load_q(bf16x8 (&qr)[4], const bf16* qrow, int lane) {
    const int hi = lane >> 5;
#pragma unroll
    for (int d0 = 0; d0 < 4; ++d0) qr[d0] = *(const bf16x8*)(qrow + 16 * d0 + 8 * hi);
}
}
template <class CM, class KS>
__device__ __forceinline__ void p0_transpose_item(const float* W, int K, int N, bf16* WT, LAS float* scr, int item, int lane, CM cm, KS ks) {
    const int nblk = N / 32, kb = item / nblk, nb = item % nblk, k0 = 64 * kb, n0 = 32 * nb;
    const int sc = cm(n0 + (lane & 31));
#pragma unroll
    for (int i = 0; i < 32; ++i) { const int kk = 2 * i + (lane >> 5); scr[kk * 33 + (lane & 31)] = __builtin_nontemporal_load(W + (size_t)(k0 + kk) * N + sc) * ks(k0 + kk); }
    LDS_WAIT(); asm volatile("" ::: "memory");
    const int c = lane & 7;
#pragma unroll
    for (int j = 0; j < 4; ++j) { const int n = (lane >> 3) + 8 * j; const LAS float* s = scr + (8 * c) * 33 + n;
        v4u o; o.x = pk2(s[0 * 33], s[1 * 33]); o.y = pk2(s[2 * 33], s[3 * 33]); o.z = pk2(s[4 * 33], s[5 * 33]); o.w = pk2(s[6 * 33], s[7 * 33]);
        *(v4u*)(WT + (size_t)(n0 + n) * K + k0 + 8 * c) = o; }
    LDS_WAIT(); asm volatile("" ::: "memory");
}
struct CMapHead { int nrope;
    __device__ __forceinline__ int operator()(int c) const { const int pn = c >> 8, bj = (c >> 7) & 1, hh = (c >> 5) & 3, p5 = c & 31, hidx = 4 * pn + hh; int p = 32 * bj + p5;
        if (hidx < nrope && p < 16) p = (p & 3) + 8 * ((p >> 2) & 1) + 4 * (p >> 3); return 64 * hidx + p; } };
struct CMapId { __device__ __forceinline__ int operator()(int c) const { return c; } };
struct KSOne { __device__ __forceinline__ float operator()(int) const { return 1.f; } };
struct KSVec { const float* g; __device__ __forceinline__ float operator()(int k) const { return g[k]; } };
struct KSOut { const float *a, *b, *m; __device__ __forceinline__ float operator()(int k) const { return k < 384 ? a[k] : (k < 768 ? b[k - 384] : m[k - 768]); } };

template <int CTRL> __device__ __forceinline__ float dpp_mov(float v) { return __uint_as_float((unsigned)__builtin_amdgcn_update_dpp(0, (int)__float_as_uint(v), CTRL, 0xf, 0xf, true)); }
__device__ __forceinline__ float wave_sum_dpp(float v) {
    v += dpp_mov<0xB1>(v); v += dpp_mov<0x4E>(v); v += dpp_mov<0x141>(v); v += dpp_mov<0x140>(v); return pg8::sum_xor32(pg8::sum_xor16(v)); }
template <int NR> __device__ __forceinline__ void rms_rows_to_bf16(const float* const (&xrow)[NR], const float* g, bf16* const (&orow)[NR], float* irstd, int lane) {
    f32x4 v[NR][4], gg[4];
#pragma unroll
    for (int j = 0; j < 4; ++j) gg[j] = ((const f32x4*)g + lane)[64 * j];
#pragma unroll
    for (int r = 0; r < NR; ++r) { const f32x4* xr = (const f32x4*)xrow[r] + lane;
#pragma unroll
        for (int j = 0; j < 4; ++j) v[r][j] = __builtin_nontemporal_load(xr + 64 * j); }
    float rs[NR];
#pragma unroll
    for (int r = 0; r < NR; ++r) {
        float s = 0.f;
#pragma unroll
        for (int j = 0; j < 4; ++j) s += (v[r][j].x * v[r][j].x + v[r][j].y * v[r][j].y) + (v[r][j].z * v[r][j].z + v[r][j].w * v[r][j].w);
        const float ms = wave_sum_dpp(s) * (1.f / DM) + RMS_EPS; rs[r] = rsqrtf(ms);
        if (irstd && lane == 0) irstd[r] = sqrtf(ms);
    }
#pragma unroll
    for (int r = 0; r < NR; ++r) {
        unsigned long long* o8 = (unsigned long long*)orow[r] + lane; const float rstd = rs[r];
#pragma unroll
        for (int j = 0; j < 4; ++j) o8[64 * j] = (unsigned long long)pg8::cvt_pk_bf16(v[r][j].x * rstd * gg[j].x, v[r][j].y * rstd * gg[j].y) | ((unsigned long long)pg8::cvt_pk_bf16(v[r][j].z * rstd * gg[j].z, v[r][j].w * rstd * gg[j].w) << 32);
    }
}
__device__ __forceinline__ void p0_prologue(Frame& F, const Args& A, const bool spec) {
    LAS float* scr = (LAS float*)(F.lds + F.wave * 16384);
    const int gw = F.vcu * NWAVES + F.wave, NGW = F.G * NWAVES;
    unsigned char* ws = F.ws;
    constexpr int I_IN = (DM / 64) * (NQKV / 32), I_MEM = (DM / 64) * (512 / 32), I_OUT = (DM / 64) * (DM / 32), I_1 = (DM / 64) * (FF / 32), I_2 = (FF / 64) * (DM / 32);
    constexpr int NITEMS = I_IN + I_MEM + I_OUT + I_1 + I_2;
    PT_SUB(F, 0);
    for (int it = gw; it < NITEMS; it += NGW) {
        int r = it;
        if (r < I_IN) { p0_transpose_item(A.in[5], DM, NQKV, (bf16*)(ws + WS_WIN), scr, r, F.lane, CMapHead{12}, KSOne{}); continue; } r -= I_IN;
        if (r < I_MEM) { p0_transpose_item(A.in[12], DM, 512, (bf16*)(ws + WS_WMEM), scr, r, F.lane, CMapHead{0}, KSOne{}); continue; } r -= I_MEM;
        if (r < I_OUT) { p0_transpose_item(A.in[18], DM, DM, (bf16*)(ws + WS_WOUT), scr, r, F.lane, CMapId{}, KSOut{A.in[15], A.in[16], A.in[17]}); continue; } r -= I_OUT;
        if (r < I_1) { p0_transpose_item(A.in[20], DM, FF, (bf16*)(ws + WS_W1), scr, r, F.lane, CMapId{}, KSVec{A.in[19]}); continue; } r -= I_1;
        p0_transpose_item(A.in[21], FF, DM, (bf16*)(ws + WS_W2), scr, r, F.lane, CMapId{}, KSOne{});
    }
    PT_ADD(F, 0); PT_SUB(F, 1);
    const int NG4 = spec ? (64 * 64 + MMEM / 4) : (MTOK + MMEM) / 4;
    for (int m4 = gw; m4 < NG4; m4 += NGW) {
        int m = 4 * m4; if (spec) { if (m4 < 4096) { const int p = m4 >> 6; m = ((24 * (p >> 3) + (p & 7)) << 8) + 4 * (m4 & 63); } else m = MTOK + 4 * (m4 - 4096); }
        const float* xr[4]; bf16* orw[4]; const float* gn; float* irs = nullptr;
        if (m < MTOK) { const float* x0 = m < TP ? A.in[0] + (size_t)m * DM : A.in[1] + (size_t)(m - TP) * DM; bf16* o0 = (bf16*)(ws + WS_XN) + (size_t)m * DM; gn = A.in[4]; irs = (float*)(ws + WS_IRSTD) + m;
#pragma unroll
            for (int r = 0; r < 4; ++r) { xr[r] = x0 + (size_t)r * DM; orw[r] = o0 + (size_t)r * DM; } }
        else { const int r0 = m - MTOK; const float* x0 = r0 < NMEM ? A.in[2] + (size_t)r0 * DM : A.in[3] + (size_t)(r0 - NMEM) * DM; bf16* o0 = (bf16*)(ws + WS_XNMEM) + (size_t)r0 * DM; gn = A.in[11];
#pragma unroll
            for (int r = 0; r < 4; ++r) { xr[r] = x0 + (size_t)r * DM; orw[r] = o0 + (size_t)r * DM; } }
        rms_rows_to_bf16<4>(xr, gn, orw, irs, F.lane);
    }
    PT_ADD(F, 1); PT_SUB(F, 2);
    float* rc = (float*)(ws + WS_ROPE); float* rs = rc + TP * 8;
    for (int i = (F.vcu * NWAVES * 64) + F.tid; i < TP * 8; i += F.G * NWAVES * 64) {
        const int pos = i >> 3, fi = i & 7;
        const float inv = exp2f(-(float)fi * 0.125f * 18.931568569324174f);
        const float ang = (float)pos * inv;
        const double rev = (double)ang * 0.15915494309189535; const float fr = (float)(rev - __builtin_rint(rev));
        rc[i] = __builtin_amdgcn_cosf(fr); rs[i] = __builtin_amdgcn_sinf(fr);
    }
    PT_ADD(F, 2);
}
__device__ __forceinline__ void p1_convert(Frame& F, const Args& A, int x, int j) {
    unsigned* ready = (unsigned*)(F.ws + WS_CTL) + CW_READY;
    for (int g = 1; g <= 2; ++g) {
        const int row0 = (24 * x + 8 * g) * 256;
        for (int s = 0; s < 2048 / (pg8::NCV * NWAVES * 8); ++s) {
            const int m = row0 + (pg8::NCV * NWAVES * 8) * s + (j * NWAVES + F.wave) * 8;
            const float* x0 = m < TP ? A.in[0] + (size_t)m * DM : A.in[1] + (size_t)(m - TP) * DM; bf16* o0 = (bf16*)(F.ws + WS_XN) + (size_t)m * DM;
            const float* xr[8]; bf16* orw[8];
#pragma unroll
            for (int r = 0; r < 8; ++r) { xr[r] = x0 + (size_t)r * DM; orw[r] = o0 + (size_t)r * DM; }
            rms_rows_to_bf16<8>(xr, A.in[4], orw, (float*)(F.ws + WS_IRSTD) + m, F.lane);
        }
        asm volatile("s_waitcnt vmcnt(0)" ::: "memory"); __syncthreads();
        if (F.tid == 0) { __builtin_amdgcn_fence(__ATOMIC_RELEASE, "agent"); asm volatile("s_waitcnt vmcnt(0)" ::: "memory");
            (void)__hip_atomic_fetch_add(ready + 64 * (2 * x + g - 1), 1u, __ATOMIC_RELAXED, __HIP_MEMORY_SCOPE_AGENT); }
    }
}
#define XB_TMO      128
#define XB_XCNT(j)  (256  + 64 * (j))
#define XB_XSUB(j)  (1280 + 64 * (j))
#define XB_XGEN(j)  (2304 + 64 * (j))
#define XB_TOP      3328
#define XB_TOPGEN   3392
#define XCD_BAR_WORDS 3456
#define XB_SPIN_CAP (1u << 18)

__device__ __forceinline__ unsigned xb_ld(unsigned* p)              { return __hip_atomic_load(p, __ATOMIC_RELAXED, __HIP_MEMORY_SCOPE_AGENT); }
__device__ __forceinline__ unsigned xb_add(unsigned* p, unsigned v) { return __hip_atomic_fetch_add(p, v, __ATOMIC_RELAXED, __HIP_MEMORY_SCOPE_AGENT); }
__device__ __forceinline__ unsigned xb_xcc_id() { return (unsigned)__builtin_amdgcn_s_getreg((3 << 11) | 20) & 0xFu; }
#define XB_SPIN(cond, bar) do { unsigned _sp = 0; while (cond) { __builtin_amdgcn_s_sleep(1); \
    if ((++_sp & 255u) == 0u) { if (xb_ld(&(bar)[XB_TMO])) break; if (_sp > XB_SPIN_CAP) { atomicAdd(&(bar)[XB_TMO], 1u); break; } } } } while (0)

struct XcdBarrier {
    unsigned* bar; unsigned x;
    volatile LAS unsigned* st;
};

__device__ __forceinline__ XcdBarrier xcd_barrier_post(unsigned* bar, volatile LAS unsigned* st) {
    XcdBarrier b; b.bar = bar; b.x = xb_xcc_id(); b.st = st;
    if (threadIdx.x == 0) (void)xb_add(&bar[XB_XCNT(b.x)], 1u);
    return b;
}
__device__ __forceinline__ void xcd_barrier_complete(unsigned* bar, unsigned x, unsigned& nloc, unsigned& nx) {
    const unsigned G = gridDim.x * gridDim.y * gridDim.z;
    unsigned sum, cnt, mine, sp = 0u;
    for (;;) {
        sum = 0u; cnt = 0u; mine = 0u;
#pragma unroll
        for (unsigned j = 0; j < 16; ++j) { const unsigned c = xb_ld(&bar[XB_XCNT(j)]); sum += c; cnt += (c > 0u) ? 1u : 0u; mine = (j == x) ? c : mine; }
        if (sum == G) break;
        __builtin_amdgcn_s_sleep(1);
        if ((++sp & 255u) == 0u) { if (xb_ld(&bar[XB_TMO])) break; if (sp > XB_SPIN_CAP) { atomicAdd(&bar[XB_TMO], 1u); break; } }
    }
    nloc = mine > 0u ? mine : 1u; nx = cnt > 0u ? cnt : 1u;
}

__device__ __forceinline__ void xcd_barrier(const XcdBarrier& b) {
    asm volatile("s_waitcnt vmcnt(0)" ::: "memory");
    __syncthreads();
    if (threadIdx.x == 0) {
        unsigned* bar = b.bar;
        __builtin_amdgcn_s_waitcnt(0);
        unsigned nloc = b.st[0], nx = b.st[1];
        if (nloc == 0u) { xcd_barrier_complete(bar, b.x, nloc, nx); b.st[0] = nloc; b.st[1] = nx; }
        const unsigned old = xb_add(&bar[XB_XSUB(b.x)], 1u);
        const unsigned gen = old / nloc;
        if (old + 1u == (gen + 1u) * nloc) {
            __builtin_amdgcn_fence(__ATOMIC_RELEASE, "agent");
            asm volatile("s_waitcnt vmcnt(0)" ::: "memory");
            const unsigned og = xb_add(&bar[XB_TOP], 1u);
            const unsigned tg = og / nx;
            if (og + 1u == (tg + 1u) * nx) xb_add(&bar[XB_TOPGEN], 1u);
            else XB_SPIN(xb_ld(&bar[XB_TOPGEN]) == tg, bar);
            __builtin_amdgcn_fence(__ATOMIC_ACQUIRE, "agent");
            xb_add(&bar[XB_XGEN(b.x)], 1u);
            asm volatile("s_waitcnt vmcnt(0)" ::: "memory");
        } else {
            XB_SPIN(xb_ld(&bar[XB_XGEN(b.x)]) == gen, bar);
            __builtin_amdgcn_fence(__ATOMIC_ACQUIRE, "agent");
            asm volatile("s_waitcnt vmcnt(0)" ::: "memory");
        }
    }
    __syncthreads();
}

struct SeqInfo { long sb; int T; int bat; };
__device__ __forceinline__ SeqInfo seq_of(int row) { SeqInfo s; if (row < TP) { s.sb = 0; s.T = TP; s.bat = 0; } else { const int b = (row - TP) >> 13; s.sb = TP + (long)b * TS; s.T = TS; s.bat = 1 + b; } return s; }


namespace att2 {
using att::bf16x8; using att::s16x4; using att::f32x16; using att::f32x4; using att::u32x4; using att::lptr; using att::creg; using att::cvtpk; using att::vtr; using att::NEG;
constexpr int NS = 4, SLOT = 32768, TILE = 16384, TV = 8192, VDH64 = 4096;
constexpr int L_RING = 0, L_TBL = NS * SLOT, TBLB = 3840, L_LS = L_TBL + 2 * TBLB, L_END = L_LS + 8 * 128;
static_assert(L_END <= LDS_MISC, "attention LDS map");
#define ATT2_WAITBAR(N) asm volatile("s_waitcnt vmcnt(" #N ") lgkmcnt(0)\n\ts_barrier" ::: "memory")

struct TileSrc { const bf16* K; const bf16* V; int p0, qs, T, pm; };
__device__ __forceinline__ void dma_tile(LAS unsigned char* tile, const TileSrc& s, int w, int lane) {
    const bool inside = (s.p0 >= 0) && (s.p0 + 63 * s.qs < s.T);
    { const int row = 8 * w + (lane >> 3); int p = s.p0 + row * s.qs; if (!inside) p = p < 0 ? 0 : (p >= s.T ? s.T - 1 : p); p &= s.pm;
      __builtin_amdgcn_global_load_lds((const unsigned*)(s.K + (size_t)p * 64 + 8 * ((lane & 7) ^ ((row >> 1) & 7))), (LAS unsigned*)(tile + w * 1024), 16, 0, 0); }
    { const int row = 16 * (w & 3) + (lane >> 2); int p = s.p0 + row * s.qs; if (!inside) p = p < 0 ? 0 : (p >= s.T ? s.T - 1 : p); p &= s.pm;
      __builtin_amdgcn_global_load_lds((const unsigned*)(s.V + (size_t)p * 64 + 32 * (w >> 2) + 8 * (lane & 3)), (LAS unsigned*)(tile + TV + (w >> 2) * VDH64 + (w & 3) * 1024), 16, 0, 0); }
}
__device__ __forceinline__ f32x16 qk_sub(lptr tile, int roff, const bf16x8 (&qr)[4], int lane) {
    const int r32 = lane & 31, hi = lane >> 5, row = roff + r32;
    lptr kp = tile + row * 128; const int sw = (row >> 1) & 7;
    f32x16 p = {};
#pragma unroll
    for (int d0 = 0; d0 < 4; ++d0) { const bf16x8 kf = *(__attribute__((address_space(3))) bf16x8*)(kp + (((2 * d0 + hi) ^ sw) * 16)); p = __builtin_amdgcn_mfma_f32_32x32x16_bf16(kf, qr[d0], p, 0, 0, 0); }
    return p;
}
__device__ __forceinline__ void pv_sub(lptr tile, int roff, f32x16& p, f32x16 (&o)[2], float& lsum, int lane) {
    const int hi = lane >> 5;
    float sacc = 0.f;
#pragma unroll
    for (int r = 0; r < 16; ++r) { p[r] = __builtin_amdgcn_exp2f(p[r]); sacc += p[r]; }
    lsum += sacc;
    u32x4 pw0, pw1;
    pw0[0] = cvtpk(p[0], p[1]); pw0[1] = cvtpk(p[2], p[3]); pw0[2] = cvtpk(p[4], p[5]); pw0[3] = cvtpk(p[6], p[7]);
    pw1[0] = cvtpk(p[8], p[9]); pw1[1] = cvtpk(p[10], p[11]); pw1[2] = cvtpk(p[12], p[13]); pw1[3] = cvtpk(p[14], p[15]);
    lptr vp = tile + TV + (roff + 4 * hi + ((lane & 15) >> 2)) * 64 + ((lane >> 4) & 1) * 32 + (lane & 3) * 8;
#pragma unroll
    for (int dh = 0; dh < 2; ++dh) {
        const s16x4 l0 = vtr(vp + dh * VDH64), h0 = vtr(vp + dh * VDH64 + 512), l1 = vtr(vp + dh * VDH64 + 1024), h1 = vtr(vp + dh * VDH64 + 1536);
        const bf16x8 f0 = {l0[0], l0[1], l0[2], l0[3], h0[0], h0[1], h0[2], h0[3]}, f1 = {l1[0], l1[1], l1[2], l1[3], h1[0], h1[1], h1[2], h1[3]};
        o[dh] = __builtin_amdgcn_mfma_f32_32x32x16_bf16(__builtin_bit_cast(bf16x8, pw0), f0, o[dh], 0, 0, 0);
        o[dh] = __builtin_amdgcn_mfma_f32_32x32x16_bf16(__builtin_bit_cast(bf16x8, pw1), f1, o[dh], 0, 0, 0);
    }
}
__device__ __forceinline__ void mask_band(f32x16& p, int rel, int kr0, int L, int lane) {
    const int r32 = lane & 31, hi = lane >> 5;
    if (rel == 0 || rel == 4) { const int base = 32 * rel - r32 + 4 * hi;
#pragma unroll
        for (int r = 0; r < 16; ++r) { if ((unsigned)(base + creg(r)) > 128u) p[r] = NEG; } }
    if (kr0 < 0 || kr0 + 31 >= L) { const int kb = kr0 + 4 * hi;
#pragma unroll
        for (int r = 0; r < 16; ++r) { if ((unsigned)(kb + creg(r)) >= (unsigned)L) p[r] = NEG; } }
}
__device__ __forceinline__ void stage_rows(const f32x16 (&o)[2], float lsum, bool normalise, lptr scr, __attribute__((address_space(3))) float* ls, int lane) {
    const int r32 = lane & 31, hi = lane >> 5;
    lsum = pg8::sum_xor32(lsum);
    if (hi == 0) ls[r32] = lsum;
    __attribute__((address_space(3))) unsigned short* stg = (__attribute__((address_space(3))) unsigned short*)scr;
    float rl[16];
#pragma unroll
    for (int g = 0; g < 4; ++g) { const f32x4 lv = *(__attribute__((address_space(3))) f32x4*)(ls + 8 * g + 4 * hi);
#pragma unroll
        for (int j = 0; j < 4; ++j) rl[4 * g + j] = normalise ? __builtin_amdgcn_rcpf(lv[j]) : 1.f; }
#pragma unroll
    for (int r = 0; r < 16; r += 2) { const int q = creg(r) + 4 * hi;
#pragma unroll
        for (int dh = 0; dh < 2; ++dh) { const unsigned pk = cvtpk(o[dh][r] * rl[r], o[dh][r + 1] * rl[r + 1]);
            stg[q * 64 + dh * 32 + r32] = (unsigned short)pk; stg[(q + 1) * 64 + dh * 32 + r32] = (unsigned short)(pk >> 16); } }
}
template <class RowFn, class SsqFn> __device__ __forceinline__ void out_final(const f32x16 (&o)[2], float lsum, lptr scr, __attribute__((address_space(3))) float* ls, const RowFn& orow, const SsqFn& ssqp, int lane) {
    stage_rows(o, lsum, true, scr, ls, lane);
    __attribute__((address_space(3))) unsigned short* stg = (__attribute__((address_space(3))) unsigned short*)scr;
#pragma unroll
    for (int i = 0; i < 4; ++i) { const int row = i * 8 + (lane >> 3), ch = lane & 7; const u32x4 v = *(__attribute__((address_space(3))) u32x4*)(stg + row * 64 + ch * 8);
        float ss = 0.f;
#pragma unroll
        for (int e = 0; e < 4; ++e) { const float a = bflo(v[e]), b = bfhi(v[e]); ss += a * a + b * b; }
        ss += __shfl_xor(ss, 1); ss += __shfl_xor(ss, 2); ss += __shfl_xor(ss, 4);
        *(u32x4*)(orow(row) + ch * 8) = v; if (ch == 0) *ssqp(row) = ss; }
}
}

constexpr int N2_M = (MTOK / 512) * 4;
constexpr int N2_B = (MTOK / 256) * 3;
constexpr int N2_A = (MTOK / 512) * 6;
constexpr size_t WS_PART = WS_X1B;
constexpr size_t WS_PARTL = WS_PART + (size_t)2 * MTOK * 384 * 2;
static_assert(WS_PARTL + (size_t)2 * MTOK * 8 * 4 <= WS_XN, "partials fit the X1B region");

struct BandU { long sb; int T, qs, L, cls, s0; };
__device__ __forceinline__ BandU band_unit(int tt, int qs) {
    BandU u; int j, nt; if (tt < TP / 256) { u.sb = 0; u.T = TP; j = tt; nt = TP / 256; } else { const int q = tt - TP / 256, b = q / (TS / 256); u.sb = TP + (long)b * TS; u.T = TS; j = q - b * (TS / 256); nt = TS / 256; }
    const int nb = nt / qs; u.qs = qs; u.L = u.T / qs; u.cls = j / nb; u.s0 = 256 * (j - u.cls * nb); return u;
}
struct UD { int kind, idx, nst; att2::TileSrc x, y; int xb, xs, yb, ys, yrot; };
__device__ __forceinline__ UD make_ud(Frame& F, int kind, int idx) {
    UD d; d.kind = kind; d.idx = idx; d.nst = 0; d.xb = d.xs = d.yb = d.ys = d.yrot = 0; d.x = att2::TileSrc{nullptr, nullptr, 0, 1, 1, F.tm}; d.y = d.x;
    const bf16* QKV = (const bf16*)(F.ws + WS_QKV);
    if (kind >= 0 && kind <= 2) {
        const int h = idx / (MTOK / 512), tt = 2 * (idx - h * (MTOK / 512)), qs = kind == 0 ? 16 : (kind == 1 ? 4 : 1);
        const BandU ux = band_unit(tt, qs), uy = band_unit(tt + 1, qs);
        const bf16* Kh = QKV + (size_t)(6 + h) * MTOK * 64; const bf16* Vh = QKV + (size_t)(12 + h) * MTOK * 64;
        d.nst = 6; d.x = att2::TileSrc{Kh + ux.sb * 64, Vh + ux.sb * 64, 0, qs, ux.T, F.tm}; d.y = att2::TileSrc{Kh + uy.sb * 64, Vh + uy.sb * 64, 0, qs, uy.T, F.tm};
        d.xb = ux.cls + (ux.s0 - 64) * qs; d.xs = 64 * qs; d.yb = uy.cls + (uy.s0 - 64) * qs; d.ys = 64 * qs; d.yrot = 3;
    } else if (kind == 3) {
        const int hp = idx / (MTOK / 256), rq4 = idx - hp * (MTOK / 256);
        int r0, rows; long sb; int T;
        if (rq4 < TP / 256) { r0 = 4 * rq4; rows = TP / 64; sb = 0; T = TP; } else { const int q = rq4 - TP / 256, b = q / (TS / 256); r0 = 4 * (q - b * (TS / 256)); rows = TS / 64; sb = TP + (long)b * TS; T = TS; }
        int rk0 = r0 - 4; rk0 = rk0 < 0 ? 0 : (rk0 > rows - 8 ? rows - 8 : rk0);
        int rk1 = r0 + 3 - 4; rk1 = rk1 < 0 ? 0 : (rk1 > rows - 8 ? rows - 8 : rk1);
        d.nst = rk1 + 8 - rk0;
        d.x = att2::TileSrc{QKV + ((size_t)(24 + 2 * hp) * MTOK + sb) * 64, QKV + ((size_t)(30 + 2 * hp) * MTOK + sb) * 64, 0, 1, T, F.tm};
        d.y = att2::TileSrc{QKV + ((size_t)(25 + 2 * hp) * MTOK + sb) * 64, QKV + ((size_t)(31 + 2 * hp) * MTOK + sb) * 64, 0, 1, T, F.tm};
        d.xb = rk0 * 64; d.xs = 64; d.yb = rk0 * 64; d.ys = 64; d.yrot = 0;
    } else if (kind == 4) {
        const int h = idx / (MTOK / 512), row0 = (idx - h * (MTOK / 512)) * 512; const SeqInfo si = seq_of(row0);
        d.nst = 4; d.x = att2::TileSrc{(const bf16*)(F.ws + WS_MK) + (size_t)(si.bat * 4 + h) * NMEM * 64, (const bf16*)(F.ws + WS_MV) + (size_t)(si.bat * 4 + h) * NMEM * 64, 0, 1, NMEM, F.tm}; d.y = d.x;
        d.xb = 0; d.xs = 64; d.yb = 0; d.ys = 64; d.yrot = 0;
    }
    return d;
}
__device__ __forceinline__ void ud_issue(Frame& F, UD& d, int s, int gstep) {
    LAS unsigned char* sl = F.lds + att2::L_RING + (gstep & (att2::NS - 1)) * att2::SLOT;
    int sy = s + d.yrot; sy = sy >= 6 ? sy - 6 : sy; if (d.yrot == 0) sy = s;
    d.x.p0 = d.xb + d.xs * s; d.y.p0 = d.yb + d.ys * sy;
    att2::dma_tile(sl, d.x, F.wave, F.lane); att2::dma_tile(sl + att2::TILE, d.y, F.wave, F.lane);
}
__device__ __forceinline__ void ud_load_q(Frame& F, const UD& d, att::bf16x8 (&qa)[4], att::bf16x8 (&qb)[4]) {
    const int w = F.wave, lane = F.lane, r32 = lane & 31;
    const bf16* QKV = (const bf16*)(F.ws + WS_QKV);
    const bf16* pa = QKV; const bf16* pb = QKV;
    if (d.kind >= 0 && d.kind <= 2) {
        const int h = d.idx / (MTOK / 512), tt = 2 * (d.idx - h * (MTOK / 512)), qs = d.kind == 0 ? 16 : (d.kind == 1 ? 4 : 1);
        const BandU ux = band_unit(tt, qs), uy = band_unit(tt + 1, qs);
        const bf16* Qh = QKV + (size_t)(0 + h) * MTOK * 64;
        pa = Qh + (size_t)(ux.sb + ux.cls + (ux.s0 + 32 * w + r32) * qs) * 64; pb = Qh + (size_t)(uy.sb + uy.cls + (uy.s0 + 32 * w + r32) * qs) * 64;
    } else if (d.kind == 3) {
        const int hp = d.idx / (MTOK / 256), rq4 = d.idx - hp * (MTOK / 256);
        int r0; long sb;
        if (rq4 < TP / 256) { r0 = 4 * rq4; sb = 0; } else { const int q = rq4 - TP / 256, b = q / (TS / 256); r0 = 4 * (q - b * (TS / 256)); sb = TP + (long)b * TS; }
        const int hd = w >> 2, g = w & 3, h = 2 * hp + hd, rq = r0 + (r32 >> 4), c = 16 * g + (r32 & 15);
        pa = QKV + ((size_t)(18 + h) * MTOK + sb + rq * 64 + c) * 64; pb = pa + (size_t)128 * 64;
    } else if (d.kind == 4) {
        const int h = d.idx / (MTOK / 512), row0 = (d.idx - h * (MTOK / 512)) * 512;
        pa = QKV + ((size_t)(36 + h) * MTOK + row0 + 32 * w + r32) * 64; pb = pa + (size_t)256 * 64;
    }
    att::load_q(qa, pa, lane); att::load_q(qb, pb, lane);
}
#define ATT3_STEP_BEGIN() do { if (s == 0) PT_ADD(F, 5); PT_SUB(F, 0); const int ahead_ = gi - gs - 1; \
        if (ahead_ >= 2) { ATT2_WAITBAR(8); } else if (ahead_ == 1) { ATT2_WAITBAR(4); } else { ATT2_WAITBAR(0); } \
        { const int t_ = s + 3; if (t_ < d.nst) { ud_issue(F, d, t_, gi); ++gi; } else if (dn.kind >= 0 && t_ - d.nst < 3) { ud_issue(F, dn, t_ - d.nst, gi); ++gi; } } PT_ADD(F, 0); PT_SUB(F, 1); } while (0)
#define ATT3_UNIT_END() asm volatile("s_waitcnt lgkmcnt(0)\n\ts_barrier" ::: "memory")

__device__ __forceinline__ void att3_body_M(Frame& F, UD& d, UD& dn, int& gs, int& gi, att::bf16x8 (&qr)[4], att::bf16x8 (&qnb)[4]) {
    const int h = d.idx / (MTOK / 512), row0 = (d.idx - h * (MTOK / 512)) * 512;
    const int w = F.wave, lane = F.lane;
    att::f32x16 o[2] = {}, o2[2] = {}; float lsum = 0.f, lsum2 = 0.f;
#pragma unroll 1
    for (int s = 0; s < 4; ++s) {
        ATT3_STEP_BEGIN();
        att::lptr tile = (att::lptr)(F.lds + att2::L_RING + (gs & (att2::NS - 1)) * att2::SLOT);
#pragma unroll
        for (int hf = 0; hf < 2; ++hf) {
            att::f32x16 pa = att2::qk_sub(tile, 32 * hf, qr, lane), pb = att2::qk_sub(tile, 32 * hf, qnb, lane);
            att2::pv_sub(tile, 32 * hf, pa, o, lsum, lane); att2::pv_sub(tile, 32 * hf, pb, o2, lsum2, lane);
            asm volatile("" ::: "memory");
        }
        ++gs; PT_ADD(F, 1);
    }
    ud_load_q(F, dn, qr, qnb);
    PT_SUB(F, 2); ATT3_UNIT_END();
    att::lptr scr = (att::lptr)(F.lds + att2::L_RING + ((gs - 1) & (att2::NS - 1)) * att2::SLOT + w * 4096);
    __attribute__((address_space(3))) float* ls = (__attribute__((address_space(3))) float*)(F.lds + att2::L_LS + w * 128);
    { bf16* O = (bf16*)F.out + (size_t)(row0 + 32 * w) * DM + 768 + 64 * h; float* SQ = (float*)(F.ws + WS_SSQA) + (size_t)(row0 + 32 * w) * 16 + 12 + h;
      att2::out_final(o, lsum, scr, ls, [=](int q) { return O + (size_t)q * DM; }, [=](int q) { return SQ + (size_t)q * 16; }, lane); }
    { bf16* O = (bf16*)F.out + (size_t)(row0 + 256 + 32 * w) * DM + 768 + 64 * h; float* SQ = (float*)(F.ws + WS_SSQA) + (size_t)(row0 + 256 + 32 * w) * 16 + 12 + h;
      att2::out_final(o2, lsum2, scr, ls, [=](int q) { return O + (size_t)q * DM; }, [=](int q) { return SQ + (size_t)q * 16; }, lane); }
    PT_ADD(F, 2);
}
__device__ __forceinline__ void att3_body_B(Frame& F, const Args& A, UD& d, UD& dn, int& gs, int& gi, att::bf16x8 (&qr)[4], att::bf16x8 (&qnb)[4]) {
    const int hp = d.idx / (MTOK / 256), rq4 = d.idx - hp * (MTOK / 256);
    int r0, rows; long sb;
    if (rq4 < TP / 256) { r0 = 4 * rq4; rows = TP / 64; sb = 0; } else { const int q = rq4 - TP / 256, b = q / (TS / 256); r0 = 4 * (q - b * (TS / 256)); rows = TS / 64; sb = TP + (long)b * TS; }
    const int w = F.wave, lane = F.lane, r32 = lane & 31, hi = lane >> 5;
    const int hd = w >> 2, g = w & 3, h = 2 * hp + hd;
    const int c = 16 * g + (r32 & 15);
    int cs = c - 8; cs = cs < 0 ? 0 : (cs > 48 ? 48 : cs);
    const int rk0 = d.xb >> 6;
    const int w0 = g == 0 ? 0 : (g == 1 ? 8 : (g == 2 ? 24 : 32));
    { const int th = F.tid >> 8, tl = F.tid & 255;
      __attribute__((address_space(3))) float* tbl = (__attribute__((address_space(3))) float*)(F.lds + att2::L_TBL + th * att2::TBLB);
      const float* rpb = A.in[10] + (2 * hp + th) * 465;
      for (int idx = tl; idx < 465; idx += 256) { const int dr = idx / 31, dl = idx - dr * 31; tbl[dr * 64 + 16 + dl] = rpb[idx] * LOG2E; } }
    att::f32x16 o[2] = {}, o2[2] = {}; float lsum = 0.f, lsum2 = 0.f;
    const __attribute__((address_space(3))) float* tb = (const __attribute__((address_space(3))) float*)(F.lds + att2::L_TBL + hd * att2::TBLB) + (31 + w0 - c) + 4 * hi;
    const int cb = w0 - cs + 4 * hi, nst = d.nst;
    const int rq0 = r0 + (r32 >> 4), rq1 = rq0 + 2;
    int rlo0 = rq0 - 4; rlo0 = rlo0 < 0 ? 0 : (rlo0 > rows - 8 ? rows - 8 : rlo0);
    int rlo1 = rq1 - 4; rlo1 = rlo1 < 0 ? 0 : (rlo1 > rows - 8 ? rows - 8 : rlo1);
    int b0lo = r0 - 4; b0lo = b0lo < 0 ? 0 : (b0lo > rows - 8 ? rows - 8 : b0lo); int b0hi = r0 + 1 - 4; b0hi = (b0hi < 0 ? 0 : (b0hi > rows - 8 ? rows - 8 : b0hi)) + 7;
    int b1lo = r0 + 2 - 4; b1lo = b1lo < 0 ? 0 : (b1lo > rows - 8 ? rows - 8 : b1lo); int b1hi = r0 + 3 - 4; b1hi = (b1hi < 0 ? 0 : (b1hi > rows - 8 ? rows - 8 : b1hi)) + 7;
#pragma unroll 1
    for (int s = 0; s < nst; ++s) {
        ATT3_STEP_BEGIN();
        att::lptr tile = (att::lptr)(F.lds + att2::L_RING + (gs & (att2::NS - 1)) * att2::SLOT + hd * att2::TILE);
        const int rk = rk0 + s;
        if (rk >= b0lo && rk <= b0hi) {
            att::f32x16 p = att2::qk_sub(tile, w0, qr, lane);
            const bool rok = (unsigned)(rk - rlo0) < 8u; int dr = rk + 7 - rq0; dr = dr < 0 ? 0 : (dr > 14 ? 14 : dr);
            const __attribute__((address_space(3))) float* tp = tb + dr * 64; const int cbh = rok ? cb : -4096;
#pragma unroll
            for (int r = 0; r < 16; ++r) { const float sbv = p[r] + tp[att::creg(r)]; p[r] = ((unsigned)(cbh + att::creg(r)) < 16u) ? sbv : att::NEG; }
            att2::pv_sub(tile, w0, p, o, lsum, lane);
        }
        if (rk >= b1lo && rk <= b1hi) {
            att::f32x16 p = att2::qk_sub(tile, w0, qnb, lane);
            const bool rok = (unsigned)(rk - rlo1) < 8u; int dr = rk + 7 - rq1; dr = dr < 0 ? 0 : (dr > 14 ? 14 : dr);
            const __attribute__((address_space(3))) float* tp = tb + dr * 64; const int cbh = rok ? cb : -4096;
#pragma unroll
            for (int r = 0; r < 16; ++r) { const float sbv = p[r] + tp[att::creg(r)]; p[r] = ((unsigned)(cbh + att::creg(r)) < 16u) ? sbv : att::NEG; }
            att2::pv_sub(tile, w0, p, o2, lsum2, lane);
        }
        ++gs; PT_ADD(F, 1);
    }
    ud_load_q(F, dn, qr, qnb);
    PT_SUB(F, 2); ATT3_UNIT_END();
    att::lptr scr = (att::lptr)(F.lds + att2::L_RING + ((gs - 1) & (att2::NS - 1)) * att2::SLOT + w * 4096);
    __attribute__((address_space(3))) float* ls = (__attribute__((address_space(3))) float*)(F.lds + att2::L_LS + w * 128);
    { bf16* O = (bf16*)F.out + (size_t)(sb + r0 * 64 + 16 * g) * DM + 384 + 64 * h; float* SQ = (float*)(F.ws + WS_SSQA) + (size_t)(sb + r0 * 64 + 16 * g) * 16 + 6 + h;
      att2::out_final(o, lsum, scr, ls, [=](int q) { return O + (size_t)((q >> 4) * 64 + (q & 15)) * DM; }, [=](int q) { return SQ + (size_t)((q >> 4) * 64 + (q & 15)) * 16; }, lane); }
    { bf16* O = (bf16*)F.out + (size_t)(sb + (r0 + 2) * 64 + 16 * g) * DM + 384 + 64 * h; float* SQ = (float*)(F.ws + WS_SSQA) + (size_t)(sb + (r0 + 2) * 64 + 16 * g) * 16 + 6 + h;
      att2::out_final(o2, lsum2, scr, ls, [=](int q) { return O + (size_t)((q >> 4) * 64 + (q & 15)) * DM; }, [=](int q) { return SQ + (size_t)((q >> 4) * 64 + (q & 15)) * 16; }, lane); }
    PT_ADD(F, 2);
}
__device__ __forceinline__ void att3_body_A(Frame& F, UD& d, UD& dn, int& gs, int& gi, att::bf16x8 (&qx)[4], att::bf16x8 (&qy)[4]) {
    const int pat = d.kind, ud = d.idx;
    const int h = ud / (MTOK / 512), tt = 2 * (ud - h * (MTOK / 512)), qs = pat == 0 ? 16 : (pat == 1 ? 4 : 1);
    const BandU ux = band_unit(tt, qs), uy = band_unit(tt + 1, qs);
    const int w = F.wave, lane = F.lane, r32 = lane & 31;
    const bf16* Qh = (const bf16*)(F.ws + WS_QKV) + (size_t)(0 + h) * MTOK * 64;
    att::f32x16 ox[2] = {}, oy[2] = {}; float lx = 0.f, ly = 0.f;
#pragma unroll 1
    for (int s = 0; s < 6; ++s) {
        ATT3_STEP_BEGIN();
        att::lptr tX = (att::lptr)(F.lds + att2::L_RING + (gs & (att2::NS - 1)) * att2::SLOT), tY = tX + att2::TILE;
        const int sy = (s + 3) % 6;
#pragma unroll
        for (int hf = 0; hf < 2; ++hf) {
            const int gx = 2 * s + hf, gy = 2 * sy + hf;
            const bool ax = (unsigned)(gx - w) <= 4u, ay = (unsigned)(gy - w) <= 4u;
            att::f32x16 pxx, pyy;
            if (ax) pxx = att2::qk_sub(tX, 32 * hf, qx, lane);
            if (ay) pyy = att2::qk_sub(tY, 32 * hf, qy, lane);
            if (ax) { att2::mask_band(pxx, gx - w, ux.s0 - 64 + 32 * gx, ux.L, lane); att2::pv_sub(tX, 32 * hf, pxx, ox, lx, lane); }
            if (ay) { att2::mask_band(pyy, gy - w, uy.s0 - 64 + 32 * gy, uy.L, lane); att2::pv_sub(tY, 32 * hf, pyy, oy, ly, lane); }
        }
        ++gs; PT_ADD(F, 1);
    }
    ud_load_q(F, dn, qx, qy);
    bf16* PB = (bf16*)(F.ws + WS_PART); float* PL = (float*)(F.ws + WS_PARTL);
    int lane_o = F.lane; asm volatile("" : "+v"(lane_o));
    att::u32x4 pa[4], pb[4]; float pl[4];
#define ATT3_LOAD_PART(side_) do { const BandU& u_ = (side_) ? uy : ux; const long t0_ = u_.sb + u_.cls + (long)(u_.s0 + 32 * w); \
        _Pragma("unroll") for (int i = 0; i < 4; ++i) { const int row = i * 8 + (lane_o >> 3), ch = lane_o & 7; const long tok = t0_ + row; \
            pa[i] = *(const att::u32x4*)(PB + ((size_t)tok) * 384 + 64 * h + ch * 8); pb[i] = *(const att::u32x4*)(PB + ((size_t)MTOK + tok) * 384 + 64 * h + ch * 8); \
            pl[i] = PL[(size_t)tok * 8 + h] + PL[((size_t)MTOK + tok) * 8 + h]; } } while (0)
    if (pat == 2) ATT3_LOAD_PART(0);
    PT_SUB(F, 2); ATT3_UNIT_END();
    att::lptr scr = (att::lptr)(F.lds + att2::L_RING + ((gs - 1) & (att2::NS - 1)) * att2::SLOT + w * 4096);
    __attribute__((address_space(3))) unsigned short* stg = (__attribute__((address_space(3))) unsigned short*)scr;
    __attribute__((address_space(3))) float* ls = (__attribute__((address_space(3))) float*)(F.lds + att2::L_LS + w * 128);
#pragma unroll
    for (int side = 0; side < 2; ++side) {
        const BandU& u = side ? uy : ux;
        const long tok0 = u.sb + u.cls + (long)(u.s0 + 32 * w) * qs;
        att2::stage_rows(side ? oy : ox, side ? ly : lx, false, scr, ls, lane);
        if (pat < 2) {
#pragma unroll
            for (int i = 0; i < 4; ++i) { const int row = i * 8 + (lane_o >> 3), ch = lane_o & 7; const att::u32x4 v = *(__attribute__((address_space(3))) att::u32x4*)(stg + row * 64 + ch * 8);
                *(att::u32x4*)(PB + ((size_t)pat * MTOK + tok0 + (long)row * qs) * 384 + 64 * h + ch * 8) = v; }
            if (lane_o < 32) PL[((size_t)pat * MTOK + tok0 + (long)lane_o * qs) * 8 + h] = ls[lane_o];
        } else {
            att::u32x4 a4[4], b4[4]; float l4[4];
#pragma unroll
            for (int i = 0; i < 4; ++i) { a4[i] = pa[i]; b4[i] = pb[i]; l4[i] = pl[i]; }
            if (side == 0) ATT3_LOAD_PART(1);
#pragma unroll
            for (int i = 0; i < 4; ++i) { const int row = i * 8 + (lane_o >> 3), ch = lane_o & 7; const long tok = tok0 + row;
                const att::u32x4 v = *(__attribute__((address_space(3))) att::u32x4*)(stg + row * 64 + ch * 8);
                const att::u32x4 a = a4[i], b = b4[i];
                const float rl = __builtin_amdgcn_rcpf(ls[row] + l4[i]);
                att::u32x4 ov; float ss = 0.f;
#pragma unroll
                for (int e = 0; e < 4; ++e) { const float x0 = (bflo(v[e]) + bflo(a[e]) + bflo(b[e])) * rl, x1 = (bfhi(v[e]) + bfhi(a[e]) + bfhi(b[e])) * rl; ov[e] = pk2(x0, x1);
                    const float y0 = bflo(ov[e]), y1 = bfhi(ov[e]); ss += y0 * y0 + y1 * y1; }
                ss += __shfl_xor(ss, 1); ss += __shfl_xor(ss, 2); ss += __shfl_xor(ss, 4);
                *(att::u32x4*)((bf16*)F.out + (size_t)tok * DM + 64 * h + ch * 8) = ov;
                if (ch == 0) ((float*)(F.ws + WS_SSQA))[(size_t)tok * 16 + h] = ss; }
        }
    }
#undef ATT3_LOAD_PART
    PT_ADD(F, 2);
}
template <class ListFn> __device__ __forceinline__ void att3_run(Frame& F, const Args& A, const ListFn& unit_of) {
    PT_SUB(F, 3);
    int gs = 0, gi = 0, k, i;
    unit_of(0, k, i); UD d = make_ud(F, k, i);
    if (d.kind < 0) return;
    for (int s = 0; s < 3; ++s) { ud_issue(F, d, s, gi); ++gi; }
    att::bf16x8 qa[4], qb[4]; ud_load_q(F, d, qa, qb);
    for (int j = 0; d.kind >= 0; ++j) {
        PT_SUB(F, 4); unit_of(j + 1, k, i); UD dn = make_ud(F, k, i); PT_ADD(F, 4); PT_SUB(F, 5);
        const int kslot_ = d.kind; PTK_SUB(F, kslot_);
        if (d.kind <= 2) att3_body_A(F, d, dn, gs, gi, qa, qb); else if (d.kind == 3) att3_body_B(F, A, d, dn, gs, gi, qa, qb); else att3_body_M(F, d, dn, gs, gi, qa, qb);
        PTK_ADD(F, kslot_);
        d = dn;
    }
    ATT2_WAITBAR(0);
    PT_ADD(F, 3);
}
__device__ __forceinline__ void att2_phase_a(Frame& F, const Args& A) {
    const int NU = 2 * N2_A + N2_B, G = F.G;
    const bool blk = (G == 256); const int per = NU / 8, xcd = blockIdx.x & 7, ci = blockIdx.x >> 3, bx = blockIdx.x;
    att3_run(F, A, [=](int j, int& kind, int& idx) {
        const int jj = blk ? ci + 32 * j : bx + G * j; const bool ok = blk ? (jj < per) : (jj < NU);
        const int u = blk ? xcd * per + jj : jj, i = u / 3, k = u - 3 * i;
        kind = !ok ? -1 : (k == 0 ? 0 : (k == 1 ? 1 : 3)); idx = i; });
}
__device__ __forceinline__ void att2_phase_b(Frame& F, const Args& A) {
    const int NU = N2_A + N2_M, G = F.G;
    const bool blk = (G == 256); const int per = NU / 8, xcd = blockIdx.x & 7, ci = blockIdx.x >> 3, bx = blockIdx.x;
    att3_run(F, A, [=](int j, int& kind, int& idx) {
        const int jj = blk ? ci + 32 * j : bx + G * j; const bool ok = blk ? (jj < per) : (jj < NU);
        const int u = blk ? xcd * per + jj : jj, gq = u / 5, k = u - 5 * gq;
        kind = !ok ? -1 : (k < 3 ? 2 : 4); idx = k < 3 ? 3 * gq + k : 2 * gq + (k - 3); });
}
__global__ void __launch_bounds__(NWAVES * 64, 2) skel_fwd(Args args) {
    extern __shared__ __attribute__((aligned(16))) unsigned char lds[];
    cg::grid_group grid = cg::this_grid();
    Frame F;
    F.lds = (LAS unsigned char*)lds;
    F.tid = threadIdx.x; F.lane = F.tid & 63; F.wave = __builtin_amdgcn_readfirstlane(F.tid >> 6);
    F.G = gridDim.x; { const int bx = blockIdx.x; F.vcu = (F.G % 8 == 0) ? (bx % 8) * (F.G / 8) + bx / 8 : bx; }
    F.out = args.out; F.ws = args.ws; F.tm = -1;
    unsigned char* ws = args.ws;
    const int lo = args.ph_lo, hi = args.ph_hi & 255; if (args.ph_hi >> 8) F.tm = 63;
    volatile LAS unsigned* bst = (volatile LAS unsigned*)(F.lds + LDS_MISC);
    if (F.tid < 2) bst[F.tid] = 0u;
    if (F.tid >= 8 && F.tid < 24) ((volatile LAS unsigned*)(F.lds + LDS_MISC))[F.tid] = 0u;
    __syncthreads();
    XcdBarrier bar = xcd_barrier_post((unsigned*)(ws + WS_CTL) + CW_BAR, bst);
    if (lo < 0) grid.sync();
#define IN(k) (lo <= (k) && (k) < hi)
#define BOTH(k) (IN(k) && IN((k) + 1))
#define GRID_BAR() xcd_barrier(bar)
#if PROBE_T == 3
#define PT_STAMP(k) do { if (F.tid == 0 && blockIdx.x == 0) PT_SLOTS_L(F.lds)[k] = (long long)__builtin_amdgcn_s_memrealtime(); } while (0)
#else
#define PT_STAMP(k) do {} while (0)
#endif
#if PROBE_T
#define PT_PHASE(k) do { if (F.tid == 0) PT_ON_L(F.lds) = ((k) == PROBE_PHASE) ? 1u : 0u; } while (0)
#else
#define PT_PHASE(k) do {} while (0)
#endif

    PT_STAMP(0);
    const bool spec = SPEC_ROLES && (F.G == 256);
    if (IN(0)) { PT_PHASE(0); p0_prologue(F, args, spec); PT_PHASE(-1); if (BOTH(0)) GRID_BAR(); }
    PT_STAMP(1);

    if (IN(1)) {
        PT_PHASE(1);
        {
            pg8::Gemm g{(const pg8::bf16_t*)(ws + WS_XN), (const pg8::bf16_t*)(ws + WS_WIN), MTOK, NQKV, DM}; pg8::SpecOrder S; S.init(MTOK, NQKV, F.G, (int)blockIdx.x, spec, (unsigned*)(ws + WS_CTL) + CW_READY);
            if (spec && S.j < pg8::NCV && !(args.ph_hi >> 8)) p1_convert(F, args, S.x, S.j);
            pg8::EpiQKV E{(pg8::bf16_t*)(ws + WS_QKV), args.in[6], args.in[7], args.in[8], args.in[9], args.in[13], (const float*)(ws + WS_ROPE), (const float*)(ws + WS_ROPE) + TP * 8};
            pg8::gemm_phase<pg8::EpiQKV, pg8::SpecOrder, true, true>(F.lds, g, S, E);
        }
        PT_PHASE(-1);
        if (BOTH(1)) GRID_BAR();
    }
    PT_STAMP(2);

    if (IN(2)) {
        {
            pg8::Gemm g{(const pg8::bf16_t*)(ws + WS_XNMEM), (const pg8::bf16_t*)(ws + WS_WMEM), MMEM, 512, DM};
            const int bx = (int)blockIdx.x, mi = spec ? (((bx >> 3) - 24) * 8 + (bx & 7)) : F.G - 1 - bx;
            pg8::ListOrder S{2, 10, (mi < 0 || mi >= 10) ? 10 : mi, spec ? 16 : F.G};
            pg8::EpiMemKV E{(pg8::bf16_t*)(ws + WS_MK), (pg8::bf16_t*)(ws + WS_MV), args.in[14]};
            pg8::gemm_phase<pg8::EpiMemKV, pg8::ListOrder, true, true>(F.lds, g, S, E);
            __syncthreads();
        }
        PT_PHASE(2); att2_phase_a(F, args); PT_PHASE(-1); if (BOTH(2)) GRID_BAR(); }
    PT_STAMP(3);
    if (IN(3)) { PT_PHASE(3); att2_phase_b(F, args); PT_PHASE(-1); if (BOTH(3)) GRID_BAR(); }
    PT_STAMP(4);

    if (IN(4)) {
        pg8::Gemm g{(const pg8::bf16_t*)F.out, (const pg8::bf16_t*)(ws + WS_WOUT), MTOK, DM, DM};   pg8::StaticOrder S; S.init(MTOK, DM, F.G, (int)blockIdx.x);
        pg8::EpiX1 E{(const pg8::bf16_t*)(ws + WS_XN), (const float*)(ws + WS_IRSTD), args.in[4], (pg8::bf16_t*)(ws + WS_X1B), (float*)(ws + WS_SSQF), (const float*)(ws + WS_SSQA)};
        PT_PHASE(4); pg8::gemm_phase<pg8::EpiX1, pg8::StaticOrder, true, true>(F.lds, g, S, E); PT_PHASE(-1);
        if (BOTH(4)) GRID_BAR();
    }
    PT_STAMP(5);

    if (IN(5)) {
        pg8::Gemm g{(const pg8::bf16_t*)(ws + WS_X1B), (const pg8::bf16_t*)(ws + WS_W1), MTOK, FF, DM}; pg8::StaticOrder S; S.init(MTOK, FF, F.G, (int)blockIdx.x);
        pg8::EpiH E{(pg8::bf16_t*)(ws + WS_H), (const float*)(ws + WS_SSQF), args.ph_hi >> 8};
        PT_PHASE(5); pg8::gemm_phase<pg8::EpiH, pg8::StaticOrder, true, true>(F.lds, g, S, E); PT_PHASE(-1);
        if (BOTH(5)) GRID_BAR();
    }
    PT_STAMP(6);

    if (IN(6)) {
        pg8::Gemm g{(const pg8::bf16_t*)(ws + WS_H), (const pg8::bf16_t*)(ws + WS_W2), MTOK, DM, FF}; pg8::StaticOrder S; S.init(MTOK, DM, F.G, (int)blockIdx.x);
        pg8::EpiOut E{F.out, (const pg8::bf16_t*)(ws + WS_X1B)};
        PT_PHASE(6); pg8::gemm_phase<pg8::EpiOut, pg8::StaticOrder, true, true>(F.lds, g, S, E); PT_PHASE(-1);
    }
#if PROBE_T == 3
    PT_STAMP(7);
    __syncthreads();
    if (blockIdx.x == 0 && F.tid == 0) { F.out[0] = (float)(PT_SLOTS_L(F.lds)[PROBE_I + 1] - PT_SLOTS_L(F.lds)[PROBE_I]) * 0.01f; F.out[1] = 0.f; }
#elif PROBE_T
    __syncthreads();
    if (blockIdx.x == 0 && F.tid == 0) { F.out[0] = (float)(PT_SLOTS_L(F.lds)[PROBE_I] >> 15) * 16.384f; F.out[1] = (float)PT_SLOTS_L(F.lds)[PROBE_J] * (1.0f / 2000.0f); }
#endif
#undef IN
#undef BOTH
}

extern "C" void kernel_launch(void* const* d_in, const int* in_sizes, int n_in, void* d_out, int out_size, void* d_ws, size_t ws_size, hipStream_t stream) {
    static int grid = 0;
    if (grid == 0) {
        if (n_in != 22 || in_sizes[0] != TP * DM || in_sizes[1] != NBS * TS * DM || out_size != MTOK * DM || ws_size < WS_END) {
            fprintf(stderr, "kernel_launch: unexpected shapes / workspace (n_in %d, in0 %d, out %d, ws %zu); nothing launched\n", n_in, n_in > 0 ? in_sizes[0] : -1, out_size, ws_size); grid = -1; return; }
        int dev = 0, cus = 0, per_cu = 0;
        if (hipGetDevice(&dev) != hipSuccess || hipDeviceGetAttribute(&cus, hipDeviceAttributeMultiprocessorCount, dev) != hipSuccess) { grid = -1; return; }
        if (hipFuncSetAttribute((const void*)skel_fwd, hipFuncAttributeMaxDynamicSharedMemorySize, LDS_BYTES) != hipSuccess) { fprintf(stderr, "kernel_launch: hipFuncSetAttribute failed\n"); grid = -1; return; }
        if (hipOccupancyMaxActiveBlocksPerMultiprocessor(&per_cu, (const void*)skel_fwd, NWAVES * 64, LDS_BYTES) != hipSuccess || per_cu < 1) { fprintf(stderr, "kernel_launch: occupancy query says %d\n", per_cu); (void)hipGetLastError(); grid = -1; return; }
        grid = cus * per_cu;
    }
    if (grid < 0) return;
    if (hipMemsetAsync((char*)d_ws + WS_CTL, 0, CTL_ZERO_BYTES, stream) != hipSuccess) return;
    Args a{};
    for (int i = 0; i < 22; ++i) a.in[i] = (const float*)d_in[i];
    a.out = (float*)d_out; a.ws = (unsigned char*)d_ws;
    auto launch = [&](int lo, int hi) {
        if (lo > 0) (void)hipMemsetAsync((char*)d_ws + WS_CTL + (size_t)CW_BAR * 4, 0, (size_t)XCD_BAR_WORDS * 4, stream);
        a.ph_lo = lo; a.ph_hi = hi; void* kargs[] = {&a};
        hipError_t e = hipLaunchCooperativeKernel((const void*)skel_fwd, dim3(grid), dim3(NWAVES * 64), kargs, LDS_BYTES, stream);
        if (e != hipSuccess) fprintf(stderr, "kernel_launch: cooperative launch failed: %s (grid %d)\n", hipGetErrorString(e), grid);
    };
#if PROBE_SEQ == 0
    launch(0, NPH);
#elif PROBE_SEQ == 1
    launch(0, NPH); launch(0, 1);
#elif PROBE_SEQ == 2
    launch(0, NPH); launch(1, 2);
#elif PROBE_SEQ == 3
    launch(0, 4); (void)hipMemsetAsync((char*)d_ws + WS_SSQA, 0, (size_t)MTOK * 16, stream); launch(2, 4); launch(4, NPH);
#elif PROBE_SEQ == 4
    launch(0, 5); (void)hipMemsetAsync((char*)d_ws + WS_SSQF, 0, (size_t)MTOK * 4, stream); launch(4, 5); launch(5, NPH);
#elif PROBE_SEQ == 5
    launch(0, NPH); launch(5, 6);
#elif PROBE_SEQ == 7
    launch(0, NPH); launch(2, 3);
#elif PROBE_SEQ == 8
    launch(0, NPH); launch(2, 3 | 256);
#elif PROBE_SEQ == 9
    launch(0, NPH); launch(3, 4);
#elif PROBE_SEQ == 10
    launch(0, NPH); launch(3, 4 | 256);
#elif PROBE_SEQ == 11
    launch(0, NPH); launch(5, 6 | 256);
#elif PROBE_SEQ == 12
    launch(0, NPH); launch(5, 6 | 512);
#elif PROBE_SEQ == 13
    launch(0, NPH); launch(0, 1 | 256);
#elif PROBE_SEQ == 14
    launch(0, NPH); launch(1, 2 | 256);
#elif PROBE_SEQ == 6
    launch(0, 3); (void)hipMemsetAsync((char*)d_ws + WS_SSQA, 0, (size_t)MTOK * 16, stream); launch(2, 3); launch(3, NPH);
#endif
}
```

```cpp
#include <hip/hip_runtime.h>
#include <hip/hip_cooperative_groups.h>
#include <cstdio>
#include <cstdint>
namespace cg = cooperative_groups;

constexpr int DM = 1024, TP = 16384, TS = 8192, NBS = 4, MTOK = TP + NBS * TS;
constexpr int NQKV = 2560, NHEADS = 40, FF = 4096, NMEM = 256, NBATCH = 1 + NBS, MMEM = NBATCH * NMEM;
constexpr float RMS_EPS = 1e-6f;
constexpr float LOG2E = 1.4426950408889634f;
constexpr float QSCALE = 0.125f * LOG2E;

#ifndef PROBE_SEQ
#define PROBE_SEQ 0
#endif
#ifndef PROBE_T
#define PROBE_T 0
#endif
#ifndef PROBE_I
#define PROBE_I 6
#endif
#ifndef PROBE_J
#define PROBE_J 7
#endif
#ifndef PROBE_PHASE
#define PROBE_PHASE 3
#endif
#ifndef PROBE_PHASE
#define PROBE_PHASE 3
#endif
#ifndef SPEC_ROLES
#define SPEC_ROLES 0
#endif
#ifndef STAG_TICKS
#define STAG_TICKS 0
#endif
#ifndef TEAM_SYNC
#define TEAM_SYNC 1
#endif
constexpr int RING_BYTES = 131072;
constexpr int LDS_BYTES = 155648, LDS_MISC = LDS_BYTES - 128;
constexpr int CW_BAR = 4096, CW_ARANK = 8192, CW_READY = 16384, CW_TEAM = 20480, CW_P4DONE = 28672;
constexpr int LDS_BYTES_UNUSED = 0;


#if PROBE_T
#define PT_SLOTS_L(lds) ((volatile __attribute__((address_space(3))) long long*)((lds) + LDS_MISC + 32))
#define PT_ON_L(lds) (*(volatile __attribute__((address_space(3))) unsigned*)((lds) + LDS_MISC + 24))
#define PT_SUB_L(lds, i) do { if (threadIdx.x == 0 && blockIdx.x == 0 && PT_ON_L(lds)) PT_SLOTS_L(lds)[i] -= (long long)__builtin_readcyclecounter(); } while (0)
#define PT_ADD_L(lds, i) do { if (threadIdx.x == 0 && blockIdx.x == 0 && PT_ON_L(lds)) PT_SLOTS_L(lds)[i] += (long long)__builtin_readcyclecounter(); } while (0)
#else
#define PT_SUB_L(lds, i) do {} while (0)
#define PT_ADD_L(lds, i) do {} while (0)
#endif
#if PROBE_T == 2
#define PTK_SUB(F, i) PT_SUB_L((F).lds, i)
#define PTK_ADD(F, i) PT_ADD_L((F).lds, i)
#define PT_SUB(F, i) do {} while (0)
#define PT_ADD(F, i) do {} while (0)
#else
#define PTK_SUB(F, i) do {} while (0)
#define PTK_ADD(F, i) do {} while (0)
#define PT_SUB(F, i) PT_SUB_L((F).lds, i)
#define PT_ADD(F, i) PT_ADD_L((F).lds, i)
#endif
namespace pg8 {
#define PG8_LAS __attribute__((address_space(3)))
typedef unsigned short bf16_t;
typedef short bf16x8 __attribute__((ext_vector_type(8)));
typedef float f32x4 __attribute__((ext_vector_type(4)));
typedef unsigned u32x4 __attribute__((ext_vector_type(4)));
constexpr int BM = 256, BK = 64, HALF = 128, HTB = HALF * BK * 2  , STAGE_BYTES = 8 * HTB, NXCD = 8, WGM = 8;

__host__ __device__ __forceinline__ int lds_byte(int r, int c) { const int st = (r >> 4) * 2 + (c >> 5), rr = r & 15, cc = c & 31, ob = rr * 64 + cc * 2; return st * 1024 + (ob ^ (((ob >> 9) & 1) << 5)); }
__host__ __device__ __forceinline__ void stage_rc(int b, int& R, int& C) { const int st = b / 1024, sb = b % 1024, swz = sb ^ (((sb >> 9) & 1) << 5); R = (st >> 1) * 16 + swz / 64; C = (st & 1) * 32 + (swz % 64) / 2; }
__host__ __device__ __forceinline__ int perm32(int rho) { const int n = rho >> 4, i = rho & 15; return 8 * (i >> 2) + 4 * n + (i & 3); }

struct Unit { int pm, pn; };
struct Gemm { const bf16_t* A; const bf16_t* Bt; int M, N, K; };

struct StaticOrder {
    int nM, nN, nwg, G, c;
    __host__ __device__ void init(int M, int N, int G_, int c_) { nM = M / BM; nN = N / BM; nwg = nM * nN; G = G_; c = c_; }
    __host__ __device__ bool next(int i, Unit& u) const {
        const long L = (long)i * G + c; if (L >= nwg) return false;
        int wgid = (int)L; { const int q = nwg / NXCD, r = nwg % NXCD, xcd = wgid % NXCD, off = wgid / NXCD; wgid = (xcd < r ? xcd * (q + 1) : r * (q + 1) + (xcd - r) * q) + off; }
        const int nig = WGM * nN, gid = wgid / nig, fm = gid * WGM, gsz = (nM - fm) < WGM ? (nM - fm) : WGM;
        u.pm = fm + ((wgid % nig) % gsz); u.pn = (wgid % nig) / gsz; return true;
    }
    __device__ __forceinline__ void a_ready(const Unit&) const {}
    __device__ __forceinline__ void done(const Unit&) const {}
};

constexpr int NCV = 8;
struct SpecOrder {
    int nM, nN, nwg, G, c, x, j; bool spec; unsigned* ready; mutable int have;
    __device__ void init(int M, int N, int G_, int c_, bool spec_, unsigned* ready_) { nM = M / BM; nN = N / BM; nwg = nM * nN; G = G_; c = c_; spec = spec_; x = c_ & 7; j = c_ >> 3; ready = ready_; have = 0; }
    __device__ __forceinline__ bool next(int i, Unit& u) const {
        int wgid;
        if (spec) { const int off = (j >= NCV) ? (i < 2 ? (32 - NCV) * i + (j - NCV) : 2 * (32 - NCV) + 32 * (i - 2) + j) : 2 * (32 - NCV) + 32 * i + j; if (off >= nwg / NXCD) return false; wgid = x * (nwg / NXCD) + off; }
        else { const long L = (long)i * G + c; if (L >= nwg) return false;
            wgid = (int)L; { const int q = nwg / NXCD, r = nwg % NXCD, xcd = wgid % NXCD, off = wgid / NXCD; wgid = (xcd < r ? xcd * (q + 1) : r * (q + 1) + (xcd - r) * q) + off; } }
        const int nig = WGM * nN, gid = wgid / nig, fm = gid * WGM, gsz = (nM - fm) < WGM ? (nM - fm) : WGM;
        u.pm = fm + ((wgid % nig) % gsz); u.pn = (wgid % nig) / gsz; return true;
    }
    __device__ __forceinline__ void a_ready(const Unit& u) const {
        if (!spec) return;
        const int ch = u.pm / 24, grp = (u.pm - 24 * ch) >> 3;
        if (grp <= have) return;
        if (threadIdx.x < 64) {
            const unsigned long long t0 = __builtin_amdgcn_s_memrealtime();
            while ((unsigned)__builtin_amdgcn_readfirstlane(__hip_atomic_load(ready + 64 * (2 * ch + grp - 1), __ATOMIC_RELAXED, __HIP_MEMORY_SCOPE_AGENT)) < (unsigned)NCV) {
                if (__builtin_amdgcn_s_memrealtime() - t0 > 2000000ull) break;
                __builtin_amdgcn_s_sleep(2); }
            __builtin_amdgcn_fence(__ATOMIC_ACQUIRE, "agent");
            asm volatile("s_waitcnt vmcnt(0)" ::: "memory");
        }
        asm volatile("" ::: "memory"); __builtin_amdgcn_s_barrier(); asm volatile("" ::: "memory");
        have = grp;
    }
    __device__ __forceinline__ void done(const Unit&) const {}
};
struct ListOrder {
    int nN, n, first, stride;
    __device__ __forceinline__ bool next(int i, Unit& u) const { const long L = (long)first + (long)i * stride; if (L >= n) return false; u.pm = (int)L / nN; u.pn = (int)L % nN; return true; }
    __device__ __forceinline__ void a_ready(const Unit&) const {}
    __device__ __forceinline__ void done(const Unit&) const {}
};

__device__ __forceinline__ unsigned cvt_pk_bf16(float lo, float hi) { unsigned r; asm volatile("v_cvt_pk_bf16_f32 %0, %1, %2" : "=v"(r) : "v"(lo), "v"(hi)); return r; }
typedef float f32x2 __attribute__((ext_vector_type(2)));
__device__ __forceinline__ float sum_xor16(float v) { const auto r = __builtin_amdgcn_permlane16_swap(__float_as_uint(v), __float_as_uint(v), false, false); return __uint_as_float(r[0]) + __uint_as_float(r[1]); }
__device__ __forceinline__ float sum_xor32(float v) { const auto r = __builtin_amdgcn_permlane32_swap(__float_as_uint(v), __float_as_uint(v), false, false); return __uint_as_float(r[0]) + __uint_as_float(r[1]); }
__device__ __forceinline__ float sq4(const f32x4 v) { return (v[0] * v[0] + v[1] * v[1]) + (v[2] * v[2] + v[3] * v[3]); }
__device__ __forceinline__ u32x4 pack8(const f32x4 a, const f32x4 b) { u32x4 w; w.x = cvt_pk_bf16(a[0], a[1]); w.y = cvt_pk_bf16(a[2], a[3]); w.z = cvt_pk_bf16(b[0], b[1]); w.w = cvt_pk_bf16(b[2], b[3]); return w; }

struct EpiQKV {
    static constexpr bool PERM = true, AFTER_DRAIN = false, KSCALE = false, PREP = true, PREFETCH = false; static constexpr int KS_T1 = -1, KS_T2 = -1;
    static constexpr int NE = 0 * 16;
    bf16_t* QKV;
    const float *gqa, *gka, *gqb, *gkb, *gqm;
    const float *rc, *rs;
    static constexpr int GAIN_OFF = 131072 + 4096;
    __device__ __forceinline__ void prep(const Unit&, PG8_LAS unsigned char* lds, int idx, int tid, int = -1) const {
        if (idx != 0) return;
        const int wid = __builtin_amdgcn_readfirstlane(tid >> 6), lane = tid & 63;
        if (wid < 5 && lane < 16) {
            const float* gp = wid == 0 ? gqa : (wid == 1 ? gka : (wid == 2 ? gqb : (wid == 3 ? gkb : gqm)));
            __builtin_amdgcn_global_load_lds((const unsigned*)(gp + lane * 4), (PG8_LAS unsigned*)(lds + GAIN_OFF + wid * 256), 16, 0, 0); }
    }
    __device__ __forceinline__ void epi(const f32x4 (&acc)[2][2][4][2], const Unit& u, int wr, int wc, int fr, int fq, PG8_LAS unsigned char* lds, int) const {
        const int hidx = u.pn * 4 + wc;
        int gsel = -1; bool rope = false; float qs = 1.f;
        if (hidx < 6) { gsel = 0; rope = true; qs = QSCALE; } else if (hidx < 12) { gsel = 1; rope = true; } else if (hidx < 18) { } else if (hidx < 24) { gsel = 2; qs = QSCALE; }
        else if (hidx < 30) { gsel = 3; } else if (hidx < 36) { } else { gsel = 4; qs = QSCALE; }
        const bool gain = gsel >= 0;
        const PG8_LAS float* gl = (const PG8_LAS float*)(lds + GAIN_OFF + (gsel < 0 ? 0 : gsel) * 256);
        const bool rl = rope && fq < 2;
        f32x4 g[2][2];
#pragma unroll
        for (int bj = 0; bj < 2; ++bj)
#pragma unroll
            for (int n = 0; n < 2; ++n) { const int d0 = (rl && bj == 0) ? (8 * n + 4 * fq) : (32 * bj + 8 * fq + 4 * n); g[bj][n] = gain ? *(const PG8_LAS f32x4*)(gl + d0) : (f32x4){1.f, 1.f, 1.f, 1.f}; }
        bf16_t* base = QKV + (size_t)hidx * MTOK * 64 + 8 * fq;
#pragma unroll
        for (int ai = 0; ai < 2; ++ai) {
            f32x4 rcv[4], rsv[4];
            if (rope) {
#pragma unroll
                for (int m = 0; m < 4; ++m) { const int row = u.pm * BM + ai * HALF + wr * 64 + m * 16 + fr, pos = row < TP ? row : ((row - TP) & (TS - 1));
                    rcv[m] = *(const f32x4*)(rc + pos * 8 + 4 * (fq & 1)); rsv[m] = *(const f32x4*)(rs + pos * 8 + 4 * (fq & 1)); }
#pragma unroll
                for (int m = 0; m < 4; ++m) asm volatile("" : "+v"(rcv[m]), "+v"(rsv[m]));
            }
#pragma unroll
            for (int m = 0; m < 4; ++m) {
                const int row = u.pm * BM + ai * HALF + wr * 64 + m * 16 + fr;
                f32x4 v[2][2];
#pragma unroll
                for (int bj = 0; bj < 2; ++bj)
#pragma unroll
                    for (int n = 0; n < 2; ++n) v[bj][n] = acc[ai][bj][m][n];
                if (gain) {
                    float ss = (sq4(v[0][0]) + sq4(v[0][1])) + (sq4(v[1][0]) + sq4(v[1][1]));
                    ss = sum_xor32(sum_xor16(ss));
                    const float r = rsqrtf(ss * (1.f / 64.f) + RMS_EPS) * qs;
#pragma unroll
                    for (int bj = 0; bj < 2; ++bj)
#pragma unroll
                        for (int n = 0; n < 2; ++n) v[bj][n] = v[bj][n] * r * g[bj][n];
                    if (rope) {
                        const f32x4 c = rcv[m], s = rsv[m];
                        if (fq < 2) { const f32x4 x1 = v[0][0], x2 = v[0][1]; v[0][0] = x1 * c - x2 * s; v[0][1] = x2 * c + x1 * s; }
                    }
                }
                bf16_t* rowp = base + (size_t)row * 64;
                __builtin_nontemporal_store(pack8(v[0][0], v[0][1]), (u32x4*)(rowp));
                __builtin_nontemporal_store(pack8(v[1][0], v[1][1]), (u32x4*)(rowp + 32));
            }
        }
    }
};
struct EpiMemKV {
    static constexpr bool PERM = true, AFTER_DRAIN = false, KSCALE = false, PREP = false, PREFETCH = false; static constexpr int KS_T1 = -1, KS_T2 = -1;
    static constexpr int NE = 0;
    bf16_t* MK; bf16_t* MV; const float* gk;
    __device__ __forceinline__ void operator()(const f32x4 (&acc)[2][2][4][2], const Unit& u, int wr, int wc, int fr, int fq) const {
        const int hidx = u.pn * 4 + wc; const bool isk = hidx < 4; const int h = hidx & 3;
        f32x4 g[2][2];
#pragma unroll
        for (int bj = 0; bj < 2; ++bj)
#pragma unroll
            for (int n = 0; n < 2; ++n) g[bj][n] = isk ? *(const f32x4*)(gk + 32 * bj + 8 * fq + 4 * n) : (f32x4){1.f, 1.f, 1.f, 1.f};
        bf16_t* base = (isk ? MK : MV) + 8 * fq;
#pragma unroll
        for (int ai = 0; ai < 2; ++ai)
#pragma unroll
            for (int m = 0; m < 4; ++m) {
                const int row = u.pm * BM + ai * HALF + wr * 64 + m * 16 + fr;
                f32x4 v[2][2];
#pragma unroll
                for (int bj = 0; bj < 2; ++bj)
#pragma unroll
                    for (int n = 0; n < 2; ++n) v[bj][n] = acc[ai][bj][m][n];
                if (isk) {
                    float ss = (sq4(v[0][0]) + sq4(v[0][1])) + (sq4(v[1][0]) + sq4(v[1][1]));
                    ss = sum_xor32(sum_xor16(ss));
                    const float r = rsqrtf(ss * (1.f / 64.f) + RMS_EPS);
#pragma unroll
                    for (int bj = 0; bj < 2; ++bj)
#pragma unroll
                        for (int n = 0; n < 2; ++n) v[bj][n] = v[bj][n] * r * g[bj][n];
                }
                bf16_t* rowp = base + ((size_t)((row >> 8) * 4 + h) * NMEM + (row & 255)) * 64;
                __builtin_nontemporal_store(pack8(v[0][0], v[0][1]), (u32x4*)(rowp));
                __builtin_nontemporal_store(pack8(v[1][0], v[1][1]), (u32x4*)(rowp + 32));
            }
    }
};
struct EpiX1 {
    static constexpr int NE = 0 * 32;
    static constexpr bool PERM = true, AFTER_DRAIN = false, KSCALE = true, PREP = true, PREFETCH = false; static constexpr int KS_T1 = 6, KS_T2 = 12;
    const bf16_t* xn; const float* irstd; const float* gin; bf16_t* x1b; float* ssq; const float* ssqa;
    static constexpr int TBL_OFF = 131072, GTBL_OFF = 131072 + 8192;
    __device__ __forceinline__ void prep(const Unit& u, PG8_LAS unsigned char* lds, int idx, int tid, int = -1) const {
        if (tid < BM) { const f32x4* qp = (const f32x4*)(ssqa + (size_t)(u.pm * BM + tid) * 16); const f32x4 q0 = qp[0], q1 = qp[1], q2 = qp[2], q3 = qp[3];
            const float qa = (q0[0] + q0[1]) + (q0[2] + q0[3]) + (q1[0] + q1[1]), qb = (q1[2] + q1[3]) + (q2[0] + q2[1]) + (q2[2] + q2[3]), qm = (q3[0] + q3[1]) + (q3[2] + q3[3]);
            const float sa = rsqrtf(qa * (1.f / 384.f) + RMS_EPS), sb = rsqrtf(qb * (1.f / 384.f) + RMS_EPS), sm = rsqrtf(qm * (1.f / 256.f) + RMS_EPS);
            *(PG8_LAS f32x4*)(lds + TBL_OFF + (idx & 1) * 4096 + tid * 16) = (f32x4){sa / sb, sb / sm, sm, irstd[u.pm * BM + tid]}; }
        else { const int c = tid - BM; *(PG8_LAS float*)(lds + GTBL_OFF + (idx & 1) * 1024 + c * 4) = 1.0f / gin[u.pn * BM + c]; }
    }
    __device__ __forceinline__ void kscale(f32x4 (&acc)[2][2][4][2], int t, int wr, int fr, PG8_LAS unsigned char* lds, int idx) const {
        const PG8_LAS float* tb = (const PG8_LAS float*)(lds + TBL_OFF + (idx & 1) * 4096) + ((t == KS_T1) ? 0 : 1);
#pragma unroll
        for (int ai = 0; ai < 2; ++ai)
#pragma unroll
            for (int m = 0; m < 4; ++m) {
                const float f = tb[(ai * HALF + wr * 64 + m * 16 + fr) * 4];
#pragma unroll
                for (int bj = 0; bj < 2; ++bj)
#pragma unroll
                    for (int n = 0; n < 2; ++n) acc[ai][bj][m][n] = acc[ai][bj][m][n] * f;
            }
    }
    __device__ __forceinline__ void epi(const f32x4 (&acc)[2][2][4][2], const Unit& u, int wr, int wc, int fr, int fq, PG8_LAS unsigned char* lds, int idx) const {
        const PG8_LAS float* tb = (const PG8_LAS float*)(lds + TBL_OFF + (idx & 1) * 4096);
        const PG8_LAS f32x4* gt = (const PG8_LAS f32x4*)(lds + GTBL_OFF + (idx & 1) * 1024 + (wc * 32 + 8 * fq) * 4);
        f32x4 ig[2][2];
#pragma unroll
        for (int bj = 0; bj < 2; ++bj) { ig[bj][0] = gt[bj * 32]; ig[bj][1] = gt[bj * 32 + 1]; }
        const int col0 = u.pn * BM + wc * 32 + 8 * fq;
        u32x4 xr[2][4][2];
#pragma unroll
        for (int ai = 0; ai < 2; ++ai)
#pragma unroll
            for (int m = 0; m < 4; ++m) { const bf16_t* xrow = xn + (size_t)(u.pm * BM + ai * HALF + wr * 64 + m * 16 + fr) * DM + col0;
#pragma unroll
                for (int bj = 0; bj < 2; ++bj) xr[ai][m][bj] = __builtin_nontemporal_load((const u32x4*)(xrow + bj * HALF)); }
#pragma unroll
        for (int ai = 0; ai < 2; ++ai) {
#pragma unroll
            for (int m = 0; m < 4; ++m) {
                const int rl = ai * HALF + wr * 64 + m * 16 + fr, row = u.pm * BM + rl;
                const float sm = tb[rl * 4 + 2], ir = tb[rl * 4 + 3];
                bf16_t* brow = x1b + (size_t)row * DM + col0;
                float ss = 0.f;
#pragma unroll
                for (int bj = 0; bj < 2; ++bj) {
                    const u32x4 r = xr[ai][m][bj];
                    const f32x4 r0 = {__uint_as_float(r.x << 16), __uint_as_float(r.x & 0xffff0000u), __uint_as_float(r.y << 16), __uint_as_float(r.y & 0xffff0000u)};
                    const f32x4 r1 = {__uint_as_float(r.z << 16), __uint_as_float(r.z & 0xffff0000u), __uint_as_float(r.w << 16), __uint_as_float(r.w & 0xffff0000u)};
                    const f32x4 v0 = acc[ai][bj][m][0] * sm + r0 * ig[bj][0] * ir, v1 = acc[ai][bj][m][1] * sm + r1 * ig[bj][1] * ir;
                    *(u32x4*)(brow + bj * HALF) = pack8(v0, v1);
                    ss += sq4(v0) + sq4(v1);
                }
                ss = sum_xor32(sum_xor16(ss));
                if (fq == 0) ssq[(size_t)row * 16 + u.pn * 4 + wc] = ss;
            }
            asm volatile("" ::: "memory");
        }
    }
};
struct EpiH {
    static constexpr bool PERM = true, AFTER_DRAIN = false, KSCALE = false, PREP = true, PREFETCH = false; static constexpr int KS_T1 = -1, KS_T2 = -1;
    static constexpr int NE = 16;
    bf16_t* H; const float* ssq; int mode;
    static constexpr int TBL_OFF = 131072;
    __device__ __forceinline__ void prep(const Unit& u, PG8_LAS unsigned char* lds, int idx, int tid, int prev_pm = -1) const {
        if (u.pm == prev_pm) {
            if (tid < BM) *(PG8_LAS float*)(lds + TBL_OFF + (idx & 1) * 1024 + tid * 4) = *(const PG8_LAS float*)(lds + TBL_OFF + ((idx & 1) ^ 1) * 1024 + tid * 4);
            return; }
        if (tid < BM) { const f32x4* qp = (const f32x4*)(ssq + (size_t)(u.pm * BM + tid) * 16); const f32x4 q0 = qp[0], q1 = qp[1], q2 = qp[2], q3 = qp[3];
            const float s = ((q0[0] + q0[1]) + (q0[2] + q0[3])) + ((q1[0] + q1[1]) + (q1[2] + q1[3])) + ((q2[0] + q2[1]) + (q2[2] + q2[3])) + ((q3[0] + q3[1]) + (q3[2] + q3[3]));
            *(PG8_LAS float*)(lds + TBL_OFF + (idx & 1) * 1024 + tid * 4) = rsqrtf(s * (1.f / DM) + RMS_EPS); }
    }
    __device__ __forceinline__ void epi(const f32x4 (&acc)[2][2][4][2], const Unit& u, int wr, int wc, int fr, int fq, PG8_LAS unsigned char* lds, int idx) const {
        if (mode == 2) return;
        const PG8_LAS float* tb = (const PG8_LAS float*)(lds + TBL_OFF + (idx & 1) * 1024);
        const int col0 = u.pn * BM + wc * 32 + 8 * fq;
#pragma unroll
        for (int ai = 0; ai < 2; ++ai)
#pragma unroll
            for (int m = 0; m < 4; ++m) {
                const int row = u.pm * BM + ai * HALF + wr * 64 + m * 16 + fr;
                const float r = tb[ai * HALF + wr * 64 + m * 16 + fr];
                bf16_t* hrow = H + (size_t)row * FF + col0;
#pragma unroll
                for (int bj = 0; bj < 2; ++bj) {
                    f32x4 v0 = acc[ai][bj][m][0] * r, v1 = acc[ai][bj][m][1] * r;
#pragma unroll
                    for (int e = 0; e < 4; ++e) { const float a = fmaxf(v0[e], 0.f), b = fmaxf(v1[e], 0.f); v0[e] = a * a; v1[e] = b * b; }
                    const u32x4 pk = pack8(v0, v1); if (mode == 0) *(u32x4*)(hrow + bj * HALF) = pk; else asm volatile("" :: "v"(pk));
                }
            }
    }
};
struct EpiOut {
    static constexpr bool PERM = true, AFTER_DRAIN = false, KSCALE = false, PREP = false, PREFETCH = false; static constexpr int KS_T1 = -1, KS_T2 = -1;
    static constexpr int NE = 0 * 48;
    float* out; const bf16_t* x1b;
    static constexpr int JUNK_OFF = 131072 + 8192;
    __device__ __forceinline__ void prefetch(const Unit& u, PG8_LAS unsigned char* lds, int tid) const {
        const int wid = tid >> 6;
#pragma unroll
        for (int i = 0; i < 2; ++i) { const int line = i * 512 + tid; const bf16_t* src = x1b + (size_t)(u.pm * BM + (line >> 2)) * DM + u.pn * BM + (line & 3) * 64;
            __builtin_amdgcn_global_load_lds((const unsigned*)src, (PG8_LAS unsigned*)(lds + JUNK_OFF + (wid & 3) * 256), 4, 0, 0); }
    }
    __device__ __forceinline__ void operator()(const f32x4 (&acc)[2][2][4][2], const Unit& u, int wr, int wc, int fr, int fq) const {
        const int col0 = u.pn * BM + wc * 32 + 8 * fq;
        u32x4 rr[2][4][2];
#pragma unroll
        for (int ai = 0; ai < 2; ++ai)
#pragma unroll
            for (int m = 0; m < 4; ++m) { const bf16_t* brow = x1b + (size_t)(u.pm * BM + ai * HALF + wr * 64 + m * 16 + fr) * DM + col0;
#pragma unroll
                for (int bj = 0; bj < 2; ++bj) rr[ai][m][bj] = *(const u32x4*)(brow + bj * HALF); }
#pragma unroll
        for (int ai = 0; ai < 2; ++ai) {
#pragma unroll
            for (int m = 0; m < 4; ++m) {
                const int row = u.pm * BM + ai * HALF + wr * 64 + m * 16 + fr;
                float* orow = out + (size_t)row * DM + col0;
#pragma unroll
                for (int bj = 0; bj < 2; ++bj) {
                    const u32x4 r = rr[ai][m][bj];
                    const f32x4 r0 = {__uint_as_float(r.x << 16), __uint_as_float(r.x & 0xffff0000u), __uint_as_float(r.y << 16), __uint_as_float(r.y & 0xffff0000u)};
                    const f32x4 r1 = {__uint_as_float(r.z << 16), __uint_as_float(r.z & 0xffff0000u), __uint_as_float(r.w << 16), __uint_as_float(r.w & 0xffff0000u)};
                    *(f32x4*)(orow + bj * HALF) = acc[ai][bj][m][0] + r0; *(f32x4*)(orow + bj * HALF + 4) = acc[ai][bj][m][1] + r1;
                }
            }
            asm volatile("" ::: "memory");
        }
    }
};

template <class Epi, class Sched, bool ALIGN_EPI = false, bool SP2 = false>
__device__ __forceinline__ void gemm_phase(PG8_LAS unsigned char* lds, const Gemm g, const Sched& S, const Epi& E) {
    const int tid = threadIdx.x, wid = __builtin_amdgcn_readfirstlane(tid >> 6), lane = tid & 63, wr = wid >> 2, wc = wid & 3, fr = lane & 15, fq = lane >> 4;
    const int K = g.K, nt = K / BK;
    unsigned voffA[2], voffB[2];
#pragma unroll
    for (int i = 0; i < 2; ++i) { int R, C; stage_rc(tid * 16 + i * 8192, R, C); const int Rb = Epi::PERM ? ((R & ~31) + perm32(R & 31)) : R;
        voffA[i] = (unsigned)(R * K + C) * 2u; voffB[i] = (unsigned)(Rb * K + C) * 2u; }
    const size_t kstep = (size_t)(BK * 2);
    const size_t hstep = (size_t)HALF * K * 2;
    const size_t tstep = 2 * hstep;
    const unsigned ldsw = (unsigned)wid * 1024u;
    const int aoff = lds_byte(wr * 64 + fr, fq * 8), boff = lds_byte(wc * 32 + fr, fq * 8);
#define PG8_SA(b, h) (((b) * 2 + (h)) * HTB)
#define PG8_SB(b, h) ((4 + (b) * 2 + (h)) * HTB)
#define PG8_STAGE(bufoff, gbase, voff) do { _Pragma("unroll") for (int _i = 0; _i < 2; ++_i) \
        __builtin_amdgcn_global_load_lds((const unsigned*)((const char*)(gbase) + (voff)[_i]), (PG8_LAS unsigned*)(lds + (bufoff) + ldsw + _i * 8192), 16, 0, 0); } while (0)
#define PG8_LDA(dst, b, h) do { _Pragma("unroll") for (int m = 0; m < 4; ++m) _Pragma("unroll") for (int k = 0; k < 2; ++k) dst[m][k] = *(const PG8_LAS bf16x8*)(lds + PG8_SA(b, h) + aoff + m * 2048 + k * 1024); } while (0)
#define PG8_LDB(dst, b, h) do { _Pragma("unroll") for (int n = 0; n < 2; ++n) _Pragma("unroll") for (int k = 0; k < 2; ++k) dst[n][k] = *(const PG8_LAS bf16x8*)(lds + PG8_SB(b, h) + boff + n * 2048 + k * 1024); } while (0)
#define PG8_MMA(ai, bj, At, Bt) do { __builtin_amdgcn_s_setprio(1); _Pragma("unroll") for (int m = 0; m < 4; ++m) _Pragma("unroll") for (int n = 0; n < 2; ++n) _Pragma("unroll") for (int k = 0; k < 2; ++k) \
        acc[ai][bj][m][n] = __builtin_amdgcn_mfma_f32_16x16x32_bf16(Bt[n][k], At[m][k], acc[ai][bj][m][n], 0, 0, 0); __builtin_amdgcn_s_setprio(0); } while (0)
#define PG8_WAIT_V(n) asm volatile("s_waitcnt vmcnt(" #n ")" ::: "memory")
#define PG8_WAIT_VN(n) asm volatile("s_waitcnt vmcnt(%0)" :: "n"(n) : "memory")
#define PG8_WAIT_L(n) asm volatile("s_waitcnt lgkmcnt(" #n ")" ::: "memory")
#define PG8_BAR __builtin_amdgcn_s_barrier()
#define PG8_SCHED __builtin_amdgcn_sched_barrier(0)
    constexpr bool GRACE = SP2 && ALIGN_EPI && (Epi::NE > 0);
    constexpr int JUNK_LDS = 131072 + 12288;
#define PG8_KPAIR(FIRST) do { \
    PG8_LDB(B0, 0, 0); PG8_LDB(B1, 0, 1); PG8_SCHED; PG8_LDA(At, 0, 0); if (!(FIRST)) PG8_STAGE(PG8_SA(1, 1), a1 + hstep, voffA); \
    PG8_WAIT_VN((FIRST) ? 8 + Epi::NE : 8); PG8_WAIT_L(0); PG8_BAR; PG8_MMA(0, 0, At, B0); PG8_MMA(0, 1, At, B1); PG8_BAR; PG8_SCHED; \
    PG8_LDA(At, 0, 1); PG8_STAGE(PG8_SB(0, 0), b2, voffB); PG8_STAGE(PG8_SB(0, 1), b2 + hstep, voffB); PG8_STAGE(PG8_SA(0, 0), a2, voffA); \
    PG8_WAIT_VN((FIRST) ? 8 + Epi::NE : 8); PG8_WAIT_L(0); PG8_BAR; PG8_MMA(1, 0, At, B0); PG8_MMA(1, 1, At, B1); PG8_BAR; PG8_SCHED; \
    PG8_LDB(B0, 1, 0); PG8_LDB(B1, 1, 1); PG8_SCHED; PG8_LDA(At, 1, 0); PG8_STAGE(PG8_SA(0, 1), a2 + hstep, voffA); \
    PG8_WAIT_VN((FIRST) ? 8 + Epi::NE : 8); PG8_WAIT_L(0); PG8_BAR; PG8_MMA(0, 0, At, B0); PG8_MMA(0, 1, At, B1); PG8_BAR; PG8_SCHED; \
    PG8_LDA(At, 1, 1); PG8_STAGE(PG8_SB(1, 0), b3, voffB); PG8_STAGE(PG8_SB(1, 1), b3 + hstep, voffB); PG8_STAGE(PG8_SA(1, 0), a3, voffA); \
    PG8_WAIT_V(8); PG8_WAIT_L(0); PG8_BAR; PG8_MMA(1, 0, At, B0); PG8_MMA(1, 1, At, B1); PG8_BAR; PG8_SCHED; } while (0)
    Unit cur, nxt; int ui = 0;
    if (!S.next(0, cur)) return;
    PT_SUB_L(lds, 5);
    f32x4 acc[2][2][4][2];
#pragma unroll
    for (int a = 0; a < 2; ++a)
#pragma unroll
        for (int b = 0; b < 2; ++b)
#pragma unroll
            for (int m = 0; m < 4; ++m)
#pragma unroll
                for (int n = 0; n < 2; ++n) acc[a][b][m][n] = (f32x4){0.f, 0.f, 0.f, 0.f};
    bf16x8 At[4][2], B0[2][2], B1[2][2];
    const char* cA = (const char*)g.A + (size_t)cur.pm * tstep; const char* cB = (const char*)g.Bt + (size_t)cur.pn * tstep;
    S.a_ready(cur);
    if constexpr (Epi::PREP) E.prep(cur, lds, 0, tid);
    if constexpr (SP2) {
        PG8_STAGE(PG8_SB(0, 0), cB, voffB); PG8_STAGE(PG8_SB(0, 1), cB + hstep, voffB); PG8_STAGE(PG8_SA(0, 0), cA, voffA); PG8_STAGE(PG8_SA(0, 1), cA + hstep, voffA);
        if (wr == 1) PG8_BAR;
        PG8_WAIT_V(2); PG8_BAR;
        PG8_STAGE(PG8_SB(1, 0), cB + kstep, voffB); PG8_STAGE(PG8_SA(1, 0), cA + kstep, voffA); PG8_STAGE(PG8_SB(1, 1), cB + hstep + kstep, voffB);
        PG8_WAIT_V(6); PG8_BAR;
        if constexpr (GRACE) { PG8_STAGE(PG8_SA(1, 1), cA + kstep + hstep, voffA);
#pragma unroll
            for (int i = 0; i < Epi::NE; ++i) __builtin_amdgcn_global_load_lds((const unsigned*)((const char*)g.A + (unsigned)(lane * 4)), (PG8_LAS unsigned*)(lds + JUNK_LDS), 4, 0, 0); }
    } else {
        PG8_STAGE(PG8_SB(0, 0), cB, voffB); PG8_STAGE(PG8_SA(0, 0), cA, voffA); PG8_STAGE(PG8_SB(0, 1), cB + hstep, voffB); PG8_STAGE(PG8_SA(0, 1), cA + hstep, voffA);
        if (wr == 1) PG8_BAR;
        PG8_WAIT_V(4); PG8_BAR;
        PG8_STAGE(PG8_SB(1, 0), cB + kstep, voffB); PG8_STAGE(PG8_SA(1, 0), cA + kstep, voffA); PG8_STAGE(PG8_SB(1, 1), cB + hstep + kstep, voffB);
        PG8_WAIT_V(6); PG8_BAR;
    }
    for (;;) {
        const bool has_next = S.next(ui + 1, nxt);
        const char* nA = has_next ? (const char*)g.A + (size_t)nxt.pm * tstep : cA; const char* nB = has_next ? (const char*)g.Bt + (size_t)nxt.pn * tstep : cB;
        if constexpr (GRACE) {
            const char* a1 = cA + kstep; const char* a2 = cA + 2 * kstep; const char* b2 = cB + 2 * kstep; const char* a3 = a2 + kstep; const char* b3 = b2 + kstep;
            PG8_KPAIR(1);
        }
        for (int t = GRACE ? 2 : 0; t < nt; t += 2) {
            const bool last = (t == nt - 2);
            if constexpr (Epi::KSCALE) { if (t == Epi::KS_T1 || t == Epi::KS_T2) E.kscale(acc, t, wr, fr, lds, ui); }
            if constexpr (Epi::PREFETCH) { if (t == 4) E.prefetch(cur, lds, tid); }
            const char* a1 = cA + (size_t)(t + 1) * kstep;
            const char* a2 = last ? nA : cA + (size_t)(t + 2) * kstep; const char* b2 = last ? nB : cB + (size_t)(t + 2) * kstep;
            const char* a3 = a2 + kstep; const char* b3 = b2 + kstep;
            if (last && has_next) { S.a_ready(nxt); if constexpr (Epi::PREP) { int tid2 = threadIdx.x; asm volatile("" : "+v"(tid2)); E.prep(nxt, lds, ui + 1, tid2, cur.pm); } }
            if constexpr (SP2) {
            PG8_KPAIR(0);
            } else {
            PG8_LDB(B0, 0, 0); PG8_SCHED; PG8_LDA(At, 0, 0); PG8_STAGE(PG8_SA(1, 1), a1 + hstep, voffA);
            PG8_WAIT_L(8); PG8_BAR; PG8_WAIT_L(0); PG8_MMA(0, 0, At, B0); PG8_BAR; PG8_SCHED;
            PG8_LDB(B1, 0, 1); PG8_STAGE(PG8_SB(0, 0), b2, voffB);
            PG8_BAR; PG8_WAIT_L(0); PG8_MMA(0, 1, At, B1); PG8_BAR;
            PG8_LDA(At, 0, 1); PG8_STAGE(PG8_SA(0, 0), a2, voffA);
            PG8_BAR; PG8_WAIT_L(0); PG8_MMA(1, 0, At, B0); PG8_BAR; PG8_SCHED;
            PG8_STAGE(PG8_SB(0, 1), b2 + hstep, voffB);
            PG8_WAIT_V(6); PG8_BAR; PG8_MMA(1, 1, At, B1); PG8_BAR;
            PG8_LDB(B0, 1, 0); PG8_SCHED; PG8_LDA(At, 1, 0); PG8_STAGE(PG8_SA(0, 1), a2 + hstep, voffA);
            PG8_WAIT_L(8); PG8_BAR; PG8_WAIT_L(0); PG8_MMA(0, 0, At, B0); PG8_BAR; PG8_SCHED;
            PG8_LDB(B1, 1, 1); PG8_STAGE(PG8_SB(1, 0), b3, voffB);
            PG8_BAR; PG8_WAIT_L(0); PG8_MMA(0, 1, At, B1); PG8_BAR;
            PG8_LDA(At, 1, 1); PG8_STAGE(PG8_SA(1, 0), a3, voffA);
            PG8_BAR; PG8_WAIT_L(0); PG8_MMA(1, 0, At, B0); PG8_BAR; PG8_SCHED;
            PG8_STAGE(PG8_SB(1, 1), b3 + hstep, voffB);
            PG8_WAIT_V(6); PG8_BAR; PG8_MMA(1, 1, At, B1); PG8_BAR;
            }
        }
        if constexpr (ALIGN_EPI) { if (wr == 0) PG8_BAR; }
        if constexpr (GRACE) PG8_STAGE(PG8_SA(1, 1), nA + kstep + hstep, voffA);
        PT_SUB_L(lds, 4);
        if constexpr (!Epi::AFTER_DRAIN) { int l2 = threadIdx.x; asm volatile("" : "+v"(l2)); const int fr2 = l2 & 15, fq2 = (l2 >> 4) & 3;
            if constexpr (Epi::PREP) E.epi(acc, cur, wr, wc, fr2, fq2, lds, ui); else E(acc, cur, wr, wc, fr2, fq2); S.done(cur); }
        PT_ADD_L(lds, 4);
        if (!has_next) break;
#pragma unroll
        for (int a = 0; a < 2; ++a)
#pragma unroll
            for (int b = 0; b < 2; ++b)
#pragma unroll
                for (int m = 0; m < 4; ++m)
#pragma unroll
                    for (int n = 0; n < 2; ++n) acc[a][b][m][n] = (f32x4){0.f, 0.f, 0.f, 0.f};
        cur = nxt; cA = nA; cB = nB; ++ui;
        if constexpr (ALIGN_EPI) { if (wr == 1) PG8_BAR; }
    }
    PT_ADD_L(lds, 5);
    PG8_WAIT_V(0);
    if constexpr (!ALIGN_EPI) { if (wr == 0) PG8_BAR; }
    PG8_BAR;
    if constexpr (Epi::AFTER_DRAIN) { E.fused(acc, cur, wr, wc, fr, fq, lds, wid, lane); S.done(cur); }
#undef PG8_SA
#undef PG8_SB
#undef PG8_STAGE
#undef PG8_LDA
#undef PG8_LDB
#undef PG8_MMA
#undef PG8_WAIT_V
#undef PG8_WAIT_VN
#undef PG8_KPAIR
#undef PG8_WAIT_L
#undef PG8_BAR
#undef PG8_SCHED
}
}

constexpr int NWAVES = 8;
#ifndef MK_N_LAUNCHES
#define MK_N_LAUNCHES 1
#endif
constexpr int NPH = 7;
constexpr int N_LAUNCHES = MK_N_LAUNCHES;

constexpr size_t MiB = 1u << 20;
constexpr size_t WS_CTL = 0, CTL_ZERO_BYTES = MiB / 4;
constexpr size_t WS_SSQF = 27 * MiB;
constexpr size_t WS_SSQA = 3 * MiB;
constexpr size_t WS_ROPE = 2 * MiB;
constexpr size_t WS_WIN = 3 * MiB, WS_WMEM = 8 * MiB, WS_WOUT = 9 * MiB, WS_W1 = 11 * MiB, WS_W2 = 19 * MiB;
constexpr size_t WS_XNMEM = 27 * MiB, WS_MK = 30 * MiB, WS_MV = 31 * MiB;
constexpr size_t WS_X1B = 32 * MiB;
#define XN_BASE(outp) ((bf16*)(outp) + (size_t)MTOK * DM)
constexpr size_t WS_IRSTD = MiB / 2;
constexpr size_t WS_QKV = 224 * MiB;
constexpr size_t WS_H = 128 * MiB;
constexpr size_t WS_END = 512 * MiB;
static_assert(WS_QKV + (size_t)NHEADS * MTOK * 64 * 2 <= WS_END && WS_H + (size_t)MTOK * FF * 2 <= WS_END && WS_X1B + (size_t)MTOK * DM * 2 <= WS_H && CTL_ZERO_BYTES <= WS_IRSTD && WS_IRSTD + (size_t)MTOK * 4 <= MiB && WS_SSQA + (size_t)MTOK * 64 <= WS_WMEM, "d_ws map");

#define LAS __attribute__((address_space(3)))
typedef unsigned short bf16;
typedef unsigned v4u __attribute__((ext_vector_type(4)));
typedef float f32x4 __attribute__((ext_vector_type(4)));
#define LDS_WAIT() asm volatile("s_waitcnt lgkmcnt(0)" ::: "memory")
__device__ __forceinline__ unsigned f2bf(float f) { unsigned u = __builtin_bit_cast(unsigned, f); return (u + 0x7fffu + ((u >> 16) & 1u)) >> 16; }
__device__ __forceinline__ unsigned pk2(float lo, float hi) { return f2bf(lo) | (f2bf(hi) << 16); }
__device__ __forceinline__ float bflo(unsigned w) { return __uint_as_float(w << 16); }
__device__ __forceinline__ float bfhi(unsigned w) { return __uint_as_float(w & 0xffff0000u); }
__device__ __forceinline__ float wave_sum(float v) {
#pragma unroll
    for (int o = 1; o < 64; o <<= 1) v += __shfl_xor(v, o);
    return v;
}

struct Frame {
    LAS unsigned char* lds;
    int tid, lane, wave, vcu, G, tm;
    float* out; unsigned char* ws;
};
struct Args { const float* in[22]; float* out; unsigned char* ws; int ph_lo, ph_hi; };


namespace att {
typedef short bf16x8 __attribute__((ext_vector_type(8)));
typedef short s16x4 __attribute__((ext_vector_type(4)));
typedef short v4i16_t __attribute__((ext_vector_type(4)));
typedef float f32x16 __attribute__((ext_vector_type(16)));
typedef float f32x4 __attribute__((ext_vector_type(4)));
typedef unsigned u32x4 __attribute__((ext_vector_type(4)));
typedef float f32x2_t __attribute__((ext_vector_type(2))); typedef __bf16 bf16x2_t __attribute__((ext_vector_type(2)));
typedef __attribute__((address_space(3))) unsigned char* lptr;
__device__ __forceinline__ unsigned cvtpk(float lo, float hi) { f32x2_t v = {lo, hi}; bf16x2_t b = __builtin_convertvector(v, bf16x2_t); return __builtin_bit_cast(unsigned, b); }
__device__ __forceinline__ s16x4 vtr(lptr p) { return __builtin_bit_cast(s16x4, __builtin_amdgcn_ds_read_tr16_b64_v4i16((__attribute__((address_space(3))) v4i16_t*)p)); }
__device__ __forceinline__ int creg(int r) { return (r & 3) + 8 * (r >> 2); }
constexpr float NEG = -INFINITY;

__device__ __forceinline__ void load_q(bf16x8 (&qr)[4], const bf16* qrow, int lane) {
    const int hi = lane >> 5;
#pragma unroll
    for (int d0 = 0; d0 < 4; ++d0) qr[d0] = *(const bf16x8*)(qrow + 16 * d0 + 8 * hi);
}
}
template <class CM, class KS>
__device__ __forceinline__ void p0_transpose_item(const float* W, int K, int N, bf16* WT, LAS float* scr, int item, int lane, CM cm, KS ks) {
    const int nblk = N / 32, kb = item / nblk, nb = item % nblk, k0 = 64 * kb, n0 = 32 * nb;
    const int sc = cm(n0 + (lane & 31));
#pragma unroll
    for (int i = 0; i < 32; ++i) { const int kk = 2 * i + (lane >> 5); scr[kk * 33 + (lane & 31)] = __builtin_nontemporal_load(W + (size_t)(k0 + kk) * N + sc) * ks(k0 + kk); }
    LDS_WAIT(); asm volatile("" ::: "memory");
    const int c = lane & 7;
#pragma unroll
    for (int j = 0; j < 4; ++j) { const int n = (lane >> 3) + 8 * j; const LAS float* s = scr + (8 * c) * 33 + n;
        v4u o; o.x = pk2(s[0 * 33], s[1 * 33]); o.y = pk2(s[2 * 33], s[3 * 33]); o.z = pk2(s[4 * 33], s[5 * 33]); o.w = pk2(s[6 * 33], s[7 * 33]);
        *(v4u*)(WT + (size_t)(n0 + n) * K + k0 + 8 * c) = o; }
    LDS_WAIT(); asm volatile("" ::: "memory");
}
struct CMapHead { int nrope;
    __device__ __forceinline__ int operator()(int c) const { const int pn = c >> 8, bj = (c >> 7) & 1, hh = (c >> 5) & 3, p5 = c & 31, hidx = 4 * pn + hh; int p = 32 * bj + p5;
        if (hidx < nrope && p < 16) p = (p & 3) + 8 * ((p >> 2) & 1) + 4 * (p >> 3); return 64 * hidx + p; } };
struct CMapId { __device__ __forceinline__ int operator()(int c) const { return c; } };
struct KSOne { __device__ __forceinline__ float operator()(int) const { return 1.f; } };
struct KSVec { const float* g; __device__ __forceinline__ float operator()(int k) const { return g[k]; } };
struct KSOut { const float *a, *b, *m; __device__ __forceinline__ float operator()(int k) const { return k < 384 ? a[k] : (k < 768 ? b[k - 384] : m[k - 768]); } };

template <int CTRL> __device__ __forceinline__ float dpp_mov(float v) { return __uint_as_float((unsigned)__builtin_amdgcn_update_dpp(0, (int)__float_as_uint(v), CTRL, 0xf, 0xf, true)); }
__device__ __forceinline__ float wave_sum_dpp(float v) {
    v += dpp_mov<0xB1>(v); v += dpp_mov<0x4E>(v); v += dpp_mov<0x141>(v); v += dpp_mov<0x140>(v); return pg8::sum_xor32(pg8::sum_xor16(v)); }
template <int NR> struct RowBuf { f32x4 v[NR][4]; };
template <int NR> __device__ __forceinline__ void rows_load(RowBuf<NR>& b, const float* x0, int lane) {
#pragma unroll
    for (int r = 0; r < NR; ++r) { const f32x4* xr = (const f32x4*)(x0 + (size_t)r * DM) + lane;
#pragma unroll
        for (int j = 0; j < 4; ++j) b.v[r][j] = __builtin_nontemporal_load(xr + 64 * j); }
}
template <int NR> __device__ __forceinline__ void rows_finish(const RowBuf<NR>& b, const f32x4 (&gg)[4], bf16* o0, float* irstd, int lane) {
    float rs[NR];
#pragma unroll
    for (int r = 0; r < NR; ++r) {
        float s = 0.f;
#pragma unroll
        for (int j = 0; j < 4; ++j) s += (b.v[r][j].x * b.v[r][j].x + b.v[r][j].y * b.v[r][j].y) + (b.v[r][j].z * b.v[r][j].z + b.v[r][j].w * b.v[r][j].w);
        const float ms = wave_sum_dpp(s) * (1.f / DM) + RMS_EPS; rs[r] = rsqrtf(ms);
        if (irstd && lane == 0) irstd[r] = sqrtf(ms);
    }
#pragma unroll
    for (int r = 0; r < NR; ++r) {
        unsigned long long* o8 = (unsigned long long*)(o0 + (size_t)r * DM) + lane; const float rstd = rs[r];
#pragma unroll
        for (int j = 0; j < 4; ++j) o8[64 * j] = (unsigned long long)pg8::cvt_pk_bf16(b.v[r][j].x * rstd * gg[j].x, b.v[r][j].y * rstd * gg[j].y) | ((unsigned long long)pg8::cvt_pk_bf16(b.v[r][j].z * rstd * gg[j].z, b.v[r][j].w * rstd * gg[j].w) << 32);
    }
}
__device__ __forceinline__ void gains_load(f32x4 (&gg)[4], const float* g, int lane) {
#pragma unroll
    for (int j = 0; j < 4; ++j) gg[j] = ((const f32x4*)g + lane)[64 * j];
}
__device__ __forceinline__ void p0_prologue(Frame& F, const Args& A, const bool spec) {
    LAS float* scr = (LAS float*)(F.lds + F.wave * 16384);
    const int gw = F.vcu * NWAVES + F.wave, NGW = F.G * NWAVES;
    unsigned char* ws = F.ws;
    constexpr int I_IN = (DM / 64) * (NQKV / 32), I_MEM = (DM / 64) * (512 / 32), I_OUT = (DM / 64) * (DM / 32), I_1 = (DM / 64) * (FF / 32), I_2 = (FF / 64) * (DM / 32);
    constexpr int NITEMS = I_IN + I_MEM + I_OUT + I_1 + I_2;
    PT_SUB(F, 0);
    for (int it = gw; it < NITEMS; it += NGW) {
        int r = it;
        if (r < I_IN) { p0_transpose_item(A.in[5], DM, NQKV, (bf16*)(ws + WS_WIN), scr, r, F.lane, CMapHead{12}, KSOne{}); continue; } r -= I_IN;
        if (r < I_MEM) { p0_transpose_item(A.in[12], DM, 512, (bf16*)(ws + WS_WMEM), scr, r, F.lane, CMapHead{0}, KSOne{}); continue; } r -= I_MEM;
        if (r < I_OUT) { p0_transpose_item(A.in[18], DM, DM, (bf16*)(ws + WS_WOUT), scr, r, F.lane, CMapId{}, KSOut{A.in[15], A.in[16], A.in[17]}); continue; } r -= I_OUT;
        if (r < I_1) { p0_transpose_item(A.in[20], DM, FF, (bf16*)(ws + WS_W1), scr, r, F.lane, CMapId{}, KSVec{A.in[19]}); continue; } r -= I_1;
        p0_transpose_item(A.in[21], FF, DM, (bf16*)(ws + WS_W2), scr, r, F.lane, CMapId{}, KSOne{});
    }
    PT_ADD(F, 0); PT_SUB(F, 1);
    const int NG4 = spec ? (64 * 64 + MMEM / 4) : (MTOK + MMEM) / 4;
    for (int m4 = gw; m4 < NG4; m4 += NGW) {
        int m = 4 * m4; if (spec) { if (m4 < 4096) { const int p = m4 >> 6; m = ((24 * (p >> 3) + (p & 7)) << 8) + 4 * (m4 & 63); } else m = MTOK + 4 * (m4 - 4096); }
        const float* x0; bf16* o0; const float* gn; float* irs = nullptr;
        if (m < MTOK) { x0 = m < TP ? A.in[0] + (size_t)m * DM : A.in[1] + (size_t)(m - TP) * DM; o0 = XN_BASE(F.out) + (size_t)m * DM; gn = A.in[4]; irs = (float*)(ws + WS_IRSTD) + m; }
        else { const int r0 = m - MTOK; x0 = r0 < NMEM ? A.in[2] + (size_t)r0 * DM : A.in[3] + (size_t)(r0 - NMEM) * DM; o0 = (bf16*)(ws + WS_XNMEM) + (size_t)r0 * DM; gn = A.in[11]; }
        f32x4 gg[4]; gains_load(gg, gn, F.lane);
        RowBuf<4> rb; rows_load<4>(rb, x0, F.lane); rows_finish<4>(rb, gg, o0, irs, F.lane);
    }
    PT_ADD(F, 1); PT_SUB(F, 2);
    float* rc = (float*)(ws + WS_ROPE); float* rs = rc + TP * 8;
    for (int i = (F.vcu * NWAVES * 64) + F.tid; i < TP * 8; i += F.G * NWAVES * 64) {
        const int pos = i >> 3, fi = i & 7;
        const float inv = exp2f(-(float)fi * 0.125f * 18.931568569324174f);
        const float ang = (float)pos * inv;
        const double rev = (double)ang * 0.15915494309189535; const float fr = (float)(rev - __builtin_rint(rev));
        rc[i] = __builtin_amdgcn_cosf(fr); rs[i] = __builtin_amdgcn_sinf(fr);
    }
    PT_ADD(F, 2);
}
__device__ __forceinline__ void p1_convert(Frame& F, const Args& A, int x, int j) {
    unsigned* ready = (unsigned*)(F.ws + WS_CTL) + CW_READY;
    f32x4 gg[4]; gains_load(gg, A.in[4], F.lane);
    constexpr int RPS = pg8::NCV * NWAVES * 4, NST = 2048 / RPS;
    for (int g = 1; g <= 2; ++g) {
        const int m0 = (24 * x + 8 * g) * 256 + (j * NWAVES + F.wave) * 4;
        const float* x0 = m0 < TP ? A.in[0] + (size_t)m0 * DM : A.in[1] + (size_t)(m0 - TP) * DM; bf16* o0 = XN_BASE(F.out) + (size_t)m0 * DM; float* ir = (float*)(F.ws + WS_IRSTD) + m0;
        RowBuf<4> ba, bb;
        rows_load<4>(ba, x0, F.lane);
        for (int s = 0; s < NST; s += 2) {
            rows_load<4>(bb, x0 + (size_t)(s + 1) * RPS * DM, F.lane);
            rows_finish<4>(ba, gg, o0 + (size_t)s * RPS * DM, ir + s * RPS, F.lane);
            if (s + 2 < NST) rows_load<4>(ba, x0 + (size_t)(s + 2) * RPS * DM, F.lane);
            rows_finish<4>(bb, gg, o0 + (size_t)(s + 1) * RPS * DM, ir + (s + 1) * RPS, F.lane);
        }
        asm volatile("s_waitcnt vmcnt(0)" ::: "memory"); __syncthreads();
        if (F.tid == 0) { __builtin_amdgcn_fence(__ATOMIC_RELEASE, "agent"); asm volatile("s_waitcnt vmcnt(0)" ::: "memory");
            (void)__hip_atomic_fetch_add(ready + 64 * (2 * x + g - 1), 1u, __ATOMIC_RELAXED, __HIP_MEMORY_SCOPE_AGENT); }
    }
}
#define XB_TMO      128
#define XB_XCNT(j)  (256  + 64 * (j))
#define XB_XSUB(j)  (1280 + 64 * (j))
#define XB_XGEN(j)  (2304 + 64 * (j))
#define XB_TOP      3328
#define XB_TOPGEN   3392
#define XCD_BAR_WORDS 3456
#define XB_SPIN_CAP (1u << 18)

__device__ __forceinline__ unsigned xb_ld(unsigned* p)              { return __hip_atomic_load(p, __ATOMIC_RELAXED, __HIP_MEMORY_SCOPE_AGENT); }
__device__ __forceinline__ unsigned xb_add(unsigned* p, unsigned v) { return __hip_atomic_fetch_add(p, v, __ATOMIC_RELAXED, __HIP_MEMORY_SCOPE_AGENT); }
__device__ __forceinline__ unsigned xb_xcc_id() { return (unsigned)__builtin_amdgcn_s_getreg((3 << 11) | 20) & 0xFu; }
#define XB_SPIN(cond, bar) do { unsigned _sp = 0; while (cond) { __builtin_amdgcn_s_sleep(1); \
    if ((++_sp & 255u) == 0u) { if (xb_ld(&(bar)[XB_TMO])) break; if (_sp > XB_SPIN_CAP) { atomicAdd(&(bar)[XB_TMO], 1u); break; } } } } while (0)

struct XcdBarrier {
    unsigned* bar; unsigned x;
    volatile LAS unsigned* st;
};

__device__ __forceinline__ XcdBarrier xcd_barrier_post(unsigned* bar, volatile LAS unsigned* st) {
    XcdBarrier b; b.bar = bar; b.x = xb_xcc_id(); b.st = st;
    if (threadIdx.x == 0) (void)xb_add(&bar[XB_XCNT(b.x)], 1u);
    return b;
}
__device__ __forceinline__ void xcd_barrier_complete(unsigned* bar, unsigned x, unsigned& nloc, unsigned& nx) {
    const unsigned G = gridDim.x * gridDim.y * gridDim.z;
    unsigned sum, cnt, mine, sp = 0u;
    for (;;) {
        sum = 0u; cnt = 0u; mine = 0u;
#pragma unroll
        for (unsigned j = 0; j < 16; ++j) { const unsigned c = xb_ld(&bar[XB_XCNT(j)]); sum += c; cnt += (c > 0u) ? 1u : 0u; mine = (j == x) ? c : mine; }
        if (sum == G) break;
        __builtin_amdgcn_s_sleep(1);
        if ((++sp & 255u) == 0u) { if (xb_ld(&bar[XB_TMO])) break; if (sp > XB_SPIN_CAP) { atomicAdd(&bar[XB_TMO], 1u); break; } }
    }
    nloc = mine > 0u ? mine : 1u; nx = cnt > 0u ? cnt : 1u;
}

__device__ __forceinline__ void xcd_barrier(const XcdBarrier& b) {
    asm volatile("s_waitcnt vmcnt(0)" ::: "memory");
    __syncthreads();
    if (threadIdx.x == 0) {
        unsigned* bar = b.bar;
        __builtin_amdgcn_s_waitcnt(0);
        unsigned nloc = b.st[0], nx = b.st[1];
        if (nloc == 0u) { xcd_barrier_complete(bar, b.x, nloc, nx); b.st[0] = nloc; b.st[1] = nx; }
        const unsigned old = xb_add(&bar[XB_XSUB(b.x)], 1u);
        const unsigned gen = old / nloc;
        if (old + 1u == (gen + 1u) * nloc) {
            __builtin_amdgcn_fence(__ATOMIC_RELEASE, "agent");
            asm volatile("s_waitcnt vmcnt(0)" ::: "memory");
            const unsigned og = xb_add(&bar[XB_TOP], 1u);
            const unsigned tg = og / nx;
            if (og + 1u == (tg + 1u) * nx) xb_add(&bar[XB_TOPGEN], 1u);
            else XB_SPIN(xb_ld(&bar[XB_TOPGEN]) == tg, bar);
            __builtin_amdgcn_fence(__ATOMIC_ACQUIRE, "agent");
            xb_add(&bar[XB_XGEN(b.x)], 1u);
            asm volatile("s_waitcnt vmcnt(0)" ::: "memory");
        } else {
            XB_SPIN(xb_ld(&bar[XB_XGEN(b.x)]) == gen, bar);
            __builtin_amdgcn_fence(__ATOMIC_ACQUIRE, "agent");
            asm volatile("s_waitcnt vmcnt(0)" ::: "memory");
        }
    }
    __syncthreads();
}

struct SeqInfo { long sb; int T; int bat; };
__device__ __forceinline__ SeqInfo seq_of(int row) { SeqInfo s; if (row < TP) { s.sb = 0; s.T = TP; s.bat = 0; } else { const int b = (row - TP) >> 13; s.sb = TP + (long)b * TS; s.T = TS; s.bat = 1 + b; } return s; }


namespace att2 {
using att::bf16x8; using att::s16x4; using att::f32x16; using att::f32x4; using att::u32x4; using att::lptr; using att::creg; using att::cvtpk; using att::vtr; using att::NEG;
constexpr int NS = 4, SLOT = 32768, TILE = 16384, TV = 8192, VDH64 = 4096;
constexpr int L_RING = 0, L_TBL = NS * SLOT, TBLB = 3840, L_LS = L_TBL + 6 * TBLB, L_END = L_LS + 8 * 128;
static_assert(L_END <= LDS_MISC, "attention LDS map");
#define ATT2_WAITBAR(N) asm volatile("s_waitcnt vmcnt(" #N ") lgkmcnt(0)\n\ts_barrier" ::: "memory")

struct TileSrc { const bf16* K; const bf16* V; int p0, qs, T, pm; };
__device__ __forceinline__ void dma_tile(LAS unsigned char* tile, const TileSrc& s, int w, int lane) {
    const bool inside = (s.p0 >= 0) && (s.p0 + 63 * s.qs < s.T);
    { const int row = 8 * w + (lane >> 3); int p = s.p0 + row * s.qs; if (!inside) p = p < 0 ? 0 : (p >= s.T ? s.T - 1 : p); p &= s.pm;
      __builtin_amdgcn_global_load_lds((const unsigned*)(s.K + (size_t)p * 64 + 8 * ((lane & 7) ^ ((row >> 1) & 7))), (LAS unsigned*)(tile + w * 1024), 16, 0, 0); }
    { const int row = 16 * (w & 3) + (lane >> 2); int p = s.p0 + row * s.qs; if (!inside) p = p < 0 ? 0 : (p >= s.T ? s.T - 1 : p); p &= s.pm;
      __builtin_amdgcn_global_load_lds((const unsigned*)(s.V + (size_t)p * 64 + 32 * (w >> 2) + 8 * (lane & 3)), (LAS unsigned*)(tile + TV + (w >> 2) * VDH64 + (w & 3) * 1024), 16, 0, 0); }
}
__device__ __forceinline__ f32x16 qk_sub(lptr tile, int roff, const bf16x8 (&qr)[4], int lane) {
    const int r32 = lane & 31, hi = lane >> 5, row = roff + r32;
    lptr kp = tile + row * 128; const int sw = (row >> 1) & 7;
    f32x16 p = {};
#pragma unroll
    for (int d0 = 0; d0 < 4; ++d0) { const bf16x8 kf = *(__attribute__((address_space(3))) bf16x8*)(kp + (((2 * d0 + hi) ^ sw) * 16)); p = __builtin_amdgcn_mfma_f32_32x32x16_bf16(kf, qr[d0], p, 0, 0, 0); }
    return p;
}
__device__ __forceinline__ void pv_sub(lptr tile, int roff, f32x16& p, f32x16 (&o)[2], float& lsum, int lane) {
    const int hi = lane >> 5;
    const unsigned va = (unsigned)(size_t)(tile + TV + (roff + 4 * hi + ((lane & 15) >> 2)) * 64 + ((lane >> 4) & 1) * 32 + (lane & 3) * 8);
    s16x4 l00, h00, l10, h10, l01, h01, l11, h11;
    asm volatile("ds_read_b64_tr_b16 %0, %8\n\tds_read_b64_tr_b16 %1, %8 offset:512\n\tds_read_b64_tr_b16 %2, %8 offset:1024\n\tds_read_b64_tr_b16 %3, %8 offset:1536\n\t"
                 "ds_read_b64_tr_b16 %4, %8 offset:4096\n\tds_read_b64_tr_b16 %5, %8 offset:4608\n\tds_read_b64_tr_b16 %6, %8 offset:5120\n\tds_read_b64_tr_b16 %7, %8 offset:5632"
                 : "=&v"(l00), "=&v"(h00), "=&v"(l10), "=&v"(h10), "=&v"(l01), "=&v"(h01), "=&v"(l11), "=&v"(h11) : "v"(va) : "memory");
    float sacc = 0.f;
#pragma unroll
    for (int r = 0; r < 16; ++r) { p[r] = __builtin_amdgcn_exp2f(p[r]); sacc += p[r]; }
    lsum += sacc;
    u32x4 pw0, pw1;
    pw0[0] = cvtpk(p[0], p[1]); pw0[1] = cvtpk(p[2], p[3]); pw0[2] = cvtpk(p[4], p[5]); pw0[3] = cvtpk(p[6], p[7]);
    pw1[0] = cvtpk(p[8], p[9]); pw1[1] = cvtpk(p[10], p[11]); pw1[2] = cvtpk(p[12], p[13]); pw1[3] = cvtpk(p[14], p[15]);
    asm volatile("s_waitcnt lgkmcnt(0)" : "+v"(l00), "+v"(h00), "+v"(l10), "+v"(h10), "+v"(l01), "+v"(h01), "+v"(l11), "+v"(h11) :: "memory");
    {   const bf16x8 f0 = {l00[0], l00[1], l00[2], l00[3], h00[0], h00[1], h00[2], h00[3]}, f1 = {l10[0], l10[1], l10[2], l10[3], h10[0], h10[1], h10[2], h10[3]};
        o[0] = __builtin_amdgcn_mfma_f32_32x32x16_bf16(__builtin_bit_cast(bf16x8, pw0), f0, o[0], 0, 0, 0);
        o[0] = __builtin_amdgcn_mfma_f32_32x32x16_bf16(__builtin_bit_cast(bf16x8, pw1), f1, o[0], 0, 0, 0); }
    {   const bf16x8 f0 = {l01[0], l01[1], l01[2], l01[3], h01[0], h01[1], h01[2], h01[3]}, f1 = {l11[0], l11[1], l11[2], l11[3], h11[0], h11[1], h11[2], h11[3]};
        o[1] = __builtin_amdgcn_mfma_f32_32x32x16_bf16(__builtin_bit_cast(bf16x8, pw0), f0, o[1], 0, 0, 0);
        o[1] = __builtin_amdgcn_mfma_f32_32x32x16_bf16(__builtin_bit_cast(bf16x8, pw1), f1, o[1], 0, 0, 0); }
}
__device__ __forceinline__ void pv_sub2(lptr tile, int roff, f32x16& pa, f32x16& pb, f32x16 (&oa)[2], f32x16 (&ob)[2], float& lsa, float& lsb, int lane) {
    const int hi = lane >> 5;
    const unsigned va = (unsigned)(size_t)(tile + TV + (roff + 4 * hi + ((lane & 15) >> 2)) * 64 + ((lane >> 4) & 1) * 32 + (lane & 3) * 8);
    s16x4 l00, h00, l10, h10, l01, h01, l11, h11;
    asm volatile("ds_read_b64_tr_b16 %0, %8\n\tds_read_b64_tr_b16 %1, %8 offset:512\n\tds_read_b64_tr_b16 %2, %8 offset:1024\n\tds_read_b64_tr_b16 %3, %8 offset:1536\n\t"
                 "ds_read_b64_tr_b16 %4, %8 offset:4096\n\tds_read_b64_tr_b16 %5, %8 offset:4608\n\tds_read_b64_tr_b16 %6, %8 offset:5120\n\tds_read_b64_tr_b16 %7, %8 offset:5632"
                 : "=&v"(l00), "=&v"(h00), "=&v"(l10), "=&v"(h10), "=&v"(l01), "=&v"(h01), "=&v"(l11), "=&v"(h11) : "v"(va) : "memory");
    float sa = 0.f, sb = 0.f;
#pragma unroll
    for (int r = 0; r < 16; ++r) { pa[r] = __builtin_amdgcn_exp2f(pa[r]); sa += pa[r]; }
#pragma unroll
    for (int r = 0; r < 16; ++r) { pb[r] = __builtin_amdgcn_exp2f(pb[r]); sb += pb[r]; }
    lsa += sa; lsb += sb;
    u32x4 a0, a1, b0, b1;
    a0[0] = cvtpk(pa[0], pa[1]); a0[1] = cvtpk(pa[2], pa[3]); a0[2] = cvtpk(pa[4], pa[5]); a0[3] = cvtpk(pa[6], pa[7]);
    a1[0] = cvtpk(pa[8], pa[9]); a1[1] = cvtpk(pa[10], pa[11]); a1[2] = cvtpk(pa[12], pa[13]); a1[3] = cvtpk(pa[14], pa[15]);
    b0[0] = cvtpk(pb[0], pb[1]); b0[1] = cvtpk(pb[2], pb[3]); b0[2] = cvtpk(pb[4], pb[5]); b0[3] = cvtpk(pb[6], pb[7]);
    b1[0] = cvtpk(pb[8], pb[9]); b1[1] = cvtpk(pb[10], pb[11]); b1[2] = cvtpk(pb[12], pb[13]); b1[3] = cvtpk(pb[14], pb[15]);
    asm volatile("s_waitcnt lgkmcnt(0)" : "+v"(l00), "+v"(h00), "+v"(l10), "+v"(h10), "+v"(l01), "+v"(h01), "+v"(l11), "+v"(h11) :: "memory");
    {   const bf16x8 f0 = {l00[0], l00[1], l00[2], l00[3], h00[0], h00[1], h00[2], h00[3]}, f1 = {l10[0], l10[1], l10[2], l10[3], h10[0], h10[1], h10[2], h10[3]};
        oa[0] = __builtin_amdgcn_mfma_f32_32x32x16_bf16(__builtin_bit_cast(bf16x8, a0), f0, oa[0], 0, 0, 0); ob[0] = __builtin_amdgcn_mfma_f32_32x32x16_bf16(__builtin_bit_cast(bf16x8, b0), f0, ob[0], 0, 0, 0);
        oa[0] = __builtin_amdgcn_mfma_f32_32x32x16_bf16(__builtin_bit_cast(bf16x8, a1), f1, oa[0], 0, 0, 0); ob[0] = __builtin_amdgcn_mfma_f32_32x32x16_bf16(__builtin_bit_cast(bf16x8, b1), f1, ob[0], 0, 0, 0); }
    {   const bf16x8 f0 = {l01[0], l01[1], l01[2], l01[3], h01[0], h01[1], h01[2], h01[3]}, f1 = {l11[0], l11[1], l11[2], l11[3], h11[0], h11[1], h11[2], h11[3]};
        oa[1] = __builtin_amdgcn_mfma_f32_32x32x16_bf16(__builtin_bit_cast(bf16x8, a0), f0, oa[1], 0, 0, 0); ob[1] = __builtin_amdgcn_mfma_f32_32x32x16_bf16(__builtin_bit_cast(bf16x8, b0), f0, ob[1], 0, 0, 0);
        oa[1] = __builtin_amdgcn_mfma_f32_32x32x16_bf16(__builtin_bit_cast(bf16x8, a1), f1, oa[1], 0, 0, 0); ob[1] = __builtin_amdgcn_mfma_f32_32x32x16_bf16(__builtin_bit_cast(bf16x8, b1), f1, ob[1], 0, 0, 0); }
}
__device__ __forceinline__ void mask_band(f32x16& p, int rel, int kr0, int L, int lane) {
    const int r32 = lane & 31, hi = lane >> 5;
    if (rel == 0 || rel == 4) { const int base = 32 * rel - r32 + 4 * hi;
#pragma unroll
        for (int r = 0; r < 16; ++r) { if ((unsigned)(base + creg(r)) > 128u) p[r] = NEG; } }
    if (kr0 < 0 || kr0 + 31 >= L) { const int kb = kr0 + 4 * hi;
#pragma unroll
        for (int r = 0; r < 16; ++r) { if ((unsigned)(kb + creg(r)) >= (unsigned)L) p[r] = NEG; } }
}
__device__ __forceinline__ void stage_rows(const f32x16 (&o)[2], float lsum, bool normalise, lptr scr, __attribute__((address_space(3))) float* ls, int lane) {
    const int r32 = lane & 31, hi = lane >> 5;
    lsum = pg8::sum_xor32(lsum);
    if (hi == 0) ls[r32] = lsum;
    __attribute__((address_space(3))) unsigned short* stg = (__attribute__((address_space(3))) unsigned short*)scr;
    float rl[16];
#pragma unroll
    for (int g = 0; g < 4; ++g) { const f32x4 lv = *(__attribute__((address_space(3))) f32x4*)(ls + 8 * g + 4 * hi);
#pragma unroll
        for (int j = 0; j < 4; ++j) rl[4 * g + j] = normalise ? __builtin_amdgcn_rcpf(lv[j]) : 1.f; }
#pragma unroll
    for (int r = 0; r < 16; r += 2) { const int q = creg(r) + 4 * hi;
#pragma unroll
        for (int dh = 0; dh < 2; ++dh) { const unsigned pk = cvtpk(o[dh][r] * rl[r], o[dh][r + 1] * rl[r + 1]);
            stg[q * 64 + dh * 32 + r32] = (unsigned short)pk; stg[(q + 1) * 64 + dh * 32 + r32] = (unsigned short)(pk >> 16); } }
}
template <class RowFn, class SsqFn> __device__ __forceinline__ void out_final(const f32x16 (&o)[2], float lsum, lptr scr, __attribute__((address_space(3))) float* ls, const RowFn& orow, const SsqFn& ssqp, int lane) {
    stage_rows(o, lsum, true, scr, ls, lane);
    __attribute__((address_space(3))) unsigned short* stg = (__attribute__((address_space(3))) unsigned short*)scr;
#pragma unroll
    for (int i = 0; i < 4; ++i) { const int row = i * 8 + (lane >> 3), ch = lane & 7; const u32x4 v = *(__attribute__((address_space(3))) u32x4*)(stg + row * 64 + ch * 8);
        float ss = 0.f;
#pragma unroll
        for (int e = 0; e < 4; ++e) { const float a = bflo(v[e]), b = bfhi(v[e]); ss += a * a + b * b; }
        ss += __shfl_xor(ss, 1); ss += __shfl_xor(ss, 2); ss += __shfl_xor(ss, 4);
        *(u32x4*)(orow(row) + ch * 8) = v; if (ch == 0) *ssqp(row) = ss; }
}
}

constexpr int N2_M = (MTOK / 512) * 4;
constexpr int N2_B = (MTOK / 256) * 3;
constexpr int N2_A = (MTOK / 512) * 6;
constexpr size_t WS_PART = WS_X1B;
constexpr size_t WS_PARTL = WS_PART + (size_t)2 * MTOK * 384 * 2;
static_assert(WS_PARTL + (size_t)2 * MTOK * 8 * 4 <= WS_H, "partials fit the X1B region");

struct BandU { long sb; int T, qs, L, cls, s0; };
__device__ __forceinline__ BandU band_unit(int tt, int qs) {
    BandU u; int j, nt; if (tt < TP / 256) { u.sb = 0; u.T = TP; j = tt; nt = TP / 256; } else { const int q = tt - TP / 256, b = q / (TS / 256); u.sb = TP + (long)b * TS; u.T = TS; j = q - b * (TS / 256); nt = TS / 256; }
    const int lg = qs == 16 ? 4 : (qs == 4 ? 2 : 0), lnt = nt == 64 ? 6 : 5;
    const int nb = nt >> lg; u.qs = qs; u.L = u.T >> lg; u.cls = j >> (lnt - lg); u.s0 = 256 * (j - u.cls * nb); return u;
}
struct UD { int kind, idx, nst; att2::TileSrc x, y; int xb, xs, yb, ys, yrot; };
__device__ __forceinline__ UD make_ud(Frame& F, int kind, int idx) {
    UD d; d.kind = kind; d.idx = idx; d.nst = 0; d.xb = d.xs = d.yb = d.ys = d.yrot = 0; d.x = att2::TileSrc{nullptr, nullptr, 0, 1, 1, F.tm}; d.y = d.x;
    const bf16* QKV = (const bf16*)(F.ws + WS_QKV);
    if (kind >= 0 && kind <= 2) {
        const int h = idx / (MTOK / 512), tt = 2 * (idx - h * (MTOK / 512)), qs = kind == 0 ? 16 : (kind == 1 ? 4 : 1);
        const BandU ux = band_unit(tt, qs), uy = band_unit(tt + 1, qs);
        const bf16* Kh = QKV + (size_t)(6 + h) * MTOK * 64; const bf16* Vh = QKV + (size_t)(12 + h) * MTOK * 64;
        d.nst = 6; d.x = att2::TileSrc{Kh + ux.sb * 64, Vh + ux.sb * 64, 0, qs, ux.T, F.tm}; d.y = att2::TileSrc{Kh + uy.sb * 64, Vh + uy.sb * 64, 0, qs, uy.T, F.tm};
        d.xb = ux.cls + (ux.s0 - 64) * qs; d.xs = 64 * qs; d.yb = uy.cls + (uy.s0 - 64) * qs; d.ys = 64 * qs; d.yrot = 3;
    } else if (kind == 3) {
        const int hp = idx / (MTOK / 256), rq4 = idx - hp * (MTOK / 256);
        int r0, rows; long sb; int T;
        if (rq4 < TP / 256) { r0 = 4 * rq4; rows = TP / 64; sb = 0; T = TP; } else { const int q = rq4 - TP / 256, b = q / (TS / 256); r0 = 4 * (q - b * (TS / 256)); rows = TS / 64; sb = TP + (long)b * TS; T = TS; }
        int rk0 = r0 - 4; rk0 = rk0 < 0 ? 0 : (rk0 > rows - 8 ? rows - 8 : rk0);
        int rk1 = r0 + 3 - 4; rk1 = rk1 < 0 ? 0 : (rk1 > rows - 8 ? rows - 8 : rk1);
        d.nst = rk1 + 8 - rk0;
        d.x = att2::TileSrc{QKV + ((size_t)(24 + 2 * hp) * MTOK + sb) * 64, QKV + ((size_t)(30 + 2 * hp) * MTOK + sb) * 64, 0, 1, T, F.tm};
        d.y = att2::TileSrc{QKV + ((size_t)(25 + 2 * hp) * MTOK + sb) * 64, QKV + ((size_t)(31 + 2 * hp) * MTOK + sb) * 64, 0, 1, T, F.tm};
        d.xb = rk0 * 64; d.xs = 64; d.yb = rk0 * 64; d.ys = 64; d.yrot = 0;
    } else if (kind == 4) {
        const int h = idx / (MTOK / 512), row0 = (idx - h * (MTOK / 512)) * 512; const SeqInfo si = seq_of(row0);
        d.nst = 4; d.x = att2::TileSrc{(const bf16*)(F.ws + WS_MK) + (size_t)(si.bat * 4 + h) * NMEM * 64, (const bf16*)(F.ws + WS_MV) + (size_t)(si.bat * 4 + h) * NMEM * 64, 0, 1, NMEM, F.tm}; d.y = d.x;
        d.xb = 0; d.xs = 64; d.yb = 0; d.ys = 64; d.yrot = 0;
    }
    return d;
}
__device__ __forceinline__ void ud_issue(Frame& F, UD& d, int s, int gstep) {
    LAS unsigned char* sl = F.lds + att2::L_RING + (gstep & (att2::NS - 1)) * att2::SLOT;
    int sy = s + d.yrot; sy = sy >= 6 ? sy - 6 : sy; if (d.yrot == 0) sy = s;
    d.x.p0 = d.xb + d.xs * s; d.y.p0 = d.yb + d.ys * sy;
    att2::dma_tile(sl, d.x, F.wave, F.lane); att2::dma_tile(sl + att2::TILE, d.y, F.wave, F.lane);
}
__device__ __forceinline__ void ud_load_q(Frame& F, const UD& d, att::bf16x8 (&qa)[4], att::bf16x8 (&qb)[4]) {
    const int w = F.wave, lane = F.lane, r32 = lane & 31;
    const bf16* QKV = (const bf16*)(F.ws + WS_QKV);
    const bf16* pa = QKV; const bf16* pb = QKV;
    if (d.kind >= 0 && d.kind <= 2) {
        const int h = d.idx / (MTOK / 512), tt = 2 * (d.idx - h * (MTOK / 512)), qs = d.kind == 0 ? 16 : (d.kind == 1 ? 4 : 1);
        const BandU ux = band_unit(tt, qs), uy = band_unit(tt + 1, qs);
        const bf16* Qh = QKV + (size_t)(0 + h) * MTOK * 64;
        pa = Qh + (size_t)(ux.sb + ux.cls + (ux.s0 + 32 * w + r32) * qs) * 64; pb = Qh + (size_t)(uy.sb + uy.cls + (uy.s0 + 32 * w + r32) * qs) * 64;
    } else if (d.kind == 3) {
        const int hp = d.idx / (MTOK / 256), rq4 = d.idx - hp * (MTOK / 256);
        int r0; long sb;
        if (rq4 < TP / 256) { r0 = 4 * rq4; sb = 0; } else { const int q = rq4 - TP / 256, b = q / (TS / 256); r0 = 4 * (q - b * (TS / 256)); sb = TP + (long)b * TS; }
        const int hd = w >> 2, g = w & 3, h = 2 * hp + hd, rq = r0 + (r32 >> 4), c = 16 * g + (r32 & 15);
        pa = QKV + ((size_t)(18 + h) * MTOK + sb + rq * 64 + c) * 64; pb = pa + (size_t)128 * 64;
    } else if (d.kind == 4) {
        const int h = d.idx / (MTOK / 512), row0 = (d.idx - h * (MTOK / 512)) * 512;
        pa = QKV + ((size_t)(36 + h) * MTOK + row0 + 32 * w + r32) * 64; pb = pa + (size_t)256 * 64;
    }
    att::load_q(qa, pa, lane); att::load_q(qb, pb, lane);
}
#define ATT3_STEP_BEGIN() do { if (s == 0) PT_ADD(F, 5); PT_SUB(F, 0); const int ahead_ = gi - gs - 1; \
        if (ahead_ >= 2) { ATT2_WAITBAR(8); } else if (ahead_ == 1) { ATT2_WAITBAR(4); } else { ATT2_WAITBAR(0); } \
        { const int t_ = s + 3; if (t_ < d.nst) { ud_issue(F, d, t_, gi); ++gi; } else if (dn.kind >= 0 && t_ - d.nst < 3) { ud_issue(F, dn, t_ - d.nst, gi); ++gi; } } PT_ADD(F, 0); PT_SUB(F, 1); } while (0)
#define ATT3_UNIT_END() asm volatile("s_waitcnt lgkmcnt(0)\n\ts_barrier" ::: "memory")

__device__ __forceinline__ void att3_body_M(Frame& F, UD& d, UD& dn, int& gs, int& gi, att::bf16x8 (&qr)[4], att::bf16x8 (&qnb)[4]) {
    const int h = d.idx / (MTOK / 512), row0 = (d.idx - h * (MTOK / 512)) * 512;
    const int w = F.wave, lane = F.lane;
    att::f32x16 o[2] = {}, o2[2] = {}; float lsum = 0.f, lsum2 = 0.f;
#pragma unroll 1
    for (int s = 0; s < 4; ++s) {
        ATT3_STEP_BEGIN();
        att::lptr tile = (att::lptr)(F.lds + att2::L_RING + (gs & (att2::NS - 1)) * att2::SLOT);
#pragma unroll
        for (int hf = 0; hf < 2; ++hf) {
            att::f32x16 pa = att2::qk_sub(tile, 32 * hf, qr, lane), pb = att2::qk_sub(tile, 32 * hf, qnb, lane);
            att2::pv_sub2(tile, 32 * hf, pa, pb, o, o2, lsum, lsum2, lane);
            asm volatile("" ::: "memory");
        }
        ++gs; PT_ADD(F, 1);
    }
    ud_load_q(F, dn, qr, qnb);
    PT_SUB(F, 2); ATT3_UNIT_END();
    att::lptr scr = (att::lptr)(F.lds + att2::L_RING + ((gs - 1) & (att2::NS - 1)) * att2::SLOT + w * 4096);
    __attribute__((address_space(3))) float* ls = (__attribute__((address_space(3))) float*)(F.lds + att2::L_LS + w * 128);
    { bf16* O = (bf16*)F.out + (size_t)(row0 + 32 * w) * DM + 768 + 64 * h; float* SQ = (float*)(F.ws + WS_SSQA) + (size_t)(row0 + 32 * w) * 16 + 12 + h;
      att2::out_final(o, lsum, scr, ls, [=](int q) { return O + (size_t)q * DM; }, [=](int q) { return SQ + (size_t)q * 16; }, lane); }
    { bf16* O = (bf16*)F.out + (size_t)(row0 + 256 + 32 * w) * DM + 768 + 64 * h; float* SQ = (float*)(F.ws + WS_SSQA) + (size_t)(row0 + 256 + 32 * w) * 16 + 12 + h;
      att2::out_final(o2, lsum2, scr, ls, [=](int q) { return O + (size_t)q * DM; }, [=](int q) { return SQ + (size_t)q * 16; }, lane); }
    PT_ADD(F, 2);
}
__device__ __forceinline__ void att3_body_B(Frame& F, const Args& A, UD& d, UD& dn, int& gs, int& gi, att::bf16x8 (&qr)[4], att::bf16x8 (&qnb)[4]) {
    const int hp = d.idx / (MTOK / 256), rq4 = d.idx - hp * (MTOK / 256);
    int r0, rows; long sb;
    if (rq4 < TP / 256) { r0 = 4 * rq4; rows = TP / 64; sb = 0; } else { const int q = rq4 - TP / 256, b = q / (TS / 256); r0 = 4 * (q - b * (TS / 256)); rows = TS / 64; sb = TP + (long)b * TS; }
    const int w = F.wave, lane = F.lane, r32 = lane & 31, hi = lane >> 5;
    const int hd = w >> 2, g = w & 3, h = 2 * hp + hd;
    const int c = 16 * g + (r32 & 15);
    int cs = c - 8; cs = cs < 0 ? 0 : (cs > 48 ? 48 : cs);
    const int rk0 = d.xb >> 6;
    const int w0 = g == 0 ? 0 : (g == 1 ? 8 : (g == 2 ? 24 : 32));
    att::f32x16 o[2] = {}, o2[2] = {}; float lsum = 0.f, lsum2 = 0.f;
    const __attribute__((address_space(3))) float* tb = (const __attribute__((address_space(3))) float*)(F.lds + att2::L_TBL + h * att2::TBLB) + (31 + w0 - c) + 4 * hi;
    const int cb = w0 - cs + 4 * hi, nst = d.nst;
    const int rq0 = r0 + (r32 >> 4), rq1 = rq0 + 2;
    int rlo0 = rq0 - 4; rlo0 = rlo0 < 0 ? 0 : (rlo0 > rows - 8 ? rows - 8 : rlo0);
    int rlo1 = rq1 - 4; rlo1 = rlo1 < 0 ? 0 : (rlo1 > rows - 8 ? rows - 8 : rlo1);
    int b0lo = r0 - 4; b0lo = b0lo < 0 ? 0 : (b0lo > rows - 8 ? rows - 8 : b0lo); int b0hi = r0 + 1 - 4; b0hi = (b0hi < 0 ? 0 : (b0hi > rows - 8 ? rows - 8 : b0hi)) + 7;
    int b1lo = r0 + 2 - 4; b1lo = b1lo < 0 ? 0 : (b1lo > rows - 8 ? rows - 8 : b1lo); int b1hi = r0 + 3 - 4; b1hi = (b1hi < 0 ? 0 : (b1hi > rows - 8 ? rows - 8 : b1hi)) + 7;
#pragma unroll 1
    for (int s = 0; s < nst; ++s) {
        ATT3_STEP_BEGIN();
        att::lptr tile = (att::lptr)(F.lds + att2::L_RING + (gs & (att2::NS - 1)) * att2::SLOT + hd * att2::TILE);
        const int rk = rk0 + s;
        if (rk >= b0lo && rk <= b0hi) {
            att::f32x16 p = att2::qk_sub(tile, w0, qr, lane);
            const bool rok = (unsigned)(rk - rlo0) < 8u; int dr = rk + 7 - rq0; dr = dr < 0 ? 0 : (dr > 14 ? 14 : dr);
            const __attribute__((address_space(3))) float* tp = tb + dr * 64; const int cbh = rok ? cb : -4096;
#pragma unroll
            for (int r = 0; r < 16; ++r) { const float sbv = p[r] + tp[att::creg(r)]; p[r] = ((unsigned)(cbh + att::creg(r)) < 16u) ? sbv : att::NEG; }
            att2::pv_sub(tile, w0, p, o, lsum, lane);
        }
        if (rk >= b1lo && rk <= b1hi) {
            att::f32x16 p = att2::qk_sub(tile, w0, qnb, lane);
            const bool rok = (unsigned)(rk - rlo1) < 8u; int dr = rk + 7 - rq1; dr = dr < 0 ? 0 : (dr > 14 ? 14 : dr);
            const __attribute__((address_space(3))) float* tp = tb + dr * 64; const int cbh = rok ? cb : -4096;
#pragma unroll
            for (int r = 0; r < 16; ++r) { const float sbv = p[r] + tp[att::creg(r)]; p[r] = ((unsigned)(cbh + att::creg(r)) < 16u) ? sbv : att::NEG; }
            att2::pv_sub(tile, w0, p, o2, lsum2, lane);
        }
        ++gs; PT_ADD(F, 1);
    }
    ud_load_q(F, dn, qr, qnb);
    PT_SUB(F, 2); ATT3_UNIT_END();
    att::lptr scr = (att::lptr)(F.lds + att2::L_RING + ((gs - 1) & (att2::NS - 1)) * att2::SLOT + w * 4096);
    __attribute__((address_space(3))) float* ls = (__attribute__((address_space(3))) float*)(F.lds + att2::L_LS + w * 128);
    { bf16* O = (bf16*)F.out + (size_t)(sb + r0 * 64 + 16 * g) * DM + 384 + 64 * h; float* SQ = (float*)(F.ws + WS_SSQA) + (size_t)(sb + r0 * 64 + 16 * g) * 16 + 6 + h;
      att2::out_final(o, lsum, scr, ls, [=](int q) { return O + (size_t)((q >> 4) * 64 + (q & 15)) * DM; }, [=](int q) { return SQ + (size_t)((q >> 4) * 64 + (q & 15)) * 16; }, lane); }
    { bf16* O = (bf16*)F.out + (size_t)(sb + (r0 + 2) * 64 + 16 * g) * DM + 384 + 64 * h; float* SQ = (float*)(F.ws + WS_SSQA) + (size_t)(sb + (r0 + 2) * 64 + 16 * g) * 16 + 6 + h;
      att2::out_final(o2, lsum2, scr, ls, [=](int q) { return O + (size_t)((q >> 4) * 64 + (q & 15)) * DM; }, [=](int q) { return SQ + (size_t)((q >> 4) * 64 + (q & 15)) * 16; }, lane); }
    PT_ADD(F, 2);
}
__device__ __forceinline__ void att3_body_A(Frame& F, UD& d, UD& dn, int& gs, int& gi, att::bf16x8 (&qx)[4], att::bf16x8 (&qy)[4]) {
    const int pat = d.kind, ud = d.idx;
    const int h = ud / (MTOK / 512), tt = 2 * (ud - h * (MTOK / 512)), qs = pat == 0 ? 16 : (pat == 1 ? 4 : 1);
    const BandU ux = band_unit(tt, qs), uy = band_unit(tt + 1, qs);
    const int w = F.wave, lane = F.lane, r32 = lane & 31;
    const bf16* Qh = (const bf16*)(F.ws + WS_QKV) + (size_t)(0 + h) * MTOK * 64;
    att::f32x16 ox[2] = {}, oy[2] = {}; float lx = 0.f, ly = 0.f;
#pragma unroll 1
    for (int s = 0; s < 6; ++s) {
        ATT3_STEP_BEGIN();
        att::lptr tX = (att::lptr)(F.lds + att2::L_RING + (gs & (att2::NS - 1)) * att2::SLOT), tY = tX + att2::TILE;
        const int sy = (s + 3) % 6;
#pragma unroll
        for (int hf = 0; hf < 2; ++hf) {
            const int gx = 2 * s + hf, gy = 2 * sy + hf;
            const bool ax = (unsigned)(gx - w) <= 4u, ay = (unsigned)(gy - w) <= 4u;
            att::f32x16 pxx, pyy;
            if (ax) pxx = att2::qk_sub(tX, 32 * hf, qx, lane);
            if (ay) pyy = att2::qk_sub(tY, 32 * hf, qy, lane);
            if (ax) { att2::mask_band(pxx, gx - w, ux.s0 - 64 + 32 * gx, ux.L, lane); att2::pv_sub(tX, 32 * hf, pxx, ox, lx, lane); }
            if (ay) { att2::mask_band(pyy, gy - w, uy.s0 - 64 + 32 * gy, uy.L, lane); att2::pv_sub(tY, 32 * hf, pyy, oy, ly, lane); }
        }
        ++gs; PT_ADD(F, 1);
    }
    ud_load_q(F, dn, qx, qy);
    bf16* PB = (bf16*)(F.ws + WS_PART); float* PL = (float*)(F.ws + WS_PARTL);
    int lane_o = F.lane; asm volatile("" : "+v"(lane_o));
    att::u32x4 pa[4], pb[4]; float pl[4];
#define ATT3_LOAD_PART(side_) do { const BandU& u_ = (side_) ? uy : ux; const long t0_ = u_.sb + u_.cls + (long)(u_.s0 + 32 * w); \
        _Pragma("unroll") for (int i = 0; i < 4; ++i) { const int row = i * 8 + (lane_o >> 3), ch = lane_o & 7; const long tok = t0_ + row; \
            pa[i] = *(const att::u32x4*)(PB + ((size_t)tok) * 384 + 64 * h + ch * 8); pb[i] = *(const att::u32x4*)(PB + ((size_t)MTOK + tok) * 384 + 64 * h + ch * 8); \
            pl[i] = PL[(size_t)tok * 8 + h] + PL[((size_t)MTOK + tok) * 8 + h]; } } while (0)
    if (pat == 2) ATT3_LOAD_PART(0);
    PT_SUB(F, 2); ATT3_UNIT_END();
    att::lptr scr = (att::lptr)(F.lds + att2::L_RING + ((gs - 1) & (att2::NS - 1)) * att2::SLOT + w * 4096);
    __attribute__((address_space(3))) unsigned short* stg = (__attribute__((address_space(3))) unsigned short*)scr;
    __attribute__((address_space(3))) float* ls = (__attribute__((address_space(3))) float*)(F.lds + att2::L_LS + w * 128);
#pragma unroll
    for (int side = 0; side < 2; ++side) {
        const BandU& u = side ? uy : ux;
        const long tok0 = u.sb + u.cls + (long)(u.s0 + 32 * w) * qs;
        att2::stage_rows(side ? oy : ox, side ? ly : lx, false, scr, ls, lane);
        if (pat < 2) {
#pragma unroll
            for (int i = 0; i < 4; ++i) { const int row = i * 8 + (lane_o >> 3), ch = lane_o & 7; const att::u32x4 v = *(__attribute__((address_space(3))) att::u32x4*)(stg + row * 64 + ch * 8);
                *(att::u32x4*)(PB + ((size_t)pat * MTOK + tok0 + (long)row * qs) * 384 + 64 * h + ch * 8) = v; }
            if (lane_o < 32) PL[((size_t)pat * MTOK + tok0 + (long)lane_o * qs) * 8 + h] = ls[lane_o];
        } else {
            att::u32x4 a4[4], b4[4]; float l4[4];
#pragma unroll
            for (int i = 0; i < 4; ++i) { a4[i] = pa[i]; b4[i] = pb[i]; l4[i] = pl[i]; }
            if (side == 0) ATT3_LOAD_PART(1);
#pragma unroll
            for (int i = 0; i < 4; ++i) { const int row = i * 8 + (lane_o >> 3), ch = lane_o & 7; const long tok = tok0 + row;
                const att::u32x4 v = *(__attribute__((address_space(3))) att::u32x4*)(stg + row * 64 + ch * 8);
                const att::u32x4 a = a4[i], b = b4[i];
                const float rl = __builtin_amdgcn_rcpf(ls[row] + l4[i]);
                att::u32x4 ov; float ss = 0.f;
#pragma unroll
                for (int e = 0; e < 4; ++e) { const float x0 = (bflo(v[e]) + bflo(a[e]) + bflo(b[e])) * rl, x1 = (bfhi(v[e]) + bfhi(a[e]) + bfhi(b[e])) * rl; ov[e] = att::cvtpk(x0, x1);
                    const float y0 = bflo(ov[e]), y1 = bfhi(ov[e]); ss += y0 * y0 + y1 * y1; }
                ss += __shfl_xor(ss, 1); ss += __shfl_xor(ss, 2); ss += __shfl_xor(ss, 4);
                *(att::u32x4*)((bf16*)F.out + (size_t)tok * DM + 64 * h + ch * 8) = ov;
                if (ch == 0) ((float*)(F.ws + WS_SSQA))[(size_t)tok * 16 + h] = ss; }
        }
    }
#undef ATT3_LOAD_PART
    PT_ADD(F, 2);
}
template <class ListFn> __device__ __forceinline__ void att3_run(Frame& F, const Args& A, const ListFn& unit_of) {
    PT_SUB(F, 3);
    int gs = 0, gi = 0, k, i;
    unit_of(0, k, i); UD d = make_ud(F, k, i);
    if (d.kind < 0) return;
    for (int s = 0; s < 3; ++s) { ud_issue(F, d, s, gi); ++gi; }
    att::bf16x8 qa[4], qb[4]; ud_load_q(F, d, qa, qb);
    for (int j = 0; d.kind >= 0; ++j) {
        PT_SUB(F, 4); unit_of(j + 1, k, i); UD dn = make_ud(F, k, i); PT_ADD(F, 4); PT_SUB(F, 5);
        const int kslot_ = d.kind; PTK_SUB(F, kslot_);
        if (d.kind <= 2) att3_body_A(F, d, dn, gs, gi, qa, qb); else if (d.kind == 3) att3_body_B(F, A, d, dn, gs, gi, qa, qb); else att3_body_M(F, d, dn, gs, gi, qa, qb);
        PTK_ADD(F, kslot_);
        d = dn;
    }
    ATT2_WAITBAR(0);
    PT_ADD(F, 3);
}
__device__ __forceinline__ void att2_phase_a(Frame& F, const Args& A) {
    const int NU = 2 * N2_A + N2_B, G = F.G;
    const bool blk = (G == 256); const int per = NU / 8, xcd = blockIdx.x & 7, ci = blockIdx.x >> 3, bx = blockIdx.x;
    for (int idx = F.tid; idx < 6 * 465; idx += NWAVES * 64) { const int hh = idx / 465, r = idx - hh * 465, dr = r / 31, dl = r - dr * 31;
        ((__attribute__((address_space(3))) float*)(F.lds + att2::L_TBL + hh * att2::TBLB))[dr * 64 + 16 + dl] = A.in[10][idx] * LOG2E; }
    __syncthreads();
    att3_run(F, A, [=](int j, int& kind, int& idx) {
        if (blk) {
            const bool big = ci < 24; const int nb = big ? 2 : 3, na = big ? 5 : 3, b0 = big ? 2 * ci : 48 + 3 * (ci - 24), a0 = big ? 5 * ci : 120 + 3 * (ci - 24);
            int kb = -1, ka = -1;
            if (big) { if (j == 2) kb = 0; else if (j == 5) kb = 1; else ka = j - (j > 2) - (j > 5); }
            else { if (j & 1) kb = j >> 1; else ka = j >> 1; }
            if (j >= nb + na) { kind = -1; idx = 0; }
            else if (kb >= 0) { kind = 3; idx = 72 * xcd + b0 + kb; }
            else { const int a = a0 + ka; kind = a & 1; idx = 72 * xcd + (a >> 1); }
            return; }
        const int jj = bx + G * j; const bool ok = jj < NU;
        const int u = jj, i = u / 3, k = u - 3 * i;
        kind = !ok ? -1 : (k == 0 ? 0 : (k == 1 ? 1 : 3)); idx = i; });
}
__device__ __forceinline__ void att2_phase_b(Frame& F, const Args& A) {
    const int NU = N2_A + N2_M, G = F.G;
    const bool blk = (G == 256); const int per = NU / 8, xcd = blockIdx.x & 7, ci = blockIdx.x >> 3, bx = blockIdx.x;
    att3_run(F, A, [=](int j, int& kind, int& idx) {
        if (blk) {
            if (ci < 8) { if (j < 3) { kind = 2; idx = 72 * xcd + 3 * ci + j; } else { kind = -1; idx = 0; } }
            else { const int c2 = ci - 8; if (j >= 4) { kind = -1; idx = 0; } else if (j & 1) { kind = 4; idx = 48 * xcd + 2 * c2 + (j >> 1); } else { kind = 2; idx = 72 * xcd + 24 + 2 * c2 + (j >> 1); } }
            return; }
        const int jj = bx + G * j; const bool ok = jj < NU;
        const int u = jj, gq = u / 5, k = u - 5 * gq;
        kind = !ok ? -1 : (k < 3 ? 2 : 4); idx = k < 3 ? 3 * gq + k : 2 * gq + (k - 3); });
}
__device__ __forceinline__ void team_barrier(unsigned* tw, unsigned target) {
    asm volatile("s_waitcnt vmcnt(0)" ::: "memory");
    __syncthreads();
    if (threadIdx.x == 0) {
        const unsigned a = xb_ld(tw + 8), b = xb_ld(tw + 9), c2 = xb_ld(tw + 10), d = xb_ld(tw + 11);
        if (!(a != 0u && a == b && a == c2 && a == d)) { __builtin_amdgcn_fence(__ATOMIC_RELEASE, "agent"); asm volatile("s_waitcnt vmcnt(0)" ::: "memory"); }
        (void)xb_add(tw, 1u);
        unsigned sp = 0u; while (xb_ld(tw) < target) { __builtin_amdgcn_s_sleep(2); if (++sp > (1u << 22)) break; }
        __builtin_amdgcn_fence(__ATOMIC_ACQUIRE, "agent"); asm volatile("s_waitcnt vmcnt(0)" ::: "memory");
    }
    __syncthreads();
}
__device__ __forceinline__ void stagger_delay(unsigned ticks) {
    const unsigned long long t0 = __builtin_amdgcn_s_memrealtime(); while (__builtin_amdgcn_s_memrealtime() - t0 < (unsigned long long)ticks) __builtin_amdgcn_s_sleep(8);
}
__global__ void __launch_bounds__(NWAVES * 64, 2) skel_fwd(Args args) {
    extern __shared__ __attribute__((aligned(16))) unsigned char lds[];
    cg::grid_group grid = cg::this_grid();
    Frame F;
    F.lds = (LAS unsigned char*)lds;
    F.tid = threadIdx.x; F.lane = F.tid & 63; F.wave = __builtin_amdgcn_readfirstlane(F.tid >> 6);
    F.G = gridDim.x; { const int bx = blockIdx.x; F.vcu = (F.G % 8 == 0) ? (bx % 8) * (F.G / 8) + bx / 8 : bx; }
    F.out = args.out; F.ws = args.ws; F.tm = -1;
    unsigned char* ws = args.ws;
    const int lo = args.ph_lo, hi = args.ph_hi & 255; if (args.ph_hi >> 8) F.tm = 63;
    volatile LAS unsigned* bst = (volatile LAS unsigned*)(F.lds + LDS_MISC);
    if (F.tid < 2) bst[F.tid] = 0u;
    if (F.tid >= 8 && F.tid < 24) ((volatile LAS unsigned*)(F.lds + LDS_MISC))[F.tid] = 0u;
    __syncthreads();
    XcdBarrier bar = xcd_barrier_post((unsigned*)(ws + WS_CTL) + CW_BAR, bst);
    if (F.tid == 0 && F.G == 256) __hip_atomic_store((unsigned*)(ws + WS_CTL) + CW_TEAM + 64 * (8 * ((int)blockIdx.x & 7) + (((int)blockIdx.x >> 3) & 7)) + 8 + ((int)blockIdx.x >> 6), bar.x + 1u, __ATOMIC_RELAXED, __HIP_MEMORY_SCOPE_AGENT);
    if (lo < 0) grid.sync();
#define IN(k) (lo <= (k) && (k) < hi)
#define BOTH(k) (IN(k) && IN((k) + 1))
#define GRID_BAR() xcd_barrier(bar)
#if PROBE_T == 3
#define PT_STAMP(k) do { if (F.tid == 0 && blockIdx.x == 0) PT_SLOTS_L(F.lds)[k] = (long long)__builtin_amdgcn_s_memrealtime(); } while (0)
#else
#define PT_STAMP(k) do {} while (0)
#endif
#if PROBE_T
#define PT_PHASE(k) do { if (F.tid == 0) PT_ON_L(F.lds) = ((k) == PROBE_PHASE) ? 1u : 0u; } while (0)
#else
#define PT_PHASE(k) do {} while (0)
#endif

    PT_STAMP(0);
    const bool spec = SPEC_ROLES && (F.G == 256);
    if (IN(0)) { PT_PHASE(0); p0_prologue(F, args, spec); PT_PHASE(-1); if (BOTH(0)) GRID_BAR(); }
    PT_STAMP(1);

    if (IN(1)) {
        PT_PHASE(1);
        {
            pg8::Gemm g{(const pg8::bf16_t*)XN_BASE(F.out), (const pg8::bf16_t*)(ws + WS_WIN), MTOK, NQKV, DM}; pg8::SpecOrder S; S.init(MTOK, NQKV, F.G, (int)blockIdx.x, spec, (unsigned*)(ws + WS_CTL) + CW_READY);
            if (spec && S.j < pg8::NCV && !(args.ph_hi >> 8)) p1_convert(F, args, S.x, S.j);
            pg8::EpiQKV E{(pg8::bf16_t*)(ws + WS_QKV), args.in[6], args.in[7], args.in[8], args.in[9], args.in[13], (const float*)(ws + WS_ROPE), (const float*)(ws + WS_ROPE) + TP * 8};
            pg8::gemm_phase<pg8::EpiQKV, pg8::SpecOrder, true, true>(F.lds, g, S, E);
        }
        {
            pg8::Gemm g{(const pg8::bf16_t*)(ws + WS_XNMEM), (const pg8::bf16_t*)(ws + WS_WMEM), MMEM, 512, DM};
            const int bx = (int)blockIdx.x, mi = (F.G == 256) ? (((bx >> 3) - 30) * 8 + (bx & 7)) : F.G - 1 - bx;
            pg8::ListOrder S{2, 10, (mi < 0 || mi >= 10) ? 10 : mi, (F.G == 256) ? 16 : F.G};
            pg8::EpiMemKV E{(pg8::bf16_t*)(ws + WS_MK), (pg8::bf16_t*)(ws + WS_MV), args.in[14]};
            pg8::gemm_phase<pg8::EpiMemKV, pg8::ListOrder, true, true>(F.lds, g, S, E);
            __syncthreads();
        }
        PT_PHASE(-1);
        if (BOTH(1)) GRID_BAR();
    }
    PT_STAMP(2);

    if (IN(2)) {
        PT_PHASE(2); att2_phase_a(F, args); PT_PHASE(-1); if (BOTH(2)) GRID_BAR(); }
    PT_STAMP(3);
    if (IN(3)) { PT_PHASE(3); att2_phase_b(F, args); PT_PHASE(-1); if (BOTH(3)) GRID_BAR(); }
    PT_STAMP(4);

    const bool teams = TEAM_SYNC && (F.G == 256);
#define TCNT ((unsigned*)(args.ws + WS_CTL) + CW_TEAM + 64 * (8 * ((int)blockIdx.x & 7) + (((int)blockIdx.x >> 3) & 7)))
    if (IN(4)) {
        if (teams && STAG_TICKS > 0 && ((blockIdx.x >> 3) & 1)) stagger_delay(STAG_TICKS);
        pg8::Gemm g{(const pg8::bf16_t*)F.out, (const pg8::bf16_t*)(ws + WS_WOUT), MTOK, DM, DM};   pg8::StaticOrder S; S.init(MTOK, DM, F.G, (int)blockIdx.x);
        pg8::EpiX1 E{(const pg8::bf16_t*)XN_BASE(F.out), (const float*)(ws + WS_IRSTD), args.in[4], (pg8::bf16_t*)(ws + WS_X1B), (float*)(ws + WS_SSQF), (const float*)(ws + WS_SSQA)};
        PT_PHASE(4); pg8::gemm_phase<pg8::EpiX1, pg8::StaticOrder, true, true>(F.lds, g, S, E); PT_PHASE(-1);
        if (BOTH(4)) { if (teams) { team_barrier(TCNT, 4u); if (F.tid == 0) (void)xb_add((unsigned*)(ws + WS_CTL) + CW_P4DONE, 1u); } else GRID_BAR(); }
    }
    PT_STAMP(5);

    if (IN(5)) {
        pg8::Gemm g{(const pg8::bf16_t*)(ws + WS_X1B), (const pg8::bf16_t*)(ws + WS_W1), MTOK, FF, DM}; pg8::StaticOrder S; S.init(MTOK, FF, F.G, (int)blockIdx.x);
        pg8::EpiH E{(pg8::bf16_t*)(ws + WS_H), (const float*)(ws + WS_SSQF), args.ph_hi >> 8};
        PT_PHASE(5); pg8::gemm_phase<pg8::EpiH, pg8::StaticOrder, true, true>(F.lds, g, S, E); PT_PHASE(-1);
        if (BOTH(5)) { if (teams) team_barrier(TCNT, 8u); else GRID_BAR(); }
    }
    PT_STAMP(6);

    if (IN(6)) {
        if (teams && IN(4)) {
            if (F.tid == 0) { unsigned sp = 0u; while (xb_ld((unsigned*)(ws + WS_CTL) + CW_P4DONE) < (unsigned)F.G) { __builtin_amdgcn_s_sleep(2); if (++sp > (1u << 22)) break; } }
            __syncthreads();
        }
        pg8::Gemm g{(const pg8::bf16_t*)(ws + WS_H), (const pg8::bf16_t*)(ws + WS_W2), MTOK, DM, FF}; pg8::StaticOrder S; S.init(MTOK, DM, F.G, (int)blockIdx.x);
        pg8::EpiOut E{F.out, (const pg8::bf16_t*)(ws + WS_X1B)};
        PT_PHASE(6); pg8::gemm_phase<pg8::EpiOut, pg8::StaticOrder, true, true>(F.lds, g, S, E); PT_PHASE(-1);
    }
#if PROBE_T == 3
    PT_STAMP(7);
    __syncthreads();
    if (blockIdx.x == 0 && F.tid == 0) { F.out[0] = (float)(PT_SLOTS_L(F.lds)[PROBE_I + 1] - PT_SLOTS_L(F.lds)[PROBE_I]) * 0.01f; F.out[1] = 0.f; }
#elif PROBE_T
    __syncthreads();
    if (blockIdx.x == 0 && F.tid == 0) { F.out[0] = (float)(PT_SLOTS_L(F.lds)[PROBE_I] >> 15) * 16.384f; F.out[1] = (float)PT_SLOTS_L(F.lds)[PROBE_J] * (1.0f / 2000.0f); }
#endif
#undef TCNT
#undef IN
#undef BOTH
}

extern "C" void kernel_launch(void* const* d_in, const int* in_sizes, int n_in, void* d_out, int out_size, void* d_ws, size_t ws_size, hipStream_t stream) {
    static int grid = 0;
    if (grid == 0) {
        if (n_in != 22 || in_sizes[0] != TP * DM || in_sizes[1] != NBS * TS * DM || out_size != MTOK * DM || ws_size < WS_END) {
            fprintf(stderr, "kernel_launch: unexpected shapes / workspace (n_in %d, in0 %d, out %d, ws %zu); nothing launched\n", n_in, n_in > 0 ? in_sizes[0] : -1, out_size, ws_size); grid = -1; return; }
        int dev = 0, cus = 0, per_cu = 0;
        if (hipGetDevice(&dev) != hipSuccess || hipDeviceGetAttribute(&cus, hipDeviceAttributeMultiprocessorCount, dev) != hipSuccess) { grid = -1; return; }
        if (hipFuncSetAttribute((const void*)skel_fwd, hipFuncAttributeMaxDynamicSharedMemorySize, LDS_BYTES) != hipSuccess) { fprintf(stderr, "kernel_launch: hipFuncSetAttribute failed\n"); grid = -1; return; }
        if (hipOccupancyMaxActiveBlocksPerMultiprocessor(&per_cu, (const void*)skel_fwd, NWAVES * 64, LDS_BYTES) != hipSuccess || per_cu < 1) { fprintf(stderr, "kernel_launch: occupancy query says %d\n", per_cu); (void)hipGetLastError(); grid = -1; return; }
        grid = cus * per_cu;
    }
    if (grid < 0) return;
    if (hipMemsetAsync((char*)d_ws + WS_CTL, 0, CTL_ZERO_BYTES, stream) != hipSuccess) return;
    Args a{};
    for (int i = 0; i < 22; ++i) a.in[i] = (const float*)d_in[i];
    a.out = (float*)d_out; a.ws = (unsigned char*)d_ws;
    int nlaunch = 0;
    auto launch = [&](int lo, int hi) {
        if (nlaunch++ > 0) (void)hipMemsetAsync((char*)d_ws + WS_CTL, 0, CTL_ZERO_BYTES, stream);
        a.ph_lo = lo; a.ph_hi = hi; void* kargs[] = {&a};
        hipError_t e = hipLaunchCooperativeKernel((const void*)skel_fwd, dim3(grid), dim3(NWAVES * 64), kargs, LDS_BYTES, stream);
        if (e != hipSuccess) fprintf(stderr, "kernel_launch: cooperative launch failed: %s (grid %d)\n", hipGetErrorString(e), grid);
    };
#if PROBE_SEQ == 0
    launch(0, NPH);
#elif PROBE_SEQ == 1
    launch(0, NPH); launch(0, 1);
#elif PROBE_SEQ == 2
    launch(0, NPH); launch(1, 2);
#elif PROBE_SEQ == 3
    launch(0, 4); (void)hipMemsetAsync((char*)d_ws + WS_SSQA, 0, (size_t)MTOK * 16, stream); launch(2, 4); launch(4, NPH);
#elif PROBE_SEQ == 4
    launch(0, 5); (void)hipMemsetAsync((char*)d_ws + WS_SSQF, 0, (size_t)MTOK * 4, stream); launch(4, 5); launch(5, NPH);
#elif PROBE_SEQ == 5
    launch(0, NPH); launch(5, 6);
#elif PROBE_SEQ == 7
    launch(0, NPH); launch(2, 3);
#elif PROBE_SEQ == 8
    launch(0, NPH); launch(2, 3 | 256);
#elif PROBE_SEQ == 9
    launch(0, NPH); launch(3, 4);
#elif PROBE_SEQ == 10
    launch(0, NPH); launch(3, 4 | 256);
#elif PROBE_SEQ == 11
    launch(0, NPH); launch(5, 6 | 256);
#elif PROBE_SEQ == 12
    launch(0, NPH); launch(5, 6 | 512);
#elif PROBE_SEQ == 13
    launch(0, NPH); launch(0, 1 | 256);
#elif PROBE_SEQ == 18
    launch(0, 2); launch(0, NPH);
#elif PROBE_SEQ == 19
    launch(0, 4); launch(0, NPH);
#elif PROBE_SEQ == 20
    launch(0, 1); launch(0, NPH);
#elif PROBE_SEQ == 21
    launch(0, 3); launch(0, NPH);
#elif PROBE_SEQ == 22
    launch(0, 3 | 256); launch(0, NPH);
#elif PROBE_SEQ == 23
    launch(0, 4 | 256); launch(0, NPH);
#elif PROBE_SEQ == 15
    launch(0, NPH); launch(6, 7);
#elif PROBE_SEQ == 14
    launch(0, NPH); launch(1, 2 | 256);
#elif PROBE_SEQ == 6
    launch(0, 3); (void)hipMemsetAsync((char*)d_ws + WS_SSQA, 0, (size_t)MTOK * 16, stream); launch(2, 3); launch(3, NPH);
#endif
}
```
